# Optimizing an MI355X kernel written in HIP

```python
import math
import jax
import jax.numpy as jnp
from jax import lax
import numpy as np

D_MODEL = 1024
BATCH = 4
SEQ = 8192
DEPTH = 1

CHUNK = 64
N_BACK = 8
BAND = (N_BACK + 1) * CHUNK
N_HEADS = 8
HEAD_DIM = 64
ATTN_WIDTH = N_HEADS * HEAD_DIM
REL_CLIP = 256
SG_BLOCK = 128
SG_GROUPS = 4
SG_WIDTH = 512
SG_GROUP_DIM = SG_WIDTH // SG_GROUPS
IN_WIDTH = 3 * ATTN_WIDTH + 2 * SG_WIDTH + 2 * D_MODEL
N_EXPERTS = 32
TOP_K = 4
D_FF = D_MODEL
SWIGLU_LIMIT = 7.0
SWIGLU_ALPHA = 1.702
MOE_BLOCK = 128
EPS = 1e-6

kernel_name = "chunked_attn_gmlp_gated_moe_block"


def rms_norm(x, g):
    xf = x.astype(jnp.float32)
    y = xf * lax.rsqrt(jnp.mean(xf * xf, axis=-1, keepdims=True) + EPS)
    return (y * g.astype(jnp.float32)).astype(x.dtype)


def layer_norm(x, g, b):
    xf = x.astype(jnp.float32)
    mu = jnp.mean(xf, axis=-1, keepdims=True)
    xc = xf - mu
    y = xc * lax.rsqrt(jnp.mean(xc * xc, axis=-1, keepdims=True) + EPS)
    return (y * g.astype(jnp.float32) + b.astype(jnp.float32)).astype(x.dtype)


def rel_index():
    qi = np.arange(CHUNK)[:, None] + N_BACK * CHUNK
    kk = np.arange(BAND)[None, :]
    return np.clip(qi - kk, -REL_CLIP, REL_CLIP) + REL_CLIP


def chunked_attention(q, k, v, rel_bias):
    B, S, H, Dh = q.shape
    n_chunks = S // CHUNK
    pad = N_BACK * CHUNK
    kp = jnp.pad(k, ((0, 0), (pad, 0), (0, 0), (0, 0)))
    vp = jnp.pad(v, ((0, 0), (pad, 0), (0, 0), (0, 0)))
    bias = rel_bias.astype(jnp.float32)[:, rel_index()]
    kk = jnp.arange(BAND)
    scale = 1.0 / math.sqrt(Dh)

    def one_chunk(n):
        qs = lax.dynamic_slice_in_dim(q, n * CHUNK, CHUNK, axis=1)
        ks = lax.dynamic_slice_in_dim(kp, n * CHUNK, BAND, axis=1)
        vs = lax.dynamic_slice_in_dim(vp, n * CHUNK, BAND, axis=1)
        s = jnp.einsum('bqhd,bkhd->bhqk', qs, ks).astype(jnp.float32) * scale + bias
        valid = kk >= (N_BACK - n) * CHUNK
        s = jnp.where(valid, s, -1e30)
        p = jax.nn.softmax(s, axis=-1).astype(v.dtype)
        return jnp.einsum('bhqk,bkhd->bqhd', p, vs)

    out = lax.map(one_chunk, jnp.arange(n_chunks))
    return out.transpose(1, 0, 2, 3, 4).reshape(B, S, H * Dh)


def spatial_gating(u, v, ln_g, ln_b, w_s, b_s):
    B, S, _ = u.shape
    vg = v.reshape(B, S // SG_BLOCK, SG_BLOCK, SG_GROUPS, SG_GROUP_DIM)
    vn = layer_norm(vg, ln_g.reshape(SG_GROUPS, SG_GROUP_DIM), ln_b.reshape(SG_GROUPS, SG_GROUP_DIM))
    mask = jnp.tril(jnp.ones((SG_BLOCK, SG_BLOCK), w_s.dtype))
    mixed = jnp.einsum('gts,bnsgc->bntgc', w_s * mask, vn) + b_s.T[:, :, None]
    return u * mixed.reshape(B, S, SG_WIDTH)


def clamped_swiglu(gu):
    gate, up = jnp.split(gu, 2, axis=-1)
    gate = jnp.minimum(gate, SWIGLU_LIMIT)
    up = jnp.clip(up, -SWIGLU_LIMIT, SWIGLU_LIMIT)
    return (up + 1.0) * (gate * jax.nn.sigmoid(gate * SWIGLU_ALPHA))


def moe(h, router_w, router_b, w_gate_up, b_gate_up, w_down, b_down):
    T, D = h.shape
    logits = (h @ router_w + router_b).astype(jnp.float32)
    top_v, top_i = lax.top_k(logits, TOP_K)
    probs = jax.nn.softmax(top_v, axis=-1)
    n_assign = T * TOP_K
    e_flat = top_i.reshape(n_assign)
    tok_flat = jnp.arange(n_assign, dtype=jnp.int32) // TOP_K
    order = jnp.argsort(e_flat)
    e_sorted = e_flat[order]
    tok_sorted = tok_flat[order]
    w_sorted = probs.reshape(n_assign)[order]
    counts = jnp.zeros((N_EXPERTS,), jnp.int32).at[e_flat].add(1)
    starts = jnp.cumsum(counts) - counts
    padded = (counts + MOE_BLOCK - 1) // MOE_BLOCK * MOE_BLOCK
    pends = jnp.cumsum(padded)
    pstarts = pends - padded
    rank = jnp.arange(n_assign, dtype=jnp.int32) - starts[e_sorted]
    dest = pstarts[e_sorted] + rank
    n_slots = n_assign + N_EXPERTS * MOE_BLOCK
    n_blocks = n_slots // MOE_BLOCK
    slot_tok = jnp.full((n_slots,), T, jnp.int32).at[dest].set(tok_sorted)
    h_pad = jnp.concatenate([h, jnp.zeros((1, D), h.dtype)], axis=0)
    x_slots = h_pad[slot_tok].reshape(n_blocks, MOE_BLOCK, D)
    blk_start = jnp.arange(n_blocks, dtype=jnp.int32) * MOE_BLOCK
    blk_expert = jnp.minimum(jnp.searchsorted(pends, blk_start, side='right'), N_EXPERTS - 1)

    def expert_block(args):
        xb, e = args
        gu = xb @ w_gate_up[e] + b_gate_up[e]
        return clamped_swiglu(gu) @ w_down[e] + b_down[e]

    y_slots = lax.map(expert_block, (x_slots, blk_expert)).reshape(n_slots, D)
    y_assign = y_slots[dest] * w_sorted[:, None].astype(h.dtype)
    return jnp.zeros((T, D), h.dtype).at[tok_sorted].add(y_assign)


def setup_inputs(seed: int = 0) -> dict:
    key = jax.random.key(seed)
    ks = jax.random.split(key, 24)
    f32 = jnp.float32

    def nrm(k, shape, scale):
        return jax.random.normal(k, shape, f32) * scale

    return {
        "x": nrm(ks[0], (BATCH, SEQ, D_MODEL), 1.0),
        "norm1_g": 1.0 + nrm(ks[1], (DEPTH, D_MODEL), 0.02),
        "w_in": nrm(ks[2], (DEPTH, D_MODEL, IN_WIDTH), D_MODEL ** -0.5),
        "q_norm_g": 1.0 + nrm(ks[3], (DEPTH, HEAD_DIM), 0.02),
        "k_norm_g": 1.0 + nrm(ks[4], (DEPTH, HEAD_DIM), 0.02),
        "rel_bias": nrm(ks[5], (DEPTH, N_HEADS, 2 * REL_CLIP + 1), 0.5),
        "sg_ln_g": 1.0 + nrm(ks[6], (DEPTH, SG_WIDTH), 0.02),
        "sg_ln_b": nrm(ks[7], (DEPTH, SG_WIDTH), 0.02),
        "sg_w": nrm(ks[8], (DEPTH, SG_GROUPS, SG_BLOCK, SG_BLOCK), SG_BLOCK ** -0.5),
        "sg_b": 1.0 + nrm(ks[9], (DEPTH, SG_GROUPS, SG_BLOCK), 0.02),
        "w_branch_a": nrm(ks[10], (DEPTH, ATTN_WIDTH, D_MODEL), ATTN_WIDTH ** -0.5),
        "w_branch_b": nrm(ks[11], (DEPTH, SG_WIDTH, D_MODEL), SG_WIDTH ** -0.5),
        "w_out": nrm(ks[12], (DEPTH, D_MODEL, D_MODEL), D_MODEL ** -0.5),
        "norm2_g": 1.0 + nrm(ks[13], (DEPTH, D_MODEL), 0.02),
        "router_w": nrm(ks[14], (DEPTH, D_MODEL, N_EXPERTS), D_MODEL ** -0.5),
        "router_b": nrm(ks[15], (DEPTH, N_EXPERTS), 0.01),
        "w_gate_up": nrm(ks[16], (DEPTH, N_EXPERTS, D_MODEL, 2 * D_FF), D_MODEL ** -0.5),
        "b_gate_up": nrm(ks[17], (DEPTH, N_EXPERTS, 2 * D_FF), 0.01),
        "w_down": nrm(ks[18], (DEPTH, N_EXPERTS, D_FF, D_MODEL), D_FF ** -0.5),
        "b_down": nrm(ks[19], (DEPTH, N_EXPERTS, D_MODEL), 0.01),
    }


def reference(x, norm1_g, w_in, q_norm_g, k_norm_g, rel_bias, sg_ln_g, sg_ln_b, sg_w, sg_b,
              w_branch_a, w_branch_b, w_out, norm2_g, router_w, router_b,
              w_gate_up, b_gate_up, w_down, b_down):
    B, S, D = x.shape
    cuts = np.cumsum([ATTN_WIDTH, ATTN_WIDTH, ATTN_WIDTH, SG_WIDTH, SG_WIDTH, D_MODEL]).tolist()
    for l in range(DEPTH):
        h = rms_norm(x, norm1_g[l])
        proj = jnp.einsum('bsd,de->bse', h, w_in[l])
        q, k, v, u_sg, v_sg, g_a, g_b = jnp.split(proj, cuts, axis=-1)
        q = rms_norm(q.reshape(B, S, N_HEADS, HEAD_DIM), q_norm_g[l])
        k = rms_norm(k.reshape(B, S, N_HEADS, HEAD_DIM), k_norm_g[l])
        v = v.reshape(B, S, N_HEADS, HEAD_DIM)
        y_attn = chunked_attention(q, k, v, rel_bias[l])
        y_sg = spatial_gating(jax.nn.gelu(u_sg), jax.nn.gelu(v_sg),
                              sg_ln_g[l], sg_ln_b[l], sg_w[l], sg_b[l])
        merged = (jax.nn.sigmoid(g_a) * (y_attn @ w_branch_a[l])
                  + jax.nn.sigmoid(g_b) * (y_sg @ w_branch_b[l]))
        x = x + merged @ w_out[l]
        h2 = rms_norm(x, norm2_g[l]).reshape(B * S, D)
        x = x + moe(h2, router_w[l], router_b[l], w_gate_up[l], b_gate_up[l],
                    w_down[l], b_down[l]).reshape(B, S, D)
    return x
```

```cpp
#include <hip/hip_runtime.h>
#include <cstdio>
#include <cstdint>

#ifndef MK_N_LAUNCHES
#define MK_N_LAUNCHES 1
#endif

#ifndef REP_PHASE
#define REP_PHASE -1
#endif
#define LAS __attribute__((address_space(3)))
#define GAS __attribute__((address_space(1)))
typedef unsigned short bf16;
typedef short bf16x8 __attribute__((ext_vector_type(8)));
typedef short s16x4 __attribute__((ext_vector_type(4)));
typedef float f32x2 __attribute__((ext_vector_type(2)));
typedef float f32x4 __attribute__((ext_vector_type(4)));
typedef float f32x16 __attribute__((ext_vector_type(16)));
typedef unsigned u32x2 __attribute__((ext_vector_type(2)));
typedef unsigned u32x4 __attribute__((ext_vector_type(4)));
typedef GAS unsigned gu32;

constexpr int NB = 4, SEQ = 8192, T = NB * SEQ, D = 1024, AW = 512, SGW = 512, INW = 4608, NE = 32, FF = 1024;
constexpr int NHEAD = 8, HD = 64, CHUNK = 64, NBACK = 8, NREL = 513;
constexpr int LCAP = 32768;
constexpr float LOG2E = 1.4426950408889634f;
constexpr float EPS = 1e-6f;

constexpr size_t MiB = 1u << 20;
constexpr size_t WS_CTL = 0, CTL_ZERO_BYTES = 1 * MiB;
constexpr size_t WS_WIN = 7 * MiB;
constexpr size_t WS_WAB = 11 * MiB;
constexpr size_t WS_WO = 13 * MiB;
constexpr size_t WS_WR = 15 * MiB;
constexpr size_t WS_WM = 15 * MiB + 256 * 1024;
constexpr size_t WS_WIN8 = 2 * MiB;
constexpr size_t WS_HS = 15 * MiB + 512 * 1024;
constexpr size_t WS_CS = 15 * MiB + 768 * 1024;
constexpr size_t WS_H8 = 976 * MiB;
constexpr size_t WS_LID = 16 * MiB;
constexpr size_t WS_LRS = 20 * MiB;
constexpr size_t WS_LP = 24 * MiB;
constexpr size_t WS_WGU = 28 * MiB;
constexpr size_t WS_WD = 156 * MiB;
constexpr size_t WS_H = 220 * MiB;
constexpr size_t WS_Q = 284 * MiB, WS_K = 316 * MiB, WS_V = 348 * MiB;
constexpr size_t WS_UG = 380 * MiB, WS_VG = 412 * MiB;
constexpr size_t WS_GA = 444 * MiB, WS_GB = 508 * MiB;
constexpr size_t WS_YCAT = 572 * MiB;
constexpr size_t WS_X1B = 636 * MiB;
constexpr size_t WS_ACT = 700 * MiB;
constexpr size_t WS_X1H = 380 * MiB;
constexpr size_t WS_Y = 220 * MiB;
constexpr size_t WS_END = 1008 * MiB;
constexpr int CW_TMO = 0, CW_CODE = 1;
constexpr int CW_CNT = 64;
constexpr int CW_BAR = 4096;
constexpr int CW_CMAX = 8192;
constexpr int CW_TILE = 32768;
constexpr int CW_CCNT = 16384;

constexpr int RING_BYTES = 131072;
constexpr int LDSCTL_OFF = RING_BYTES, MISC_OFF = LDSCTL_OFF + 320;
constexpr int MOE_OFF = MISC_OFF + 128;
constexpr int PARK_OFF = LDSCTL_OFF + 1024;
constexpr int LDS_BYTES = 147456;

#define LDS_WAIT() asm volatile("s_waitcnt lgkmcnt(0)" ::: "memory")
#define VM_WAIT() asm volatile("s_waitcnt vmcnt(0)" ::: "memory")
#define RLX_AGENT __ATOMIC_RELAXED, __HIP_MEMORY_SCOPE_AGENT

__device__ __forceinline__ unsigned f2bf(float f) { unsigned u = __builtin_bit_cast(unsigned, f); return (u + 0x7fffu + ((u >> 16) & 1u)) >> 16; }
__device__ __forceinline__ unsigned pk2(float lo, float hi) { return f2bf(lo) | (f2bf(hi) << 16); }
__device__ __forceinline__ float bf2f(unsigned short b) { return __builtin_bit_cast(float, (unsigned)b << 16); }
__device__ __forceinline__ float bflo(unsigned w) { return __builtin_bit_cast(float, w << 16); }
__device__ __forceinline__ float bfhi(unsigned w) { return __builtin_bit_cast(float, w & 0xffff0000u); }
__device__ __forceinline__ unsigned cvt_pk_bf16(float lo, float hi) { unsigned r; asm volatile("v_cvt_pk_bf16_f32 %0, %1, %2" : "=v"(r) : "v"(lo), "v"(hi)); return r; }
__device__ __forceinline__ float fast_rcp(float x) { return __builtin_amdgcn_rcpf(x); }
__device__ __forceinline__ float fast_exp2(float x) { return __builtin_amdgcn_exp2f(x); }
__device__ __forceinline__ float sigmoidf_(float x) { return fast_rcp(1.0f + fast_exp2(-LOG2E * x)); }
__device__ __forceinline__ float gelu_tanh(float x) {
    const float t = x * ((-LOG2E * 1.5957691216057308f) + (-LOG2E * 1.5957691216057308f * 0.044715f) * (x * x));
    return x * fast_rcp(1.0f + fast_exp2(t));
}

namespace pg8 {
constexpr int BM = 256, BK = 64, HALF = 128, HTB = HALF * BK * 2, STAGE_BYTES = 8 * HTB, NXCD = 8, WGM = 8;
__host__ __device__ __forceinline__ int lds_byte(int r, int c) { const int st = (r >> 4) * 2 + (c >> 5), rr = r & 15, cc = c & 31, ob = rr * 64 + cc * 2; return st * 1024 + (ob ^ (((ob >> 9) & 1) << 5)); }
__host__ __device__ __forceinline__ void stage_rc(int b, int& R, int& C) { const int st = b / 1024, sb = b % 1024, swz = sb ^ (((sb >> 9) & 1) << 5); R = (st >> 1) * 16 + swz / 64; C = (st & 1) * 32 + (swz % 64) / 2; }
__host__ __device__ __forceinline__ int perm32(int rho) { const int n = rho >> 4, i = rho & 15; return 8 * (i >> 2) + 4 * n + (i & 3); }

typedef int v4i_t __attribute__((ext_vector_type(4)));
typedef int v8i_t __attribute__((ext_vector_type(8)));
__device__ __forceinline__ v8i_t cat8(bf16x8 lo, bf16x8 hi) { return __builtin_shufflevector(__builtin_bit_cast(v4i_t, lo), __builtin_bit_cast(v4i_t, hi), 0, 1, 2, 3, 4, 5, 6, 7); }
struct Unit { int pm, pn, e, s0, cnt, idx; };

struct StaticOrder {
    int nM, nN, nwg, G, c;
    __device__ void init(int M, int N, int G_, int c_) { nM = M / BM; nN = N / BM; nwg = nM * nN; G = G_; c = c_; }
    __device__ bool tile(int i, int& pm, int& pn) const {
        const long L = (long)i * G + c; if (L >= nwg) return false;
        int wgid = (int)L; { const int q = nwg / NXCD, r = nwg % NXCD, xcd = wgid % NXCD, off = wgid / NXCD; wgid = (xcd < r ? xcd * (q + 1) : r * (q + 1) + (xcd - r) * q) + off; }
        const int nig = WGM * nN, gid = wgid / nig, fm = gid * WGM, gsz = (nM - fm) < WGM ? (nM - fm) : WGM;
        pm = fm + ((wgid % nig) % gsz); pn = (wgid % nig) / gsz; return true;
    }
};

template <class P>
__device__ __forceinline__ void gemm_phase(LAS unsigned char* lds, const P& S) {
    const int tid = threadIdx.x, wid = __builtin_amdgcn_readfirstlane(tid >> 6), lane = tid & 63, wr = wid >> 2, wc = wid & 3, fr = lane & 15, fq = lane >> 4;
    constexpr int nt = P::NT;
    unsigned vA[2][2], voffB[2];
    LAS u32x4* park = (LAS u32x4*)(lds + PARK_OFF) + tid;
#pragma unroll
    for (int i = 0; i < 2; ++i) { int R, C; stage_rc(tid * 16 + i * 8192, R, C); const int Rb = (R & ~31) + perm32(R & 31);
        vA[0][i] = (unsigned)(R * P::LDA + C) * 2u; vA[1][i] = (unsigned)((R + HALF) * P::LDA + C) * 2u; voffB[i] = (unsigned)(Rb * P::LDB + C) * 2u; }
    const size_t kstep = (size_t)(BK * 2);
    const size_t hstepB = (size_t)HALF * P::LDB * 2;
    const unsigned ldsw = (unsigned)wid * 1024u;
    const int aoff = lds_byte(wr * 64 + fr, fq * 8), boff = lds_byte(wc * 32 + fr, fq * 8);
#define PG8_SA(b, h) (((b) * 2 + (h)) * HTB)
#define PG8_SB(b, h) ((4 + (b) * 2 + (h)) * HTB)
#define PG8_STAGE2X(bufoff, gbase, o0, o1, AUX) do { \
        __builtin_amdgcn_global_load_lds((const unsigned*)((const char*)(gbase) + (o0)), (LAS unsigned*)(lds + (bufoff) + ldsw), 16, 0, AUX); \
        __builtin_amdgcn_global_load_lds((const unsigned*)((const char*)(gbase) + (o1)), (LAS unsigned*)(lds + (bufoff) + ldsw + 8192), 16, 0, AUX); } while (0)
#define PG8_STAGE2(bufoff, gbase, o0, o1) PG8_STAGE2X(bufoff, gbase, o0, o1, P::A_AUX)
#define PG8_STAGEB(bufoff, gbase) PG8_STAGE2X(bufoff, gbase, voffB[0], voffB[1], 0)
#define PG8_LDA(dst, b, h) do { _Pragma("unroll") for (int m = 0; m < 4; ++m) _Pragma("unroll") for (int k = 0; k < 2; ++k) dst[m][k] = *(const LAS bf16x8*)(lds + PG8_SA(b, h) + aoff + m * 2048 + k * 1024); } while (0)
#define PG8_LDB(dst, b, h) do { _Pragma("unroll") for (int n = 0; n < 2; ++n) _Pragma("unroll") for (int k = 0; k < 2; ++k) dst[n][k] = *(const LAS bf16x8*)(lds + PG8_SB(b, h) + boff + n * 2048 + k * 1024); } while (0)
#define PG8_MMA(ai, bj, At, Bt) do { __builtin_amdgcn_s_setprio(1); _Pragma("unroll") for (int m = 0; m < 4; ++m) _Pragma("unroll") for (int n = 0; n < 2; ++n) { \
        if constexpr (P::I8) { _Pragma("unroll") for (int k = 0; k < 2; ++k) acc[ai][bj][m][n] = __builtin_bit_cast(f32x4, __builtin_amdgcn_mfma_i32_16x16x64_i8(__builtin_bit_cast(v4i_t, Bt[n][k]), __builtin_bit_cast(v4i_t, At[m][k]), __builtin_bit_cast(v4i_t, acc[ai][bj][m][n]), 0, 0, 0)); }     \
        else if constexpr (P::FP8) { acc[ai][bj][m][n] = __builtin_amdgcn_mfma_scale_f32_16x16x128_f8f6f4(cat8(Bt[n][0], Bt[n][1]), cat8(At[m][0], At[m][1]), acc[ai][bj][m][n], 0, 0, 0, 0, 0, 0); }     \
        else { _Pragma("unroll") for (int k = 0; k < 2; ++k) acc[ai][bj][m][n] = __builtin_amdgcn_mfma_f32_16x16x32_bf16(Bt[n][k], At[m][k], acc[ai][bj][m][n], 0, 0, 0); } } \
        __builtin_amdgcn_s_setprio(0); } while (0)
#define PG8_WAIT_V(n) asm volatile("s_waitcnt vmcnt(" #n ")" ::: "memory")
#define PG8_WAIT_L(n) asm volatile("s_waitcnt lgkmcnt(" #n ")" ::: "memory")
#define PG8_BAR __builtin_amdgcn_s_barrier()
#define PG8_SCHED __builtin_amdgcn_sched_barrier(0)
    Unit cur, nxt, prv; int ui = 0;
    if (!S.next(0, cur)) return;
    if constexpr (P::GATHER) S.a_off(cur, tid, vA);
    f32x4 acc[2][2][4][2];
#pragma unroll
    for (int a = 0; a < 2; ++a)
#pragma unroll
        for (int b = 0; b < 2; ++b)
#pragma unroll
            for (int m = 0; m < 4; ++m)
#pragma unroll
                for (int n = 0; n < 2; ++n) acc[a][b][m][n] = (f32x4){0.f, 0.f, 0.f, 0.f};
    bf16x8 At[4][2], B0[2][2], B1[2][2];
    const char* cA = S.a_ptr(cur); const char* cB = S.b_ptr(cur);
    PG8_STAGEB(PG8_SB(0, 0), cB); PG8_STAGEB(PG8_SB(0, 1), cB + hstepB); PG8_STAGE2(PG8_SA(0, 0), cA, vA[0][0], vA[0][1]); PG8_STAGE2(PG8_SA(0, 1), cA, vA[1][0], vA[1][1]);
    if (wr == 1) PG8_BAR;
    PG8_WAIT_V(2); PG8_BAR;
    PG8_STAGEB(PG8_SB(1, 0), cB + kstep); PG8_STAGE2(PG8_SA(1, 0), cA + kstep, vA[0][0], vA[0][1]); PG8_STAGEB(PG8_SB(1, 1), cB + hstepB + kstep);
    PG8_WAIT_V(6); PG8_BAR;
    for (;;) {
        const bool has_next = S.next(ui + 1, nxt);
        const char* nA = has_next ? S.a_ptr(nxt) : cA; const char* nB = has_next ? S.b_ptr(nxt) : cB;
        if constexpr (P::GATHER) {
            unsigned vn[2][2];
            if (has_next) S.a_off(nxt, tid, vn);
            else { vn[0][0] = vA[0][0]; vn[0][1] = vA[0][1]; vn[1][0] = vA[1][0]; vn[1][1] = vA[1][1]; }
            *park = (u32x4){vn[0][0], vn[0][1], vn[1][0], vn[1][1]};
        }
#pragma nounroll
        for (int t = 0; t < nt; t += 2) {
            const bool last = (t == nt - 2);
            asm volatile("" : "+v"(vA[0][0]), "+v"(vA[0][1]), "+v"(vA[1][0]), "+v"(vA[1][1]), "+v"(voffB[0]), "+v"(voffB[1]));
            const char* a1 = cA + (size_t)(t + 1) * kstep;
            const char* a2 = last ? nA : cA + (size_t)(t + 2) * kstep; const char* b2 = last ? nB : cB + (size_t)(t + 2) * kstep;
            const char* a3 = a2 + kstep; const char* b3 = b2 + kstep;
            PG8_LDB(B0, 0, 0); PG8_LDB(B1, 0, 1); PG8_SCHED; PG8_LDA(At, 0, 0); PG8_STAGE2(PG8_SA(1, 1), a1, vA[1][0], vA[1][1]);
            if constexpr (P::GATHER) { if (last) { const u32x4 nv = *park; vA[0][0] = nv.x; vA[0][1] = nv.y; vA[1][0] = nv.z; vA[1][1] = nv.w; } }
            PG8_WAIT_V(8); PG8_WAIT_L(0); PG8_BAR; PG8_MMA(0, 0, At, B0); PG8_MMA(0, 1, At, B1); PG8_BAR; PG8_SCHED;
            PG8_LDA(At, 0, 1); PG8_STAGEB(PG8_SB(0, 0), b2); PG8_STAGEB(PG8_SB(0, 1), b2 + hstepB); PG8_STAGE2(PG8_SA(0, 0), a2, vA[0][0], vA[0][1]);
            PG8_WAIT_V(8); PG8_WAIT_L(0); PG8_BAR; PG8_MMA(1, 0, At, B0); PG8_MMA(1, 1, At, B1); PG8_BAR; PG8_SCHED;
            PG8_LDB(B0, 1, 0); PG8_LDB(B1, 1, 1); PG8_SCHED; PG8_LDA(At, 1, 0); PG8_STAGE2(PG8_SA(0, 1), a2, vA[1][0], vA[1][1]);
            PG8_WAIT_V(8); PG8_WAIT_L(0); PG8_BAR; PG8_MMA(0, 0, At, B0); PG8_MMA(0, 1, At, B1); PG8_BAR; PG8_SCHED;
            PG8_LDA(At, 1, 1); PG8_STAGEB(PG8_SB(1, 0), b3); PG8_STAGEB(PG8_SB(1, 1), b3 + hstepB); PG8_STAGE2(PG8_SA(1, 0), a3, vA[0][0], vA[0][1]);
            PG8_WAIT_V(8); PG8_WAIT_L(0); PG8_BAR; PG8_MMA(1, 0, At, B0); PG8_MMA(1, 1, At, B1); PG8_BAR; PG8_SCHED;
        }
        if (wr == 0) PG8_BAR;
        int fr_ = fr, fq_ = fq; asm volatile("" : "+v"(fr_), "+v"(fq_));
        bool keep = false;
        if constexpr (P::SIGNAL) {
            typename P::Stash st;
            S.epi_compute(acc, cur, wr, wc, fr_, fq_, st);
            PG8_WAIT_V(0); PG8_BAR;
            if (tid == 0 && ui > 0) S.signal(prv);
            S.epi_store(cur, wr, wc, fr_, fq_, st);
            prv = cur;
        } else keep = S.epi(acc, cur, wr, wc, fr_, fq_);
        if (!has_next) break;
        if (!keep) {
#pragma unroll
            for (int a = 0; a < 2; ++a)
#pragma unroll
                for (int b = 0; b < 2; ++b)
#pragma unroll
                    for (int m = 0; m < 4; ++m)
#pragma unroll
                        for (int n = 0; n < 2; ++n) acc[a][b][m][n] = (f32x4){0.f, 0.f, 0.f, 0.f};
        }
        cur = nxt; cA = nA; cB = nB; ++ui;
        if (wr == 1) PG8_BAR;
    }
    PG8_WAIT_V(0);
    PG8_BAR;
    if constexpr (P::SIGNAL) { if (tid == 0) S.signal(cur); }
#undef PG8_SA
#undef PG8_SB
#undef PG8_STAGE2
#undef PG8_STAGE2X
#undef PG8_STAGEB
#undef PG8_LDA
#undef PG8_LDB
#undef PG8_MMA
#undef PG8_WAIT_V
#undef PG8_WAIT_L
#undef PG8_BAR
#undef PG8_SCHED
}
}
using pg8::Unit;

__device__ __forceinline__ void st8(bf16* p, const f32x4& a, const f32x4& b) {
    u32x4 w; w.x = cvt_pk_bf16(a[0], a[1]); w.y = cvt_pk_bf16(a[2], a[3]); w.z = cvt_pk_bf16(b[0], b[1]); w.w = cvt_pk_bf16(b[2], b[3]);
    *(u32x4*)p = w;
}
__device__ __forceinline__ void ld8(const bf16* p, f32x4& a, f32x4& b) {
    const u32x4 w = *(const u32x4*)p;
    a = (f32x4){bflo(w.x), bfhi(w.x), bflo(w.y), bfhi(w.y)}; b = (f32x4){bflo(w.z), bfhi(w.z), bflo(w.w), bfhi(w.w)};
}

__device__ __forceinline__ void st8q(unsigned char* p, const f32x4& a, const f32x4& b) {
    int w0 = 0, w1 = 0;
    w0 = __builtin_amdgcn_cvt_pk_fp8_f32(a[0], a[1], w0, false); w0 = __builtin_amdgcn_cvt_pk_fp8_f32(a[2], a[3], w0, true);
    w1 = __builtin_amdgcn_cvt_pk_fp8_f32(b[0], b[1], w1, false); w1 = __builtin_amdgcn_cvt_pk_fp8_f32(b[2], b[3], w1, true);
    *(u32x2*)p = (u32x2){(unsigned)w0, (unsigned)w1};
}
__device__ __forceinline__ u32x2 pack8q(const f32x4& a, const f32x4& b) {
    int w0 = 0, w1 = 0;
    w0 = __builtin_amdgcn_cvt_pk_fp8_f32(a[0], a[1], w0, false); w0 = __builtin_amdgcn_cvt_pk_fp8_f32(a[2], a[3], w0, true);
    w1 = __builtin_amdgcn_cvt_pk_fp8_f32(b[0], b[1], w1, false); w1 = __builtin_amdgcn_cvt_pk_fp8_f32(b[2], b[3], w1, true);
    return (u32x2){(unsigned)w0, (unsigned)w1};
}
constexpr float WQ_SCALE = 32.0f, WQ_INV = 1.0f / 32.0f;

struct PolIn {
    static constexpr int NT = 8, LDA = 512, LDB = 512; static constexpr bool GATHER = false, FP8 = false, I8 = true, SIGNAL = false; static constexpr int A_AUX = 0;
    pg8::StaticOrder so; const unsigned char* A; const unsigned char* Bt; unsigned char* ws; const float* qg; const float* kg; const float* hs; const float* cs;
    __device__ bool next(int i, Unit& u) const { u.e = 0; u.s0 = 0; u.cnt = 0; return so.tile(i, u.pm, u.pn); }
    __device__ const char* a_ptr(const Unit& u) const { return (const char*)(A + (size_t)u.pm * 256 * 1024); }
    __device__ const char* b_ptr(const Unit& u) const { return (const char*)(Bt + (size_t)u.pn * 256 * 1024); }
    __device__ void a_off(const Unit&, int, unsigned (&)[2][2]) const {}
    __device__ __forceinline__ bool epi(f32x4 (&acc)[2][2][4][2], const Unit& u, int wr, int wc, int fr, int fq) const {
        const int pn = u.pn;
        {
            const float* hsr = hs + u.pm * 256 + wr * 64 + fr;
            const float* csp = cs + pn * 256 + 64 * wc + 8 * fq;
            float hv[2][4]; f32x4 cv[2][2];
#pragma unroll
            for (int a = 0; a < 2; ++a)
#pragma unroll
                for (int m = 0; m < 4; ++m) hv[a][m] = hsr[a * 128 + m * 16];
#pragma unroll
            for (int b = 0; b < 2; ++b)
#pragma unroll
                for (int n = 0; n < 2; ++n) cv[b][n] = *(const f32x4*)(csp + 32 * b + 4 * n);
#pragma unroll
            for (int a = 0; a < 2; ++a)
#pragma unroll
                for (int b = 0; b < 2; ++b)
#pragma unroll
                    for (int m = 0; m < 4; ++m)
#pragma unroll
                        for (int n = 0; n < 2; ++n) { const pg8::v4i_t ia = __builtin_bit_cast(pg8::v4i_t, acc[a][b][m][n]);
                            acc[a][b][m][n] = (f32x4){(float)ia.x, (float)ia.y, (float)ia.z, (float)ia.w} * hv[a][m] * cv[b][n]; }
        }
        int kind, ld, tcol; size_t off;
        if (pn < 2) { kind = 0; off = WS_Q; ld = AW; tcol = pn; }
        else if (pn < 4) { kind = 1; off = WS_K; ld = AW; tcol = pn - 2; }
        else if (pn < 6) { kind = 2; off = WS_V; ld = AW; tcol = pn - 4; }
        else if (pn < 8) { kind = 3; off = WS_UG; ld = SGW; tcol = pn - 6; }
        else if (pn < 10) { kind = 3; off = WS_VG; ld = SGW; tcol = pn - 8; }
        else if (pn < 14) { kind = 4; off = WS_GA; ld = D; tcol = pn - 10; }
        else { kind = 4; off = WS_GB; ld = D; tcol = pn - 14; }
        bf16* base = (bf16*)(ws + off) + tcol * 256 + 64 * wc + 8 * fq;
        const int row0 = u.pm * 256 + wr * 64 + fr;
        if (kind <= 1) {
            const float* g = (kind == 0 ? qg : kg) + 8 * fq;
            const float sc = (kind == 0) ? (0.125f * LOG2E) : 1.0f;
            f32x4 gv[2][2];
#pragma unroll
            for (int bj = 0; bj < 2; ++bj)
#pragma unroll
                for (int n = 0; n < 2; ++n) gv[bj][n] = *(const f32x4*)(g + 32 * bj + 4 * n) * sc;
#pragma unroll
            for (int ai = 0; ai < 2; ++ai)
#pragma unroll
                for (int m = 0; m < 4; ++m) {
                    float ss = 0.f;
#pragma unroll
                    for (int bj = 0; bj < 2; ++bj)
#pragma unroll
                        for (int n = 0; n < 2; ++n) { const f32x4 v = acc[ai][bj][m][n]; ss += (v[0] * v[0] + v[1] * v[1]) + (v[2] * v[2] + v[3] * v[3]); }
                    ss += __shfl_xor(ss, 16); ss += __shfl_xor(ss, 32);
                    const float rs = 1.0f / sqrtf(ss * (1.0f / 64.0f) + EPS);
                    bf16* rowp = base + (size_t)(row0 + ai * 128 + m * 16) * ld;
#pragma unroll
                    for (int bj = 0; bj < 2; ++bj) st8(rowp + 32 * bj, acc[ai][bj][m][0] * rs * gv[bj][0], acc[ai][bj][m][1] * rs * gv[bj][1]);
                }
        } else if (kind == 2) {
#pragma unroll
            for (int ai = 0; ai < 2; ++ai)
#pragma unroll
                for (int m = 0; m < 4; ++m) { bf16* rowp = base + (size_t)(row0 + ai * 128 + m * 16) * ld;
#pragma unroll
                    for (int bj = 0; bj < 2; ++bj) st8(rowp + 32 * bj, acc[ai][bj][m][0], acc[ai][bj][m][1]); }
        } else if (kind == 4) {
            unsigned char* b8 = ws + off + tcol * 256 + 64 * wc + 8 * fq;
#pragma unroll
            for (int ai = 0; ai < 2; ++ai)
#pragma unroll
                for (int m = 0; m < 4; ++m) { unsigned char* rowp = b8 + (size_t)(row0 + ai * 128 + m * 16) * ld;
#pragma unroll
                    for (int bj = 0; bj < 2; ++bj) st8q(rowp + 32 * bj, acc[ai][bj][m][0], acc[ai][bj][m][1]); }
        } else {
#pragma unroll
            for (int ai = 0; ai < 2; ++ai)
#pragma unroll
                for (int m = 0; m < 4; ++m) { bf16* rowp = base + (size_t)(row0 + ai * 128 + m * 16) * ld;
#pragma unroll
                    for (int bj = 0; bj < 2; ++bj) { f32x4 a = acc[ai][bj][m][0], b = acc[ai][bj][m][1];
#pragma unroll
                        for (int j = 0; j < 4; ++j) { a[j] = gelu_tanh(a[j]); b[j] = gelu_tanh(b[j]); }
                        st8(rowp + 32 * bj, a, b); } }
        }
        return false;
    }
};

struct PolMerge {
    static constexpr int NT = 8, LDA = D, LDB = D; static constexpr bool GATHER = false, FP8 = false, I8 = false, SIGNAL = false; static constexpr int A_AUX = 0;
    pg8::StaticOrder so; const bf16* A; const bf16* Bt; const unsigned char* ga; const unsigned char* gb; bf16* out;
    __device__ bool next(int i, Unit& u) const { u.e = i & 1; u.s0 = 0; u.cnt = 0; return so.tile(i >> 1, u.pm, u.pn); }
    __device__ const char* a_ptr(const Unit& u) const { return (const char*)(A + (size_t)u.pm * 256 * LDA + 512 * u.e); }
    __device__ const char* b_ptr(const Unit& u) const { return (const char*)(Bt + (size_t)u.pn * 256 * LDB + 512 * u.e); }
    __device__ void a_off(const Unit&, int, unsigned (&)[2][2]) const {}
    __device__ __forceinline__ bool epi(f32x4 (&acc)[2][2][4][2], const Unit& u, int wr, int wc, int fr, int fq) const {
        const int row0 = u.pm * 256 + wr * 64 + fr, col0 = u.pn * 256 + 64 * wc + 8 * fq;
#pragma unroll
        for (int ai = 0; ai < 2; ++ai) {
            u32x2 gbv[4][2]; u32x2 gav[4][2];
#pragma unroll
            for (int m = 0; m < 4; ++m) { const size_t o = (size_t)(row0 + ai * 128 + m * 16) * D + col0;
#pragma unroll
                for (int bj = 0; bj < 2; ++bj) { gbv[m][bj] = *(const u32x2*)(gb + o + 32 * bj); if (u.e == 0) gav[m][bj] = *(const u32x2*)(ga + o + 32 * bj); } }
#pragma unroll
            for (int m = 0; m < 4; ++m) { const size_t o = (size_t)(row0 + ai * 128 + m * 16) * D + col0;
#pragma unroll
                for (int bj = 0; bj < 2; ++bj) {
                    const u32x2 wb = gbv[m][bj];
                    const f32x2 p0 = __builtin_amdgcn_cvt_pk_f32_fp8((int)wb.x, false), p1 = __builtin_amdgcn_cvt_pk_f32_fp8((int)wb.x, true), p2 = __builtin_amdgcn_cvt_pk_f32_fp8((int)wb.y, false), p3 = __builtin_amdgcn_cvt_pk_f32_fp8((int)wb.y, true);
                    const f32x4 b0 = (f32x4){p0[0], p0[1], p1[0], p1[1]}, b1 = (f32x4){p2[0], p2[1], p3[0], p3[1]};
                    if (u.e == 0) {
                        const u32x2 wa = gav[m][bj];
                        const f32x2 q0 = __builtin_amdgcn_cvt_pk_f32_fp8((int)wa.x, false), q1 = __builtin_amdgcn_cvt_pk_f32_fp8((int)wa.x, true), q2 = __builtin_amdgcn_cvt_pk_f32_fp8((int)wa.y, false), q3 = __builtin_amdgcn_cvt_pk_f32_fp8((int)wa.y, true);
                        const f32x4 a0 = (f32x4){q0[0], q0[1], q1[0], q1[1]}, a1 = (f32x4){q2[0], q2[1], q3[0], q3[1]};
#pragma unroll
                        for (int j = 0; j < 4; ++j) {
                            acc[ai][bj][m][0][j] *= (1.0f + fast_exp2(-LOG2E * b0[j])) * fast_rcp(1.0f + fast_exp2(-LOG2E * a0[j]));
                            acc[ai][bj][m][1][j] *= (1.0f + fast_exp2(-LOG2E * b1[j])) * fast_rcp(1.0f + fast_exp2(-LOG2E * a1[j])); }
                    } else {
                        f32x4 r0, r1;
#pragma unroll
                        for (int j = 0; j < 4; ++j) { r0[j] = acc[ai][bj][m][0][j] * sigmoidf_(b0[j]); r1[j] = acc[ai][bj][m][1][j] * sigmoidf_(b1[j]); }
                        st8(out + o + 32 * bj, r0, r1);
                    }
                } }
        }
        return u.e == 0;
    }
};

struct PolOut {
    static constexpr int NT = 16, LDA = D, LDB = D; static constexpr bool GATHER = false, FP8 = false, I8 = false, SIGNAL = false; static constexpr int A_AUX = 0;
    pg8::StaticOrder so; const bf16* A; const bf16* Bt; const float* x; bf16* x1; unsigned char* x1q;
    __device__ bool next(int i, Unit& u) const { u.e = 0; u.s0 = 0; u.cnt = 0; return so.tile(i, u.pm, u.pn); }
    __device__ const char* a_ptr(const Unit& u) const { return (const char*)(A + (size_t)u.pm * 256 * LDA); }
    __device__ const char* b_ptr(const Unit& u) const { return (const char*)(Bt + (size_t)u.pn * 256 * LDB); }
    __device__ void a_off(const Unit&, int, unsigned (&)[2][2]) const {}
    __device__ __forceinline__ bool epi(f32x4 (&acc)[2][2][4][2], const Unit& u, int wr, int wc, int fr, int fq) const {
        const int row0 = u.pm * 256 + wr * 64 + fr, col0 = u.pn * 256 + 64 * wc + 8 * fq;
#pragma unroll
        for (int ai = 0; ai < 2; ++ai) {
            f32x4 xv[4][2][2];
#pragma unroll
            for (int m = 0; m < 4; ++m) { const size_t o = (size_t)(row0 + ai * 128 + m * 16) * D + col0;
#pragma unroll
                for (int bj = 0; bj < 2; ++bj) { xv[m][bj][0] = *(const f32x4*)(x + o + 32 * bj); xv[m][bj][1] = *(const f32x4*)(x + o + 32 * bj + 4); } }
#pragma unroll
            for (int m = 0; m < 4; ++m) { const size_t o = (size_t)(row0 + ai * 128 + m * 16) * D + col0;
#pragma unroll
                for (int bj = 0; bj < 2; ++bj) {
                    const f32x4 r0 = xv[m][bj][0] + acc[ai][bj][m][0], r1 = xv[m][bj][1] + acc[ai][bj][m][1];
                    st8(x1 + o + 32 * bj, r0, r1); st8q(x1q + o + 32 * bj, r0, r1);
                } }
        }
        return false;
    }
};

struct MoeOrder {
    const LAS int* tb;
    int NN, nwg, G, c;
    __device__ void init(const LAS int* tb_, int NN_, int G_, int c_) { tb = tb_; NN = NN_; G = G_; c = c_; nwg = tb_[32] * NN_; }
    __device__ bool unit(int i, Unit& u) const {
        const int nt_ = nwg / NN, xcd = c % 8, t0 = (nt_ * xcd) / 8, t1 = (nt_ * (xcd + 1)) / 8;
        const int li = i * (G / 8) + c / 8; if (li >= (t1 - t0) * NN) return false;
        const int wgid = t0 * NN + li;
        const int Mt = wgid / NN;
        const int ln = threadIdx.x & 63;
        const unsigned long long bal = __ballot(ln < NE && tb[ln & 31] <= Mt);
        const int e = __popcll(bal) - 1;
        u.idx = i; u.pm = __builtin_amdgcn_readfirstlane(Mt); u.pn = __builtin_amdgcn_readfirstlane(wgid % NN); u.e = __builtin_amdgcn_readfirstlane(e);
        u.s0 = __builtin_amdgcn_readfirstlane((Mt - tb[e]) * 256); u.cnt = __builtin_amdgcn_readfirstlane(tb[33 + e]);
        return true;
    }
};

struct PolGU {
    static constexpr int NT = 8, LDA = 512, LDB = 512; static constexpr bool GATHER = true, FP8 = true, I8 = false, SIGNAL = true; static constexpr int A_AUX = 0;
    MoeOrder mo; const unsigned char* A; const unsigned char* Bt; const int* lid; const float* lrs; const float* bgu; unsigned char* act; unsigned* tcnt;
    __device__ __forceinline__ void signal(const Unit& u) const { (void)__hip_atomic_fetch_add(tcnt + u.pm, 1u, RLX_AGENT); }
    __device__ bool next(int i, Unit& u) const { return mo.unit(i, u); }
    __device__ const char* a_ptr(const Unit&) const { return (const char*)A; }
    __device__ const char* b_ptr(const Unit& u) const { return (const char*)(Bt + ((size_t)u.e * 2048 + (size_t)u.pn * 256) * 1024); }
    __device__ __forceinline__ void a_off(const Unit& u, int tid, unsigned (&v)[2][2]) const {
        const int* l = lid + (size_t)u.e * LCAP;
#pragma unroll
        for (int i = 0; i < 2; ++i) { int R, C; pg8::stage_rc(tid * 16 + i * 8192, R, C);
#pragma unroll
            for (int h = 0; h < 2; ++h) { const int s = u.s0 + h * 128 + R; const int id = l[s]; const int tok = (s < u.cnt) ? (id >> 2) : 0; v[h][i] = (unsigned)(tok * LDA + C) * 2u; } }
    }
    struct Stash { u32x2 pk[2][4]; };
    __device__ __forceinline__ void epi_compute(f32x4 (&acc)[2][2][4][2], const Unit& u, int wr, int wc, int fr, int fq, Stash& st) const {
        const float* rsl = lrs + (size_t)u.e * LCAP + u.s0;
        const float* bg = bgu + (size_t)u.e * 2048 + u.pn * 128 + 32 * wc + 8 * fq;
        const f32x4 bg0 = *(const f32x4*)bg, bg1 = *(const f32x4*)(bg + 4), bu0 = *(const f32x4*)(bg + 1024), bu1 = *(const f32x4*)(bg + 1028);
        float rsv[2][4];
#pragma unroll
        for (int ai = 0; ai < 2; ++ai)
#pragma unroll
            for (int m = 0; m < 4; ++m) { const int r = ai * 128 + wr * 64 + m * 16 + fr; const bool valid = (u.s0 + r < u.cnt); float t_ = rsl[valid ? r : 0]; asm volatile("" : "+v"(t_)); rsv[ai][m] = valid ? t_ * WQ_INV : 0.f; }
#pragma unroll
        for (int ai = 0; ai < 2; ++ai)
#pragma unroll
            for (int m = 0; m < 4; ++m) { const int r = ai * 128 + wr * 64 + m * 16 + fr; const float rs = rsv[ai][m];
                f32x4 o[2];
#pragma unroll
                for (int n = 0; n < 2; ++n)
#pragma unroll
                    for (int h2 = 0; h2 < 2; ++h2) {
                        const f32x2 ag = {acc[ai][0][m][n][2 * h2], acc[ai][0][m][n][2 * h2 + 1]}, au = {acc[ai][1][m][n][2 * h2], acc[ai][1][m][n][2 * h2 + 1]};
                        const f32x2 bgv = n ? (f32x2){bg1[2 * h2], bg1[2 * h2 + 1]} : (f32x2){bg0[2 * h2], bg0[2 * h2 + 1]}, buv = n ? (f32x2){bu1[2 * h2], bu1[2 * h2 + 1]} : (f32x2){bu0[2 * h2], bu0[2 * h2 + 1]};
                        f32x2 g = ag * rs + bgv, up = au * rs + buv;
                        g = __builtin_elementwise_min(g, (f32x2){7.0f, 7.0f});
                        up.x = __builtin_amdgcn_fmed3f(up.x, -7.0f, 7.0f); up.y = __builtin_amdgcn_fmed3f(up.y, -7.0f, 7.0f);
                        const f32x2 t = g * (-1.702f * LOG2E);
                        f32x2 e; e.x = fast_exp2(t.x); e.y = fast_exp2(t.y);
                        const f32x2 den = e + 1.0f;
                        f32x2 rc; rc.x = fast_rcp(den.x); rc.y = fast_rcp(den.y);
                        const f32x2 res = (up + 1.0f) * (g * rc);
                        o[n][2 * h2] = res.x; o[n][2 * h2 + 1] = res.y; }
                st.pk[ai][m] = pack8q(o[0], o[1]); }
    }
    __device__ __forceinline__ void epi_store(const Unit& u, int wr, int wc, int fr, int fq, const Stash& st) const {
        unsigned char* ob = act + (size_t)u.pm * 256 * FF + u.pn * 128 + 32 * wc + 8 * fq;
#pragma unroll
        for (int ai = 0; ai < 2; ++ai)
#pragma unroll
            for (int m = 0; m < 4; ++m) { const int r = ai * 128 + wr * 64 + m * 16 + fr;
                *(u32x2*)(ob + (size_t)r * FF) = st.pk[ai][m]; }
    }
};

struct PolDown {
    static constexpr int NT = 8, LDA = 512, LDB = 512; static constexpr bool GATHER = true, FP8 = true, I8 = false, SIGNAL = false; static constexpr int A_AUX = 0;
    MoeOrder mo; const unsigned char* A; const unsigned char* Bt; const int* lid; const float* lp; const float* bd; unsigned char* y; unsigned* tcnt; unsigned* tmo;
    __device__ __forceinline__ void wait_tile(int pm) const {
        unsigned sp = 0;
        while (__hip_atomic_load(tcnt + pm, RLX_AGENT) < 8u) { __builtin_amdgcn_s_sleep(2);
            if ((++sp & 255u) == 0u) { if (__hip_atomic_load(tmo, RLX_AGENT)) break; if (sp > (1u << 18)) { atomicAdd(tmo, 1u); break; } } }
        asm volatile("" ::: "memory");
    }
    __device__ __forceinline__ bool next(int i, Unit& u) const {
        if (!mo.unit(i, u)) return false;
        if (i < 2) wait_tile(u.pm);
        return true;
    }
    __device__ const char* a_ptr(const Unit& u) const { return (const char*)(A + (size_t)u.pm * 256 * 1024); }
    __device__ const char* b_ptr(const Unit& u) const { return (const char*)(Bt + ((size_t)u.e * 1024 + (size_t)u.pn * 256) * 1024); }
    __device__ __forceinline__ void a_off(const Unit&, int tid, unsigned (&v)[2][2]) const {
#pragma unroll
        for (int i = 0; i < 2; ++i) { int R, C; pg8::stage_rc(tid * 16 + i * 8192, R, C); v[0][i] = (unsigned)(R * LDA + C) * 2u; v[1][i] = (unsigned)((R + 128) * LDA + C) * 2u; }
    }
    __device__ __forceinline__ bool epi(f32x4 (&acc)[2][2][4][2], const Unit& u, int wr, int wc, int fr, int fq) const {
        const int* idl = lid + (size_t)u.e * LCAP + u.s0; const float* pl = lp + (size_t)u.e * LCAP + u.s0;
        const int col0 = u.pn * 256 + 64 * wc + 8 * fq;
        const float* b = bd + (size_t)u.e * D + col0;
        Unit u2; const bool h2 = mo.unit(u.idx + 2, u2);
        unsigned fl2 = 8u; if (h2) fl2 = __hip_atomic_load(tcnt + u2.pm, RLX_AGENT);
        int idv[2][4]; float pv_[2][4];
#pragma unroll
        for (int ai = 0; ai < 2; ++ai)
#pragma unroll
            for (int m = 0; m < 4; ++m) { const int r = ai * 128 + wr * 64 + m * 16 + fr; const bool valid = (u.s0 + r < u.cnt); const int rr = valid ? r : 0;
                int t_ = idl[rr]; float q_ = pl[rr]; asm volatile("" : "+v"(t_), "+v"(q_)); idv[ai][m] = valid ? t_ : T * 4; pv_[ai][m] = q_; }
        f32x4 bv[2][2];
#pragma unroll
        for (int bj = 0; bj < 2; ++bj)
#pragma unroll
            for (int n = 0; n < 2; ++n) bv[bj][n] = *(const f32x4*)(b + 32 * bj + 4 * n);
#pragma unroll
        for (int ai = 0; ai < 2; ++ai)
#pragma unroll
            for (int m = 0; m < 4; ++m) { const float p = pv_[ai][m] * 16.0f; unsigned char* op = y + (size_t)idv[ai][m] * D + col0;
#pragma unroll
                for (int bj = 0; bj < 2; ++bj) st8q(op + 32 * bj, (acc[ai][bj][m][0] * WQ_INV + bv[bj][0]) * p, (acc[ai][bj][m][1] * WQ_INV + bv[bj][1]) * p); }
        if (h2 && fl2 < 8u) wait_tile(u2.pm);
        return false;
    }
};

constexpr int CONV_GU_ITEMS = NE * 16 * 32, CONV_D_ITEMS = NE * 16 * 16, CONV_ITEMS = CONV_GU_ITEMS + CONV_D_ITEMS, CONV_PER_WAVE = CONV_ITEMS / 2048;
static_assert(CONV_PER_WAVE * 2048 == CONV_ITEMS, "items divide over 2048 waves");
struct MoeConv {
    const float* wgu; const float* wd; const float* g2; unsigned char* WGU8; unsigned char* WD8;
    struct Regs { f32x4 v0, v1, v2, v3, v4, v5, v6, v7, v8, v9, v10, v11, v12, v13, v14, v15; };
    __device__ __forceinline__ void src_of(int item, const float*& W, int& N, int& k0, int& n0) const {
        if (item < CONV_GU_ITEMS) { const int e = item >> 9, q = item & 511; W = wgu + (size_t)e * D * 2048; N = 2048; k0 = 64 * (q >> 5); n0 = 64 * (q & 31); }
        else { const int r = item - CONV_GU_ITEMS, e = r >> 8, q = r & 255; W = wd + (size_t)e * FF * D; N = D; k0 = 64 * (q >> 4); n0 = 64 * (q & 15); }
    }
    __device__ __forceinline__ void finish(Regs& R, int item, int lane) const {
        const float* W; int N, k0, n0; src_of(item, W, N, k0, n0);
        const int kc = lane >> 4, nq = lane & 15; const bool gu = item < CONV_GU_ITEMS;
        float sc[16];
        if (gu) { const f32x4* gp = (const f32x4*)(g2 + k0 + 16 * kc);
#pragma unroll
            for (int q = 0; q < 4; ++q) { const f32x4 t = gp[q]; sc[4 * q] = t[0] * 32.0f; sc[4 * q + 1] = t[1] * 32.0f; sc[4 * q + 2] = t[2] * 32.0f; sc[4 * q + 3] = t[3] * 32.0f; } }
        else {
#pragma unroll
            for (int i = 0; i < 16; ++i) sc[i] = 32.0f; }
        const int nb = n0 + 32 * (nq >> 3);
        const int e = gu ? (item >> 9) : ((item - CONV_GU_ITEMS) >> 8);
        const int up = nb >= 1024, cc = nb & 1023;
        const int pos = gu ? ((cc >> 7) * 256 + up * 128 + ((cc >> 5) & 3) * 32) : ((nb & ~255) + ((nb >> 5) & 1) * 128 + ((nb >> 6) & 3) * 32);
        unsigned char* base = (gu ? (WGU8 + ((size_t)e * 2048 + pos + ((4 * nq) & 31)) * 1024) : (WD8 + ((size_t)e * 1024 + pos + ((4 * nq) & 31)) * 1024)) + k0 + 16 * kc;
#pragma unroll
        for (int c = 0; c < 4; ++c) {
            int w0 = 0, w1 = 0, w2 = 0, w3 = 0;
            w0 = __builtin_amdgcn_cvt_pk_fp8_f32(R.v0[c] * sc[0], R.v1[c] * sc[1], w0, false); w0 = __builtin_amdgcn_cvt_pk_fp8_f32(R.v2[c] * sc[2], R.v3[c] * sc[3], w0, true);
            w1 = __builtin_amdgcn_cvt_pk_fp8_f32(R.v4[c] * sc[4], R.v5[c] * sc[5], w1, false); w1 = __builtin_amdgcn_cvt_pk_fp8_f32(R.v6[c] * sc[6], R.v7[c] * sc[7], w1, true);
            w2 = __builtin_amdgcn_cvt_pk_fp8_f32(R.v8[c] * sc[8], R.v9[c] * sc[9], w2, false); w2 = __builtin_amdgcn_cvt_pk_fp8_f32(R.v10[c] * sc[10], R.v11[c] * sc[11], w2, true);
            w3 = __builtin_amdgcn_cvt_pk_fp8_f32(R.v12[c] * sc[12], R.v13[c] * sc[13], w3, false); w3 = __builtin_amdgcn_cvt_pk_fp8_f32(R.v14[c] * sc[14], R.v15[c] * sc[15], w3, true);
            *(u32x4*)(base + (size_t)c * 1024) = (u32x4){(unsigned)w0, (unsigned)w1, (unsigned)w2, (unsigned)w3};
        }
    }
    template <int SUB> __device__ __forceinline__ void sub(Regs& R, int& st, int item0, int istride, int lane) const {
        if (SUB == 0 && (st & 1)) { finish(R, item0 + ((st >> 1) - 1) * istride, lane); st &= ~1; }
        const int it = st >> 1;
        if (it < CONV_PER_WAVE) {
            const float* W; int N, k0, n0; src_of(item0 + it * istride, W, N, k0, n0);
            const float* p = W + (size_t)(k0 + 16 * (lane >> 4) + 4 * SUB) * N + n0 + 4 * (lane & 15);
            const f32x4 t0 = *(const f32x4*)p, t1 = *(const f32x4*)(p + N), t2 = *(const f32x4*)(p + 2 * (size_t)N), t3 = *(const f32x4*)(p + 3 * (size_t)N);
            if (SUB == 0) { R.v0 = t0; R.v1 = t1; R.v2 = t2; R.v3 = t3; }
            else if (SUB == 1) { R.v4 = t0; R.v5 = t1; R.v6 = t2; R.v7 = t3; }
            else if (SUB == 2) { R.v8 = t0; R.v9 = t1; R.v10 = t2; R.v11 = t3; }
            else { R.v12 = t0; R.v13 = t1; R.v14 = t2; R.v15 = t3; st = ((it + 1) << 1) | 1; }
        }
    }
    __device__ __forceinline__ void drain(Regs& R, int& st, int item0, int istride, int lane) const {
        if (st & 1) { finish(R, item0 + ((st >> 1) - 1) * istride, lane); st &= ~1; }
        for (int it = st >> 1; it < CONV_PER_WAVE; ++it) { sub<0>(R, st, item0, istride, lane); sub<1>(R, st, item0, istride, lane); sub<2>(R, st, item0, istride, lane); sub<3>(R, st, item0, istride, lane);
            finish(R, item0 + it * istride, lane); st &= ~1; }
    }
};

namespace att {
constexpr int PITCH = 512, SLOTB = 8192;
constexpr int L_K = 0, L_V = 2 * SLOTB, L_TBL = 4 * SLOTB, L_WS = L_TBL + 4096, L_OST = L_WS + 8 * 256, L_END = L_OST + 8 * 4096;
constexpr int NTBL = 832;
__device__ __forceinline__ int crow(int r, int hi) { return (r & 3) + 8 * (r >> 2) + 4 * hi; }
__device__ __forceinline__ void glds16(const void* gsrc, unsigned lds_dst) { unsigned keep;
    asm volatile("s_mov_b32 %0, m0\n\ts_mov_b32 m0, %2\n\ts_nop 0\n\tglobal_load_lds_dwordx4 %1, off\n\ts_mov_b32 m0, %0" : "=&s"(keep) : "v"(gsrc), "s"(lds_dst) : "memory"); }
__device__ __forceinline__ unsigned cvtpk_s(float lo, float hi) { typedef __bf16 bf16x2_t __attribute__((ext_vector_type(2))); f32x2 v = {lo, hi}; bf16x2_t b = __builtin_convertvector(v, bf16x2_t); return __builtin_bit_cast(unsigned, b); }
#define ATT_SBAR() __builtin_amdgcn_sched_barrier(0)
__device__ __forceinline__ void pv(f32x16* o, int vb, bf16x8 pa0, bf16x8 pa1, bf16x8 pa2, bf16x8 pa3) {
#pragma unroll
    for (int d0 = 0; d0 < 2; ++d0) { s16x4 lo[4], hi[4];
#pragma unroll
        for (int ks = 0; ks < 4; ++ks) {
            asm volatile("ds_read_b64_tr_b16 %0,%1 offset:%c2" : "=&v"(lo[ks]) : "v"(vb), "i"(d0 * 4096 + ks * 1024) : "memory");
            asm volatile("ds_read_b64_tr_b16 %0,%1 offset:%c2" : "=&v"(hi[ks]) : "v"(vb), "i"(d0 * 4096 + ks * 1024 + 512) : "memory"); }
        asm volatile("s_waitcnt lgkmcnt(0)" ::: "memory"); ATT_SBAR();
#define ATT_PK(k) (bf16x8){lo[k][0], lo[k][1], lo[k][2], lo[k][3], hi[k][0], hi[k][1], hi[k][2], hi[k][3]}
        o[d0] = __builtin_amdgcn_mfma_f32_32x32x16_bf16(pa0, ATT_PK(0), o[d0], 0, 0, 0);
        o[d0] = __builtin_amdgcn_mfma_f32_32x32x16_bf16(pa1, ATT_PK(1), o[d0], 0, 0, 0);
        o[d0] = __builtin_amdgcn_mfma_f32_32x32x16_bf16(pa2, ATT_PK(2), o[d0], 0, 0, 0);
        o[d0] = __builtin_amdgcn_mfma_f32_32x32x16_bf16(pa3, ATT_PK(3), o[d0], 0, 0, 0);
#undef ATT_PK
    }
}
__device__ __forceinline__ void unit(int b, int h, int cg, const bf16* Q, const bf16* K, const bf16* V, const float* relb, bf16* O  , LAS unsigned char* shm,
                                     const MoeConv& cv, MoeConv::Regs& sreg, int& sctr, int item0, int istride) {
    const int tid = threadIdx.x, lane = tid & 63, r32 = lane & 31, hi = lane >> 5; const int wid = __builtin_amdgcn_readfirstlane(tid >> 6);
    const long rowbase = (long)b * SEQ; const int cq = 4 * cg + (wid >> 1), wq = wid & 1;
    const bf16* Qw = Q + (rowbase + 64 * cq + 32 * wq) * PITCH + h * HD;
    const unsigned lds0 = (unsigned)(uintptr_t)shm;
    LAS float* tbl = (LAS float*)(shm + L_TBL);
    LAS float* wsf = (LAS float*)(shm + L_WS) + wid * 64;
    for (int i = tid; i < NTBL; i += 512) tbl[i] = relb[h * NREL + (i < 512 ? i : 512)] * LOG2E;
    const int srow = tid >> 3, sc = tid & 7;
    const bf16* ksrc = K + (rowbase + srow) * PITCH + h * HD + sc * 8;
    const bf16* vsrc = V + (rowbase + srow) * PITCH + h * HD + sc * 8;
    const int kwr = L_K + sc * 1024 + ((srow ^ sc) << 4);
    const int vwr = L_V + (4 * (sc >> 2) + (srow >> 4)) * 1024 + (srow & 15) * 64 + (sc & 3) * 16;
    const int vb0 = (int)(lds0 + L_V) + ((lane >> 4) & 1) * 32 + (lane & 3) * 8 + (4 * hi + ((lane & 15) >> 2)) * 64;
    int kra[4];
#pragma unroll
    for (int d0 = 0; d0 < 4; ++d0) kra[d0] = L_K + (2 * d0 + hi) * 1024 + ((r32 ^ (2 * d0 + hi)) << 4);
    bf16x8 qr[4];
#pragma unroll
    for (int d0 = 0; d0 < 4; ++d0) qr[d0] = *reinterpret_cast<const bf16x8*>(&Qw[(long)r32 * PITCH + d0 * 16 + hi * 8]);
    f32x16 o[2]; o[0] = f32x16{}; o[1] = f32x16{}; float l_reg = 0.f;
    const int j0 = (8 - 4 * cg) > 0 ? (8 - 4 * cg) : 0;
    u32x4 kreg, vreg;
    { const long ro = (long)(4 * cg - 8 + j0) * 64 * PITCH; kreg = *(const u32x4*)(ksrc + ro); vreg = *(const u32x4*)(vsrc + ro); }
#define ATT_STEP(JX, SUBP) do { const int j = (JX); \
        const int s = (j - j0) & 1; \
        *(LAS u32x4*)(shm + kwr + s * SLOTB) = kreg; *(LAS u32x4*)(shm + vwr + s * SLOTB) = vreg; \
        if (j < 11) { const long ro = (long)(4 * cg - 8 + j + 1) * 64 * PITCH; kreg = *(const u32x4*)(ksrc + ro); vreg = *(const u32x4*)(vsrc + ro); } \
        asm volatile("s_waitcnt lgkmcnt(0)\n\ts_barrier" ::: "memory"); \
        cv.template sub<SUBP>(sreg, sctr, item0, istride, lane);     \
        const int d = (wid >> 1) + 8 - j; \
        if (d >= 0 && d <= 8) { \
            f32x16 p0 = f32x16{}, p1 = f32x16{}; \
            const LAS unsigned char* kbs = shm + s * SLOTB; \
        _Pragma("unroll") \
            for (int d0 = 0; d0 < 4; ++d0) { \
                const bf16x8 b0 = *(const LAS bf16x8*)(kbs + kra[d0]), b1 = *(const LAS bf16x8*)(kbs + kra[d0] + 512); \
                p0 = __builtin_amdgcn_mfma_f32_32x32x16_bf16(b0, qr[d0], p0, 0, 0, 0); p1 = __builtin_amdgcn_mfma_f32_32x32x16_bf16(b1, qr[d0], p1, 0, 0, 0); } \
            const LAS float* tb = tbl + (256 + 64 * d + 32 * wq + r32 - 4 * hi - 63); \
            float sacc = 0.f; \
        _Pragma("unroll") \
            for (int r = 0; r < 16; ++r) { const int c = (r & 3) + 8 * (r >> 2); \
                p0[r] = fast_exp2(p0[r] + tb[63 - c]); p1[r] = fast_exp2(p1[r] + tb[31 - c]); sacc += p0[r] + p1[r]; } \
            l_reg += sacc; \
            u32x4 pw0, pw1, pw2, pw3; \
            pw0 = (u32x4){cvtpk_s(p0[0], p0[1]), cvtpk_s(p0[2], p0[3]), cvtpk_s(p0[4], p0[5]), cvtpk_s(p0[6], p0[7])}; \
            pw1 = (u32x4){cvtpk_s(p0[8], p0[9]), cvtpk_s(p0[10], p0[11]), cvtpk_s(p0[12], p0[13]), cvtpk_s(p0[14], p0[15])}; \
            pw2 = (u32x4){cvtpk_s(p1[0], p1[1]), cvtpk_s(p1[2], p1[3]), cvtpk_s(p1[4], p1[5]), cvtpk_s(p1[6], p1[7])}; \
            pw3 = (u32x4){cvtpk_s(p1[8], p1[9]), cvtpk_s(p1[10], p1[11]), cvtpk_s(p1[12], p1[13]), cvtpk_s(p1[14], p1[15])}; \
            ATT_SBAR(); \
            pv(o, vb0 + s * SLOTB, __builtin_bit_cast(bf16x8, pw0), __builtin_bit_cast(bf16x8, pw1), __builtin_bit_cast(bf16x8, pw2), __builtin_bit_cast(bf16x8, pw3)); \
        } \
    } while (0)
    for (int jb = j0; jb < 12; jb += 4) { ATT_STEP(jb, 0); ATT_STEP(jb + 1, 1); ATT_STEP(jb + 2, 2); ATT_STEP(jb + 3, 3); }
#undef ATT_STEP
    asm volatile("s_waitcnt lgkmcnt(0)\n\ts_barrier" ::: "memory");
    { auto rr = __builtin_amdgcn_permlane32_swap(__float_as_uint(l_reg), __float_as_uint(l_reg), false, false); l_reg = __uint_as_float(rr[0]) + __uint_as_float(rr[1]); }
    if (hi == 0) wsf[32 + r32] = l_reg; asm volatile("s_waitcnt lgkmcnt(0)" ::: "memory");
    float rli[16];
#pragma unroll
    for (int r = 0; r < 16; ++r) rli[r] = fast_rcp(wsf[32 + crow(r, hi)]);
    bf16* Ow = O + (rowbase + 64 * cq + 32 * wq) * D + h * HD;
    { LAS bf16* stg = (LAS bf16*)(shm + L_OST) + wid * 2048;
#pragma unroll
        for (int r = 0; r < 16; ++r) { const int orow = crow(r, hi);
#pragma unroll
            for (int d0 = 0; d0 < 2; ++d0) stg[orow * 64 + d0 * 32 + r32] = (bf16)f2bf(o[d0][r] * rli[r]); }
        asm volatile("s_waitcnt lgkmcnt(0)" ::: "memory");
#pragma unroll
        for (int i = 0; i < 4; ++i) { const int row = i * 8 + (lane >> 3), ch = lane & 7; const u32x4 v = *(const LAS u32x4*)(stg + row * 64 + ch * 8); *(u32x4*)(Ow + (long)row * D + ch * 8) = v; } }
    asm volatile("s_waitcnt lgkmcnt(0)\n\ts_barrier" ::: "memory");
}
#undef ATT_SBAR
}

constexpr int SGU_WM_OFF = 128 * 136 * 2;
__device__ __forceinline__ void sgu_load_wm(int g, const bf16* WM, LAS unsigned char* shm) {
    const int tid = threadIdx.x, t = tid >> 2, c0 = (tid & 3) * 32;
    const bf16* src = WM + ((size_t)g * 128 + t) * 128 + c0;
#pragma unroll
    for (int q = 0; q < 4; ++q) *(LAS u32x4*)(shm + SGU_WM_OFF + (t * 136 + c0 + 8 * q) * 2) = *(const u32x4*)(src + 8 * q);
}
__device__ __forceinline__ void sgu_item(int item, const bf16* VG, const bf16* UG, const float* lng, const float* lnb, const float* sgb, bf16* YC, LAS unsigned char* shm,
                                         const MoeConv& cv, MoeConv::Regs& sreg, int& sctr, int item0, int istride) {
    const int tid = threadIdx.x, lane = tid & 63; const int wid = __builtin_amdgcn_readfirstlane(tid >> 6);
    const int g = item & 3, blk = item >> 2;
    const long t0 = (long)blk * 128;
    LAS bf16* vt = (LAS bf16*)shm;
    const LAS bf16* wmL = (const LAS bf16*)(shm + SGU_WM_OFF);
    const int ch = tid & 15, fr = lane & 15, fq = lane >> 4;
    u32x4 vraw[4];
#pragma unroll
    for (int it = 0; it < 4; ++it) vraw[it] = *(const u32x4*)(VG + (t0 + (tid >> 4) + 32 * it) * SGW + g * 128 + ch * 8);
    u32x2 uw[8]; float bs[8];
#pragma unroll
    for (int tt = 0; tt < 8; ++tt) { const int t = 16 * tt + fr; uw[tt] = *(const u32x2*)(UG + (size_t)(t0 + t) * SGW + g * 128 + 16 * wid + 4 * fq); bs[tt] = sgb[g * 128 + t]; }
    const f32x4 gA = *(const f32x4*)(lng + g * 128 + ch * 8), gB = *(const f32x4*)(lng + g * 128 + ch * 8 + 4);
    const f32x4 bA = *(const f32x4*)(lnb + g * 128 + ch * 8), bB = *(const f32x4*)(lnb + g * 128 + ch * 8 + 4);
#pragma unroll
    for (int it = 0; it < 4; ++it) {
        const int s = (tid >> 4) + 32 * it;
        const u32x4 w = vraw[it];
        f32x4 a = (f32x4){bflo(w.x), bfhi(w.x), bflo(w.y), bfhi(w.y)}, b = (f32x4){bflo(w.z), bfhi(w.z), bflo(w.w), bfhi(w.w)};
        float sum = (a[0] + a[1]) + (a[2] + a[3]) + (b[0] + b[1]) + (b[2] + b[3]);
        sum += __shfl_xor(sum, 1); sum += __shfl_xor(sum, 2); sum += __shfl_xor(sum, 4); sum += __shfl_xor(sum, 8);
        const float mean = sum * (1.0f / 128.0f);
        a = a - mean; b = b - mean;
        float q = (a[0] * a[0] + a[1] * a[1]) + (a[2] * a[2] + a[3] * a[3]) + (b[0] * b[0] + b[1] * b[1]) + (b[2] * b[2] + b[3] * b[3]);
        q += __shfl_xor(q, 1); q += __shfl_xor(q, 2); q += __shfl_xor(q, 4); q += __shfl_xor(q, 8);
        const float rstd = 1.0f / sqrtf(q * (1.0f / 128.0f) + EPS);
        a = a * rstd * gA + bA; b = b * rstd * gB + bB;
#pragma unroll
        for (int j = 0; j < 4; ++j) { vt[(ch * 8 + j) * 136 + s] = (bf16)f2bf(a[j]); vt[(ch * 8 + 4 + j) * 136 + s] = (bf16)f2bf(b[j]); }
    }
    asm volatile("s_waitcnt lgkmcnt(0)\n\ts_barrier" ::: "memory");
    f32x4 acc[8];
#pragma unroll
    for (int tt = 0; tt < 8; ++tt) acc[tt] = (f32x4){0.f, 0.f, 0.f, 0.f};
#pragma unroll
    for (int ks = 0; ks < 4; ++ks) {
        const bf16x8 a = *(const LAS bf16x8*)(vt + (16 * wid + fr) * 136 + 32 * ks + 8 * fq);
#pragma unroll
        for (int tt = 0; tt < 8; ++tt) if (ks <= (tt >> 1)) {
            const bf16x8 bfrag = *(const LAS bf16x8*)(wmL + (16 * tt + fr) * 136 + 32 * ks + 8 * fq);
            acc[tt] = __builtin_amdgcn_mfma_f32_16x16x32_bf16(a, bfrag, acc[tt], 0, 0, 0); }
    }
#pragma unroll
    for (int tt = 0; tt < 8; ++tt) { const int t = 16 * tt + fr; const float b_ = bs[tt];
        const u32x2 u_ = uw[tt];
        u32x2 w; w.x = cvt_pk_bf16(bflo(u_.x) * (acc[tt][0] + b_), bfhi(u_.x) * (acc[tt][1] + b_)); w.y = cvt_pk_bf16(bflo(u_.y) * (acc[tt][2] + b_), bfhi(u_.y) * (acc[tt][3] + b_));
        *(u32x2*)(YC + (size_t)(t0 + t) * D + AW + g * 128 + 16 * wid + 4 * fq) = w; }
    asm volatile("s_waitcnt lgkmcnt(0)\n\ts_barrier" ::: "memory");
}

#define XB_TMO      128
#define XB_XCNT(j)  (256  + 64 * (j))
#define XB_XSUB(j)  (1280 + 64 * (j))
#define XB_XGEN(j)  (2304 + 64 * (j))
#define XB_TOP      3328
#define XB_TOPGEN   3392
#define XCD_BAR_WORDS 3456
#define XB_SPIN_CAP (1u << 18)
__device__ __forceinline__ unsigned xb_ld(unsigned* p)              { return __hip_atomic_load(p, __ATOMIC_RELAXED, __HIP_MEMORY_SCOPE_AGENT); }
__device__ __forceinline__ unsigned xb_add(unsigned* p, unsigned v) { return __hip_atomic_fetch_add(p, v, __ATOMIC_RELAXED, __HIP_MEMORY_SCOPE_AGENT); }
__device__ __forceinline__ unsigned xb_xcc_id() { return (unsigned)__builtin_amdgcn_s_getreg((3 << 11) | 20) & 0xFu; }
#define XB_SPIN(cond, bar) do { unsigned _sp = 0; while (cond) { __builtin_amdgcn_s_sleep(1); \
    if ((++_sp & 255u) == 0u) { if (xb_ld(&(bar)[XB_TMO])) break; if (_sp > XB_SPIN_CAP) { atomicAdd(&(bar)[XB_TMO], 1u); break; } } } } while (0)
struct XcdBarrier { unsigned* bar; unsigned x; volatile LAS unsigned* st; };
__device__ __forceinline__ XcdBarrier xcd_barrier_post(unsigned* bar, volatile LAS unsigned* st) {
    XcdBarrier b; b.bar = bar; b.x = xb_xcc_id(); b.st = st;
    if (threadIdx.x == 0) st[2] = xb_add(&bar[XB_XCNT(b.x)], 1u);
    return b;
}
__device__ __forceinline__ void xcd_barrier_complete(unsigned* bar, unsigned x, unsigned& nloc, unsigned& nx) {
    const unsigned G = gridDim.x * gridDim.y * gridDim.z;
    unsigned sum, cnt, mine, sp = 0u;
    for (;;) {
        sum = 0u; cnt = 0u; mine = 0u;
#pragma unroll
        for (unsigned j = 0; j < 16; ++j) { const unsigned c = xb_ld(&bar[XB_XCNT(j)]); sum += c; cnt += (c > 0u) ? 1u : 0u; mine = (j == x) ? c : mine; }
        if (sum == G) break;
        __builtin_amdgcn_s_sleep(1);
        if ((++sp & 255u) == 0u) { if (xb_ld(&bar[XB_TMO])) break; if (sp > XB_SPIN_CAP) { atomicAdd(&bar[XB_TMO], 1u); break; } }
    }
    nloc = mine > 0u ? mine : 1u; nx = cnt > 0u ? cnt : 1u;
}
__device__ __forceinline__ void xcd_barrier(const XcdBarrier& b) {
    asm volatile("s_waitcnt vmcnt(0)" ::: "memory");
    __syncthreads();
    if (threadIdx.x == 0) {
        unsigned* bar = b.bar;
        __builtin_amdgcn_s_waitcnt(0);
        unsigned nloc = b.st[0], nx = b.st[1];
        if (nloc == 0u) { xcd_barrier_complete(bar, b.x, nloc, nx); b.st[0] = nloc; b.st[1] = nx; }
        const unsigned old = xb_add(&bar[XB_XSUB(b.x)], 1u);
        const unsigned gen = old / nloc;
        if (old + 1u == (gen + 1u) * nloc) {
            __builtin_amdgcn_fence(__ATOMIC_RELEASE, "agent");
            asm volatile("s_waitcnt vmcnt(0)" ::: "memory");
            const unsigned og = xb_add(&bar[XB_TOP], 1u);
            const unsigned tg = og / nx;
            if (og + 1u == (tg + 1u) * nx) xb_add(&bar[XB_TOPGEN], 1u);
            else XB_SPIN(xb_ld(&bar[XB_TOPGEN]) == tg, bar);
            __builtin_amdgcn_fence(__ATOMIC_ACQUIRE, "agent");
            xb_add(&bar[XB_XGEN(b.x)], 1u);
            asm volatile("s_waitcnt vmcnt(0)" ::: "memory");
        } else {
            XB_SPIN(xb_ld(&bar[XB_XGEN(b.x)]) == gen, bar);
            __builtin_amdgcn_fence(__ATOMIC_ACQUIRE, "agent");
            asm volatile("s_waitcnt vmcnt(0)" ::: "memory");
        }
    }
    __syncthreads();
}

__device__ __forceinline__ float wave_sum(float v) {
#pragma unroll
    for (int o = 1; o < 64; o <<= 1) v += __shfl_xor(v, o);
    return v;
}
__device__ __forceinline__ int pos_gen(int n0) { return (n0 & ~255) + ((n0 >> 5) & 1) * 128 + ((n0 >> 6) & 3) * 32; }
__device__ __forceinline__ int pos_gu(int c0) { const int up = c0 >= 1024, cc = c0 & 1023; return (cc >> 7) * 256 + up * 128 + ((cc >> 5) & 3) * 32; }
__device__ __forceinline__ unsigned pack_i8(const f32x4& v) {
    const int a = (int)__builtin_rintf(v.x), b = (int)__builtin_rintf(v.y), c = (int)__builtin_rintf(v.z), d = (int)__builtin_rintf(v.w);
    return ((unsigned)a & 255u) | (((unsigned)b & 255u) << 8) | (((unsigned)c & 255u) << 16) | ((unsigned)d << 24);
}
__device__ __forceinline__ void win_absmax(const float* W, int k0, int n0, unsigned* cmax, unsigned* ccnt, int lane) {
    const int kc = lane >> 4, nq = lane & 15;
    f32x4 v[16];
#pragma unroll
    for (int i = 0; i < 16; ++i) v[i] = *(const f32x4*)(W + (size_t)(k0 + 16 * kc + i) * INW + n0 + 4 * nq);
    f32x4 mx = (f32x4){0.f, 0.f, 0.f, 0.f};
#pragma unroll
    for (int i = 0; i < 16; ++i) { mx.x = fmaxf(mx.x, fabsf(v[i].x)); mx.y = fmaxf(mx.y, fabsf(v[i].y)); mx.z = fmaxf(mx.z, fabsf(v[i].z)); mx.w = fmaxf(mx.w, fabsf(v[i].w)); }
#pragma unroll
    for (int c = 0; c < 4; ++c) { mx[c] = fmaxf(mx[c], __shfl_xor(mx[c], 16)); mx[c] = fmaxf(mx[c], __shfl_xor(mx[c], 32)); }
    if (kc == 0) {
#pragma unroll
        for (int c = 0; c < 4; ++c) (void)__hip_atomic_fetch_max(cmax + n0 + 4 * nq + c, __float_as_uint(mx[c]), RLX_AGENT);
    }
    asm volatile("s_waitcnt vmcnt(0)" ::: "memory");
    if (lane == 0) (void)__hip_atomic_fetch_add(ccnt, 1u, RLX_AGENT);
}
__device__ __forceinline__ void win_quant(const float* W, int k0, int n0, unsigned char* WT, unsigned* cmax, unsigned* ccnt, float* cs, bool write_cs, unsigned* tmo, int lane) {
    const int kc = lane >> 4, nq = lane & 15;
    f32x4 v[16];
#pragma unroll
    for (int i = 0; i < 16; ++i) v[i] = *(const f32x4*)(W + (size_t)(k0 + 16 * kc + i) * INW + n0 + 4 * nq);
    { unsigned sp = 0; while (__hip_atomic_load(ccnt, RLX_AGENT) < 16u) { __builtin_amdgcn_s_sleep(1);
        if ((++sp & 255u) == 0u) { if (__hip_atomic_load(tmo, RLX_AGENT)) break; if (sp > (1u << 18)) { atomicAdd(tmo, 1u); break; } } } }
    asm volatile("" ::: "memory");
    float sc[4];
#pragma unroll
    for (int c = 0; c < 4; ++c) { const float cm = __uint_as_float(__hip_atomic_load(cmax + n0 + 4 * nq + c, RLX_AGENT)); sc[c] = cm > 0.f ? 127.0f / cm : 0.f; if (write_cs && kc == 0) cs[n0 + 4 * nq + c] = cm * (1.0f / 127.0f); }
    const int nb = n0 + 32 * (nq >> 3);
    const int rowb = pos_gen(nb) + ((4 * nq) & 31);
#pragma unroll
    for (int c = 0; c < 4; ++c) {
        u32x4 o;
        o.x = pack_i8((f32x4){v[0][c], v[1][c], v[2][c], v[3][c]} * sc[c]); o.y = pack_i8((f32x4){v[4][c], v[5][c], v[6][c], v[7][c]} * sc[c]);
        o.z = pack_i8((f32x4){v[8][c], v[9][c], v[10][c], v[11][c]} * sc[c]); o.w = pack_i8((f32x4){v[12][c], v[13][c], v[14][c], v[15][c]} * sc[c]);
        *(u32x4*)(WT + (size_t)(rowb + c) * D + k0 + 16 * kc) = o;
    }
}
template <int MODE, int POSK>
__device__ __forceinline__ void tr_tile(const float* W, int N, int k0, int n0, unsigned char* WT, int ldt_bytes, int dk0, const float* ks, float wscale, int lane, int rowadj = 0) {
    const int kc = lane >> 4, nq = lane & 15;
    f32x4 v[16];
#pragma unroll
    for (int i = 0; i < 16; ++i) { const int kk = MODE ? (16 * kc + i) : (32 * (i >> 3) + 8 * kc + (i & 7)); v[i] = *(const f32x4*)(W + (size_t)(k0 + kk) * N + n0 + 4 * nq); }
    if (ks) {
#pragma unroll
        for (int i = 0; i < 16; ++i) { const int kk = MODE ? (16 * kc + i) : (32 * (i >> 3) + 8 * kc + (i & 7)); v[i] = v[i] * (ks[k0 + kk] * wscale); }
    } else if (MODE) {
#pragma unroll
        for (int i = 0; i < 16; ++i) v[i] = v[i] * wscale;
    }
    const int nb = n0 + 32 * (nq >> 3);
    const int rowb = (POSK ? pos_gu(nb) : pos_gen(nb)) + ((4 * nq) & 31) + rowadj;
#pragma unroll
    for (int c = 0; c < 4; ++c) {
        unsigned char* rp = WT + (size_t)(rowb + c) * ldt_bytes;
        if (MODE == 0) {
#pragma unroll
            for (int p = 0; p < 2; ++p) { u32x4 o; o.x = pk2(v[8 * p + 0][c], v[8 * p + 1][c]); o.y = pk2(v[8 * p + 2][c], v[8 * p + 3][c]); o.z = pk2(v[8 * p + 4][c], v[8 * p + 5][c]); o.w = pk2(v[8 * p + 6][c], v[8 * p + 7][c]);
                *(u32x4*)(rp + (size_t)(dk0 + 32 * p + 8 * kc) * 2) = o; }
        } else {
            int w0 = 0, w1 = 0, w2 = 0, w3 = 0;
            w0 = __builtin_amdgcn_cvt_pk_fp8_f32(v[0][c], v[1][c], w0, false); w0 = __builtin_amdgcn_cvt_pk_fp8_f32(v[2][c], v[3][c], w0, true);
            w1 = __builtin_amdgcn_cvt_pk_fp8_f32(v[4][c], v[5][c], w1, false); w1 = __builtin_amdgcn_cvt_pk_fp8_f32(v[6][c], v[7][c], w1, true);
            w2 = __builtin_amdgcn_cvt_pk_fp8_f32(v[8][c], v[9][c], w2, false); w2 = __builtin_amdgcn_cvt_pk_fp8_f32(v[10][c], v[11][c], w2, true);
            w3 = __builtin_amdgcn_cvt_pk_fp8_f32(v[12][c], v[13][c], w3, false); w3 = __builtin_amdgcn_cvt_pk_fp8_f32(v[14][c], v[15][c], w3, true);
            *(u32x4*)(rp + (size_t)(dk0 + 16 * kc)) = (u32x4){(unsigned)w0, (unsigned)w1, (unsigned)w2, (unsigned)w3};
        }
    }
}

struct Args { const float* in[20]; float* out; unsigned char* ws; int ph_lo, ph_hi, li, pad; };

__global__ void __launch_bounds__(512, 2) moe_block_fwd(Args args) {
    extern __shared__ __attribute__((aligned(16))) unsigned char lds_raw[];
    LAS unsigned char* lds = (LAS unsigned char*)lds_raw;
    volatile LAS unsigned* MISC = (volatile LAS unsigned*)(lds + MISC_OFF);
    const int tid = threadIdx.x, lane = tid & 63, wave = __builtin_amdgcn_readfirstlane(tid >> 6);
    const int G = gridDim.x, bx = blockIdx.x;
    const int vcu = (G % 8 == 0) ? (bx % 8) * (G / 8) + bx / 8 : bx;
    unsigned char* ws = args.ws;
    gu32* ctl = (gu32*)(ws + WS_CTL);
    const float* x = args.in[0]; const float* norm1_g = args.in[1]; const float* w_in = args.in[2]; const float* q_norm_g = args.in[3]; const float* k_norm_g = args.in[4];
    const float* rel_bias = args.in[5]; const float* sg_ln_g = args.in[6]; const float* sg_ln_b = args.in[7]; const float* sg_w = args.in[8]; const float* sg_b = args.in[9];
    const float* w_branch_a = args.in[10]; const float* w_branch_b = args.in[11]; const float* w_out = args.in[12]; const float* norm2_g = args.in[13];
    const float* router_w = args.in[14]; const float* router_b = args.in[15]; const float* w_gate_up = args.in[16]; const float* b_gate_up = args.in[17];
    const float* w_down = args.in[18]; const float* b_down = args.in[19];
    float* out = args.out;
    bf16* WIN = (bf16*)(ws + WS_WIN); unsigned char* WIN8 = ws + WS_WIN8; float* HS = (float*)(ws + WS_HS); float* CS = (float*)(ws + WS_CS); unsigned char* H8 = ws + WS_H8; bf16* WAB = (bf16*)(ws + WS_WAB); bf16* WO = (bf16*)(ws + WS_WO); bf16* WRH = (bf16*)(ws + WS_WR); bf16* WRL = (bf16*)(ws + WS_WR + 65536); bf16* WM = (bf16*)(ws + WS_WM);
    int* LID = (int*)(ws + WS_LID); float* LRS = (float*)(ws + WS_LRS); float* LP = (float*)(ws + WS_LP);
    unsigned char* WGU = ws + WS_WGU; unsigned char* WD = ws + WS_WD;
    bf16* HB = (bf16*)(ws + WS_H); bf16* QB = (bf16*)(ws + WS_Q); bf16* KB = (bf16*)(ws + WS_K); bf16* VB = (bf16*)(ws + WS_V);
    bf16* UG = (bf16*)(ws + WS_UG); bf16* VG = (bf16*)(ws + WS_VG); unsigned char* GA = ws + WS_GA; bf16* GB = (bf16*)(ws + WS_GB);
    bf16* YCAT = (bf16*)(ws + WS_YCAT); unsigned char* X1Q = ws + WS_X1B; bf16* X1H = (bf16*)(ws + WS_X1H); unsigned char* ACT = ws + WS_ACT; unsigned char* YB = ws + WS_Y;

    for (int u = tid; u < (LDS_BYTES - LDSCTL_OFF) / 4; u += 512) ((LAS unsigned*)(lds + LDSCTL_OFF))[u] = 0u;
    __syncthreads();
    XcdBarrier bar; bar.bar = (unsigned*)(ctl + CW_BAR); bar.x = 0; bar.st = nullptr;
    if (MK_N_LAUNCHES == 1) bar = xcd_barrier_post((unsigned*)(ctl + CW_BAR), MISC + 8);
    const int lo = args.ph_lo, hi = args.ph_hi;
#define IN(k) (lo <= (k) && (k) < hi)
#define SEAM(k) do { if (IN(k) && IN((k) + 1)) xcd_barrier(bar); } while (0)
#define REPS(k) for (int rep_ = 0; rep_ < ((REP_PHASE == (k)) ? 2 : 1); ++rep_)
#define REPSEAM(k) do { if (REP_PHASE == (k) && rep_ == 0) xcd_barrier(bar); } while (0)
    const int gw = vcu * 8 + wave, NGW = G * 8;

    if (IN(0)) REPS(0) {
        constexpr int I_IN = 16 * 72, I_A = 8 * 16, I_O = 16 * 16, I_GU = 16 * 32, I_D = 16 * 16;
        constexpr int NITEMS = I_IN + 2 * I_A + I_O;
        for (int it = gw; it < NITEMS; it += NGW) {
            int r = it;
            if (r < I_IN) { const int kb = r / 72, nb = r % 72; win_absmax(w_in, 64 * kb, 64 * nb, (unsigned*)(ctl + CW_CMAX), (unsigned*)(ctl + CW_CCNT + nb), lane); continue; } r -= I_IN;
            if (r < I_A) { const int kb = r / 16, nb = r % 16; tr_tile<0, 0>(w_branch_a, D, 64 * kb, 64 * nb, (unsigned char*)WAB, D * 2, 64 * kb, nullptr, 1.f, lane); continue; } r -= I_A;
            if (r < I_A) { const int kb = r / 16, nb = r % 16; tr_tile<0, 0>(w_branch_b, D, 64 * kb, 64 * nb, (unsigned char*)WAB, D * 2, 512 + 64 * kb, nullptr, 1.f, lane); continue; } r -= I_A;
            { const int kb = r / 16, nb = r % 16; tr_tile<0, 0>(w_out, D, 64 * kb, 64 * nb, (unsigned char*)WO, D * 2, 64 * kb, nullptr, 1.f, lane); }
        }
        for (int i = gw * 64 + lane; i < 4 * 128 * 128; i += NGW * 64) { const int s = i & 127, t = (i >> 7) & 127; WM[i] = (bf16)f2bf(s <= t ? sg_w[i] : 0.f); }
        for (int i = gw * 64 + lane; i < NE * D; i += NGW * 64) { const int k = i & 1023, e = i >> 10; const float w = router_w[k * NE + e] * norm2_g[k]; const unsigned h_ = f2bf(w); WRH[i] = (bf16)h_; WRL[i] = (bf16)f2bf(w - bf2f((unsigned short)h_)); }
        for (int m = 2 * gw; m < T; m += 2 * NGW) {
            const f32x4* xr = (const f32x4*)(x + (size_t)m * D) + lane; const f32x4* gr = (const f32x4*)norm1_g + lane;
            f32x4 v[2][4]; float s0 = 0.f, s1 = 0.f, a0 = 0.f, a1 = 0.f;
#pragma unroll
            for (int j = 0; j < 4; ++j) { v[0][j] = xr[64 * j]; v[1][j] = xr[256 + 64 * j]; }
#pragma unroll
            for (int j = 0; j < 4; ++j) { const f32x4 gq = gr[64 * j];
                s0 += (v[0][j].x * v[0][j].x + v[0][j].y * v[0][j].y) + (v[0][j].z * v[0][j].z + v[0][j].w * v[0][j].w);
                s1 += (v[1][j].x * v[1][j].x + v[1][j].y * v[1][j].y) + (v[1][j].z * v[1][j].z + v[1][j].w * v[1][j].w);
                v[0][j] = v[0][j] * gq; v[1][j] = v[1][j] * gq;
                a0 = fmaxf(a0, fmaxf(fmaxf(fabsf(v[0][j].x), fabsf(v[0][j].y)), fmaxf(fabsf(v[0][j].z), fabsf(v[0][j].w))));
                a1 = fmaxf(a1, fmaxf(fmaxf(fabsf(v[1][j].x), fabsf(v[1][j].y)), fmaxf(fabsf(v[1][j].z), fabsf(v[1][j].w)))); }
            s0 = wave_sum(s0); s1 = wave_sum(s1);
#pragma unroll
            for (int o = 1; o < 64; o <<= 1) { a0 = fmaxf(a0, __shfl_xor(a0, o)); a1 = fmaxf(a1, __shfl_xor(a1, o)); }
            const float rs0 = 1.0f / sqrtf(s0 * (1.0f / D) + EPS), rs1 = 1.0f / sqrtf(s1 * (1.0f / D) + EPS);
            const float q0 = a0 > 0.f ? 127.0f / a0 : 0.f, q1 = a1 > 0.f ? 127.0f / a1 : 0.f;
            if (lane == 0) { HS[m] = rs0 * a0 * (1.0f / 127.0f); HS[m + 1] = rs1 * a1 * (1.0f / 127.0f); }
            unsigned* q8 = (unsigned*)(H8 + (size_t)m * D) + lane;
#pragma unroll
            for (int j = 0; j < 4; ++j) { q8[64 * j] = pack_i8(v[0][j] * q0); q8[256 + 64 * j] = pack_i8(v[1][j] * q1); }
        }
        for (int it = gw; it < I_IN; it += NGW) { const int kb = it / 72, nb = it % 72;
            win_quant(w_in, 64 * kb, 64 * nb, WIN8, (unsigned*)(ctl + CW_CMAX), (unsigned*)(ctl + CW_CCNT + nb), CS, kb == 0, (unsigned*)(ctl + CW_BAR) + XB_TMO, lane); }
        REPSEAM(0);
    }
    SEAM(0);

    if (IN(1)) REPS(1) {
        { PolIn P; P.so.init(T, INW, G, bx); P.A = H8; P.Bt = WIN8; P.ws = ws; P.qg = q_norm_g; P.kg = k_norm_g; P.hs = HS; P.cs = CS;
          pg8::gemm_phase<PolIn>(lds, P); }
        REPSEAM(1);
    }
    SEAM(1);

    if (IN(2)) REPS(2) {
        const MoeConv cv{w_gate_up, w_down, norm2_g, WGU, WD}; MoeConv::Regs sreg; int sctr = 0;
        for (int u = vcu; u < NB * NHEAD * 32; u += G) {
            const int cg = u & 31, bh = u >> 5;
            att::unit(bh >> 3, bh & 7, cg, QB, KB, VB, rel_bias, YCAT, lds, cv, sreg, sctr, gw, NGW);
        }
        sgu_load_wm(vcu & 3, WM, lds);
        for (int it = vcu; it < 4 * (T / 128); it += G) sgu_item(it, VG, UG, sg_ln_g, sg_ln_b, sg_b, YCAT, lds, cv, sreg, sctr, gw, NGW);
        cv.drain(sreg, sctr, gw, NGW, lane);
        REPSEAM(2);
    }
    SEAM(2);

    if (IN(3)) REPS(3) {
        PolMerge P; P.so.init(T, D, G, bx); P.A = YCAT; P.Bt = WAB; P.ga = GA; P.gb = (const unsigned char*)GB; P.out = HB;
        pg8::gemm_phase<PolMerge>(lds, P);
        REPSEAM(3);
    }
    SEAM(3);

    if (IN(4)) REPS(4) {
        PolOut P; P.so.init(T, D, G, bx); P.A = HB; P.Bt = WO; P.x = x; P.x1 = X1H; P.x1q = X1Q;
        pg8::gemm_phase<PolOut>(lds, P);
        REPSEAM(4);
    }
    SEAM(4);

    if (IN(5)) {
        LAS int* lcnt = (LAS int*)(lds + PARK_OFF); LAS int* gbase = lcnt + 32;
        if (tid < 64) lcnt[tid] = 0;
        for (int i = tid; i < 4096; i += 512) { const int e = i & 31, gq = (i >> 5) & 3, kq = i >> 7;
            *(LAS u32x4*)(lds + (size_t)i * 16) = *(const u32x4*)(WRH + (size_t)e * D + 32 * kq + 8 * gq); *(LAS u32x4*)(lds + 65536 + (size_t)i * 16) = *(const u32x4*)(WRL + (size_t)e * D + 32 * kq + 8 * gq); }
        __syncthreads();
        const int r = lane & 15, g = lane >> 4;
        int sel_e[4], sel_rank[4]; float sel_p[4]; float rs_row = 0.f; int tok = 0;
        for (int grp = bx * 8 + wave; grp < T / 16; grp += NGW) {
            const int row0 = grp * 16; tok = row0 + r;
            const bf16* xr = X1H + (size_t)(row0 + r) * D + 8 * g;
            const LAS unsigned char* wl_ = lds + (g * 32 + r) * 16;
            f32x4 a0 = (f32x4){0.f, 0.f, 0.f, 0.f}, a1 = a0; float ssq = 0.f;
            u32x4 xq[4][4];
#define P5_LOAD(S, ss) do { _Pragma("unroll") for (int q = 0; q < 4; ++q) xq[S][q] = *(const u32x4*)(xr + 128 * (ss) + 32 * q); } while (0)
#define P5_COMP(S, ss) do { _Pragma("unroll") for (int q = 0; q < 4; ++q) { const u32x4 w_ = xq[S][q]; const int ks = 4 * (ss) + q; \
                const bf16x8 wh_0 = *(const LAS bf16x8*)(wl_ + ks * 2048), wh_1 = *(const LAS bf16x8*)(wl_ + ks * 2048 + 256), wl_0 = *(const LAS bf16x8*)(wl_ + 65536 + ks * 2048), wl_1 = *(const LAS bf16x8*)(wl_ + 65536 + ks * 2048 + 256); \
                ssq += (bflo(w_.x) * bflo(w_.x) + bfhi(w_.x) * bfhi(w_.x)) + (bflo(w_.y) * bflo(w_.y) + bfhi(w_.y) * bfhi(w_.y)) + (bflo(w_.z) * bflo(w_.z) + bfhi(w_.z) * bfhi(w_.z)) + (bflo(w_.w) * bflo(w_.w) + bfhi(w_.w) * bfhi(w_.w)); \
                const bf16x8 xh = __builtin_bit_cast(bf16x8, w_); \
                a0 = __builtin_amdgcn_mfma_f32_16x16x32_bf16(wh_0, xh, a0, 0, 0, 0); a1 = __builtin_amdgcn_mfma_f32_16x16x32_bf16(wh_1, xh, a1, 0, 0, 0); \
                a0 = __builtin_amdgcn_mfma_f32_16x16x32_bf16(wl_0, xh, a0, 0, 0, 0); a1 = __builtin_amdgcn_mfma_f32_16x16x32_bf16(wl_1, xh, a1, 0, 0, 0); } } while (0)
            P5_LOAD(0, 0); P5_LOAD(1, 1); P5_LOAD(2, 2); P5_LOAD(3, 3);
            P5_COMP(0, 0); P5_LOAD(0, 4);
            P5_COMP(1, 1); P5_LOAD(1, 5);
            P5_COMP(2, 2); P5_LOAD(2, 6);
            P5_COMP(3, 3); P5_LOAD(3, 7);
            P5_COMP(0, 4); P5_COMP(1, 5); P5_COMP(2, 6); P5_COMP(3, 7);
#undef P5_LOAD
#undef P5_COMP
            ssq += __shfl_xor(ssq, 16); ssq += __shfl_xor(ssq, 32);
            const float rs = 1.0f / sqrtf(ssq * (1.0f / D) + EPS); rs_row = rs;
            float v[8];
#pragma unroll
            for (int j = 0; j < 4; ++j) { v[j] = a0[j] * rs + router_b[4 * g + j]; v[4 + j] = a1[j] * rs + router_b[16 + 4 * g + j]; }
            unsigned taken = 0u; float sel_v[4];
#pragma unroll
            for (int k = 0; k < 4; ++k) {
                float best = -INFINITY; int bi = 1 << 20;
#pragma unroll
                for (int i = 0; i < 8; ++i) { const int ei = (i >> 2) * 16 + 4 * g + (i & 3); if (!((taken >> i) & 1u) && v[i] > best) { best = v[i]; bi = ei; } }
#pragma unroll
                for (int m = 16; m <= 32; m <<= 1) { const float ob = __shfl_xor(best, m); const int oi = __shfl_xor(bi, m); if (ob > best || (ob == best && oi < bi)) { best = ob; bi = oi; } }
                sel_e[k] = bi; sel_v[k] = best;
                if (((bi & 15) >> 2) == g) taken |= 1u << (((bi >> 4) << 2) | (bi & 3));
            }
            float den = 0.f;
#pragma unroll
            for (int k = 0; k < 4; ++k) { sel_p[k] = __expf(sel_v[k] - sel_v[0]); den += sel_p[k]; }
            const float inv = 1.0f / den;
#pragma unroll
            for (int k = 0; k < 4; ++k) sel_p[k] *= inv;
            if (g == 0) {
#pragma unroll
                for (int k = 0; k < 4; ++k) sel_rank[k] = __hip_atomic_fetch_add(lcnt + sel_e[k], 1, __ATOMIC_RELAXED, __HIP_MEMORY_SCOPE_WORKGROUP);
            }
        }
        __syncthreads();
        if (tid < NE) gbase[tid] = (int)__hip_atomic_fetch_add((unsigned*)(ctl + CW_CNT + tid), (unsigned)lcnt[tid], RLX_AGENT);
        __syncthreads();
        if (g == 0 && (bx * 8 + wave) < T / 16) {
#pragma unroll
            for (int k = 0; k < 4; ++k) { const size_t pos = (size_t)sel_e[k] * LCAP + gbase[sel_e[k]] + sel_rank[k];
                LID[pos] = tok * 4 + k; LRS[pos] = rs_row; LP[pos] = sel_p[k]; }
        }
        __syncthreads();
    }
    SEAM(5);

    if (IN(6) || IN(7)) {
        LAS int* tb = (LAS int*)(lds + MOE_OFF);
        if (tid < NE) tb[33 + tid] = (int)__hip_atomic_load(ctl + CW_CNT + tid, RLX_AGENT);
        __syncthreads();
        if (tid == 0) { int acc = 0; for (int e = 0; e < NE; ++e) { tb[e] = acc; acc += (tb[33 + e] + 255) >> 8; } tb[32] = acc;
            bool reg = (MK_N_LAUNCHES == 1) && (G % 16 == 0);
            unsigned* xb = (unsigned*)(ctl + CW_BAR);
            for (int j = 0; j < 16; ++j) { const unsigned cx = xb_ld(&xb[XB_XCNT(j)]); reg = reg && (cx == (j < 8 ? (unsigned)(G / 8) : 0u)); }
            MISC[12] = reg ? 1u : 0u; MISC[13] = reg ? (bar.x + 8u * MISC[10]) : (unsigned)bx; }
        __syncthreads();
    }
    const bool moe_reg = (MISC[12] != 0u); const int moe_c = (int)MISC[13];
    if (IN(6)) REPS(6) {
        PolGU P; P.mo.init((const LAS int*)(lds + MOE_OFF), 8, G, moe_c); P.A = X1Q; P.Bt = WGU; P.lid = LID; P.lrs = LRS; P.bgu = b_gate_up; P.act = ACT; P.tcnt = (unsigned*)(ctl + CW_TILE);
        pg8::gemm_phase<PolGU>(lds, P);
        REPSEAM(6);
    }
    if (!moe_reg) SEAM(6);
    if (IN(7)) REPS(7) {
        if (moe_reg) { if (tid == 0) { __builtin_amdgcn_fence(__ATOMIC_ACQUIRE, "agent"); asm volatile("s_waitcnt vmcnt(0)" ::: "memory"); } __syncthreads(); }
        PolDown P; P.mo.init((const LAS int*)(lds + MOE_OFF), 4, G, (G % 16 == 0) ? (moe_c + G / 2) % G : moe_c); P.A = ACT; P.Bt = WD; P.lid = LID; P.lp = LP; P.bd = b_down; P.y = YB; P.tcnt = (unsigned*)(ctl + CW_TILE); P.tmo = (unsigned*)(ctl + CW_BAR) + XB_TMO;
        pg8::gemm_phase<PolDown>(lds, P);
        REPSEAM(7);
    }
    SEAM(7);
    if (IN(8)) {
        f32x4 xa[4], xb[4]; u32x4 ya[4], yb[4];
#define P8_LOAD(X, Y, m_) do { const bf16* xr_ = X1H + (size_t)(m_) * D + 16 * lane; { f32x4 a_, b_; ld8(xr_, a_, b_); X[0] = a_; X[1] = b_; ld8(xr_ + 8, a_, b_); X[2] = a_; X[3] = b_; } \
            _Pragma("unroll") for (int k = 0; k < 4; ++k) Y[k] = *(const u32x4*)(YB + ((size_t)(m_) * 4 + k) * D + 16 * lane); } while (0)
#define P8_DONE(X, Y, m_) do { _Pragma("unroll") for (int k = 0; k < 4; ++k) { const unsigned ww[4] = {Y[k].x, Y[k].y, Y[k].z, Y[k].w}; \
            _Pragma("unroll") for (int q = 0; q < 4; ++q) { const f32x2 lo_ = __builtin_amdgcn_cvt_pk_f32_fp8((int)ww[q], false), hi_ = __builtin_amdgcn_cvt_pk_f32_fp8((int)ww[q], true); \
                X[q][0] += lo_[0] * 0.0625f; X[q][1] += lo_[1] * 0.0625f; X[q][2] += hi_[0] * 0.0625f; X[q][3] += hi_[1] * 0.0625f; } } \
            float* or_ = out + (size_t)(m_) * D + 16 * lane; _Pragma("unroll") for (int j = 0; j < 4; ++j) *(f32x4*)(or_ + 4 * j) = X[j]; } while (0)
        for (int m = gw; m < T; m += 2 * NGW) { const int m2 = m + NGW;
            P8_LOAD(xa, ya, m); P8_LOAD(xb, yb, m2);
            P8_DONE(xa, ya, m); P8_DONE(xb, yb, m2); }
#undef P8_LOAD
#undef P8_DONE
    }
#undef IN
#undef SEAM
}

extern "C" void kernel_launch(void* const* d_in, const int* in_sizes, int n_in, void* d_out, int out_size, void* d_ws, size_t ws_size, hipStream_t stream) {
    static int grid = 0;
    if (grid == 0) {
        if (n_in != 20 || in_sizes[0] != T * D || out_size != T * D || ws_size < WS_END) { fprintf(stderr, "kernel_launch: unexpected shapes (n_in %d, ws %zu)\n", n_in, ws_size); grid = -1; return; }
        int dev = 0, cus = 0;
        if (hipGetDevice(&dev) != hipSuccess || hipDeviceGetAttribute(&cus, hipDeviceAttributeMultiprocessorCount, dev) != hipSuccess) { grid = -1; return; }
        if (hipFuncSetAttribute((const void*)moe_block_fwd, hipFuncAttributeMaxDynamicSharedMemorySize, LDS_BYTES) != hipSuccess) { fprintf(stderr, "kernel_launch: hipFuncSetAttribute failed\n"); grid = -1; return; }
        (void)hipGetLastError();
        grid = cus;
        if (grid != 256) { fprintf(stderr, "kernel_launch: built for a 256-CU device, got %d\n", cus); grid = -1; return; }
    }
    if (grid < 0) return;
    if (hipMemsetAsync((char*)d_ws + WS_CTL, 0, CTL_ZERO_BYTES, stream) != hipSuccess) return;
    Args a{};
    for (int i = 0; i < 20; ++i) a.in[i] = (const float*)d_in[i];
    a.out = (float*)d_out; a.ws = (unsigned char*)d_ws;
    constexpr int NPH = 9;
    for (int li = 0; li < MK_N_LAUNCHES; ++li) {
        a.ph_lo = (MK_N_LAUNCHES == 1) ? 0 : li; a.ph_hi = (MK_N_LAUNCHES == 1) ? NPH : li + 1; a.li = li;
        hipLaunchKernelGGL(moe_block_fwd, dim3(grid), dim3(512), LDS_BYTES, stream, a);
    }
}
```

```cpp
#include <hip/hip_runtime.h>
#include <cstdio>
#include <cstdint>

#ifndef MK_N_LAUNCHES
#define MK_N_LAUNCHES 1
#endif

#ifndef REP_PHASE
#define REP_PHASE -1
#endif
#define LAS __attribute__((address_space(3)))
#define GAS __attribute__((address_space(1)))
typedef unsigned short bf16;
typedef short bf16x8 __attribute__((ext_vector_type(8)));
typedef short s16x4 __attribute__((ext_vector_type(4)));
typedef float f32x2 __attribute__((ext_vector_type(2)));
typedef float f32x4 __attribute__((ext_vector_type(4)));
typedef float f32x16 __attribute__((ext_vector_type(16)));
typedef unsigned u32x2 __attribute__((ext_vector_type(2)));
typedef unsigned u32x4 __attribute__((ext_vector_type(4)));
typedef GAS unsigned gu32;

constexpr int NB = 4, SEQ = 8192, T = NB * SEQ, D = 1024, AW = 512, SGW = 512, INW = 4608, NE = 32, FF = 1024;
constexpr int NHEAD = 8, HD = 64, CHUNK = 64, NBACK = 8, NREL = 513;
constexpr int LCAP = 32768;
constexpr float LOG2E = 1.4426950408889634f;
constexpr float EPS = 1e-6f;

constexpr size_t MiB = 1u << 20;
constexpr size_t WS_CTL = 0, CTL_ZERO_BYTES = 1 * MiB;
constexpr size_t WS_WIN = 7 * MiB;
constexpr size_t WS_WAB = 11 * MiB;
constexpr size_t WS_WO = 13 * MiB;
constexpr size_t WS_WR = 15 * MiB;
constexpr size_t WS_WM = 15 * MiB + 256 * 1024;
constexpr size_t WS_WIN8 = 2 * MiB;
constexpr size_t WS_HS = 15 * MiB + 512 * 1024;
constexpr size_t WS_CS = 15 * MiB + 768 * 1024;
constexpr size_t WS_H8 = 976 * MiB;
constexpr size_t WS_LID = 16 * MiB;
constexpr size_t WS_LRS = 20 * MiB;
constexpr size_t WS_LP = 24 * MiB;
constexpr size_t WS_WGU = 28 * MiB;
constexpr size_t WS_WD = 156 * MiB;
constexpr size_t WS_H = 220 * MiB;
constexpr size_t WS_Q = 284 * MiB, WS_K = 316 * MiB, WS_V = 348 * MiB;
constexpr size_t WS_UG = 380 * MiB, WS_VG = 412 * MiB;
constexpr size_t WS_GA = 444 * MiB, WS_GB = 508 * MiB;
constexpr size_t WS_YCAT = 572 * MiB;
constexpr size_t WS_X1B = 636 * MiB;
constexpr size_t WS_ACT = 700 * MiB;
constexpr size_t WS_X1H = 380 * MiB;
constexpr size_t WS_Y = 220 * MiB;
constexpr size_t WS_END = 1008 * MiB;
constexpr int CW_TMO = 0, CW_CODE = 1;
constexpr int CW_CNT = 64;
constexpr int CW_BAR = 4096;
constexpr int CW_CMAX = 8192;
constexpr int CW_CCNT = 16384;

constexpr int RING_BYTES = 131072;
constexpr int LDSCTL_OFF = RING_BYTES, MISC_OFF = LDSCTL_OFF + 320;
constexpr int MOE_OFF = MISC_OFF + 128;
constexpr int PARK_OFF = LDSCTL_OFF + 1024;
constexpr int ROWS_OFF = LDSCTL_OFF + 9216;
constexpr int LDS_BYTES = 147456;

#define LDS_WAIT() asm volatile("s_waitcnt lgkmcnt(0)" ::: "memory")
#define VM_WAIT() asm volatile("s_waitcnt vmcnt(0)" ::: "memory")
#define RLX_AGENT __ATOMIC_RELAXED, __HIP_MEMORY_SCOPE_AGENT

__device__ __forceinline__ unsigned f2bf(float f) { unsigned u = __builtin_bit_cast(unsigned, f); return (u + 0x7fffu + ((u >> 16) & 1u)) >> 16; }
__device__ __forceinline__ unsigned pk2(float lo, float hi) { return f2bf(lo) | (f2bf(hi) << 16); }
__device__ __forceinline__ float bf2f(unsigned short b) { return __builtin_bit_cast(float, (unsigned)b << 16); }
__device__ __forceinline__ float bflo(unsigned w) { return __builtin_bit_cast(float, w << 16); }
__device__ __forceinline__ float bfhi(unsigned w) { return __builtin_bit_cast(float, w & 0xffff0000u); }
__device__ __forceinline__ unsigned cvt_pk_bf16(float lo, float hi) { unsigned r; asm volatile("v_cvt_pk_bf16_f32 %0, %1, %2" : "=v"(r) : "v"(lo), "v"(hi)); return r; }
__device__ __forceinline__ float fast_rcp(float x) { return __builtin_amdgcn_rcpf(x); }
__device__ __forceinline__ float fast_exp2(float x) { return __builtin_amdgcn_exp2f(x); }
__device__ __forceinline__ float sigmoidf_(float x) { return fast_rcp(1.0f + fast_exp2(-LOG2E * x)); }
__device__ __forceinline__ float gelu_tanh(float x) {
    const float t = x * ((-LOG2E * 1.5957691216057308f) + (-LOG2E * 1.5957691216057308f * 0.044715f) * (x * x));
    return x * fast_rcp(1.0f + fast_exp2(t));
}

namespace pg8 {
constexpr int BM = 256, BK = 64, HALF = 128, HTB = HALF * BK * 2, STAGE_BYTES = 8 * HTB, NXCD = 8, WGM = 8;
__host__ __device__ __forceinline__ int lds_byte(int r, int c) { const int st = (r >> 4) * 2 + (c >> 5), rr = r & 15, cc = c & 31, ob = rr * 64 + cc * 2; return st * 1024 + (ob ^ (((ob >> 9) & 1) << 5)); }
__host__ __device__ __forceinline__ void stage_rc(int b, int& R, int& C) { const int st = b / 1024, sb = b % 1024, swz = sb ^ (((sb >> 9) & 1) << 5); R = (st >> 1) * 16 + swz / 64; C = (st & 1) * 32 + (swz % 64) / 2; }
__host__ __device__ __forceinline__ int perm32(int rho) { const int n = rho >> 4, i = rho & 15; return 8 * (i >> 2) + 4 * n + (i & 3); }

typedef int v4i_t __attribute__((ext_vector_type(4)));
typedef int v8i_t __attribute__((ext_vector_type(8)));
__device__ __forceinline__ v8i_t cat8(bf16x8 lo, bf16x8 hi) { return __builtin_shufflevector(__builtin_bit_cast(v4i_t, lo), __builtin_bit_cast(v4i_t, hi), 0, 1, 2, 3, 4, 5, 6, 7); }
struct Unit { int pm, pn, e, s0, cnt, idx; };

struct StaticOrder {
    int nM, nN, nwg, G, c;
    __device__ void init(int M, int N, int G_, int c_) { nM = M / BM; nN = N / BM; nwg = nM * nN; G = G_; c = c_; }
    __device__ bool tile(int i, int& pm, int& pn) const {
        const long L = (long)i * G + c; if (L >= nwg) return false;
        int wgid = (int)L; { const int q = nwg / NXCD, r = nwg % NXCD, xcd = wgid % NXCD, off = wgid / NXCD; wgid = (xcd < r ? xcd * (q + 1) : r * (q + 1) + (xcd - r) * q) + off; }
        const int nig = WGM * nN, gid = wgid / nig, fm = gid * WGM, gsz = (nM - fm) < WGM ? (nM - fm) : WGM;
        pm = fm + ((wgid % nig) % gsz); pn = (wgid % nig) / gsz; return true;
    }
};

template <class P>
__device__ __forceinline__ void gemm_phase(LAS unsigned char* lds, const P& S) {
    const int tid = threadIdx.x, wid = __builtin_amdgcn_readfirstlane(tid >> 6), lane = tid & 63, wr = wid >> 2, wc = wid & 3, fr = lane & 15, fq = lane >> 4;
    constexpr int nt = P::NT;
    unsigned vA[2][2], voffB[2];
    LAS u32x4* park = (LAS u32x4*)(lds + PARK_OFF) + tid;
#pragma unroll
    for (int i = 0; i < 2; ++i) { int R, C; stage_rc(tid * 16 + i * 8192, R, C); const int Rb = (R & ~31) + perm32(R & 31);
        vA[0][i] = (unsigned)(R * P::LDA + C) * 2u; vA[1][i] = (unsigned)((R + HALF) * P::LDA + C) * 2u; voffB[i] = (unsigned)(Rb * P::LDB + C) * 2u; }
    const size_t kstep = (size_t)(BK * 2);
    const size_t hstepB = (size_t)HALF * P::LDB * 2;
    const unsigned ldsw = (unsigned)wid * 1024u;
    const int aoff = lds_byte(wr * 64 + fr, fq * 8), boff = lds_byte(wc * 32 + fr, fq * 8);
#define PG8_SA(b, h) (((b) * 2 + (h)) * HTB)
#define PG8_SB(b, h) ((4 + (b) * 2 + (h)) * HTB)
#define PG8_STAGE2(bufoff, gbase, o0, o1) do { \
        __builtin_amdgcn_global_load_lds((const unsigned*)((const char*)(gbase) + (o0)), (LAS unsigned*)(lds + (bufoff) + ldsw), 16, 0, 0); \
        __builtin_amdgcn_global_load_lds((const unsigned*)((const char*)(gbase) + (o1)), (LAS unsigned*)(lds + (bufoff) + ldsw + 8192), 16, 0, 0); } while (0)
#define PG8_STAGEB(bufoff, gbase) PG8_STAGE2(bufoff, gbase, voffB[0], voffB[1])
#define PG8_LDA(dst, b, h) do { _Pragma("unroll") for (int m = 0; m < 4; ++m) _Pragma("unroll") for (int k = 0; k < 2; ++k) dst[m][k] = *(const LAS bf16x8*)(lds + PG8_SA(b, h) + aoff + m * 2048 + k * 1024); } while (0)
#define PG8_LDB(dst, b, h) do { _Pragma("unroll") for (int n = 0; n < 2; ++n) _Pragma("unroll") for (int k = 0; k < 2; ++k) dst[n][k] = *(const LAS bf16x8*)(lds + PG8_SB(b, h) + boff + n * 2048 + k * 1024); } while (0)
#define PG8_MMA(ai, bj, At, Bt) do { __builtin_amdgcn_s_setprio(1); _Pragma("unroll") for (int m = 0; m < 4; ++m) _Pragma("unroll") for (int n = 0; n < 2; ++n) { \
        if constexpr (P::I8) { _Pragma("unroll") for (int k = 0; k < 2; ++k) acc[ai][bj][m][n] = __builtin_bit_cast(f32x4, __builtin_amdgcn_mfma_i32_16x16x64_i8(__builtin_bit_cast(v4i_t, Bt[n][k]), __builtin_bit_cast(v4i_t, At[m][k]), __builtin_bit_cast(v4i_t, acc[ai][bj][m][n]), 0, 0, 0)); }     \
        else if constexpr (P::FP8) { acc[ai][bj][m][n] = __builtin_amdgcn_mfma_scale_f32_16x16x128_f8f6f4(cat8(Bt[n][0], Bt[n][1]), cat8(At[m][0], At[m][1]), acc[ai][bj][m][n], 0, 0, 0, 0, 0, 0); }     \
        else { _Pragma("unroll") for (int k = 0; k < 2; ++k) acc[ai][bj][m][n] = __builtin_amdgcn_mfma_f32_16x16x32_bf16(Bt[n][k], At[m][k], acc[ai][bj][m][n], 0, 0, 0); } } \
        __builtin_amdgcn_s_setprio(0); } while (0)
#define PG8_WAIT_V(n) asm volatile("s_waitcnt vmcnt(" #n ")" ::: "memory")
#define PG8_WAIT_L(n) asm volatile("s_waitcnt lgkmcnt(" #n ")" ::: "memory")
#define PG8_BAR __builtin_amdgcn_s_barrier()
#define PG8_SCHED __builtin_amdgcn_sched_barrier(0)
    Unit cur, nxt; int ui = 0;
    if (!S.next(0, cur)) return;
    if constexpr (P::GATHER) S.a_off(cur, tid, vA);
    f32x4 acc[2][2][4][2];
#pragma unroll
    for (int a = 0; a < 2; ++a)
#pragma unroll
        for (int b = 0; b < 2; ++b)
#pragma unroll
            for (int m = 0; m < 4; ++m)
#pragma unroll
                for (int n = 0; n < 2; ++n) acc[a][b][m][n] = (f32x4){0.f, 0.f, 0.f, 0.f};
    bf16x8 At[4][2], B0[2][2], B1[2][2];
    const char* cA = S.a_ptr(cur); const char* cB = S.b_ptr(cur);
    PG8_STAGEB(PG8_SB(0, 0), cB); PG8_STAGEB(PG8_SB(0, 1), cB + hstepB); PG8_STAGE2(PG8_SA(0, 0), cA, vA[0][0], vA[0][1]); PG8_STAGE2(PG8_SA(0, 1), cA, vA[1][0], vA[1][1]);
    if (wr == 1) PG8_BAR;
    PG8_WAIT_V(2); PG8_BAR;
    PG8_STAGEB(PG8_SB(1, 0), cB + kstep); PG8_STAGE2(PG8_SA(1, 0), cA + kstep, vA[0][0], vA[0][1]); PG8_STAGEB(PG8_SB(1, 1), cB + hstepB + kstep);
    PG8_WAIT_V(6); PG8_BAR;
    for (;;) {
        const bool has_next = S.next(ui + 1, nxt);
        if constexpr (P::ROWDMA) S.row_dma(cur, lds, wid, lane);
        const char* nA = has_next ? S.a_ptr(nxt) : cA; const char* nB = has_next ? S.b_ptr(nxt) : cB;
        if constexpr (P::GATHER) {
            unsigned vn[2][2];
            if (has_next) S.a_off(nxt, tid, vn);
            else { vn[0][0] = vA[0][0]; vn[0][1] = vA[0][1]; vn[1][0] = vA[1][0]; vn[1][1] = vA[1][1]; }
            *park = (u32x4){vn[0][0], vn[0][1], vn[1][0], vn[1][1]};
        }
#pragma nounroll
        for (int t = 0; t < nt; t += 2) {
            const bool last = (t == nt - 2);
            asm volatile("" : "+v"(vA[0][0]), "+v"(vA[0][1]), "+v"(vA[1][0]), "+v"(vA[1][1]), "+v"(voffB[0]), "+v"(voffB[1]));
            const char* a1 = cA + (size_t)(t + 1) * kstep;
            const char* a2 = last ? nA : cA + (size_t)(t + 2) * kstep; const char* b2 = last ? nB : cB + (size_t)(t + 2) * kstep;
            const char* a3 = a2 + kstep; const char* b3 = b2 + kstep;
            PG8_LDB(B0, 0, 0); PG8_LDB(B1, 0, 1); PG8_SCHED; PG8_LDA(At, 0, 0); PG8_STAGE2(PG8_SA(1, 1), a1, vA[1][0], vA[1][1]);
            if constexpr (P::GATHER) { if (last) { const u32x4 nv = *park; vA[0][0] = nv.x; vA[0][1] = nv.y; vA[1][0] = nv.z; vA[1][1] = nv.w; } }
            PG8_WAIT_V(8); PG8_WAIT_L(0); PG8_BAR; PG8_MMA(0, 0, At, B0); PG8_MMA(0, 1, At, B1); PG8_BAR; PG8_SCHED;
            PG8_LDA(At, 0, 1); PG8_STAGEB(PG8_SB(0, 0), b2); PG8_STAGEB(PG8_SB(0, 1), b2 + hstepB); PG8_STAGE2(PG8_SA(0, 0), a2, vA[0][0], vA[0][1]);
            PG8_WAIT_V(8); PG8_WAIT_L(0); PG8_BAR; PG8_MMA(1, 0, At, B0); PG8_MMA(1, 1, At, B1); PG8_BAR; PG8_SCHED;
            PG8_LDB(B0, 1, 0); PG8_LDB(B1, 1, 1); PG8_SCHED; PG8_LDA(At, 1, 0); PG8_STAGE2(PG8_SA(0, 1), a2, vA[1][0], vA[1][1]);
            PG8_WAIT_V(8); PG8_WAIT_L(0); PG8_BAR; PG8_MMA(0, 0, At, B0); PG8_MMA(0, 1, At, B1); PG8_BAR; PG8_SCHED;
            PG8_LDA(At, 1, 1); PG8_STAGEB(PG8_SB(1, 0), b3); PG8_STAGEB(PG8_SB(1, 1), b3 + hstepB); PG8_STAGE2(PG8_SA(1, 0), a3, vA[0][0], vA[0][1]);
            PG8_WAIT_V(8); PG8_WAIT_L(0); PG8_BAR; PG8_MMA(1, 0, At, B0); PG8_MMA(1, 1, At, B1); PG8_BAR; PG8_SCHED;
        }
        if (wr == 0) PG8_BAR;
        int fr_ = fr, fq_ = fq; asm volatile("" : "+v"(fr_), "+v"(fq_));
        const bool keep = S.epi(acc, cur, wr, wc, fr_, fq_);
        if (!has_next) break;
        if (!keep) {
#pragma unroll
            for (int a = 0; a < 2; ++a)
#pragma unroll
                for (int b = 0; b < 2; ++b)
#pragma unroll
                    for (int m = 0; m < 4; ++m)
#pragma unroll
                        for (int n = 0; n < 2; ++n) acc[a][b][m][n] = (f32x4){0.f, 0.f, 0.f, 0.f};
        }
        cur = nxt; cA = nA; cB = nB; ++ui;
        if (wr == 1) PG8_BAR;
    }
    PG8_WAIT_V(0);
    PG8_BAR;
#undef PG8_SA
#undef PG8_SB
#undef PG8_STAGE2
#undef PG8_STAGEB
#undef PG8_LDA
#undef PG8_LDB
#undef PG8_MMA
#undef PG8_WAIT_V
#undef PG8_WAIT_L
#undef PG8_BAR
#undef PG8_SCHED
}
}
using pg8::Unit;

__device__ __forceinline__ void st8(bf16* p, const f32x4& a, const f32x4& b) {
    u32x4 w; w.x = cvt_pk_bf16(a[0], a[1]); w.y = cvt_pk_bf16(a[2], a[3]); w.z = cvt_pk_bf16(b[0], b[1]); w.w = cvt_pk_bf16(b[2], b[3]);
    *(u32x4*)p = w;
}
__device__ __forceinline__ void ld8(const bf16* p, f32x4& a, f32x4& b) {
    const u32x4 w = *(const u32x4*)p;
    a = (f32x4){bflo(w.x), bfhi(w.x), bflo(w.y), bfhi(w.y)}; b = (f32x4){bflo(w.z), bfhi(w.z), bflo(w.w), bfhi(w.w)};
}

__device__ __forceinline__ void st8q(unsigned char* p, const f32x4& a, const f32x4& b) {
    int w0 = 0, w1 = 0;
    w0 = __builtin_amdgcn_cvt_pk_fp8_f32(a[0], a[1], w0, false); w0 = __builtin_amdgcn_cvt_pk_fp8_f32(a[2], a[3], w0, true);
    w1 = __builtin_amdgcn_cvt_pk_fp8_f32(b[0], b[1], w1, false); w1 = __builtin_amdgcn_cvt_pk_fp8_f32(b[2], b[3], w1, true);
    *(u32x2*)p = (u32x2){(unsigned)w0, (unsigned)w1};
}
constexpr float WQ_SCALE = 32.0f, WQ_INV = 1.0f / 32.0f;

struct PolIn {
    static constexpr int NT = 8, LDA = 512, LDB = 512; static constexpr bool GATHER = false, FP8 = false, I8 = true, ROWDMA = false;
    pg8::StaticOrder so; const unsigned char* A; const unsigned char* Bt; unsigned char* ws; const float* qg; const float* kg; const float* hs; const float* cs;
    __device__ bool next(int i, Unit& u) const { u.e = 0; u.s0 = 0; u.cnt = 0; return so.tile(i, u.pm, u.pn); }
    __device__ const char* a_ptr(const Unit& u) const { return (const char*)(A + (size_t)u.pm * 256 * 1024); }
    __device__ const char* b_ptr(const Unit& u) const { return (const char*)(Bt + (size_t)u.pn * 256 * 1024); }
    __device__ void a_off(const Unit&, int, unsigned (&)[2][2]) const {}
    __device__ __forceinline__ bool epi(f32x4 (&acc)[2][2][4][2], const Unit& u, int wr, int wc, int fr, int fq) const {
        const int pn = u.pn;
        {
            const float* hsr = hs + u.pm * 256 + wr * 64 + fr;
            const float* csp = cs + pn * 256 + 64 * wc + 8 * fq;
            float hv[2][4]; f32x4 cv[2][2];
#pragma unroll
            for (int a = 0; a < 2; ++a)
#pragma unroll
                for (int m = 0; m < 4; ++m) hv[a][m] = hsr[a * 128 + m * 16];
#pragma unroll
            for (int b = 0; b < 2; ++b)
#pragma unroll
                for (int n = 0; n < 2; ++n) cv[b][n] = *(const f32x4*)(csp + 32 * b + 4 * n);
#pragma unroll
            for (int a = 0; a < 2; ++a)
#pragma unroll
                for (int b = 0; b < 2; ++b)
#pragma unroll
                    for (int m = 0; m < 4; ++m)
#pragma unroll
                        for (int n = 0; n < 2; ++n) { const pg8::v4i_t ia = __builtin_bit_cast(pg8::v4i_t, acc[a][b][m][n]);
                            acc[a][b][m][n] = (f32x4){(float)ia.x, (float)ia.y, (float)ia.z, (float)ia.w} * hv[a][m] * cv[b][n]; }
        }
        int kind, ld, tcol; size_t off;
        if (pn < 2) { kind = 0; off = WS_Q; ld = AW; tcol = pn; }
        else if (pn < 4) { kind = 1; off = WS_K; ld = AW; tcol = pn - 2; }
        else if (pn < 6) { kind = 2; off = WS_V; ld = AW; tcol = pn - 4; }
        else if (pn < 8) { kind = 3; off = WS_UG; ld = SGW; tcol = pn - 6; }
        else if (pn < 10) { kind = 3; off = WS_VG; ld = SGW; tcol = pn - 8; }
        else if (pn < 14) { kind = 4; off = WS_GA; ld = D; tcol = pn - 10; }
        else { kind = 4; off = WS_GB; ld = D; tcol = pn - 14; }
        bf16* base = (bf16*)(ws + off) + tcol * 256 + 64 * wc + 8 * fq;
        const int row0 = u.pm * 256 + wr * 64 + fr;
        if (kind <= 1) {
            const float* g = (kind == 0 ? qg : kg) + 8 * fq;
            const float sc = (kind == 0) ? (0.125f * LOG2E) : 1.0f;
            f32x4 gv[2][2];
#pragma unroll
            for (int bj = 0; bj < 2; ++bj)
#pragma unroll
                for (int n = 0; n < 2; ++n) gv[bj][n] = *(const f32x4*)(g + 32 * bj + 4 * n) * sc;
#pragma unroll
            for (int ai = 0; ai < 2; ++ai)
#pragma unroll
                for (int m = 0; m < 4; ++m) {
                    float ss = 0.f;
#pragma unroll
                    for (int bj = 0; bj < 2; ++bj)
#pragma unroll
                        for (int n = 0; n < 2; ++n) { const f32x4 v = acc[ai][bj][m][n]; ss += (v[0] * v[0] + v[1] * v[1]) + (v[2] * v[2] + v[3] * v[3]); }
                    ss += __shfl_xor(ss, 16); ss += __shfl_xor(ss, 32);
                    const float rs = 1.0f / sqrtf(ss * (1.0f / 64.0f) + EPS);
                    bf16* rowp = base + (size_t)(row0 + ai * 128 + m * 16) * ld;
#pragma unroll
                    for (int bj = 0; bj < 2; ++bj) st8(rowp + 32 * bj, acc[ai][bj][m][0] * rs * gv[bj][0], acc[ai][bj][m][1] * rs * gv[bj][1]);
                }
        } else if (kind == 2) {
#pragma unroll
            for (int ai = 0; ai < 2; ++ai)
#pragma unroll
                for (int m = 0; m < 4; ++m) { bf16* rowp = base + (size_t)(row0 + ai * 128 + m * 16) * ld;
#pragma unroll
                    for (int bj = 0; bj < 2; ++bj) st8(rowp + 32 * bj, acc[ai][bj][m][0], acc[ai][bj][m][1]); }
        } else if (kind == 4) {
            unsigned char* b8 = ws + off + tcol * 256 + 64 * wc + 8 * fq;
#pragma unroll
            for (int ai = 0; ai < 2; ++ai)
#pragma unroll
                for (int m = 0; m < 4; ++m) { unsigned char* rowp = b8 + (size_t)(row0 + ai * 128 + m * 16) * ld;
#pragma unroll
                    for (int bj = 0; bj < 2; ++bj) st8q(rowp + 32 * bj, acc[ai][bj][m][0], acc[ai][bj][m][1]); }
        } else {
#pragma unroll
            for (int ai = 0; ai < 2; ++ai)
#pragma unroll
                for (int m = 0; m < 4; ++m) { bf16* rowp = base + (size_t)(row0 + ai * 128 + m * 16) * ld;
#pragma unroll
                    for (int bj = 0; bj < 2; ++bj) { f32x4 a = acc[ai][bj][m][0], b = acc[ai][bj][m][1];
#pragma unroll
                        for (int j = 0; j < 4; ++j) { a[j] = gelu_tanh(a[j]); b[j] = gelu_tanh(b[j]); }
                        st8(rowp + 32 * bj, a, b); } }
        }
        return false;
    }
};

struct PolMerge {
    static constexpr int NT = 8, LDA = D, LDB = D; static constexpr bool GATHER = false, FP8 = false, I8 = false, ROWDMA = false;
    pg8::StaticOrder so; const bf16* A; const bf16* Bt; const unsigned char* ga; const unsigned char* gb; bf16* out;
    __device__ bool next(int i, Unit& u) const { u.e = i & 1; u.s0 = 0; u.cnt = 0; return so.tile(i >> 1, u.pm, u.pn); }
    __device__ const char* a_ptr(const Unit& u) const { return (const char*)(A + (size_t)u.pm * 256 * LDA + 512 * u.e); }
    __device__ const char* b_ptr(const Unit& u) const { return (const char*)(Bt + (size_t)u.pn * 256 * LDB + 512 * u.e); }
    __device__ void a_off(const Unit&, int, unsigned (&)[2][2]) const {}
    __device__ __forceinline__ bool epi(f32x4 (&acc)[2][2][4][2], const Unit& u, int wr, int wc, int fr, int fq) const {
        const int row0 = u.pm * 256 + wr * 64 + fr, col0 = u.pn * 256 + 64 * wc + 8 * fq;
#pragma unroll
        for (int ai = 0; ai < 2; ++ai) {
            u32x2 gbv[4][2]; u32x2 gav[4][2];
#pragma unroll
            for (int m = 0; m < 4; ++m) { const size_t o = (size_t)(row0 + ai * 128 + m * 16) * D + col0;
#pragma unroll
                for (int bj = 0; bj < 2; ++bj) { gbv[m][bj] = *(const u32x2*)(gb + o + 32 * bj); if (u.e == 0) gav[m][bj] = *(const u32x2*)(ga + o + 32 * bj); } }
#pragma unroll
            for (int m = 0; m < 4; ++m) { const size_t o = (size_t)(row0 + ai * 128 + m * 16) * D + col0;
#pragma unroll
                for (int bj = 0; bj < 2; ++bj) {
                    const u32x2 wb = gbv[m][bj];
                    const f32x2 p0 = __builtin_amdgcn_cvt_pk_f32_fp8((int)wb.x, false), p1 = __builtin_amdgcn_cvt_pk_f32_fp8((int)wb.x, true), p2 = __builtin_amdgcn_cvt_pk_f32_fp8((int)wb.y, false), p3 = __builtin_amdgcn_cvt_pk_f32_fp8((int)wb.y, true);
                    const f32x4 b0 = (f32x4){p0[0], p0[1], p1[0], p1[1]}, b1 = (f32x4){p2[0], p2[1], p3[0], p3[1]};
                    if (u.e == 0) {
                        const u32x2 wa = gav[m][bj];
                        const f32x2 q0 = __builtin_amdgcn_cvt_pk_f32_fp8((int)wa.x, false), q1 = __builtin_amdgcn_cvt_pk_f32_fp8((int)wa.x, true), q2 = __builtin_amdgcn_cvt_pk_f32_fp8((int)wa.y, false), q3 = __builtin_amdgcn_cvt_pk_f32_fp8((int)wa.y, true);
                        const f32x4 a0 = (f32x4){q0[0], q0[1], q1[0], q1[1]}, a1 = (f32x4){q2[0], q2[1], q3[0], q3[1]};
#pragma unroll
                        for (int j = 0; j < 4; ++j) {
                            acc[ai][bj][m][0][j] *= (1.0f + fast_exp2(-LOG2E * b0[j])) * fast_rcp(1.0f + fast_exp2(-LOG2E * a0[j]));
                            acc[ai][bj][m][1][j] *= (1.0f + fast_exp2(-LOG2E * b1[j])) * fast_rcp(1.0f + fast_exp2(-LOG2E * a1[j])); }
                    } else {
                        f32x4 r0, r1;
#pragma unroll
                        for (int j = 0; j < 4; ++j) { r0[j] = acc[ai][bj][m][0][j] * sigmoidf_(b0[j]); r1[j] = acc[ai][bj][m][1][j] * sigmoidf_(b1[j]); }
                        st8(out + o + 32 * bj, r0, r1);
                    }
                } }
        }
        return u.e == 0;
    }
};

struct PolOut {
    static constexpr int NT = 16, LDA = D, LDB = D; static constexpr bool GATHER = false, FP8 = false, I8 = false, ROWDMA = false;
    pg8::StaticOrder so; const bf16* A; const bf16* Bt; const float* x; bf16* x1; unsigned char* x1q;
    __device__ bool next(int i, Unit& u) const { u.e = 0; u.s0 = 0; u.cnt = 0; return so.tile(i, u.pm, u.pn); }
    __device__ const char* a_ptr(const Unit& u) const { return (const char*)(A + (size_t)u.pm * 256 * LDA); }
    __device__ const char* b_ptr(const Unit& u) const { return (const char*)(Bt + (size_t)u.pn * 256 * LDB); }
    __device__ void a_off(const Unit&, int, unsigned (&)[2][2]) const {}
    __device__ __forceinline__ bool epi(f32x4 (&acc)[2][2][4][2], const Unit& u, int wr, int wc, int fr, int fq) const {
        const int row0 = u.pm * 256 + wr * 64 + fr, col0 = u.pn * 256 + 64 * wc + 8 * fq;
#pragma unroll
        for (int ai = 0; ai < 2; ++ai) {
            f32x4 xv[4][2][2];
#pragma unroll
            for (int m = 0; m < 4; ++m) { const size_t o = (size_t)(row0 + ai * 128 + m * 16) * D + col0;
#pragma unroll
                for (int bj = 0; bj < 2; ++bj) { xv[m][bj][0] = *(const f32x4*)(x + o + 32 * bj); xv[m][bj][1] = *(const f32x4*)(x + o + 32 * bj + 4); } }
#pragma unroll
            for (int m = 0; m < 4; ++m) { const size_t o = (size_t)(row0 + ai * 128 + m * 16) * D + col0;
#pragma unroll
                for (int bj = 0; bj < 2; ++bj) {
                    const f32x4 r0 = xv[m][bj][0] + acc[ai][bj][m][0], r1 = xv[m][bj][1] + acc[ai][bj][m][1];
                    st8(x1 + o + 32 * bj, r0, r1); st8q(x1q + o + 32 * bj, r0, r1);
                } }
        }
        return false;
    }
};

struct MoeOrder {
    const LAS int* tb;
    int NN, nwg, G, c;
    __device__ void init(const LAS int* tb_, int NN_, int G_, int c_) { tb = tb_; NN = NN_; G = G_; c = c_; nwg = tb_[32] * NN_; }
    __device__ bool unit(int i, Unit& u) const {
        const long L = (long)i * G + c; if (L >= nwg) return false;
        int wgid = (int)L; { const int q = nwg / 8, r = nwg % 8, xcd = wgid % 8, off = wgid / 8; wgid = (xcd < r ? xcd * (q + 1) : r * (q + 1) + (xcd - r) * q) + off; }
        const int Mt = wgid / NN;
        const int ln = threadIdx.x & 63;
        const unsigned long long bal = __ballot(ln < NE && tb[ln & 31] <= Mt);
        const int e = __popcll(bal) - 1;
        u.idx = i; u.pm = __builtin_amdgcn_readfirstlane(Mt); u.pn = __builtin_amdgcn_readfirstlane(wgid % NN); u.e = __builtin_amdgcn_readfirstlane(e);
        u.s0 = __builtin_amdgcn_readfirstlane((Mt - tb[e]) * 256); u.cnt = __builtin_amdgcn_readfirstlane(tb[33 + e]);
        return true;
    }
};

struct PolGU {
    static constexpr int NT = 8, LDA = 512, LDB = 512; static constexpr bool GATHER = true, FP8 = true, I8 = false, ROWDMA = true;
    MoeOrder mo; const unsigned char* A; const unsigned char* Bt; const int* lid; const float* lrs; const float* bgu; unsigned char* act; LAS unsigned char* shm;
    __device__ __forceinline__ void row_dma(const Unit& u, LAS unsigned char* lds, int wid, int lane) const {
        if (wid < 4) __builtin_amdgcn_global_load_lds((const unsigned*)(lrs + (size_t)u.e * LCAP + u.s0 + 64 * wid + lane), (LAS unsigned*)(lds + ROWS_OFF + (u.idx & 1) * 2048 + 256 * wid), 4, 0, 0);
    }
    __device__ bool next(int i, Unit& u) const { return mo.unit(i, u); }
    __device__ const char* a_ptr(const Unit&) const { return (const char*)A; }
    __device__ const char* b_ptr(const Unit& u) const { return (const char*)(Bt + ((size_t)u.e * 2048 + (size_t)u.pn * 256) * 1024); }
    __device__ __forceinline__ void a_off(const Unit& u, int tid, unsigned (&v)[2][2]) const {
        const int* l = lid + (size_t)u.e * LCAP;
#pragma unroll
        for (int i = 0; i < 2; ++i) { int R, C; pg8::stage_rc(tid * 16 + i * 8192, R, C);
#pragma unroll
            for (int h = 0; h < 2; ++h) { const int s = u.s0 + h * 128 + R; const int id = l[s]; const int tok = (s < u.cnt) ? (id >> 2) : 0; v[h][i] = (unsigned)(tok * LDA + C) * 2u; } }
    }
    __device__ __forceinline__ bool epi(f32x4 (&acc)[2][2][4][2], const Unit& u, int wr, int wc, int fr, int fq) const {
        const LAS float* rsl = (const LAS float*)(shm + ROWS_OFF + (u.idx & 1) * 2048);
        const float* bg = bgu + (size_t)u.e * 2048 + u.pn * 128 + 32 * wc + 8 * fq;
        const f32x4 bg0 = *(const f32x4*)bg, bg1 = *(const f32x4*)(bg + 4), bu0 = *(const f32x4*)(bg + 1024), bu1 = *(const f32x4*)(bg + 1028);
        unsigned char* ob = act + (size_t)u.pm * 256 * FF + u.pn * 128 + 32 * wc + 8 * fq;
        float rsv[2][4];
#pragma unroll
        for (int ai = 0; ai < 2; ++ai)
#pragma unroll
            for (int m = 0; m < 4; ++m) { const int r = ai * 128 + wr * 64 + m * 16 + fr; const bool valid = (u.s0 + r < u.cnt); const float t_ = rsl[r]; rsv[ai][m] = valid ? t_ * WQ_INV : 0.f; }
#pragma unroll
        for (int ai = 0; ai < 2; ++ai)
#pragma unroll
            for (int m = 0; m < 4; ++m) { const int r = ai * 128 + wr * 64 + m * 16 + fr; const float rs = rsv[ai][m];
                f32x4 o[2];
#pragma unroll
                for (int n = 0; n < 2; ++n)
#pragma unroll
                    for (int h2 = 0; h2 < 2; ++h2) {
                        const f32x2 ag = {acc[ai][0][m][n][2 * h2], acc[ai][0][m][n][2 * h2 + 1]}, au = {acc[ai][1][m][n][2 * h2], acc[ai][1][m][n][2 * h2 + 1]};
                        const f32x2 bgv = n ? (f32x2){bg1[2 * h2], bg1[2 * h2 + 1]} : (f32x2){bg0[2 * h2], bg0[2 * h2 + 1]}, buv = n ? (f32x2){bu1[2 * h2], bu1[2 * h2 + 1]} : (f32x2){bu0[2 * h2], bu0[2 * h2 + 1]};
                        f32x2 g = ag * rs + bgv, up = au * rs + buv;
                        g = __builtin_elementwise_min(g, (f32x2){7.0f, 7.0f});
                        up.x = __builtin_amdgcn_fmed3f(up.x, -7.0f, 7.0f); up.y = __builtin_amdgcn_fmed3f(up.y, -7.0f, 7.0f);
                        const f32x2 t = g * (-1.702f * LOG2E);
                        f32x2 e; e.x = fast_exp2(t.x); e.y = fast_exp2(t.y);
                        const f32x2 den = e + 1.0f;
                        f32x2 rc; rc.x = fast_rcp(den.x); rc.y = fast_rcp(den.y);
                        const f32x2 res = (up + 1.0f) * (g * rc);
                        o[n][2 * h2] = res.x; o[n][2 * h2 + 1] = res.y; }
                st8q(ob + (size_t)r * FF, o[0], o[1]); }
        return false;
    }
};

struct PolDown {
    static constexpr int NT = 8, LDA = 512, LDB = 512; static constexpr bool GATHER = true, FP8 = true, I8 = false, ROWDMA = true;
    MoeOrder mo; const unsigned char* A; const unsigned char* Bt; const int* lid; const float* lp; const float* bd; unsigned char* y; LAS unsigned char* shm;
    __device__ __forceinline__ void row_dma(const Unit& u, LAS unsigned char* lds, int wid, int lane) const {
        const size_t o = (size_t)u.e * LCAP + u.s0 + 64 * (wid & 3) + lane;
        const unsigned* src = (wid < 4) ? (const unsigned*)(lid + o) : (const unsigned*)(lp + o);
        __builtin_amdgcn_global_load_lds(src, (LAS unsigned*)(lds + ROWS_OFF + (u.idx & 1) * 2048 + 256 * wid), 4, 0, 0);
    }
    __device__ bool next(int i, Unit& u) const { return mo.unit(i, u); }
    __device__ const char* a_ptr(const Unit& u) const { return (const char*)(A + (size_t)u.pm * 256 * 1024); }
    __device__ const char* b_ptr(const Unit& u) const { return (const char*)(Bt + ((size_t)u.e * 1024 + (size_t)u.pn * 256) * 1024); }
    __device__ __forceinline__ void a_off(const Unit&, int tid, unsigned (&v)[2][2]) const {
#pragma unroll
        for (int i = 0; i < 2; ++i) { int R, C; pg8::stage_rc(tid * 16 + i * 8192, R, C); v[0][i] = (unsigned)(R * LDA + C) * 2u; v[1][i] = (unsigned)((R + 128) * LDA + C) * 2u; }
    }
    __device__ __forceinline__ bool epi(f32x4 (&acc)[2][2][4][2], const Unit& u, int wr, int wc, int fr, int fq) const {
        const LAS int* idl = (const LAS int*)(shm + ROWS_OFF + (u.idx & 1) * 2048); const LAS float* pl = (const LAS float*)(shm + ROWS_OFF + (u.idx & 1) * 2048 + 1024);
        const int col0 = u.pn * 256 + 64 * wc + 8 * fq;
        const float* b = bd + (size_t)u.e * D + col0;
        int idv[2][4]; float pv_[2][4];
#pragma unroll
        for (int ai = 0; ai < 2; ++ai)
#pragma unroll
            for (int m = 0; m < 4; ++m) { const int r = ai * 128 + wr * 64 + m * 16 + fr; const bool valid = (u.s0 + r < u.cnt);
                const int t_ = idl[r]; const float q_ = pl[r]; idv[ai][m] = valid ? t_ : T * 4; pv_[ai][m] = q_; }
        f32x4 bv[2][2];
#pragma unroll
        for (int bj = 0; bj < 2; ++bj)
#pragma unroll
            for (int n = 0; n < 2; ++n) bv[bj][n] = *(const f32x4*)(b + 32 * bj + 4 * n);
#pragma unroll
        for (int ai = 0; ai < 2; ++ai)
#pragma unroll
            for (int m = 0; m < 4; ++m) { const float p = pv_[ai][m] * 16.0f; unsigned char* op = y + (size_t)idv[ai][m] * D + col0;
#pragma unroll
                for (int bj = 0; bj < 2; ++bj) st8q(op + 32 * bj, (acc[ai][bj][m][0] * WQ_INV + bv[bj][0]) * p, (acc[ai][bj][m][1] * WQ_INV + bv[bj][1]) * p); }
        return false;
    }
};

constexpr int CONV_GU_ITEMS = NE * 16 * 32, CONV_D_ITEMS = NE * 16 * 16, CONV_ITEMS = CONV_GU_ITEMS + CONV_D_ITEMS, CONV_PER_WAVE = CONV_ITEMS / 2048;
static_assert(CONV_PER_WAVE * 2048 == CONV_ITEMS, "items divide over 2048 waves");
struct MoeConv {
    const float* wgu; const float* wd; const float* g2; unsigned char* WGU8; unsigned char* WD8;
    struct Regs { f32x4 v0, v1, v2, v3, v4, v5, v6, v7, v8, v9, v10, v11, v12, v13, v14, v15; };
    __device__ __forceinline__ void src_of(int item, const float*& W, int& N, int& k0, int& n0) const {
        if (item < CONV_GU_ITEMS) { const int e = item >> 9, q = item & 511; W = wgu + (size_t)e * D * 2048; N = 2048; k0 = 64 * (q >> 5); n0 = 64 * (q & 31); }
        else { const int r = item - CONV_GU_ITEMS, e = r >> 8, q = r & 255; W = wd + (size_t)e * FF * D; N = D; k0 = 64 * (q >> 4); n0 = 64 * (q & 15); }
    }
    __device__ __forceinline__ void finish(Regs& R, int item, int lane) const {
        const float* W; int N, k0, n0; src_of(item, W, N, k0, n0);
        const int kc = lane >> 4, nq = lane & 15; const bool gu = item < CONV_GU_ITEMS;
        float sc[16];
        if (gu) { const f32x4* gp = (const f32x4*)(g2 + k0 + 16 * kc);
#pragma unroll
            for (int q = 0; q < 4; ++q) { const f32x4 t = gp[q]; sc[4 * q] = t[0] * 32.0f; sc[4 * q + 1] = t[1] * 32.0f; sc[4 * q + 2] = t[2] * 32.0f; sc[4 * q + 3] = t[3] * 32.0f; } }
        else {
#pragma unroll
            for (int i = 0; i < 16; ++i) sc[i] = 32.0f; }
        const int nb = n0 + 32 * (nq >> 3);
        const int e = gu ? (item >> 9) : ((item - CONV_GU_ITEMS) >> 8);
        const int up = nb >= 1024, cc = nb & 1023;
        const int pos = gu ? ((cc >> 7) * 256 + up * 128 + ((cc >> 5) & 3) * 32) : ((nb & ~255) + ((nb >> 5) & 1) * 128 + ((nb >> 6) & 3) * 32);
        unsigned char* base = (gu ? (WGU8 + ((size_t)e * 2048 + pos + ((4 * nq) & 31)) * 1024) : (WD8 + ((size_t)e * 1024 + pos + ((4 * nq) & 31)) * 1024)) + k0 + 16 * kc;
#pragma unroll
        for (int c = 0; c < 4; ++c) {
            int w0 = 0, w1 = 0, w2 = 0, w3 = 0;
            w0 = __builtin_amdgcn_cvt_pk_fp8_f32(R.v0[c] * sc[0], R.v1[c] * sc[1], w0, false); w0 = __builtin_amdgcn_cvt_pk_fp8_f32(R.v2[c] * sc[2], R.v3[c] * sc[3], w0, true);
            w1 = __builtin_amdgcn_cvt_pk_fp8_f32(R.v4[c] * sc[4], R.v5[c] * sc[5], w1, false); w1 = __builtin_amdgcn_cvt_pk_fp8_f32(R.v6[c] * sc[6], R.v7[c] * sc[7], w1, true);
            w2 = __builtin_amdgcn_cvt_pk_fp8_f32(R.v8[c] * sc[8], R.v9[c] * sc[9], w2, false); w2 = __builtin_amdgcn_cvt_pk_fp8_f32(R.v10[c] * sc[10], R.v11[c] * sc[11], w2, true);
            w3 = __builtin_amdgcn_cvt_pk_fp8_f32(R.v12[c] * sc[12], R.v13[c] * sc[13], w3, false); w3 = __builtin_amdgcn_cvt_pk_fp8_f32(R.v14[c] * sc[14], R.v15[c] * sc[15], w3, true);
            *(u32x4*)(base + (size_t)c * 1024) = (u32x4){(unsigned)w0, (unsigned)w1, (unsigned)w2, (unsigned)w3};
        }
    }
    template <int SUB> __device__ __forceinline__ void sub(Regs& R, int& st, int item0, int istride, int lane) const {
        if (SUB == 0 && (st & 1)) { finish(R, item0 + ((st >> 1) - 1) * istride, lane); st &= ~1; }
        const int it = st >> 1;
        if (it < CONV_PER_WAVE) {
            const float* W; int N, k0, n0; src_of(item0 + it * istride, W, N, k0, n0);
            const float* p = W + (size_t)(k0 + 16 * (lane >> 4) + 4 * SUB) * N + n0 + 4 * (lane & 15);
            const f32x4 t0 = *(const f32x4*)p, t1 = *(const f32x4*)(p + N), t2 = *(const f32x4*)(p + 2 * (size_t)N), t3 = *(const f32x4*)(p + 3 * (size_t)N);
            if (SUB == 0) { R.v0 = t0; R.v1 = t1; R.v2 = t2; R.v3 = t3; }
            else if (SUB == 1) { R.v4 = t0; R.v5 = t1; R.v6 = t2; R.v7 = t3; }
            else if (SUB == 2) { R.v8 = t0; R.v9 = t1; R.v10 = t2; R.v11 = t3; }
            else { R.v12 = t0; R.v13 = t1; R.v14 = t2; R.v15 = t3; st = ((it + 1) << 1) | 1; }
        }
    }
    __device__ __forceinline__ void drain(Regs& R, int& st, int item0, int istride, int lane) const {
        if (st & 1) { finish(R, item0 + ((st >> 1) - 1) * istride, lane); st &= ~1; }
        for (int it = st >> 1; it < CONV_PER_WAVE; ++it) { sub<0>(R, st, item0, istride, lane); sub<1>(R, st, item0, istride, lane); sub<2>(R, st, item0, istride, lane); sub<3>(R, st, item0, istride, lane);
            finish(R, item0 + it * istride, lane); st &= ~1; }
    }
};

namespace att {
constexpr int PITCH = 512, SLOTB = 8192;
constexpr int L_K = 0, L_V = 2 * SLOTB, L_TBL = 4 * SLOTB, L_WS = L_TBL + 4096, L_OST = L_WS + 8 * 256, L_END = L_OST + 8 * 4096;
constexpr int NTBL = 832;
__device__ __forceinline__ int crow(int r, int hi) { return (r & 3) + 8 * (r >> 2) + 4 * hi; }
__device__ __forceinline__ void glds16(const void* gsrc, unsigned lds_dst) { unsigned keep;
    asm volatile("s_mov_b32 %0, m0\n\ts_mov_b32 m0, %2\n\ts_nop 0\n\tglobal_load_lds_dwordx4 %1, off\n\ts_mov_b32 m0, %0" : "=&s"(keep) : "v"(gsrc), "s"(lds_dst) : "memory"); }
__device__ __forceinline__ unsigned cvtpk_s(float lo, float hi) { typedef __bf16 bf16x2_t __attribute__((ext_vector_type(2))); f32x2 v = {lo, hi}; bf16x2_t b = __builtin_convertvector(v, bf16x2_t); return __builtin_bit_cast(unsigned, b); }
#define ATT_SBAR() __builtin_amdgcn_sched_barrier(0)
__device__ __forceinline__ void pv(f32x16* o, int vb, bf16x8 pa0, bf16x8 pa1, bf16x8 pa2, bf16x8 pa3) {
#pragma unroll
    for (int d0 = 0; d0 < 2; ++d0) { s16x4 lo[4], hi[4];
#pragma unroll
        for (int ks = 0; ks < 4; ++ks) {
            asm volatile("ds_read_b64_tr_b16 %0,%1 offset:%c2" : "=&v"(lo[ks]) : "v"(vb), "i"(d0 * 4096 + ks * 1024) : "memory");
            asm volatile("ds_read_b64_tr_b16 %0,%1 offset:%c2" : "=&v"(hi[ks]) : "v"(vb), "i"(d0 * 4096 + ks * 1024 + 512) : "memory"); }
        asm volatile("s_waitcnt lgkmcnt(0)" ::: "memory"); ATT_SBAR();
#define ATT_PK(k) (bf16x8){lo[k][0], lo[k][1], lo[k][2], lo[k][3], hi[k][0], hi[k][1], hi[k][2], hi[k][3]}
        o[d0] = __builtin_amdgcn_mfma_f32_32x32x16_bf16(pa0, ATT_PK(0), o[d0], 0, 0, 0);
        o[d0] = __builtin_amdgcn_mfma_f32_32x32x16_bf16(pa1, ATT_PK(1), o[d0], 0, 0, 0);
        o[d0] = __builtin_amdgcn_mfma_f32_32x32x16_bf16(pa2, ATT_PK(2), o[d0], 0, 0, 0);
        o[d0] = __builtin_amdgcn_mfma_f32_32x32x16_bf16(pa3, ATT_PK(3), o[d0], 0, 0, 0);
#undef ATT_PK
    }
}
__device__ __forceinline__ void unit(int b, int h, int cg, const bf16* Q, const bf16* K, const bf16* V, const float* relb, bf16* O  , LAS unsigned char* shm,
                                     const MoeConv& cv, MoeConv::Regs& sreg, int& sctr, int item0, int istride) {
    const int tid = threadIdx.x, lane = tid & 63, r32 = lane & 31, hi = lane >> 5; const int wid = __builtin_amdgcn_readfirstlane(tid >> 6);
    const long rowbase = (long)b * SEQ; const int cq = 4 * cg + (wid >> 1), wq = wid & 1;
    const bf16* Qw = Q + (rowbase + 64 * cq + 32 * wq) * PITCH + h * HD;
    const unsigned lds0 = (unsigned)(uintptr_t)shm;
    LAS float* tbl = (LAS float*)(shm + L_TBL);
    LAS float* wsf = (LAS float*)(shm + L_WS) + wid * 64;
    for (int i = tid; i < NTBL; i += 512) tbl[i] = relb[h * NREL + (i < 512 ? i : 512)] * LOG2E;
    const int srow = tid >> 3, sc = tid & 7;
    const bf16* ksrc = K + (rowbase + srow) * PITCH + h * HD + sc * 8;
    const bf16* vsrc = V + (rowbase + srow) * PITCH + h * HD + sc * 8;
    const int kwr = L_K + sc * 1024 + ((srow ^ sc) << 4);
    const int vwr = L_V + (4 * (sc >> 2) + (srow >> 4)) * 1024 + (srow & 15) * 64 + (sc & 3) * 16;
    const int vb0 = (int)(lds0 + L_V) + ((lane >> 4) & 1) * 32 + (lane & 3) * 8 + (4 * hi + ((lane & 15) >> 2)) * 64;
    int kra[4];
#pragma unroll
    for (int d0 = 0; d0 < 4; ++d0) kra[d0] = L_K + (2 * d0 + hi) * 1024 + ((r32 ^ (2 * d0 + hi)) << 4);
    bf16x8 qr[4];
#pragma unroll
    for (int d0 = 0; d0 < 4; ++d0) qr[d0] = *reinterpret_cast<const bf16x8*>(&Qw[(long)r32 * PITCH + d0 * 16 + hi * 8]);
    f32x16 o[2]; o[0] = f32x16{}; o[1] = f32x16{}; float l_reg = 0.f;
    const int j0 = (8 - 4 * cg) > 0 ? (8 - 4 * cg) : 0;
    u32x4 kreg, vreg;
    { const long ro = (long)(4 * cg - 8 + j0) * 64 * PITCH; kreg = *(const u32x4*)(ksrc + ro); vreg = *(const u32x4*)(vsrc + ro); }
#define ATT_STEP(JX, SUBP) do { const int j = (JX); \
        const int s = (j - j0) & 1; \
        *(LAS u32x4*)(shm + kwr + s * SLOTB) = kreg; *(LAS u32x4*)(shm + vwr + s * SLOTB) = vreg; \
        if (j < 11) { const long ro = (long)(4 * cg - 8 + j + 1) * 64 * PITCH; kreg = *(const u32x4*)(ksrc + ro); vreg = *(const u32x4*)(vsrc + ro); } \
        asm volatile("s_waitcnt lgkmcnt(0)\n\ts_barrier" ::: "memory"); \
        cv.template sub<SUBP>(sreg, sctr, item0, istride, lane);     \
        const int d = (wid >> 1) + 8 - j; \
        if (d >= 0 && d <= 8) { \
            f32x16 p0 = f32x16{}, p1 = f32x16{}; \
            const LAS unsigned char* kbs = shm + s * SLOTB; \
        _Pragma("unroll") \
            for (int d0 = 0; d0 < 4; ++d0) { \
                const bf16x8 b0 = *(const LAS bf16x8*)(kbs + kra[d0]), b1 = *(const LAS bf16x8*)(kbs + kra[d0] + 512); \
                p0 = __builtin_amdgcn_mfma_f32_32x32x16_bf16(b0, qr[d0], p0, 0, 0, 0); p1 = __builtin_amdgcn_mfma_f32_32x32x16_bf16(b1, qr[d0], p1, 0, 0, 0); } \
            const LAS float* tb = tbl + (256 + 64 * d + 32 * wq + r32 - 4 * hi - 63); \
            float sacc = 0.f; \
        _Pragma("unroll") \
            for (int r = 0; r < 16; ++r) { const int c = (r & 3) + 8 * (r >> 2); \
                p0[r] = fast_exp2(p0[r] + tb[63 - c]); p1[r] = fast_exp2(p1[r] + tb[31 - c]); sacc += p0[r] + p1[r]; } \
            l_reg += sacc; \
            u32x4 pw0, pw1, pw2, pw3; \
            pw0 = (u32x4){cvtpk_s(p0[0], p0[1]), cvtpk_s(p0[2], p0[3]), cvtpk_s(p0[4], p0[5]), cvtpk_s(p0[6], p0[7])}; \
            pw1 = (u32x4){cvtpk_s(p0[8], p0[9]), cvtpk_s(p0[10], p0[11]), cvtpk_s(p0[12], p0[13]), cvtpk_s(p0[14], p0[15])}; \
            pw2 = (u32x4){cvtpk_s(p1[0], p1[1]), cvtpk_s(p1[2], p1[3]), cvtpk_s(p1[4], p1[5]), cvtpk_s(p1[6], p1[7])}; \
            pw3 = (u32x4){cvtpk_s(p1[8], p1[9]), cvtpk_s(p1[10], p1[11]), cvtpk_s(p1[12], p1[13]), cvtpk_s(p1[14], p1[15])}; \
            ATT_SBAR(); \
            pv(o, vb0 + s * SLOTB, __builtin_bit_cast(bf16x8, pw0), __builtin_bit_cast(bf16x8, pw1), __builtin_bit_cast(bf16x8, pw2), __builtin_bit_cast(bf16x8, pw3)); \
        } \
    } while (0)
    for (int jb = j0; jb < 12; jb += 4) { ATT_STEP(jb, 0); ATT_STEP(jb + 1, 1); ATT_STEP(jb + 2, 2); ATT_STEP(jb + 3, 3); }
#undef ATT_STEP
    asm volatile("s_waitcnt lgkmcnt(0)\n\ts_barrier" ::: "memory");
    { auto rr = __builtin_amdgcn_permlane32_swap(__float_as_uint(l_reg), __float_as_uint(l_reg), false, false); l_reg = __uint_as_float(rr[0]) + __uint_as_float(rr[1]); }
    if (hi == 0) wsf[32 + r32] = l_reg; asm volatile("s_waitcnt lgkmcnt(0)" ::: "memory");
    float rli[16];
#pragma unroll
    for (int r = 0; r < 16; ++r) rli[r] = fast_rcp(wsf[32 + crow(r, hi)]);
    bf16* Ow = O + (rowbase + 64 * cq + 32 * wq) * D + h * HD;
    { LAS bf16* stg = (LAS bf16*)(shm + L_OST) + wid * 2048;
#pragma unroll
        for (int r = 0; r < 16; ++r) { const int orow = crow(r, hi);
#pragma unroll
            for (int d0 = 0; d0 < 2; ++d0) stg[orow * 64 + d0 * 32 + r32] = (bf16)f2bf(o[d0][r] * rli[r]); }
        asm volatile("s_waitcnt lgkmcnt(0)" ::: "memory");
#pragma unroll
        for (int i = 0; i < 4; ++i) { const int row = i * 8 + (lane >> 3), ch = lane & 7; const u32x4 v = *(const LAS u32x4*)(stg + row * 64 + ch * 8); *(u32x4*)(Ow + (long)row * D + ch * 8) = v; } }
    asm volatile("s_waitcnt lgkmcnt(0)\n\ts_barrier" ::: "memory");
}
#undef ATT_SBAR
}

constexpr int SGU_WM_OFF = 128 * 136 * 2;
__device__ __forceinline__ void sgu_load_wm(int g, const bf16* WM, LAS unsigned char* shm) {
    const int tid = threadIdx.x, t = tid >> 2, c0 = (tid & 3) * 32;
    const bf16* src = WM + ((size_t)g * 128 + t) * 128 + c0;
#pragma unroll
    for (int q = 0; q < 4; ++q) *(LAS u32x4*)(shm + SGU_WM_OFF + (t * 136 + c0 + 8 * q) * 2) = *(const u32x4*)(src + 8 * q);
}
__device__ __forceinline__ void sgu_item(int item, const bf16* VG, const bf16* UG, const float* lng, const float* lnb, const float* sgb, bf16* YC, LAS unsigned char* shm,
                                         const MoeConv& cv, MoeConv::Regs& sreg, int& sctr, int item0, int istride) {
    const int tid = threadIdx.x, lane = tid & 63; const int wid = __builtin_amdgcn_readfirstlane(tid >> 6);
    const int g = item & 3, blk = item >> 2;
    const long t0 = (long)blk * 128;
    LAS bf16* vt = (LAS bf16*)shm;
    const LAS bf16* wmL = (const LAS bf16*)(shm + SGU_WM_OFF);
    const int ch = tid & 15, fr = lane & 15, fq = lane >> 4;
    u32x4 vraw[4];
#pragma unroll
    for (int it = 0; it < 4; ++it) vraw[it] = *(const u32x4*)(VG + (t0 + (tid >> 4) + 32 * it) * SGW + g * 128 + ch * 8);
    u32x2 uw[8]; float bs[8];
#pragma unroll
    for (int tt = 0; tt < 8; ++tt) { const int t = 16 * tt + fr; uw[tt] = *(const u32x2*)(UG + (size_t)(t0 + t) * SGW + g * 128 + 16 * wid + 4 * fq); bs[tt] = sgb[g * 128 + t]; }
    const f32x4 gA = *(const f32x4*)(lng + g * 128 + ch * 8), gB = *(const f32x4*)(lng + g * 128 + ch * 8 + 4);
    const f32x4 bA = *(const f32x4*)(lnb + g * 128 + ch * 8), bB = *(const f32x4*)(lnb + g * 128 + ch * 8 + 4);
#pragma unroll
    for (int it = 0; it < 4; ++it) {
        const int s = (tid >> 4) + 32 * it;
        const u32x4 w = vraw[it];
        f32x4 a = (f32x4){bflo(w.x), bfhi(w.x), bflo(w.y), bfhi(w.y)}, b = (f32x4){bflo(w.z), bfhi(w.z), bflo(w.w), bfhi(w.w)};
        float sum = (a[0] + a[1]) + (a[2] + a[3]) + (b[0] + b[1]) + (b[2] + b[3]);
        sum += __shfl_xor(sum, 1); sum += __shfl_xor(sum, 2); sum += __shfl_xor(sum, 4); sum += __shfl_xor(sum, 8);
        const float mean = sum * (1.0f / 128.0f);
        a = a - mean; b = b - mean;
        float q = (a[0] * a[0] + a[1] * a[1]) + (a[2] * a[2] + a[3] * a[3]) + (b[0] * b[0] + b[1] * b[1]) + (b[2] * b[2] + b[3] * b[3]);
        q += __shfl_xor(q, 1); q += __shfl_xor(q, 2); q += __shfl_xor(q, 4); q += __shfl_xor(q, 8);
        const float rstd = 1.0f / sqrtf(q * (1.0f / 128.0f) + EPS);
        a = a * rstd * gA + bA; b = b * rstd * gB + bB;
#pragma unroll
        for (int j = 0; j < 4; ++j) { vt[(ch * 8 + j) * 136 + s] = (bf16)f2bf(a[j]); vt[(ch * 8 + 4 + j) * 136 + s] = (bf16)f2bf(b[j]); }
    }
    asm volatile("s_waitcnt lgkmcnt(0)\n\ts_barrier" ::: "memory");
    f32x4 acc[8];
#pragma unroll
    for (int tt = 0; tt < 8; ++tt) acc[tt] = (f32x4){0.f, 0.f, 0.f, 0.f};
#pragma unroll
    for (int ks = 0; ks < 4; ++ks) {
        const bf16x8 a = *(const LAS bf16x8*)(vt + (16 * wid + fr) * 136 + 32 * ks + 8 * fq);
#pragma unroll
        for (int tt = 0; tt < 8; ++tt) if (ks <= (tt >> 1)) {
            const bf16x8 bfrag = *(const LAS bf16x8*)(wmL + (16 * tt + fr) * 136 + 32 * ks + 8 * fq);
            acc[tt] = __builtin_amdgcn_mfma_f32_16x16x32_bf16(a, bfrag, acc[tt], 0, 0, 0); }
    }
#pragma unroll
    for (int tt = 0; tt < 8; ++tt) { const int t = 16 * tt + fr; const float b_ = bs[tt];
        const u32x2 u_ = uw[tt];
        u32x2 w; w.x = cvt_pk_bf16(bflo(u_.x) * (acc[tt][0] + b_), bfhi(u_.x) * (acc[tt][1] + b_)); w.y = cvt_pk_bf16(bflo(u_.y) * (acc[tt][2] + b_), bfhi(u_.y) * (acc[tt][3] + b_));
        *(u32x2*)(YC + (size_t)(t0 + t) * D + AW + g * 128 + 16 * wid + 4 * fq) = w; }
    asm volatile("s_waitcnt lgkmcnt(0)\n\ts_barrier" ::: "memory");
}

#define XB_TMO      128
#define XB_XCNT(j)  (256  + 64 * (j))
#define XB_XSUB(j)  (1280 + 64 * (j))
#define XB_XGEN(j)  (2304 + 64 * (j))
#define XB_TOP      3328
#define XB_TOPGEN   3392
#define XCD_BAR_WORDS 3456
#define XB_SPIN_CAP (1u << 18)
__device__ __forceinline__ unsigned xb_ld(unsigned* p)              { return __hip_atomic_load(p, __ATOMIC_RELAXED, __HIP_MEMORY_SCOPE_AGENT); }
__device__ __forceinline__ unsigned xb_add(unsigned* p, unsigned v) { return __hip_atomic_fetch_add(p, v, __ATOMIC_RELAXED, __HIP_MEMORY_SCOPE_AGENT); }
__device__ __forceinline__ unsigned xb_xcc_id() { return (unsigned)__builtin_amdgcn_s_getreg((3 << 11) | 20) & 0xFu; }
#define XB_SPIN(cond, bar) do { unsigned _sp = 0; while (cond) { __builtin_amdgcn_s_sleep(1); \
    if ((++_sp & 255u) == 0u) { if (xb_ld(&(bar)[XB_TMO])) break; if (_sp > XB_SPIN_CAP) { atomicAdd(&(bar)[XB_TMO], 1u); break; } } } } while (0)
struct XcdBarrier { unsigned* bar; unsigned x; volatile LAS unsigned* st; };
__device__ __forceinline__ XcdBarrier xcd_barrier_post(unsigned* bar, volatile LAS unsigned* st) {
    XcdBarrier b; b.bar = bar; b.x = xb_xcc_id(); b.st = st;
    if (threadIdx.x == 0) (void)xb_add(&bar[XB_XCNT(b.x)], 1u);
    return b;
}
__device__ __forceinline__ void xcd_barrier_complete(unsigned* bar, unsigned x, unsigned& nloc, unsigned& nx) {
    const unsigned G = gridDim.x * gridDim.y * gridDim.z;
    unsigned sum, cnt, mine, sp = 0u;
    for (;;) {
        sum = 0u; cnt = 0u; mine = 0u;
#pragma unroll
        for (unsigned j = 0; j < 16; ++j) { const unsigned c = xb_ld(&bar[XB_XCNT(j)]); sum += c; cnt += (c > 0u) ? 1u : 0u; mine = (j == x) ? c : mine; }
        if (sum == G) break;
        __builtin_amdgcn_s_sleep(1);
        if ((++sp & 255u) == 0u) { if (xb_ld(&bar[XB_TMO])) break; if (sp > XB_SPIN_CAP) { atomicAdd(&bar[XB_TMO], 1u); break; } }
    }
    nloc = mine > 0u ? mine : 1u; nx = cnt > 0u ? cnt : 1u;
}
__device__ __forceinline__ void xcd_barrier(const XcdBarrier& b) {
    asm volatile("s_waitcnt vmcnt(0)" ::: "memory");
    __syncthreads();
    if (threadIdx.x == 0) {
        unsigned* bar = b.bar;
        __builtin_amdgcn_s_waitcnt(0);
        unsigned nloc = b.st[0], nx = b.st[1];
        if (nloc == 0u) { xcd_barrier_complete(bar, b.x, nloc, nx); b.st[0] = nloc; b.st[1] = nx; }
        const unsigned old = xb_add(&bar[XB_XSUB(b.x)], 1u);
        const unsigned gen = old / nloc;
        if (old + 1u == (gen + 1u) * nloc) {
            __builtin_amdgcn_fence(__ATOMIC_RELEASE, "agent");
            asm volatile("s_waitcnt vmcnt(0)" ::: "memory");
            const unsigned og = xb_add(&bar[XB_TOP], 1u);
            const unsigned tg = og / nx;
            if (og + 1u == (tg + 1u) * nx) xb_add(&bar[XB_TOPGEN], 1u);
            else XB_SPIN(xb_ld(&bar[XB_TOPGEN]) == tg, bar);
            __builtin_amdgcn_fence(__ATOMIC_ACQUIRE, "agent");
            xb_add(&bar[XB_XGEN(b.x)], 1u);
            asm volatile("s_waitcnt vmcnt(0)" ::: "memory");
        } else {
            XB_SPIN(xb_ld(&bar[XB_XGEN(b.x)]) == gen, bar);
            __builtin_amdgcn_fence(__ATOMIC_ACQUIRE, "agent");
            asm volatile("s_waitcnt vmcnt(0)" ::: "memory");
        }
    }
    __syncthreads();
}

__device__ __forceinline__ float wave_sum(float v) {
#pragma unroll
    for (int o = 1; o < 64; o <<= 1) v += __shfl_xor(v, o);
    return v;
}
__device__ __forceinline__ int pos_gen(int n0) { return (n0 & ~255) + ((n0 >> 5) & 1) * 128 + ((n0 >> 6) & 3) * 32; }
__device__ __forceinline__ int pos_gu(int c0) { const int up = c0 >= 1024, cc = c0 & 1023; return (cc >> 7) * 256 + up * 128 + ((cc >> 5) & 3) * 32; }
__device__ __forceinline__ unsigned pack_i8(const f32x4& v) {
    const int a = (int)__builtin_rintf(v.x), b = (int)__builtin_rintf(v.y), c = (int)__builtin_rintf(v.z), d = (int)__builtin_rintf(v.w);
    return ((unsigned)a & 255u) | (((unsigned)b & 255u) << 8) | (((unsigned)c & 255u) << 16) | ((unsigned)d << 24);
}
__device__ __forceinline__ void win_absmax(const float* W, int k0, int n0, unsigned* cmax, unsigned* ccnt, int lane) {
    const int kc = lane >> 4, nq = lane & 15;
    f32x4 v[16];
#pragma unroll
    for (int i = 0; i < 16; ++i) v[i] = *(const f32x4*)(W + (size_t)(k0 + 16 * kc + i) * INW + n0 + 4 * nq);
    f32x4 mx = (f32x4){0.f, 0.f, 0.f, 0.f};
#pragma unroll
    for (int i = 0; i < 16; ++i) { mx.x = fmaxf(mx.x, fabsf(v[i].x)); mx.y = fmaxf(mx.y, fabsf(v[i].y)); mx.z = fmaxf(mx.z, fabsf(v[i].z)); mx.w = fmaxf(mx.w, fabsf(v[i].w)); }
#pragma unroll
    for (int c = 0; c < 4; ++c) { mx[c] = fmaxf(mx[c], __shfl_xor(mx[c], 16)); mx[c] = fmaxf(mx[c], __shfl_xor(mx[c], 32)); }
    if (kc == 0) {
#pragma unroll
        for (int c = 0; c < 4; ++c) (void)__hip_atomic_fetch_max(cmax + n0 + 4 * nq + c, __float_as_uint(mx[c]), RLX_AGENT);
    }
    asm volatile("s_waitcnt vmcnt(0)" ::: "memory");
    if (lane == 0) (void)__hip_atomic_fetch_add(ccnt, 1u, RLX_AGENT);
}
__device__ __forceinline__ void win_quant(const float* W, int k0, int n0, unsigned char* WT, unsigned* cmax, unsigned* ccnt, float* cs, bool write_cs, unsigned* tmo, int lane) {
    const int kc = lane >> 4, nq = lane & 15;
    f32x4 v[16];
#pragma unroll
    for (int i = 0; i < 16; ++i) v[i] = *(const f32x4*)(W + (size_t)(k0 + 16 * kc + i) * INW + n0 + 4 * nq);
    { unsigned sp = 0; while (__hip_atomic_load(ccnt, RLX_AGENT) < 16u) { __builtin_amdgcn_s_sleep(1);
        if ((++sp & 255u) == 0u) { if (__hip_atomic_load(tmo, RLX_AGENT)) break; if (sp > (1u << 18)) { atomicAdd(tmo, 1u); break; } } } }
    asm volatile("" ::: "memory");
    float sc[4];
#pragma unroll
    for (int c = 0; c < 4; ++c) { const float cm = __uint_as_float(__hip_atomic_load(cmax + n0 + 4 * nq + c, RLX_AGENT)); sc[c] = cm > 0.f ? 127.0f / cm : 0.f; if (write_cs && kc == 0) cs[n0 + 4 * nq + c] = cm * (1.0f / 127.0f); }
    const int nb = n0 + 32 * (nq >> 3);
    const int rowb = pos_gen(nb) + ((4 * nq) & 31);
#pragma unroll
    for (int c = 0; c < 4; ++c) {
        u32x4 o;
        o.x = pack_i8((f32x4){v[0][c], v[1][c], v[2][c], v[3][c]} * sc[c]); o.y = pack_i8((f32x4){v[4][c], v[5][c], v[6][c], v[7][c]} * sc[c]);
        o.z = pack_i8((f32x4){v[8][c], v[9][c], v[10][c], v[11][c]} * sc[c]); o.w = pack_i8((f32x4){v[12][c], v[13][c], v[14][c], v[15][c]} * sc[c]);
        *(u32x4*)(WT + (size_t)(rowb + c) * D + k0 + 16 * kc) = o;
    }
}
template <int MODE, int POSK>
__device__ __forceinline__ void tr_tile(const float* W, int N, int k0, int n0, unsigned char* WT, int ldt_bytes, int dk0, const float* ks, float wscale, int lane, int rowadj = 0) {
    const int kc = lane >> 4, nq = lane & 15;
    f32x4 v[16];
#pragma unroll
    for (int i = 0; i < 16; ++i) { const int kk = MODE ? (16 * kc + i) : (32 * (i >> 3) + 8 * kc + (i & 7)); v[i] = *(const f32x4*)(W + (size_t)(k0 + kk) * N + n0 + 4 * nq); }
    if (ks) {
#pragma unroll
        for (int i = 0; i < 16; ++i) { const int kk = MODE ? (16 * kc + i) : (32 * (i >> 3) + 8 * kc + (i & 7)); v[i] = v[i] * (ks[k0 + kk] * wscale); }
    } else if (MODE) {
#pragma unroll
        for (int i = 0; i < 16; ++i) v[i] = v[i] * wscale;
    }
    const int nb = n0 + 32 * (nq >> 3);
    const int rowb = (POSK ? pos_gu(nb) : pos_gen(nb)) + ((4 * nq) & 31) + rowadj;
#pragma unroll
    for (int c = 0; c < 4; ++c) {
        unsigned char* rp = WT + (size_t)(rowb + c) * ldt_bytes;
        if (MODE == 0) {
#pragma unroll
            for (int p = 0; p < 2; ++p) { u32x4 o; o.x = pk2(v[8 * p + 0][c], v[8 * p + 1][c]); o.y = pk2(v[8 * p + 2][c], v[8 * p + 3][c]); o.z = pk2(v[8 * p + 4][c], v[8 * p + 5][c]); o.w = pk2(v[8 * p + 6][c], v[8 * p + 7][c]);
                *(u32x4*)(rp + (size_t)(dk0 + 32 * p + 8 * kc) * 2) = o; }
        } else {
            int w0 = 0, w1 = 0, w2 = 0, w3 = 0;
            w0 = __builtin_amdgcn_cvt_pk_fp8_f32(v[0][c], v[1][c], w0, false); w0 = __builtin_amdgcn_cvt_pk_fp8_f32(v[2][c], v[3][c], w0, true);
            w1 = __builtin_amdgcn_cvt_pk_fp8_f32(v[4][c], v[5][c], w1, false); w1 = __builtin_amdgcn_cvt_pk_fp8_f32(v[6][c], v[7][c], w1, true);
            w2 = __builtin_amdgcn_cvt_pk_fp8_f32(v[8][c], v[9][c], w2, false); w2 = __builtin_amdgcn_cvt_pk_fp8_f32(v[10][c], v[11][c], w2, true);
            w3 = __builtin_amdgcn_cvt_pk_fp8_f32(v[12][c], v[13][c], w3, false); w3 = __builtin_amdgcn_cvt_pk_fp8_f32(v[14][c], v[15][c], w3, true);
            *(u32x4*)(rp + (size_t)(dk0 + 16 * kc)) = (u32x4){(unsigned)w0, (unsigned)w1, (unsigned)w2, (unsigned)w3};
        }
    }
}

struct Args { const float* in[20]; float* out; unsigned char* ws; int ph_lo, ph_hi, li, pad; };

__global__ void __launch_bounds__(512, 2) moe_block_fwd(Args args) {
    extern __shared__ __attribute__((aligned(16))) unsigned char lds_raw[];
    LAS unsigned char* lds = (LAS unsigned char*)lds_raw;
    volatile LAS unsigned* MISC = (volatile LAS unsigned*)(lds + MISC_OFF);
    const int tid = threadIdx.x, lane = tid & 63, wave = __builtin_amdgcn_readfirstlane(tid >> 6);
    const int G = gridDim.x, bx = blockIdx.x;
    const int vcu = (G % 8 == 0) ? (bx % 8) * (G / 8) + bx / 8 : bx;
    unsigned char* ws = args.ws;
    gu32* ctl = (gu32*)(ws + WS_CTL);
    const float* x = args.in[0]; const float* norm1_g = args.in[1]; const float* w_in = args.in[2]; const float* q_norm_g = args.in[3]; const float* k_norm_g = args.in[4];
    const float* rel_bias = args.in[5]; const float* sg_ln_g = args.in[6]; const float* sg_ln_b = args.in[7]; const float* sg_w = args.in[8]; const float* sg_b = args.in[9];
    const float* w_branch_a = args.in[10]; const float* w_branch_b = args.in[11]; const float* w_out = args.in[12]; const float* norm2_g = args.in[13];
    const float* router_w = args.in[14]; const float* router_b = args.in[15]; const float* w_gate_up = args.in[16]; const float* b_gate_up = args.in[17];
    const float* w_down = args.in[18]; const float* b_down = args.in[19];
    float* out = args.out;
    bf16* WIN = (bf16*)(ws + WS_WIN); unsigned char* WIN8 = ws + WS_WIN8; float* HS = (float*)(ws + WS_HS); float* CS = (float*)(ws + WS_CS); unsigned char* H8 = ws + WS_H8; bf16* WAB = (bf16*)(ws + WS_WAB); bf16* WO = (bf16*)(ws + WS_WO); bf16* WRH = (bf16*)(ws + WS_WR); bf16* WRL = (bf16*)(ws + WS_WR + 65536); bf16* WM = (bf16*)(ws + WS_WM);
    int* LID = (int*)(ws + WS_LID); float* LRS = (float*)(ws + WS_LRS); float* LP = (float*)(ws + WS_LP);
    unsigned char* WGU = ws + WS_WGU; unsigned char* WD = ws + WS_WD;
    bf16* HB = (bf16*)(ws + WS_H); bf16* QB = (bf16*)(ws + WS_Q); bf16* KB = (bf16*)(ws + WS_K); bf16* VB = (bf16*)(ws + WS_V);
    bf16* UG = (bf16*)(ws + WS_UG); bf16* VG = (bf16*)(ws + WS_VG); unsigned char* GA = ws + WS_GA; bf16* GB = (bf16*)(ws + WS_GB);
    bf16* YCAT = (bf16*)(ws + WS_YCAT); unsigned char* X1Q = ws + WS_X1B; bf16* X1H = (bf16*)(ws + WS_X1H); unsigned char* ACT = ws + WS_ACT; unsigned char* YB = ws + WS_Y;

    for (int u = tid; u < (LDS_BYTES - LDSCTL_OFF) / 4; u += 512) ((LAS unsigned*)(lds + LDSCTL_OFF))[u] = 0u;
    __syncthreads();
    XcdBarrier bar; bar.bar = (unsigned*)(ctl + CW_BAR); bar.x = 0; bar.st = nullptr;
    if (MK_N_LAUNCHES == 1) bar = xcd_barrier_post((unsigned*)(ctl + CW_BAR), MISC + 8);
    const int lo = args.ph_lo, hi = args.ph_hi;
#define IN(k) (lo <= (k) && (k) < hi)
#define SEAM(k) do { if (IN(k) && IN((k) + 1)) xcd_barrier(bar); } while (0)
#define REPS(k) for (int rep_ = 0; rep_ < ((REP_PHASE == (k)) ? 2 : 1); ++rep_)
#define REPSEAM(k) do { if (REP_PHASE == (k) && rep_ == 0) xcd_barrier(bar); } while (0)
    const int gw = vcu * 8 + wave, NGW = G * 8;

    if (IN(0)) REPS(0) {
        constexpr int I_IN = 16 * 72, I_A = 8 * 16, I_O = 16 * 16, I_GU = 16 * 32, I_D = 16 * 16;
        constexpr int NITEMS = I_IN + 2 * I_A + I_O;
        for (int it = gw; it < NITEMS; it += NGW) {
            int r = it;
            if (r < I_IN) { const int kb = r / 72, nb = r % 72; win_absmax(w_in, 64 * kb, 64 * nb, (unsigned*)(ctl + CW_CMAX), (unsigned*)(ctl + CW_CCNT + nb), lane); continue; } r -= I_IN;
            if (r < I_A) { const int kb = r / 16, nb = r % 16; tr_tile<0, 0>(w_branch_a, D, 64 * kb, 64 * nb, (unsigned char*)WAB, D * 2, 64 * kb, nullptr, 1.f, lane); continue; } r -= I_A;
            if (r < I_A) { const int kb = r / 16, nb = r % 16; tr_tile<0, 0>(w_branch_b, D, 64 * kb, 64 * nb, (unsigned char*)WAB, D * 2, 512 + 64 * kb, nullptr, 1.f, lane); continue; } r -= I_A;
            { const int kb = r / 16, nb = r % 16; tr_tile<0, 0>(w_out, D, 64 * kb, 64 * nb, (unsigned char*)WO, D * 2, 64 * kb, nullptr, 1.f, lane); }
        }
        for (int i = gw * 64 + lane; i < 4 * 128 * 128; i += NGW * 64) { const int s = i & 127, t = (i >> 7) & 127; WM[i] = (bf16)f2bf(s <= t ? sg_w[i] : 0.f); }
        for (int i = gw * 64 + lane; i < NE * D; i += NGW * 64) { const int k = i & 1023, e = i >> 10; const float w = router_w[k * NE + e] * norm2_g[k]; const unsigned h_ = f2bf(w); WRH[i] = (bf16)h_; WRL[i] = (bf16)f2bf(w - bf2f((unsigned short)h_)); }
        for (int m = 2 * gw; m < T; m += 2 * NGW) {
            const f32x4* xr = (const f32x4*)(x + (size_t)m * D) + lane; const f32x4* gr = (const f32x4*)norm1_g + lane;
            f32x4 v[2][4]; float s0 = 0.f, s1 = 0.f, a0 = 0.f, a1 = 0.f;
#pragma unroll
            for (int j = 0; j < 4; ++j) { v[0][j] = xr[64 * j]; v[1][j] = xr[256 + 64 * j]; }
#pragma unroll
            for (int j = 0; j < 4; ++j) { const f32x4 gq = gr[64 * j];
                s0 += (v[0][j].x * v[0][j].x + v[0][j].y * v[0][j].y) + (v[0][j].z * v[0][j].z + v[0][j].w * v[0][j].w);
                s1 += (v[1][j].x * v[1][j].x + v[1][j].y * v[1][j].y) + (v[1][j].z * v[1][j].z + v[1][j].w * v[1][j].w);
                v[0][j] = v[0][j] * gq; v[1][j] = v[1][j] * gq;
                a0 = fmaxf(a0, fmaxf(fmaxf(fabsf(v[0][j].x), fabsf(v[0][j].y)), fmaxf(fabsf(v[0][j].z), fabsf(v[0][j].w))));
                a1 = fmaxf(a1, fmaxf(fmaxf(fabsf(v[1][j].x), fabsf(v[1][j].y)), fmaxf(fabsf(v[1][j].z), fabsf(v[1][j].w)))); }
            s0 = wave_sum(s0); s1 = wave_sum(s1);
#pragma unroll
            for (int o = 1; o < 64; o <<= 1) { a0 = fmaxf(a0, __shfl_xor(a0, o)); a1 = fmaxf(a1, __shfl_xor(a1, o)); }
            const float rs0 = 1.0f / sqrtf(s0 * (1.0f / D) + EPS), rs1 = 1.0f / sqrtf(s1 * (1.0f / D) + EPS);
            const float q0 = a0 > 0.f ? 127.0f / a0 : 0.f, q1 = a1 > 0.f ? 127.0f / a1 : 0.f;
            if (lane == 0) { HS[m] = rs0 * a0 * (1.0f / 127.0f); HS[m + 1] = rs1 * a1 * (1.0f / 127.0f); }
            unsigned* q8 = (unsigned*)(H8 + (size_t)m * D) + lane;
#pragma unroll
            for (int j = 0; j < 4; ++j) { q8[64 * j] = pack_i8(v[0][j] * q0); q8[256 + 64 * j] = pack_i8(v[1][j] * q1); }
        }
        for (int it = gw; it < I_IN; it += NGW) { const int kb = it / 72, nb = it % 72;
            win_quant(w_in, 64 * kb, 64 * nb, WIN8, (unsigned*)(ctl + CW_CMAX), (unsigned*)(ctl + CW_CCNT + nb), CS, kb == 0, (unsigned*)(ctl + CW_BAR) + XB_TMO, lane); }
        REPSEAM(0);
    }
    SEAM(0);

    if (IN(1)) REPS(1) {
        { PolIn P; P.so.init(T, INW, G, bx); P.A = H8; P.Bt = WIN8; P.ws = ws; P.qg = q_norm_g; P.kg = k_norm_g; P.hs = HS; P.cs = CS;
          pg8::gemm_phase<PolIn>(lds, P); }
        REPSEAM(1);
    }
    SEAM(1);

    if (IN(2)) REPS(2) {
        const MoeConv cv{w_gate_up, w_down, norm2_g, WGU, WD}; MoeConv::Regs sreg; int sctr = 0;
        for (int u = vcu; u < NB * NHEAD * 32; u += G) {
            const int cg = u & 31, bh = u >> 5;
            att::unit(bh >> 3, bh & 7, cg, QB, KB, VB, rel_bias, YCAT, lds, cv, sreg, sctr, gw, NGW);
        }
        sgu_load_wm(vcu & 3, WM, lds);
        for (int it = vcu; it < 4 * (T / 128); it += G) sgu_item(it, VG, UG, sg_ln_g, sg_ln_b, sg_b, YCAT, lds, cv, sreg, sctr, gw, NGW);
        cv.drain(sreg, sctr, gw, NGW, lane);
        REPSEAM(2);
    }
    SEAM(2);

    if (IN(3)) REPS(3) {
        PolMerge P; P.so.init(T, D, G, bx); P.A = YCAT; P.Bt = WAB; P.ga = GA; P.gb = (const unsigned char*)GB; P.out = HB;
        pg8::gemm_phase<PolMerge>(lds, P);
        REPSEAM(3);
    }
    SEAM(3);

    if (IN(4)) REPS(4) {
        PolOut P; P.so.init(T, D, G, bx); P.A = HB; P.Bt = WO; P.x = x; P.x1 = X1H; P.x1q = X1Q;
        pg8::gemm_phase<PolOut>(lds, P);
        REPSEAM(4);
    }
    SEAM(4);

    if (IN(5)) {
        LAS int* lcnt = (LAS int*)(lds + PARK_OFF); LAS int* gbase = lcnt + 32;
        if (tid < 64) lcnt[tid] = 0;
        for (int i = tid; i < 4096; i += 512) { const int e = i & 31, gq = (i >> 5) & 3, kq = i >> 7;
            *(LAS u32x4*)(lds + (size_t)i * 16) = *(const u32x4*)(WRH + (size_t)e * D + 32 * kq + 8 * gq); *(LAS u32x4*)(lds + 65536 + (size_t)i * 16) = *(const u32x4*)(WRL + (size_t)e * D + 32 * kq + 8 * gq); }
        __syncthreads();
        const int r = lane & 15, g = lane >> 4;
        int sel_e[4], sel_rank[4]; float sel_p[4]; float rs_row = 0.f; int tok = 0;
        for (int grp = bx * 8 + wave; grp < T / 16; grp += NGW) {
            const int row0 = grp * 16; tok = row0 + r;
            const bf16* xr = X1H + (size_t)(row0 + r) * D + 8 * g;
            const LAS unsigned char* wl_ = lds + (g * 32 + r) * 16;
            f32x4 a0 = (f32x4){0.f, 0.f, 0.f, 0.f}, a1 = a0; float ssq = 0.f;
            u32x4 xq[4][4];
#define P5_LOAD(S, ss) do { _Pragma("unroll") for (int q = 0; q < 4; ++q) xq[S][q] = *(const u32x4*)(xr + 128 * (ss) + 32 * q); } while (0)
#define P5_COMP(S, ss) do { _Pragma("unroll") for (int q = 0; q < 4; ++q) { const u32x4 w_ = xq[S][q]; const int ks = 4 * (ss) + q; \
                const bf16x8 wh_0 = *(const LAS bf16x8*)(wl_ + ks * 2048), wh_1 = *(const LAS bf16x8*)(wl_ + ks * 2048 + 256), wl_0 = *(const LAS bf16x8*)(wl_ + 65536 + ks * 2048), wl_1 = *(const LAS bf16x8*)(wl_ + 65536 + ks * 2048 + 256); \
                ssq += (bflo(w_.x) * bflo(w_.x) + bfhi(w_.x) * bfhi(w_.x)) + (bflo(w_.y) * bflo(w_.y) + bfhi(w_.y) * bfhi(w_.y)) + (bflo(w_.z) * bflo(w_.z) + bfhi(w_.z) * bfhi(w_.z)) + (bflo(w_.w) * bflo(w_.w) + bfhi(w_.w) * bfhi(w_.w)); \
                const bf16x8 xh = __builtin_bit_cast(bf16x8, w_); \
                a0 = __builtin_amdgcn_mfma_f32_16x16x32_bf16(wh_0, xh, a0, 0, 0, 0); a1 = __builtin_amdgcn_mfma_f32_16x16x32_bf16(wh_1, xh, a1, 0, 0, 0); \
                a0 = __builtin_amdgcn_mfma_f32_16x16x32_bf16(wl_0, xh, a0, 0, 0, 0); a1 = __builtin_amdgcn_mfma_f32_16x16x32_bf16(wl_1, xh, a1, 0, 0, 0); } } while (0)
            P5_LOAD(0, 0); P5_LOAD(1, 1); P5_LOAD(2, 2); P5_LOAD(3, 3);
            P5_COMP(0, 0); P5_LOAD(0, 4);
            P5_COMP(1, 1); P5_LOAD(1, 5);
            P5_COMP(2, 2); P5_LOAD(2, 6);
            P5_COMP(3, 3); P5_LOAD(3, 7);
            P5_COMP(0, 4); P5_COMP(1, 5); P5_COMP(2, 6); P5_COMP(3, 7);
#undef P5_LOAD
#undef P5_COMP
            ssq += __shfl_xor(ssq, 16); ssq += __shfl_xor(ssq, 32);
            const float rs = 1.0f / sqrtf(ssq * (1.0f / D) + EPS); rs_row = rs;
            float v[8];
#pragma unroll
            for (int j = 0; j < 4; ++j) { v[j] = a0[j] * rs + router_b[4 * g + j]; v[4 + j] = a1[j] * rs + router_b[16 + 4 * g + j]; }
            unsigned taken = 0u; float sel_v[4];
#pragma unroll
            for (int k = 0; k < 4; ++k) {
                float best = -INFINITY; int bi = 1 << 20;
#pragma unroll
                for (int i = 0; i < 8; ++i) { const int ei = (i >> 2) * 16 + 4 * g + (i & 3); if (!((taken >> i) & 1u) && v[i] > best) { best = v[i]; bi = ei; } }
#pragma unroll
                for (int m = 16; m <= 32; m <<= 1) { const float ob = __shfl_xor(best, m); const int oi = __shfl_xor(bi, m); if (ob > best || (ob == best && oi < bi)) { best = ob; bi = oi; } }
                sel_e[k] = bi; sel_v[k] = best;
                if (((bi & 15) >> 2) == g) taken |= 1u << (((bi >> 4) << 2) | (bi & 3));
            }
            float den = 0.f;
#pragma unroll
            for (int k = 0; k < 4; ++k) { sel_p[k] = __expf(sel_v[k] - sel_v[0]); den += sel_p[k]; }
            const float inv = 1.0f / den;
#pragma unroll
            for (int k = 0; k < 4; ++k) sel_p[k] *= inv;
            if (g == 0) {
#pragma unroll
                for (int k = 0; k < 4; ++k) sel_rank[k] = __hip_atomic_fetch_add(lcnt + sel_e[k], 1, __ATOMIC_RELAXED, __HIP_MEMORY_SCOPE_WORKGROUP);
            }
        }
        __syncthreads();
        if (tid < NE) gbase[tid] = (int)__hip_atomic_fetch_add((unsigned*)(ctl + CW_CNT + tid), (unsigned)lcnt[tid], RLX_AGENT);
        __syncthreads();
        if (g == 0 && (bx * 8 + wave) < T / 16) {
#pragma unroll
            for (int k = 0; k < 4; ++k) { const size_t pos = (size_t)sel_e[k] * LCAP + gbase[sel_e[k]] + sel_rank[k];
                LID[pos] = tok * 4 + k; LRS[pos] = rs_row; LP[pos] = sel_p[k]; }
        }
        __syncthreads();
    }
    SEAM(5);

    if (IN(6) || IN(7)) {
        LAS int* tb = (LAS int*)(lds + MOE_OFF);
        if (tid < NE) tb[33 + tid] = (int)__hip_atomic_load(ctl + CW_CNT + tid, RLX_AGENT);
        __syncthreads();
        if (tid == 0) { int acc = 0; for (int e = 0; e < NE; ++e) { tb[e] = acc; acc += (tb[33 + e] + 255) >> 8; } tb[32] = acc; }
        __syncthreads();
    }
    if (IN(6)) REPS(6) {
        PolGU P; P.mo.init((const LAS int*)(lds + MOE_OFF), 8, G, bx); P.A = X1Q; P.Bt = WGU; P.lid = LID; P.lrs = LRS; P.bgu = b_gate_up; P.act = ACT; P.shm = lds;
        pg8::gemm_phase<PolGU>(lds, P);
        REPSEAM(6);
    }
    SEAM(6);
    if (IN(7)) REPS(7) {
        PolDown P; P.mo.init((const LAS int*)(lds + MOE_OFF), 4, G, bx); P.A = ACT; P.Bt = WD; P.lid = LID; P.lp = LP; P.bd = b_down; P.y = YB; P.shm = lds;
        pg8::gemm_phase<PolDown>(lds, P);
        REPSEAM(7);
    }
    SEAM(7);
    if (IN(8)) {
        f32x4 xa[4], xb[4]; u32x4 ya[4], yb[4];
#define P8_LOAD(X, Y, m_) do { const bf16* xr_ = X1H + (size_t)(m_) * D + 16 * lane; { f32x4 a_, b_; ld8(xr_, a_, b_); X[0] = a_; X[1] = b_; ld8(xr_ + 8, a_, b_); X[2] = a_; X[3] = b_; } \
            _Pragma("unroll") for (int k = 0; k < 4; ++k) Y[k] = *(const u32x4*)(YB + ((size_t)(m_) * 4 + k) * D + 16 * lane); } while (0)
#define P8_DONE(X, Y, m_) do { _Pragma("unroll") for (int k = 0; k < 4; ++k) { const unsigned ww[4] = {Y[k].x, Y[k].y, Y[k].z, Y[k].w}; \
            _Pragma("unroll") for (int q = 0; q < 4; ++q) { const f32x2 lo_ = __builtin_amdgcn_cvt_pk_f32_fp8((int)ww[q], false), hi_ = __builtin_amdgcn_cvt_pk_f32_fp8((int)ww[q], true); \
                X[q][0] += lo_[0] * 0.0625f; X[q][1] += lo_[1] * 0.0625f; X[q][2] += hi_[0] * 0.0625f; X[q][3] += hi_[1] * 0.0625f; } } \
            float* or_ = out + (size_t)(m_) * D + 16 * lane; _Pragma("unroll") for (int j = 0; j < 4; ++j) *(f32x4*)(or_ + 4 * j) = X[j]; } while (0)
        for (int m = gw; m < T; m += 2 * NGW) { const int m2 = m + NGW;
            P8_LOAD(xa, ya, m); P8_LOAD(xb, yb, m2);
            P8_DONE(xa, ya, m); P8_DONE(xb, yb, m2); }
#undef P8_LOAD
#undef P8_DONE
    }
#undef IN
#undef SEAM
}

extern "C" void kernel_launch(void* const* d_in, const int* in_sizes, int n_in, void* d_out, int out_size, void* d_ws, size_t ws_size, hipStream_t stream) {
    static int grid = 0;
    if (grid == 0) {
        if (n_in != 20 || in_sizes[0] != T * D || out_size != T * D || ws_size < WS_END) { fprintf(stderr, "kernel_launch: unexpected shapes (n_in %d, ws %zu)\n", n_in, ws_size); grid = -1; return; }
        int dev = 0, cus = 0;
        if (hipGetDevice(&dev) != hipSuccess || hipDeviceGetAttribute(&cus, hipDeviceAttributeMultiprocessorCount, dev) != hipSuccess) { grid = -1; return; }
        if (hipFuncSetAttribute((const void*)moe_block_fwd, hipFuncAttributeMaxDynamicSharedMemorySize, LDS_BYTES) != hipSuccess) { fprintf(stderr, "kernel_launch: hipFuncSetAttribute failed\n"); grid = -1; return; }
        (void)hipGetLastError();
        grid = cus;
        if (grid != 256) { fprintf(stderr, "kernel_launch: built for a 256-CU device, got %d\n", cus); grid = -1; return; }
    }
    if (grid < 0) return;
    if (hipMemsetAsync((char*)d_ws + WS_CTL, 0, CTL_ZERO_BYTES, stream) != hipSuccess) return;
    Args a{};
    for (int i = 0; i < 20; ++i) a.in[i] = (const float*)d_in[i];
    a.out = (float*)d_out; a.ws = (unsigned char*)d_ws;
    constexpr int NPH = 9;
    for (int li = 0; li < MK_N_LAUNCHES; ++li) {
        a.ph_lo = (MK_N_LAUNCHES == 1) ? 0 : li; a.ph_hi = (MK_N_LAUNCHES == 1) ? NPH : li + 1; a.li = li;
        hipLaunchKernelGGL(moe_block_fwd, dim3(grid), dim3(512), LDS_BYTES, stream, a);
    }
}
```

```cpp
#include <hip/hip_runtime.h>
#include <cstdio>
#include <cstdint>

#ifndef MK_N_LAUNCHES
#define MK_N_LAUNCHES 1
#endif

#ifndef REP_PHASE
#define REP_PHASE -1
#endif
#define LAS __attribute__((address_space(3)))
#define GAS __attribute__((address_space(1)))
typedef unsigned short bf16;
typedef short bf16x8 __attribute__((ext_vector_type(8)));
typedef short s16x4 __attribute__((ext_vector_type(4)));
typedef float f32x2 __attribute__((ext_vector_type(2)));
typedef float f32x4 __attribute__((ext_vector_type(4)));
typedef float f32x16 __attribute__((ext_vector_type(16)));
typedef unsigned u32x2 __attribute__((ext_vector_type(2)));
typedef unsigned u32x4 __attribute__((ext_vector_type(4)));
typedef GAS unsigned gu32;

constexpr int NB = 4, SEQ = 8192, T = NB * SEQ, D = 1024, AW = 512, SGW = 512, INW = 4608, NE = 32, FF = 1024;
constexpr int NHEAD = 8, HD = 64, CHUNK = 64, NBACK = 8, NREL = 513;
constexpr int LCAP = 32768;
constexpr float LOG2E = 1.4426950408889634f;
constexpr float EPS = 1e-6f;

constexpr size_t MiB = 1u << 20;
constexpr size_t WS_CTL = 0, CTL_ZERO_BYTES = 1 * MiB;
constexpr size_t WS_WIN = 7 * MiB;
constexpr size_t WS_WAB = 11 * MiB;
constexpr size_t WS_WO = 13 * MiB;
constexpr size_t WS_WR = 15 * MiB;
constexpr size_t WS_WM = 15 * MiB + 256 * 1024;
constexpr size_t WS_WIN8 = 2 * MiB;
constexpr size_t WS_HS = 15 * MiB + 512 * 1024;
constexpr size_t WS_CS = 15 * MiB + 768 * 1024;
constexpr size_t WS_H8 = 976 * MiB;
constexpr size_t WS_LID = 16 * MiB;
constexpr size_t WS_LRS = 20 * MiB;
constexpr size_t WS_LP = 24 * MiB;
constexpr size_t WS_WGU = 28 * MiB;
constexpr size_t WS_WD = 156 * MiB;
constexpr size_t WS_H = 220 * MiB;
constexpr size_t WS_Q = 284 * MiB, WS_K = 316 * MiB, WS_V = 348 * MiB;
constexpr size_t WS_UG = 380 * MiB, WS_VG = 412 * MiB;
constexpr size_t WS_GA = 444 * MiB, WS_GB = 508 * MiB;
constexpr size_t WS_YCAT = 572 * MiB;
constexpr size_t WS_X1B = 636 * MiB;
constexpr size_t WS_ACT = 700 * MiB;
constexpr size_t WS_X1H = 380 * MiB;
constexpr size_t WS_Y = 220 * MiB;
constexpr size_t WS_END = 1008 * MiB;
constexpr int CW_TMO = 0, CW_CODE = 1;
constexpr int CW_CNT = 64;
constexpr int CW_BAR = 4096;
constexpr int CW_CMAX = 8192;
constexpr int CW_CCNT = 16384;

constexpr int RING_BYTES = 131072;
constexpr int LDSCTL_OFF = RING_BYTES, MISC_OFF = LDSCTL_OFF + 320;
constexpr int MOE_OFF = MISC_OFF + 128;
constexpr int PARK_OFF = LDSCTL_OFF + 1024;
constexpr int ROWS_OFF = LDSCTL_OFF + 9216, ROWS_BUF = 3072;
constexpr int LDS_BYTES = 147456;

#define LDS_WAIT() asm volatile("s_waitcnt lgkmcnt(0)" ::: "memory")
#define VM_WAIT() asm volatile("s_waitcnt vmcnt(0)" ::: "memory")
#define RLX_AGENT __ATOMIC_RELAXED, __HIP_MEMORY_SCOPE_AGENT

__device__ __forceinline__ unsigned f2bf(float f) { unsigned u = __builtin_bit_cast(unsigned, f); return (u + 0x7fffu + ((u >> 16) & 1u)) >> 16; }
__device__ __forceinline__ unsigned pk2(float lo, float hi) { return f2bf(lo) | (f2bf(hi) << 16); }
__device__ __forceinline__ float bf2f(unsigned short b) { return __builtin_bit_cast(float, (unsigned)b << 16); }
__device__ __forceinline__ float bflo(unsigned w) { return __builtin_bit_cast(float, w << 16); }
__device__ __forceinline__ float bfhi(unsigned w) { return __builtin_bit_cast(float, w & 0xffff0000u); }
__device__ __forceinline__ unsigned cvt_pk_bf16(float lo, float hi) { unsigned r; asm volatile("v_cvt_pk_bf16_f32 %0, %1, %2" : "=v"(r) : "v"(lo), "v"(hi)); return r; }
__device__ __forceinline__ float fast_rcp(float x) { return __builtin_amdgcn_rcpf(x); }
__device__ __forceinline__ float fast_exp2(float x) { return __builtin_amdgcn_exp2f(x); }
__device__ __forceinline__ float sigmoidf_(float x) { return fast_rcp(1.0f + fast_exp2(-LOG2E * x)); }
__device__ __forceinline__ float gelu_tanh(float x) {
    const float t = x * ((-LOG2E * 1.5957691216057308f) + (-LOG2E * 1.5957691216057308f * 0.044715f) * (x * x));
    return x * fast_rcp(1.0f + fast_exp2(t));
}

namespace pg8 {
constexpr int BM = 256, BK = 64, HALF = 128, HTB = HALF * BK * 2, STAGE_BYTES = 8 * HTB, NXCD = 8, WGM = 8;
__host__ __device__ __forceinline__ int lds_byte(int r, int c) { const int st = (r >> 4) * 2 + (c >> 5), rr = r & 15, cc = c & 31, ob = rr * 64 + cc * 2; return st * 1024 + (ob ^ (((ob >> 9) & 1) << 5)); }
__host__ __device__ __forceinline__ void stage_rc(int b, int& R, int& C) { const int st = b / 1024, sb = b % 1024, swz = sb ^ (((sb >> 9) & 1) << 5); R = (st >> 1) * 16 + swz / 64; C = (st & 1) * 32 + (swz % 64) / 2; }
__host__ __device__ __forceinline__ int perm32(int rho) { const int n = rho >> 4, i = rho & 15; return 8 * (i >> 2) + 4 * n + (i & 3); }

typedef int v4i_t __attribute__((ext_vector_type(4)));
typedef int v8i_t __attribute__((ext_vector_type(8)));
__device__ __forceinline__ v8i_t cat8(bf16x8 lo, bf16x8 hi) { return __builtin_shufflevector(__builtin_bit_cast(v4i_t, lo), __builtin_bit_cast(v4i_t, hi), 0, 1, 2, 3, 4, 5, 6, 7); }
struct Unit { int pm, pn, e, s0, cnt, idx; };

struct StaticOrder {
    int nM, nN, nwg, G, c;
    __device__ void init(int M, int N, int G_, int c_) { nM = M / BM; nN = N / BM; nwg = nM * nN; G = G_; c = c_; }
    __device__ bool tile(int i, int& pm, int& pn) const {
        const long L = (long)i * G + c; if (L >= nwg) return false;
        int wgid = (int)L; { const int q = nwg / NXCD, r = nwg % NXCD, xcd = wgid % NXCD, off = wgid / NXCD; wgid = (xcd < r ? xcd * (q + 1) : r * (q + 1) + (xcd - r) * q) + off; }
        const int nig = WGM * nN, gid = wgid / nig, fm = gid * WGM, gsz = (nM - fm) < WGM ? (nM - fm) : WGM;
        pm = fm + ((wgid % nig) % gsz); pn = (wgid % nig) / gsz; return true;
    }
};

template <class P>
__device__ __forceinline__ void gemm_phase(LAS unsigned char* lds, const P& S) {
    const int tid = threadIdx.x, wid = __builtin_amdgcn_readfirstlane(tid >> 6), lane = tid & 63, wr = wid >> 2, wc = wid & 3, fr = lane & 15, fq = lane >> 4;
    constexpr int nt = P::NT;
    unsigned vA[2][2], voffB[2];
    LAS u32x4* park = (LAS u32x4*)(lds + PARK_OFF) + tid;
#pragma unroll
    for (int i = 0; i < 2; ++i) { int R, C; stage_rc(tid * 16 + i * 8192, R, C); const int Rb = (R & ~31) + perm32(R & 31);
        vA[0][i] = (unsigned)(R * P::LDA + C) * 2u; vA[1][i] = (unsigned)((R + HALF) * P::LDA + C) * 2u; voffB[i] = (unsigned)(Rb * P::LDB + C) * 2u; }
    const size_t kstep = (size_t)(BK * 2);
    const size_t hstepB = (size_t)HALF * P::LDB * 2;
    const unsigned ldsw = (unsigned)wid * 1024u;
    const int aoff = lds_byte(wr * 64 + fr, fq * 8), boff = lds_byte(wc * 32 + fr, fq * 8);
#define PG8_SA(b, h) (((b) * 2 + (h)) * HTB)
#define PG8_SB(b, h) ((4 + (b) * 2 + (h)) * HTB)
#define PG8_STAGE2(bufoff, gbase, o0, o1) do { \
        __builtin_amdgcn_global_load_lds((const unsigned*)((const char*)(gbase) + (o0)), (LAS unsigned*)(lds + (bufoff) + ldsw), 16, 0, 0); \
        __builtin_amdgcn_global_load_lds((const unsigned*)((const char*)(gbase) + (o1)), (LAS unsigned*)(lds + (bufoff) + ldsw + 8192), 16, 0, 0); } while (0)
#define PG8_STAGEB(bufoff, gbase) PG8_STAGE2(bufoff, gbase, voffB[0], voffB[1])
#define PG8_LDA(dst, b, h) do { _Pragma("unroll") for (int m = 0; m < 4; ++m) _Pragma("unroll") for (int k = 0; k < 2; ++k) dst[m][k] = *(const LAS bf16x8*)(lds + PG8_SA(b, h) + aoff + m * 2048 + k * 1024); } while (0)
#define PG8_LDB(dst, b, h) do { _Pragma("unroll") for (int n = 0; n < 2; ++n) _Pragma("unroll") for (int k = 0; k < 2; ++k) dst[n][k] = *(const LAS bf16x8*)(lds + PG8_SB(b, h) + boff + n * 2048 + k * 1024); } while (0)
#define PG8_MMA(ai, bj, At, Bt) do { __builtin_amdgcn_s_setprio(1); _Pragma("unroll") for (int m = 0; m < 4; ++m) _Pragma("unroll") for (int n = 0; n < 2; ++n) { \
        if constexpr (P::I8) { _Pragma("unroll") for (int k = 0; k < 2; ++k) acc[ai][bj][m][n] = __builtin_bit_cast(f32x4, __builtin_amdgcn_mfma_i32_16x16x64_i8(__builtin_bit_cast(v4i_t, Bt[n][k]), __builtin_bit_cast(v4i_t, At[m][k]), __builtin_bit_cast(v4i_t, acc[ai][bj][m][n]), 0, 0, 0)); }     \
        else if constexpr (P::FP8) { acc[ai][bj][m][n] = __builtin_amdgcn_mfma_scale_f32_16x16x128_f8f6f4(cat8(Bt[n][0], Bt[n][1]), cat8(At[m][0], At[m][1]), acc[ai][bj][m][n], 0, 0, 0, 0, 0, 0); }     \
        else { _Pragma("unroll") for (int k = 0; k < 2; ++k) acc[ai][bj][m][n] = __builtin_amdgcn_mfma_f32_16x16x32_bf16(Bt[n][k], At[m][k], acc[ai][bj][m][n], 0, 0, 0); } } \
        __builtin_amdgcn_s_setprio(0); } while (0)
#define PG8_WAIT_V(n) asm volatile("s_waitcnt vmcnt(" #n ")" ::: "memory")
#define PG8_WAIT_L(n) asm volatile("s_waitcnt lgkmcnt(" #n ")" ::: "memory")
#define PG8_BAR __builtin_amdgcn_s_barrier()
#define PG8_SCHED __builtin_amdgcn_sched_barrier(0)
    Unit cur, nxt; int ui = 0;
    if (!S.next(0, cur)) return;
    if constexpr (P::GATHER) S.a_off(cur, tid, vA);
    f32x4 acc[2][2][4][2];
#pragma unroll
    for (int a = 0; a < 2; ++a)
#pragma unroll
        for (int b = 0; b < 2; ++b)
#pragma unroll
            for (int m = 0; m < 4; ++m)
#pragma unroll
                for (int n = 0; n < 2; ++n) acc[a][b][m][n] = (f32x4){0.f, 0.f, 0.f, 0.f};
    bf16x8 At[4][2], B0[2][2], B1[2][2];
    const char* cA = S.a_ptr(cur); const char* cB = S.b_ptr(cur);
    PG8_STAGEB(PG8_SB(0, 0), cB); PG8_STAGEB(PG8_SB(0, 1), cB + hstepB); PG8_STAGE2(PG8_SA(0, 0), cA, vA[0][0], vA[0][1]); PG8_STAGE2(PG8_SA(0, 1), cA, vA[1][0], vA[1][1]);
    if (wr == 1) PG8_BAR;
    PG8_WAIT_V(2); PG8_BAR;
    PG8_STAGEB(PG8_SB(1, 0), cB + kstep); PG8_STAGE2(PG8_SA(1, 0), cA + kstep, vA[0][0], vA[0][1]); PG8_STAGEB(PG8_SB(1, 1), cB + hstepB + kstep);
    PG8_WAIT_V(6); PG8_BAR;
    for (;;) {
        const bool has_next = S.next(ui + 1, nxt);
        if constexpr (P::ROWDMA) S.row_dma(cur, lds, wid, lane);
        const char* nA = has_next ? S.a_ptr(nxt) : cA; const char* nB = has_next ? S.b_ptr(nxt) : cB;
        if constexpr (P::GATHER) {
            unsigned vn[2][2];
            if (has_next) S.a_off(nxt, tid, vn);
            else { vn[0][0] = vA[0][0]; vn[0][1] = vA[0][1]; vn[1][0] = vA[1][0]; vn[1][1] = vA[1][1]; }
            *park = (u32x4){vn[0][0], vn[0][1], vn[1][0], vn[1][1]};
        }
#pragma nounroll
        for (int t = 0; t < nt; t += 2) {
            const bool last = (t == nt - 2);
            asm volatile("" : "+v"(vA[0][0]), "+v"(vA[0][1]), "+v"(vA[1][0]), "+v"(vA[1][1]), "+v"(voffB[0]), "+v"(voffB[1]));
            const char* a1 = cA + (size_t)(t + 1) * kstep;
            const char* a2 = last ? nA : cA + (size_t)(t + 2) * kstep; const char* b2 = last ? nB : cB + (size_t)(t + 2) * kstep;
            const char* a3 = a2 + kstep; const char* b3 = b2 + kstep;
            PG8_LDB(B0, 0, 0); PG8_LDB(B1, 0, 1); PG8_SCHED; PG8_LDA(At, 0, 0); PG8_STAGE2(PG8_SA(1, 1), a1, vA[1][0], vA[1][1]);
            if constexpr (P::GATHER) { if (last) { const u32x4 nv = *park; vA[0][0] = nv.x; vA[0][1] = nv.y; vA[1][0] = nv.z; vA[1][1] = nv.w; } }
            PG8_WAIT_V(8); PG8_WAIT_L(0); PG8_BAR; PG8_MMA(0, 0, At, B0); PG8_MMA(0, 1, At, B1); PG8_BAR; PG8_SCHED;
            PG8_LDA(At, 0, 1); PG8_STAGEB(PG8_SB(0, 0), b2); PG8_STAGEB(PG8_SB(0, 1), b2 + hstepB); PG8_STAGE2(PG8_SA(0, 0), a2, vA[0][0], vA[0][1]);
            PG8_WAIT_V(8); PG8_WAIT_L(0); PG8_BAR; PG8_MMA(1, 0, At, B0); PG8_MMA(1, 1, At, B1); PG8_BAR; PG8_SCHED;
            PG8_LDB(B0, 1, 0); PG8_LDB(B1, 1, 1); PG8_SCHED; PG8_LDA(At, 1, 0); PG8_STAGE2(PG8_SA(0, 1), a2, vA[1][0], vA[1][1]);
            PG8_WAIT_V(8); PG8_WAIT_L(0); PG8_BAR; PG8_MMA(0, 0, At, B0); PG8_MMA(0, 1, At, B1); PG8_BAR; PG8_SCHED;
            PG8_LDA(At, 1, 1); PG8_STAGEB(PG8_SB(1, 0), b3); PG8_STAGEB(PG8_SB(1, 1), b3 + hstepB); PG8_STAGE2(PG8_SA(1, 0), a3, vA[0][0], vA[0][1]);
            PG8_WAIT_V(8); PG8_WAIT_L(0); PG8_BAR; PG8_MMA(1, 0, At, B0); PG8_MMA(1, 1, At, B1); PG8_BAR; PG8_SCHED;
        }
        if (wr == 0) PG8_BAR;
        int fr_ = fr, fq_ = fq; asm volatile("" : "+v"(fr_), "+v"(fq_));
        const bool keep = S.epi(acc, cur, wr, wc, fr_, fq_);
        if (!has_next) break;
        if (!keep) {
#pragma unroll
            for (int a = 0; a < 2; ++a)
#pragma unroll
                for (int b = 0; b < 2; ++b)
#pragma unroll
                    for (int m = 0; m < 4; ++m)
#pragma unroll
                        for (int n = 0; n < 2; ++n) acc[a][b][m][n] = (f32x4){0.f, 0.f, 0.f, 0.f};
        }
        cur = nxt; cA = nA; cB = nB; ++ui;
        if (wr == 1) PG8_BAR;
    }
    PG8_WAIT_V(0);
    PG8_BAR;
#undef PG8_SA
#undef PG8_SB
#undef PG8_STAGE2
#undef PG8_STAGEB
#undef PG8_LDA
#undef PG8_LDB
#undef PG8_MMA
#undef PG8_WAIT_V
#undef PG8_WAIT_L
#undef PG8_BAR
#undef PG8_SCHED
}
}
using pg8::Unit;

__device__ __forceinline__ void st8(bf16* p, const f32x4& a, const f32x4& b) {
    u32x4 w; w.x = cvt_pk_bf16(a[0], a[1]); w.y = cvt_pk_bf16(a[2], a[3]); w.z = cvt_pk_bf16(b[0], b[1]); w.w = cvt_pk_bf16(b[2], b[3]);
    *(u32x4*)p = w;
}
__device__ __forceinline__ void ld8(const bf16* p, f32x4& a, f32x4& b) {
    const u32x4 w = *(const u32x4*)p;
    a = (f32x4){bflo(w.x), bfhi(w.x), bflo(w.y), bfhi(w.y)}; b = (f32x4){bflo(w.z), bfhi(w.z), bflo(w.w), bfhi(w.w)};
}

__device__ __forceinline__ void st8q(unsigned char* p, const f32x4& a, const f32x4& b) {
    int w0 = 0, w1 = 0;
    w0 = __builtin_amdgcn_cvt_pk_fp8_f32(a[0], a[1], w0, false); w0 = __builtin_amdgcn_cvt_pk_fp8_f32(a[2], a[3], w0, true);
    w1 = __builtin_amdgcn_cvt_pk_fp8_f32(b[0], b[1], w1, false); w1 = __builtin_amdgcn_cvt_pk_fp8_f32(b[2], b[3], w1, true);
    *(u32x2*)p = (u32x2){(unsigned)w0, (unsigned)w1};
}
constexpr float WQ_SCALE = 32.0f, WQ_INV = 1.0f / 32.0f;

struct PolIn {
    static constexpr int NT = 8, LDA = 512, LDB = 512; static constexpr bool GATHER = false, FP8 = false, I8 = true, ROWDMA = true;
    pg8::StaticOrder so; const unsigned char* A; const unsigned char* Bt; unsigned char* ws; const float* qg; const float* kg; const float* hs; const float* cs; LAS unsigned char* shm;
    __device__ bool next(int i, Unit& u) const { u.e = 0; u.s0 = 0; u.cnt = 0; u.idx = i; return so.tile(i, u.pm, u.pn); }
    __device__ __forceinline__ void row_dma(const Unit& u, LAS unsigned char* lds, int wid, int lane) const {
        const unsigned* src = (wid < 4) ? (const unsigned*)(hs + u.pm * 256 + 64 * wid + lane) : (const unsigned*)(cs + u.pn * 256 + 64 * (wid & 3) + lane);
        __builtin_amdgcn_global_load_lds(src, (LAS unsigned*)(lds + ROWS_OFF + (u.idx & 1) * ROWS_BUF + 256 * wid), 4, 0, 0);
    }
    __device__ const char* a_ptr(const Unit& u) const { return (const char*)(A + (size_t)u.pm * 256 * 1024); }
    __device__ const char* b_ptr(const Unit& u) const { return (const char*)(Bt + (size_t)u.pn * 256 * 1024); }
    __device__ void a_off(const Unit&, int, unsigned (&)[2][2]) const {}
    __device__ __forceinline__ bool epi(f32x4 (&acc)[2][2][4][2], const Unit& u, int wr, int wc, int fr, int fq) const {
        const int pn = u.pn;
        {
            const LAS float* hsr = (const LAS float*)(shm + ROWS_OFF + (u.idx & 1) * ROWS_BUF) + wr * 64 + fr;
            const LAS float* csp = (const LAS float*)(shm + ROWS_OFF + (u.idx & 1) * ROWS_BUF + 1024) + 64 * wc + 8 * fq;
            float hv[2][4]; f32x4 cv[2][2];
#pragma unroll
            for (int a = 0; a < 2; ++a)
#pragma unroll
                for (int m = 0; m < 4; ++m) hv[a][m] = hsr[a * 128 + m * 16];
#pragma unroll
            for (int b = 0; b < 2; ++b)
#pragma unroll
                for (int n = 0; n < 2; ++n) cv[b][n] = *(const LAS f32x4*)(csp + 32 * b + 4 * n);
#pragma unroll
            for (int a = 0; a < 2; ++a)
#pragma unroll
                for (int b = 0; b < 2; ++b)
#pragma unroll
                    for (int m = 0; m < 4; ++m)
#pragma unroll
                        for (int n = 0; n < 2; ++n) { const pg8::v4i_t ia = __builtin_bit_cast(pg8::v4i_t, acc[a][b][m][n]);
                            acc[a][b][m][n] = (f32x4){(float)ia.x, (float)ia.y, (float)ia.z, (float)ia.w} * hv[a][m] * cv[b][n]; }
        }
        int kind, ld, tcol; size_t off;
        if (pn < 2) { kind = 0; off = WS_Q; ld = AW; tcol = pn; }
        else if (pn < 4) { kind = 1; off = WS_K; ld = AW; tcol = pn - 2; }
        else if (pn < 6) { kind = 2; off = WS_V; ld = AW; tcol = pn - 4; }
        else if (pn < 8) { kind = 3; off = WS_UG; ld = SGW; tcol = pn - 6; }
        else if (pn < 10) { kind = 3; off = WS_VG; ld = SGW; tcol = pn - 8; }
        else if (pn < 14) { kind = 4; off = WS_GA; ld = D; tcol = pn - 10; }
        else { kind = 4; off = WS_GB; ld = D; tcol = pn - 14; }
        bf16* base = (bf16*)(ws + off) + tcol * 256 + 64 * wc + 8 * fq;
        const int row0 = u.pm * 256 + wr * 64 + fr;
        if (kind <= 1) {
            const float* g = (kind == 0 ? qg : kg) + 8 * fq;
            const float sc = (kind == 0) ? (0.125f * LOG2E) : 1.0f;
            f32x4 gv[2][2];
#pragma unroll
            for (int bj = 0; bj < 2; ++bj)
#pragma unroll
                for (int n = 0; n < 2; ++n) gv[bj][n] = *(const f32x4*)(g + 32 * bj + 4 * n) * sc;
#pragma unroll
            for (int ai = 0; ai < 2; ++ai)
#pragma unroll
                for (int m = 0; m < 4; ++m) {
                    float ss = 0.f;
#pragma unroll
                    for (int bj = 0; bj < 2; ++bj)
#pragma unroll
                        for (int n = 0; n < 2; ++n) { const f32x4 v = acc[ai][bj][m][n]; ss += (v[0] * v[0] + v[1] * v[1]) + (v[2] * v[2] + v[3] * v[3]); }
                    ss += __shfl_xor(ss, 16); ss += __shfl_xor(ss, 32);
                    const float rs = 1.0f / sqrtf(ss * (1.0f / 64.0f) + EPS);
                    bf16* rowp = base + (size_t)(row0 + ai * 128 + m * 16) * ld;
#pragma unroll
                    for (int bj = 0; bj < 2; ++bj) st8(rowp + 32 * bj, acc[ai][bj][m][0] * rs * gv[bj][0], acc[ai][bj][m][1] * rs * gv[bj][1]);
                }
        } else if (kind == 2) {
#pragma unroll
            for (int ai = 0; ai < 2; ++ai)
#pragma unroll
                for (int m = 0; m < 4; ++m) { bf16* rowp = base + (size_t)(row0 + ai * 128 + m * 16) * ld;
#pragma unroll
                    for (int bj = 0; bj < 2; ++bj) st8(rowp + 32 * bj, acc[ai][bj][m][0], acc[ai][bj][m][1]); }
        } else if (kind == 4) {
            unsigned char* b8 = ws + off + tcol * 256 + 64 * wc + 8 * fq;
#pragma unroll
            for (int ai = 0; ai < 2; ++ai)
#pragma unroll
                for (int m = 0; m < 4; ++m) { unsigned char* rowp = b8 + (size_t)(row0 + ai * 128 + m * 16) * ld;
#pragma unroll
                    for (int bj = 0; bj < 2; ++bj) st8q(rowp + 32 * bj, acc[ai][bj][m][0], acc[ai][bj][m][1]); }
        } else {
#pragma unroll
            for (int ai = 0; ai < 2; ++ai)
#pragma unroll
                for (int m = 0; m < 4; ++m) { bf16* rowp = base + (size_t)(row0 + ai * 128 + m * 16) * ld;
#pragma unroll
                    for (int bj = 0; bj < 2; ++bj) { f32x4 a = acc[ai][bj][m][0], b = acc[ai][bj][m][1];
#pragma unroll
                        for (int j = 0; j < 4; ++j) { a[j] = gelu_tanh(a[j]); b[j] = gelu_tanh(b[j]); }
                        st8(rowp + 32 * bj, a, b); } }
        }
        return false;
    }
};

struct PolMerge {
    static constexpr int NT = 8, LDA = D, LDB = D; static constexpr bool GATHER = false, FP8 = false, I8 = false, ROWDMA = false;
    pg8::StaticOrder so; const bf16* A; const bf16* Bt; const unsigned char* ga; const unsigned char* gb; bf16* out;
    __device__ bool next(int i, Unit& u) const { u.e = i & 1; u.s0 = 0; u.cnt = 0; return so.tile(i >> 1, u.pm, u.pn); }
    __device__ const char* a_ptr(const Unit& u) const { return (const char*)(A + (size_t)u.pm * 256 * LDA + 512 * u.e); }
    __device__ const char* b_ptr(const Unit& u) const { return (const char*)(Bt + (size_t)u.pn * 256 * LDB + 512 * u.e); }
    __device__ void a_off(const Unit&, int, unsigned (&)[2][2]) const {}
    __device__ __forceinline__ bool epi(f32x4 (&acc)[2][2][4][2], const Unit& u, int wr, int wc, int fr, int fq) const {
        const int row0 = u.pm * 256 + wr * 64 + fr, col0 = u.pn * 256 + 64 * wc + 8 * fq;
#pragma unroll
        for (int ai = 0; ai < 2; ++ai) {
            u32x2 gbv[4][2]; u32x2 gav[4][2];
#pragma unroll
            for (int m = 0; m < 4; ++m) { const size_t o = (size_t)(row0 + ai * 128 + m * 16) * D + col0;
#pragma unroll
                for (int bj = 0; bj < 2; ++bj) { gbv[m][bj] = *(const u32x2*)(gb + o + 32 * bj); if (u.e == 0) gav[m][bj] = *(const u32x2*)(ga + o + 32 * bj); } }
#pragma unroll
            for (int m = 0; m < 4; ++m) { const size_t o = (size_t)(row0 + ai * 128 + m * 16) * D + col0;
#pragma unroll
                for (int bj = 0; bj < 2; ++bj) {
                    const u32x2 wb = gbv[m][bj];
                    const f32x2 p0 = __builtin_amdgcn_cvt_pk_f32_fp8((int)wb.x, false), p1 = __builtin_amdgcn_cvt_pk_f32_fp8((int)wb.x, true), p2 = __builtin_amdgcn_cvt_pk_f32_fp8((int)wb.y, false), p3 = __builtin_amdgcn_cvt_pk_f32_fp8((int)wb.y, true);
                    const f32x4 b0 = (f32x4){p0[0], p0[1], p1[0], p1[1]}, b1 = (f32x4){p2[0], p2[1], p3[0], p3[1]};
                    if (u.e == 0) {
                        const u32x2 wa = gav[m][bj];
                        const f32x2 q0 = __builtin_amdgcn_cvt_pk_f32_fp8((int)wa.x, false), q1 = __builtin_amdgcn_cvt_pk_f32_fp8((int)wa.x, true), q2 = __builtin_amdgcn_cvt_pk_f32_fp8((int)wa.y, false), q3 = __builtin_amdgcn_cvt_pk_f32_fp8((int)wa.y, true);
                        const f32x4 a0 = (f32x4){q0[0], q0[1], q1[0], q1[1]}, a1 = (f32x4){q2[0], q2[1], q3[0], q3[1]};
#pragma unroll
                        for (int j = 0; j < 4; ++j) {
                            acc[ai][bj][m][0][j] *= (1.0f + fast_exp2(-LOG2E * b0[j])) * fast_rcp(1.0f + fast_exp2(-LOG2E * a0[j]));
                            acc[ai][bj][m][1][j] *= (1.0f + fast_exp2(-LOG2E * b1[j])) * fast_rcp(1.0f + fast_exp2(-LOG2E * a1[j])); }
                    } else {
                        f32x4 r0, r1;
#pragma unroll
                        for (int j = 0; j < 4; ++j) { r0[j] = acc[ai][bj][m][0][j] * sigmoidf_(b0[j]); r1[j] = acc[ai][bj][m][1][j] * sigmoidf_(b1[j]); }
                        st8(out + o + 32 * bj, r0, r1);
                    }
                } }
        }
        return u.e == 0;
    }
};

struct PolOut {
    static constexpr int NT = 16, LDA = D, LDB = D; static constexpr bool GATHER = false, FP8 = false, I8 = false, ROWDMA = false;
    pg8::StaticOrder so; const bf16* A; const bf16* Bt; const float* x; bf16* x1; unsigned char* x1q;
    __device__ bool next(int i, Unit& u) const { u.e = 0; u.s0 = 0; u.cnt = 0; return so.tile(i, u.pm, u.pn); }
    __device__ const char* a_ptr(const Unit& u) const { return (const char*)(A + (size_t)u.pm * 256 * LDA); }
    __device__ const char* b_ptr(const Unit& u) const { return (const char*)(Bt + (size_t)u.pn * 256 * LDB); }
    __device__ void a_off(const Unit&, int, unsigned (&)[2][2]) const {}
    __device__ __forceinline__ bool epi(f32x4 (&acc)[2][2][4][2], const Unit& u, int wr, int wc, int fr, int fq) const {
        const int row0 = u.pm * 256 + wr * 64 + fr, col0 = u.pn * 256 + 64 * wc + 8 * fq;
#pragma unroll
        for (int ai = 0; ai < 2; ++ai) {
            f32x4 xv[4][2][2];
#pragma unroll
            for (int m = 0; m < 4; ++m) { const size_t o = (size_t)(row0 + ai * 128 + m * 16) * D + col0;
#pragma unroll
                for (int bj = 0; bj < 2; ++bj) { xv[m][bj][0] = *(const f32x4*)(x + o + 32 * bj); xv[m][bj][1] = *(const f32x4*)(x + o + 32 * bj + 4); } }
#pragma unroll
            for (int m = 0; m < 4; ++m) { const size_t o = (size_t)(row0 + ai * 128 + m * 16) * D + col0;
#pragma unroll
                for (int bj = 0; bj < 2; ++bj) {
                    const f32x4 r0 = xv[m][bj][0] + acc[ai][bj][m][0], r1 = xv[m][bj][1] + acc[ai][bj][m][1];
                    st8(x1 + o + 32 * bj, r0, r1); st8q(x1q + o + 32 * bj, r0, r1);
                } }
        }
        return false;
    }
};

struct MoeOrder {
    const LAS int* tb;
    int NN, nwg, G, c;
    __device__ void init(const LAS int* tb_, int NN_, int G_, int c_) { tb = tb_; NN = NN_; G = G_; c = c_; nwg = tb_[32] * NN_; }
    __device__ bool unit(int i, Unit& u) const {
        const long L = (long)i * G + c; if (L >= nwg) return false;
        int wgid = (int)L; { const int q = nwg / 8, r = nwg % 8, xcd = wgid % 8, off = wgid / 8; wgid = (xcd < r ? xcd * (q + 1) : r * (q + 1) + (xcd - r) * q) + off; }
        const int Mt = wgid / NN;
        const int ln = threadIdx.x & 63;
        const unsigned long long bal = __ballot(ln < NE && tb[ln & 31] <= Mt);
        const int e = __popcll(bal) - 1;
        u.idx = i; u.pm = __builtin_amdgcn_readfirstlane(Mt); u.pn = __builtin_amdgcn_readfirstlane(wgid % NN); u.e = __builtin_amdgcn_readfirstlane(e);
        u.s0 = __builtin_amdgcn_readfirstlane((Mt - tb[e]) * 256); u.cnt = __builtin_amdgcn_readfirstlane(tb[33 + e]);
        return true;
    }
};

struct PolGU {
    static constexpr int NT = 8, LDA = 512, LDB = 512; static constexpr bool GATHER = true, FP8 = true, I8 = false, ROWDMA = true;
    MoeOrder mo; const unsigned char* A; const unsigned char* Bt; const int* lid; const float* lrs; const float* bgu; unsigned char* act; LAS unsigned char* shm;
    __device__ __forceinline__ void row_dma(const Unit& u, LAS unsigned char* lds, int wid, int lane) const {
        const unsigned* src = (wid < 4) ? (const unsigned*)(lrs + (size_t)u.e * LCAP + u.s0 + 64 * wid + lane)
                                        : (const unsigned*)(bgu + (size_t)u.e * 2048 + u.pn * 128 + 1024 * ((wid >> 1) & 1) + 64 * (wid & 1) + lane);
        __builtin_amdgcn_global_load_lds(src, (LAS unsigned*)(lds + ROWS_OFF + (u.idx & 1) * ROWS_BUF + 256 * wid), 4, 0, 0);
    }
    __device__ bool next(int i, Unit& u) const { return mo.unit(i, u); }
    __device__ const char* a_ptr(const Unit&) const { return (const char*)A; }
    __device__ const char* b_ptr(const Unit& u) const { return (const char*)(Bt + ((size_t)u.e * 2048 + (size_t)u.pn * 256) * 1024); }
    __device__ __forceinline__ void a_off(const Unit& u, int tid, unsigned (&v)[2][2]) const {
        const int* l = lid + (size_t)u.e * LCAP;
#pragma unroll
        for (int i = 0; i < 2; ++i) { int R, C; pg8::stage_rc(tid * 16 + i * 8192, R, C);
#pragma unroll
            for (int h = 0; h < 2; ++h) { const int s = u.s0 + h * 128 + R; const int id = l[s]; const int tok = (s < u.cnt) ? (id >> 2) : 0; v[h][i] = (unsigned)(tok * LDA + C) * 2u; } }
    }
    __device__ __forceinline__ bool epi(f32x4 (&acc)[2][2][4][2], const Unit& u, int wr, int wc, int fr, int fq) const {
        const LAS float* rsl = (const LAS float*)(shm + ROWS_OFF + (u.idx & 1) * ROWS_BUF);
        const LAS float* bg = (const LAS float*)(shm + ROWS_OFF + (u.idx & 1) * ROWS_BUF + 1024) + 32 * wc + 8 * fq;
        const f32x4 bg0 = *(const LAS f32x4*)bg, bg1 = *(const LAS f32x4*)(bg + 4), bu0 = *(const LAS f32x4*)(bg + 128), bu1 = *(const LAS f32x4*)(bg + 132);
        unsigned char* ob = act + (size_t)u.pm * 256 * FF + u.pn * 128 + 32 * wc + 8 * fq;
        float rsv[2][4];
#pragma unroll
        for (int ai = 0; ai < 2; ++ai)
#pragma unroll
            for (int m = 0; m < 4; ++m) { const int r = ai * 128 + wr * 64 + m * 16 + fr; const bool valid = (u.s0 + r < u.cnt); const float t_ = rsl[r]; rsv[ai][m] = valid ? t_ * WQ_INV : 0.f; }
#pragma unroll
        for (int ai = 0; ai < 2; ++ai)
#pragma unroll
            for (int m = 0; m < 4; ++m) { const int r = ai * 128 + wr * 64 + m * 16 + fr; const float rs = rsv[ai][m];
                f32x4 o[2];
#pragma unroll
                for (int n = 0; n < 2; ++n)
#pragma unroll
                    for (int h2 = 0; h2 < 2; ++h2) {
                        const f32x2 ag = {acc[ai][0][m][n][2 * h2], acc[ai][0][m][n][2 * h2 + 1]}, au = {acc[ai][1][m][n][2 * h2], acc[ai][1][m][n][2 * h2 + 1]};
                        const f32x2 bgv = n ? (f32x2){bg1[2 * h2], bg1[2 * h2 + 1]} : (f32x2){bg0[2 * h2], bg0[2 * h2 + 1]}, buv = n ? (f32x2){bu1[2 * h2], bu1[2 * h2 + 1]} : (f32x2){bu0[2 * h2], bu0[2 * h2 + 1]};
                        f32x2 g = ag * rs + bgv, up = au * rs + buv;
                        g = __builtin_elementwise_min(g, (f32x2){7.0f, 7.0f});
                        up.x = __builtin_amdgcn_fmed3f(up.x, -7.0f, 7.0f); up.y = __builtin_amdgcn_fmed3f(up.y, -7.0f, 7.0f);
                        const f32x2 t = g * (-1.702f * LOG2E);
                        f32x2 e; e.x = fast_exp2(t.x); e.y = fast_exp2(t.y);
                        const f32x2 den = e + 1.0f;
                        f32x2 rc; rc.x = fast_rcp(den.x); rc.y = fast_rcp(den.y);
                        const f32x2 res = (up + 1.0f) * (g * rc);
                        o[n][2 * h2] = res.x; o[n][2 * h2 + 1] = res.y; }
                st8q(ob + (size_t)r * FF, o[0], o[1]); }
        return false;
    }
};

struct PolDown {
    static constexpr int NT = 8, LDA = 512, LDB = 512; static constexpr bool GATHER = true, FP8 = true, I8 = false, ROWDMA = true;
    MoeOrder mo; const unsigned char* A; const unsigned char* Bt; const int* lid; const float* lp; const float* bd; unsigned char* y; LAS unsigned char* shm;
    __device__ __forceinline__ void row_dma(const Unit& u, LAS unsigned char* lds, int wid, int lane) const {
        const size_t o = (size_t)u.e * LCAP + u.s0 + 64 * (wid & 3) + lane;
        const unsigned* src = (wid < 4) ? (const unsigned*)(lid + o) : (const unsigned*)(lp + o);
        __builtin_amdgcn_global_load_lds(src, (LAS unsigned*)(lds + ROWS_OFF + (u.idx & 1) * ROWS_BUF + 256 * wid), 4, 0, 0);
        if (wid < 4) __builtin_amdgcn_global_load_lds((const unsigned*)(bd + (size_t)u.e * D + u.pn * 256 + 64 * wid + lane), (LAS unsigned*)(lds + ROWS_OFF + (u.idx & 1) * ROWS_BUF + 2048 + 256 * wid), 4, 0, 0);
    }
    __device__ bool next(int i, Unit& u) const { return mo.unit(i, u); }
    __device__ const char* a_ptr(const Unit& u) const { return (const char*)(A + (size_t)u.pm * 256 * 1024); }
    __device__ const char* b_ptr(const Unit& u) const { return (const char*)(Bt + ((size_t)u.e * 1024 + (size_t)u.pn * 256) * 1024); }
    __device__ __forceinline__ void a_off(const Unit&, int tid, unsigned (&v)[2][2]) const {
#pragma unroll
        for (int i = 0; i < 2; ++i) { int R, C; pg8::stage_rc(tid * 16 + i * 8192, R, C); v[0][i] = (unsigned)(R * LDA + C) * 2u; v[1][i] = (unsigned)((R + 128) * LDA + C) * 2u; }
    }
    __device__ __forceinline__ bool epi(f32x4 (&acc)[2][2][4][2], const Unit& u, int wr, int wc, int fr, int fq) const {
        const LAS int* idl = (const LAS int*)(shm + ROWS_OFF + (u.idx & 1) * ROWS_BUF); const LAS float* pl = (const LAS float*)(shm + ROWS_OFF + (u.idx & 1) * ROWS_BUF + 1024);
        const int col0 = u.pn * 256 + 64 * wc + 8 * fq;
        const LAS float* b = (const LAS float*)(shm + ROWS_OFF + (u.idx & 1) * ROWS_BUF + 2048) + 64 * wc + 8 * fq;
        int idv[2][4]; float pv_[2][4];
#pragma unroll
        for (int ai = 0; ai < 2; ++ai)
#pragma unroll
            for (int m = 0; m < 4; ++m) { const int r = ai * 128 + wr * 64 + m * 16 + fr; const bool valid = (u.s0 + r < u.cnt);
                const int t_ = idl[r]; const float q_ = pl[r]; idv[ai][m] = valid ? t_ : T * 4; pv_[ai][m] = q_; }
        f32x4 bv[2][2];
#pragma unroll
        for (int bj = 0; bj < 2; ++bj)
#pragma unroll
            for (int n = 0; n < 2; ++n) bv[bj][n] = *(const LAS f32x4*)(b + 32 * bj + 4 * n);
#pragma unroll
        for (int ai = 0; ai < 2; ++ai)
#pragma unroll
            for (int m = 0; m < 4; ++m) { const float p = pv_[ai][m] * 16.0f; unsigned char* op = y + (size_t)idv[ai][m] * D + col0;
#pragma unroll
                for (int bj = 0; bj < 2; ++bj) st8q(op + 32 * bj, (acc[ai][bj][m][0] * WQ_INV + bv[bj][0]) * p, (acc[ai][bj][m][1] * WQ_INV + bv[bj][1]) * p); }
        return false;
    }
};

constexpr int CONV_GU_ITEMS = NE * 16 * 32, CONV_D_ITEMS = NE * 16 * 16, CONV_ITEMS = CONV_GU_ITEMS + CONV_D_ITEMS, CONV_PER_WAVE = CONV_ITEMS / 2048;
static_assert(CONV_PER_WAVE * 2048 == CONV_ITEMS, "items divide over 2048 waves");
struct MoeConv {
    const float* wgu; const float* wd; const float* g2; unsigned char* WGU8; unsigned char* WD8;
    struct Regs { f32x4 v0, v1, v2, v3, v4, v5, v6, v7, v8, v9, v10, v11, v12, v13, v14, v15; };
    __device__ __forceinline__ void src_of(int item, const float*& W, int& N, int& k0, int& n0) const {
        if (item < CONV_GU_ITEMS) { const int e = item >> 9, q = item & 511; W = wgu + (size_t)e * D * 2048; N = 2048; k0 = 64 * (q >> 5); n0 = 64 * (q & 31); }
        else { const int r = item - CONV_GU_ITEMS, e = r >> 8, q = r & 255; W = wd + (size_t)e * FF * D; N = D; k0 = 64 * (q >> 4); n0 = 64 * (q & 15); }
    }
    __device__ __forceinline__ void finish(Regs& R, int item, int lane) const {
        const float* W; int N, k0, n0; src_of(item, W, N, k0, n0);
        const int kc = lane >> 4, nq = lane & 15; const bool gu = item < CONV_GU_ITEMS;
        float sc[16];
        if (gu) { const f32x4* gp = (const f32x4*)(g2 + k0 + 16 * kc);
#pragma unroll
            for (int q = 0; q < 4; ++q) { const f32x4 t = gp[q]; sc[4 * q] = t[0] * 32.0f; sc[4 * q + 1] = t[1] * 32.0f; sc[4 * q + 2] = t[2] * 32.0f; sc[4 * q + 3] = t[3] * 32.0f; } }
        else {
#pragma unroll
            for (int i = 0; i < 16; ++i) sc[i] = 32.0f; }
        const int nb = n0 + 32 * (nq >> 3);
        const int e = gu ? (item >> 9) : ((item - CONV_GU_ITEMS) >> 8);
        const int up = nb >= 1024, cc = nb & 1023;
        const int pos = gu ? ((cc >> 7) * 256 + up * 128 + ((cc >> 5) & 3) * 32) : ((nb & ~255) + ((nb >> 5) & 1) * 128 + ((nb >> 6) & 3) * 32);
        unsigned char* base = (gu ? (WGU8 + ((size_t)e * 2048 + pos + ((4 * nq) & 31)) * 1024) : (WD8 + ((size_t)e * 1024 + pos + ((4 * nq) & 31)) * 1024)) + k0 + 16 * kc;
#pragma unroll
        for (int c = 0; c < 4; ++c) {
            int w0 = 0, w1 = 0, w2 = 0, w3 = 0;
            w0 = __builtin_amdgcn_cvt_pk_fp8_f32(R.v0[c] * sc[0], R.v1[c] * sc[1], w0, false); w0 = __builtin_amdgcn_cvt_pk_fp8_f32(R.v2[c] * sc[2], R.v3[c] * sc[3], w0, true);
            w1 = __builtin_amdgcn_cvt_pk_fp8_f32(R.v4[c] * sc[4], R.v5[c] * sc[5], w1, false); w1 = __builtin_amdgcn_cvt_pk_fp8_f32(R.v6[c] * sc[6], R.v7[c] * sc[7], w1, true);
            w2 = __builtin_amdgcn_cvt_pk_fp8_f32(R.v8[c] * sc[8], R.v9[c] * sc[9], w2, false); w2 = __builtin_amdgcn_cvt_pk_fp8_f32(R.v10[c] * sc[10], R.v11[c] * sc[11], w2, true);
            w3 = __builtin_amdgcn_cvt_pk_fp8_f32(R.v12[c] * sc[12], R.v13[c] * sc[13], w3, false); w3 = __builtin_amdgcn_cvt_pk_fp8_f32(R.v14[c] * sc[14], R.v15[c] * sc[15], w3, true);
            *(u32x4*)(base + (size_t)c * 1024) = (u32x4){(unsigned)w0, (unsigned)w1, (unsigned)w2, (unsigned)w3};
        }
    }
    template <int SUB> __device__ __forceinline__ void sub(Regs& R, int& st, int item0, int istride, int lane) const {
        if (SUB == 0 && (st & 1)) { finish(R, item0 + ((st >> 1) - 1) * istride, lane); st &= ~1; }
        const int it = st >> 1;
        if (it < CONV_PER_WAVE) {
            const float* W; int N, k0, n0; src_of(item0 + it * istride, W, N, k0, n0);
            const float* p = W + (size_t)(k0 + 16 * (lane >> 4) + 4 * SUB) * N + n0 + 4 * (lane & 15);
            const f32x4 t0 = *(const f32x4*)p, t1 = *(const f32x4*)(p + N), t2 = *(const f32x4*)(p + 2 * (size_t)N), t3 = *(const f32x4*)(p + 3 * (size_t)N);
            if (SUB == 0) { R.v0 = t0; R.v1 = t1; R.v2 = t2; R.v3 = t3; }
            else if (SUB == 1) { R.v4 = t0; R.v5 = t1; R.v6 = t2; R.v7 = t3; }
            else if (SUB == 2) { R.v8 = t0; R.v9 = t1; R.v10 = t2; R.v11 = t3; }
            else { R.v12 = t0; R.v13 = t1; R.v14 = t2; R.v15 = t3; st = ((it + 1) << 1) | 1; }
        }
    }
    __device__ __forceinline__ void drain(Regs& R, int& st, int item0, int istride, int lane) const {
        if (st & 1) { finish(R, item0 + ((st >> 1) - 1) * istride, lane); st &= ~1; }
        for (int it = st >> 1; it < CONV_PER_WAVE; ++it) { sub<0>(R, st, item0, istride, lane); sub<1>(R, st, item0, istride, lane); sub<2>(R, st, item0, istride, lane); sub<3>(R, st, item0, istride, lane);
            finish(R, item0 + it * istride, lane); st &= ~1; }
    }
};

namespace att {
constexpr int PITCH = 512, SLOTB = 8192;
constexpr int L_K = 0, L_V = 2 * SLOTB, L_TBL = 4 * SLOTB, L_WS = L_TBL + 4096, L_OST = L_WS + 8 * 256, L_END = L_OST + 8 * 4096;
constexpr int NTBL = 832;
__device__ __forceinline__ int crow(int r, int hi) { return (r & 3) + 8 * (r >> 2) + 4 * hi; }
__device__ __forceinline__ void glds16(const void* gsrc, unsigned lds_dst) { unsigned keep;
    asm volatile("s_mov_b32 %0, m0\n\ts_mov_b32 m0, %2\n\ts_nop 0\n\tglobal_load_lds_dwordx4 %1, off\n\ts_mov_b32 m0, %0" : "=&s"(keep) : "v"(gsrc), "s"(lds_dst) : "memory"); }
__device__ __forceinline__ unsigned cvtpk_s(float lo, float hi) { typedef __bf16 bf16x2_t __attribute__((ext_vector_type(2))); f32x2 v = {lo, hi}; bf16x2_t b = __builtin_convertvector(v, bf16x2_t); return __builtin_bit_cast(unsigned, b); }
#define ATT_SBAR() __builtin_amdgcn_sched_barrier(0)
__device__ __forceinline__ void pv(f32x16* o, int vb, bf16x8 pa0, bf16x8 pa1, bf16x8 pa2, bf16x8 pa3) {
#pragma unroll
    for (int d0 = 0; d0 < 2; ++d0) { s16x4 lo[4], hi[4];
#pragma unroll
        for (int ks = 0; ks < 4; ++ks) {
            asm volatile("ds_read_b64_tr_b16 %0,%1 offset:%c2" : "=&v"(lo[ks]) : "v"(vb), "i"(d0 * 4096 + ks * 1024) : "memory");
            asm volatile("ds_read_b64_tr_b16 %0,%1 offset:%c2" : "=&v"(hi[ks]) : "v"(vb), "i"(d0 * 4096 + ks * 1024 + 512) : "memory"); }
        asm volatile("s_waitcnt lgkmcnt(0)" ::: "memory"); ATT_SBAR();
#define ATT_PK(k) (bf16x8){lo[k][0], lo[k][1], lo[k][2], lo[k][3], hi[k][0], hi[k][1], hi[k][2], hi[k][3]}
        o[d0] = __builtin_amdgcn_mfma_f32_32x32x16_bf16(pa0, ATT_PK(0), o[d0], 0, 0, 0);
        o[d0] = __builtin_amdgcn_mfma_f32_32x32x16_bf16(pa1, ATT_PK(1), o[d0], 0, 0, 0);
        o[d0] = __builtin_amdgcn_mfma_f32_32x32x16_bf16(pa2, ATT_PK(2), o[d0], 0, 0, 0);
        o[d0] = __builtin_amdgcn_mfma_f32_32x32x16_bf16(pa3, ATT_PK(3), o[d0], 0, 0, 0);
#undef ATT_PK
    }
}
__device__ __forceinline__ void unit(int b, int h, int cg, const bf16* Q, const bf16* K, const bf16* V, const float* relb, bf16* O  , LAS unsigned char* shm,
                                     const MoeConv& cv, MoeConv::Regs& sreg, int& sctr, int item0, int istride) {
    const int tid = threadIdx.x, lane = tid & 63, r32 = lane & 31, hi = lane >> 5; const int wid = __builtin_amdgcn_readfirstlane(tid >> 6);
    const long rowbase = (long)b * SEQ; const int cq = 4 * cg + (wid >> 1), wq = wid & 1;
    const bf16* Qw = Q + (rowbase + 64 * cq + 32 * wq) * PITCH + h * HD;
    const unsigned lds0 = (unsigned)(uintptr_t)shm;
    LAS float* tbl = (LAS float*)(shm + L_TBL);
    LAS float* wsf = (LAS float*)(shm + L_WS) + wid * 64;
    for (int i = tid; i < NTBL; i += 512) tbl[i] = relb[h * NREL + (i < 512 ? i : 512)] * LOG2E;
    const int srow = tid >> 3, sc = tid & 7;
    const bf16* ksrc = K + (rowbase + srow) * PITCH + h * HD + sc * 8;
    const bf16* vsrc = V + (rowbase + srow) * PITCH + h * HD + sc * 8;
    const int kwr = L_K + sc * 1024 + ((srow ^ sc) << 4);
    const int vwr = L_V + (4 * (sc >> 2) + (srow >> 4)) * 1024 + (srow & 15) * 64 + (sc & 3) * 16;
    const int vb0 = (int)(lds0 + L_V) + ((lane >> 4) & 1) * 32 + (lane & 3) * 8 + (4 * hi + ((lane & 15) >> 2)) * 64;
    int kra[4];
#pragma unroll
    for (int d0 = 0; d0 < 4; ++d0) kra[d0] = L_K + (2 * d0 + hi) * 1024 + ((r32 ^ (2 * d0 + hi)) << 4);
    bf16x8 qr[4];
#pragma unroll
    for (int d0 = 0; d0 < 4; ++d0) qr[d0] = *reinterpret_cast<const bf16x8*>(&Qw[(long)r32 * PITCH + d0 * 16 + hi * 8]);
    f32x16 o[2]; o[0] = f32x16{}; o[1] = f32x16{}; float l_reg = 0.f;
    const int j0 = (8 - 4 * cg) > 0 ? (8 - 4 * cg) : 0;
    u32x4 kreg, vreg;
    { const long ro = (long)(4 * cg - 8 + j0) * 64 * PITCH; kreg = *(const u32x4*)(ksrc + ro); vreg = *(const u32x4*)(vsrc + ro); }
#define ATT_STEP(JX, SUBP) do { const int j = (JX); \
        const int s = (j - j0) & 1; \
        *(LAS u32x4*)(shm + kwr + s * SLOTB) = kreg; *(LAS u32x4*)(shm + vwr + s * SLOTB) = vreg; \
        if (j < 11) { const long ro = (long)(4 * cg - 8 + j + 1) * 64 * PITCH; kreg = *(const u32x4*)(ksrc + ro); vreg = *(const u32x4*)(vsrc + ro); } \
        asm volatile("s_waitcnt lgkmcnt(0)\n\ts_barrier" ::: "memory"); \
        cv.template sub<SUBP>(sreg, sctr, item0, istride, lane);     \
        const int d = (wid >> 1) + 8 - j; \
        if (d >= 0 && d <= 8) { \
            f32x16 p0 = f32x16{}, p1 = f32x16{}; \
            const LAS unsigned char* kbs = shm + s * SLOTB; \
        _Pragma("unroll") \
            for (int d0 = 0; d0 < 4; ++d0) { \
                const bf16x8 b0 = *(const LAS bf16x8*)(kbs + kra[d0]), b1 = *(const LAS bf16x8*)(kbs + kra[d0] + 512); \
                p0 = __builtin_amdgcn_mfma_f32_32x32x16_bf16(b0, qr[d0], p0, 0, 0, 0); p1 = __builtin_amdgcn_mfma_f32_32x32x16_bf16(b1, qr[d0], p1, 0, 0, 0); } \
            const LAS float* tb = tbl + (256 + 64 * d + 32 * wq + r32 - 4 * hi - 63); \
            float sacc = 0.f; \
        _Pragma("unroll") \
            for (int r = 0; r < 16; ++r) { const int c = (r & 3) + 8 * (r >> 2); \
                p0[r] = fast_exp2(p0[r] + tb[63 - c]); p1[r] = fast_exp2(p1[r] + tb[31 - c]); sacc += p0[r] + p1[r]; } \
            l_reg += sacc; \
            u32x4 pw0, pw1, pw2, pw3; \
            pw0 = (u32x4){cvtpk_s(p0[0], p0[1]), cvtpk_s(p0[2], p0[3]), cvtpk_s(p0[4], p0[5]), cvtpk_s(p0[6], p0[7])}; \
            pw1 = (u32x4){cvtpk_s(p0[8], p0[9]), cvtpk_s(p0[10], p0[11]), cvtpk_s(p0[12], p0[13]), cvtpk_s(p0[14], p0[15])}; \
            pw2 = (u32x4){cvtpk_s(p1[0], p1[1]), cvtpk_s(p1[2], p1[3]), cvtpk_s(p1[4], p1[5]), cvtpk_s(p1[6], p1[7])}; \
            pw3 = (u32x4){cvtpk_s(p1[8], p1[9]), cvtpk_s(p1[10], p1[11]), cvtpk_s(p1[12], p1[13]), cvtpk_s(p1[14], p1[15])}; \
            ATT_SBAR(); \
            pv(o, vb0 + s * SLOTB, __builtin_bit_cast(bf16x8, pw0), __builtin_bit_cast(bf16x8, pw1), __builtin_bit_cast(bf16x8, pw2), __builtin_bit_cast(bf16x8, pw3)); \
        } \
    } while (0)
    for (int jb = j0; jb < 12; jb += 4) { ATT_STEP(jb, 0); ATT_STEP(jb + 1, 1); ATT_STEP(jb + 2, 2); ATT_STEP(jb + 3, 3); }
#undef ATT_STEP
    asm volatile("s_waitcnt lgkmcnt(0)\n\ts_barrier" ::: "memory");
    { auto rr = __builtin_amdgcn_permlane32_swap(__float_as_uint(l_reg), __float_as_uint(l_reg), false, false); l_reg = __uint_as_float(rr[0]) + __uint_as_float(rr[1]); }
    if (hi == 0) wsf[32 + r32] = l_reg; asm volatile("s_waitcnt lgkmcnt(0)" ::: "memory");
    float rli[16];
#pragma unroll
    for (int r = 0; r < 16; ++r) rli[r] = fast_rcp(wsf[32 + crow(r, hi)]);
    bf16* Ow = O + (rowbase + 64 * cq + 32 * wq) * D + h * HD;
    { LAS bf16* stg = (LAS bf16*)(shm + L_OST) + wid * 2048;
#pragma unroll
        for (int r = 0; r < 16; ++r) { const int orow = crow(r, hi);
#pragma unroll
            for (int d0 = 0; d0 < 2; ++d0) stg[orow * 64 + d0 * 32 + r32] = (bf16)f2bf(o[d0][r] * rli[r]); }
        asm volatile("s_waitcnt lgkmcnt(0)" ::: "memory");
#pragma unroll
        for (int i = 0; i < 4; ++i) { const int row = i * 8 + (lane >> 3), ch = lane & 7; const u32x4 v = *(const LAS u32x4*)(stg + row * 64 + ch * 8); *(u32x4*)(Ow + (long)row * D + ch * 8) = v; } }
    asm volatile("s_waitcnt lgkmcnt(0)\n\ts_barrier" ::: "memory");
}
#undef ATT_SBAR
}

constexpr int SGU_WM_OFF = 128 * 136 * 2;
__device__ __forceinline__ void sgu_load_wm(int g, const bf16* WM, LAS unsigned char* shm) {
    const int tid = threadIdx.x, t = tid >> 2, c0 = (tid & 3) * 32;
    const bf16* src = WM + ((size_t)g * 128 + t) * 128 + c0;
#pragma unroll
    for (int q = 0; q < 4; ++q) *(LAS u32x4*)(shm + SGU_WM_OFF + (t * 136 + c0 + 8 * q) * 2) = *(const u32x4*)(src + 8 * q);
}
__device__ __forceinline__ void sgu_item(int item, const bf16* VG, const bf16* UG, const float* lng, const float* lnb, const float* sgb, bf16* YC, LAS unsigned char* shm,
                                         const MoeConv& cv, MoeConv::Regs& sreg, int& sctr, int item0, int istride) {
    const int tid = threadIdx.x, lane = tid & 63; const int wid = __builtin_amdgcn_readfirstlane(tid >> 6);
    const int g = item & 3, blk = item >> 2;
    const long t0 = (long)blk * 128;
    LAS bf16* vt = (LAS bf16*)shm;
    const LAS bf16* wmL = (const LAS bf16*)(shm + SGU_WM_OFF);
    const int ch = tid & 15, fr = lane & 15, fq = lane >> 4;
    u32x4 vraw[4];
#pragma unroll
    for (int it = 0; it < 4; ++it) vraw[it] = *(const u32x4*)(VG + (t0 + (tid >> 4) + 32 * it) * SGW + g * 128 + ch * 8);
    u32x2 uw[8]; float bs[8];
#pragma unroll
    for (int tt = 0; tt < 8; ++tt) { const int t = 16 * tt + fr; uw[tt] = *(const u32x2*)(UG + (size_t)(t0 + t) * SGW + g * 128 + 16 * wid + 4 * fq); bs[tt] = sgb[g * 128 + t]; }
    const f32x4 gA = *(const f32x4*)(lng + g * 128 + ch * 8), gB = *(const f32x4*)(lng + g * 128 + ch * 8 + 4);
    const f32x4 bA = *(const f32x4*)(lnb + g * 128 + ch * 8), bB = *(const f32x4*)(lnb + g * 128 + ch * 8 + 4);
#pragma unroll
    for (int it = 0; it < 4; ++it) {
        const int s = (tid >> 4) + 32 * it;
        const u32x4 w = vraw[it];
        f32x4 a = (f32x4){bflo(w.x), bfhi(w.x), bflo(w.y), bfhi(w.y)}, b = (f32x4){bflo(w.z), bfhi(w.z), bflo(w.w), bfhi(w.w)};
        float sum = (a[0] + a[1]) + (a[2] + a[3]) + (b[0] + b[1]) + (b[2] + b[3]);
        sum += __shfl_xor(sum, 1); sum += __shfl_xor(sum, 2); sum += __shfl_xor(sum, 4); sum += __shfl_xor(sum, 8);
        const float mean = sum * (1.0f / 128.0f);
        a = a - mean; b = b - mean;
        float q = (a[0] * a[0] + a[1] * a[1]) + (a[2] * a[2] + a[3] * a[3]) + (b[0] * b[0] + b[1] * b[1]) + (b[2] * b[2] + b[3] * b[3]);
        q += __shfl_xor(q, 1); q += __shfl_xor(q, 2); q += __shfl_xor(q, 4); q += __shfl_xor(q, 8);
        const float rstd = 1.0f / sqrtf(q * (1.0f / 128.0f) + EPS);
        a = a * rstd * gA + bA; b = b * rstd * gB + bB;
#pragma unroll
        for (int j = 0; j < 4; ++j) { vt[(ch * 8 + j) * 136 + s] = (bf16)f2bf(a[j]); vt[(ch * 8 + 4 + j) * 136 + s] = (bf16)f2bf(b[j]); }
    }
    asm volatile("s_waitcnt lgkmcnt(0)\n\ts_barrier" ::: "memory");
    f32x4 acc[8];
#pragma unroll
    for (int tt = 0; tt < 8; ++tt) acc[tt] = (f32x4){0.f, 0.f, 0.f, 0.f};
#pragma unroll
    for (int ks = 0; ks < 4; ++ks) {
        const bf16x8 a = *(const LAS bf16x8*)(vt + (16 * wid + fr) * 136 + 32 * ks + 8 * fq);
#pragma unroll
        for (int tt = 0; tt < 8; ++tt) if (ks <= (tt >> 1)) {
            const bf16x8 bfrag = *(const LAS bf16x8*)(wmL + (16 * tt + fr) * 136 + 32 * ks + 8 * fq);
            acc[tt] = __builtin_amdgcn_mfma_f32_16x16x32_bf16(a, bfrag, acc[tt], 0, 0, 0); }
    }
#pragma unroll
    for (int tt = 0; tt < 8; ++tt) { const int t = 16 * tt + fr; const float b_ = bs[tt];
        const u32x2 u_ = uw[tt];
        u32x2 w; w.x = cvt_pk_bf16(bflo(u_.x) * (acc[tt][0] + b_), bfhi(u_.x) * (acc[tt][1] + b_)); w.y = cvt_pk_bf16(bflo(u_.y) * (acc[tt][2] + b_), bfhi(u_.y) * (acc[tt][3] + b_));
        *(u32x2*)(YC + (size_t)(t0 + t) * D + AW + g * 128 + 16 * wid + 4 * fq) = w; }
    asm volatile("s_waitcnt lgkmcnt(0)\n\ts_barrier" ::: "memory");
}

#define XB_TMO      128
#define XB_XCNT(j)  (256  + 64 * (j))
#define XB_XSUB(j)  (1280 + 64 * (j))
#define XB_XGEN(j)  (2304 + 64 * (j))
#define XB_TOP      3328
#define XB_TOPGEN   3392
#define XCD_BAR_WORDS 3456
#define XB_SPIN_CAP (1u << 18)
__device__ __forceinline__ unsigned xb_ld(unsigned* p)              { return __hip_atomic_load(p, __ATOMIC_RELAXED, __HIP_MEMORY_SCOPE_AGENT); }
__device__ __forceinline__ unsigned xb_add(unsigned* p, unsigned v) { return __hip_atomic_fetch_add(p, v, __ATOMIC_RELAXED, __HIP_MEMORY_SCOPE_AGENT); }
__device__ __forceinline__ unsigned xb_xcc_id() { return (unsigned)__builtin_amdgcn_s_getreg((3 << 11) | 20) & 0xFu; }
#define XB_SPIN(cond, bar) do { unsigned _sp = 0; while (cond) { __builtin_amdgcn_s_sleep(1); \
    if ((++_sp & 255u) == 0u) { if (xb_ld(&(bar)[XB_TMO])) break; if (_sp > XB_SPIN_CAP) { atomicAdd(&(bar)[XB_TMO], 1u); break; } } } } while (0)
struct XcdBarrier { unsigned* bar; unsigned x; volatile LAS unsigned* st; };
__device__ __forceinline__ XcdBarrier xcd_barrier_post(unsigned* bar, volatile LAS unsigned* st) {
    XcdBarrier b; b.bar = bar; b.x = xb_xcc_id(); b.st = st;
    if (threadIdx.x == 0) (void)xb_add(&bar[XB_XCNT(b.x)], 1u);
    return b;
}
__device__ __forceinline__ void xcd_barrier_complete(unsigned* bar, unsigned x, unsigned& nloc, unsigned& nx) {
    const unsigned G = gridDim.x * gridDim.y * gridDim.z;
    unsigned sum, cnt, mine, sp = 0u;
    for (;;) {
        sum = 0u; cnt = 0u; mine = 0u;
#pragma unroll
        for (unsigned j = 0; j < 16; ++j) { const unsigned c = xb_ld(&bar[XB_XCNT(j)]); sum += c; cnt += (c > 0u) ? 1u : 0u; mine = (j == x) ? c : mine; }
        if (sum == G) break;
        __builtin_amdgcn_s_sleep(1);
        if ((++sp & 255u) == 0u) { if (xb_ld(&bar[XB_TMO])) break; if (sp > XB_SPIN_CAP) { atomicAdd(&bar[XB_TMO], 1u); break; } }
    }
    nloc = mine > 0u ? mine : 1u; nx = cnt > 0u ? cnt : 1u;
}
__device__ __forceinline__ void xcd_barrier(const XcdBarrier& b) {
    asm volatile("s_waitcnt vmcnt(0)" ::: "memory");
    __syncthreads();
    if (threadIdx.x == 0) {
        unsigned* bar = b.bar;
        __builtin_amdgcn_s_waitcnt(0);
        unsigned nloc = b.st[0], nx = b.st[1];
        if (nloc == 0u) { xcd_barrier_complete(bar, b.x, nloc, nx); b.st[0] = nloc; b.st[1] = nx; }
        const unsigned old = xb_add(&bar[XB_XSUB(b.x)], 1u);
        const unsigned gen = old / nloc;
        if (old + 1u == (gen + 1u) * nloc) {
            __builtin_amdgcn_fence(__ATOMIC_RELEASE, "agent");
            asm volatile("s_waitcnt vmcnt(0)" ::: "memory");
            const unsigned og = xb_add(&bar[XB_TOP], 1u);
            const unsigned tg = og / nx;
            if (og + 1u == (tg + 1u) * nx) xb_add(&bar[XB_TOPGEN], 1u);
            else XB_SPIN(xb_ld(&bar[XB_TOPGEN]) == tg, bar);
            __builtin_amdgcn_fence(__ATOMIC_ACQUIRE, "agent");
            xb_add(&bar[XB_XGEN(b.x)], 1u);
            asm volatile("s_waitcnt vmcnt(0)" ::: "memory");
        } else {
            XB_SPIN(xb_ld(&bar[XB_XGEN(b.x)]) == gen, bar);
            __builtin_amdgcn_fence(__ATOMIC_ACQUIRE, "agent");
            asm volatile("s_waitcnt vmcnt(0)" ::: "memory");
        }
    }
    __syncthreads();
}

__device__ __forceinline__ float wave_sum(float v) {
#pragma unroll
    for (int o = 1; o < 64; o <<= 1) v += __shfl_xor(v, o);
    return v;
}
__device__ __forceinline__ int pos_gen(int n0) { return (n0 & ~255) + ((n0 >> 5) & 1) * 128 + ((n0 >> 6) & 3) * 32; }
__device__ __forceinline__ int pos_gu(int c0) { const int up = c0 >= 1024, cc = c0 & 1023; return (cc >> 7) * 256 + up * 128 + ((cc >> 5) & 3) * 32; }
__device__ __forceinline__ unsigned pack_i8(const f32x4& v) {
    const int a = (int)__builtin_rintf(v.x), b = (int)__builtin_rintf(v.y), c = (int)__builtin_rintf(v.z), d = (int)__builtin_rintf(v.w);
    return ((unsigned)a & 255u) | (((unsigned)b & 255u) << 8) | (((unsigned)c & 255u) << 16) | ((unsigned)d << 24);
}
__device__ __forceinline__ void win_absmax(const float* W, int k0, int n0, unsigned* cmax, unsigned* ccnt, int lane) {
    const int kc = lane >> 4, nq = lane & 15;
    f32x4 v[16];
#pragma unroll
    for (int i = 0; i < 16; ++i) v[i] = *(const f32x4*)(W + (size_t)(k0 + 16 * kc + i) * INW + n0 + 4 * nq);
    f32x4 mx = (f32x4){0.f, 0.f, 0.f, 0.f};
#pragma unroll
    for (int i = 0; i < 16; ++i) { mx.x = fmaxf(mx.x, fabsf(v[i].x)); mx.y = fmaxf(mx.y, fabsf(v[i].y)); mx.z = fmaxf(mx.z, fabsf(v[i].z)); mx.w = fmaxf(mx.w, fabsf(v[i].w)); }
#pragma unroll
    for (int c = 0; c < 4; ++c) { mx[c] = fmaxf(mx[c], __shfl_xor(mx[c], 16)); mx[c] = fmaxf(mx[c], __shfl_xor(mx[c], 32)); }
    if (kc == 0) {
#pragma unroll
        for (int c = 0; c < 4; ++c) (void)__hip_atomic_fetch_max(cmax + n0 + 4 * nq + c, __float_as_uint(mx[c]), RLX_AGENT);
    }
    asm volatile("s_waitcnt vmcnt(0)" ::: "memory");
    if (lane == 0) (void)__hip_atomic_fetch_add(ccnt, 1u, RLX_AGENT);
}
__device__ __forceinline__ void win_quant(const float* W, int k0, int n0, unsigned char* WT, unsigned* cmax, unsigned* ccnt, float* cs, bool write_cs, unsigned* tmo, int lane) {
    const int kc = lane >> 4, nq = lane & 15;
    f32x4 v[16];
#pragma unroll
    for (int i = 0; i < 16; ++i) v[i] = *(const f32x4*)(W + (size_t)(k0 + 16 * kc + i) * INW + n0 + 4 * nq);
    { unsigned sp = 0; while (__hip_atomic_load(ccnt, RLX_AGENT) < 16u) { __builtin_amdgcn_s_sleep(1);
        if ((++sp & 255u) == 0u) { if (__hip_atomic_load(tmo, RLX_AGENT)) break; if (sp > (1u << 18)) { atomicAdd(tmo, 1u); break; } } } }
    asm volatile("" ::: "memory");
    float sc[4];
#pragma unroll
    for (int c = 0; c < 4; ++c) { const float cm = __uint_as_float(__hip_atomic_load(cmax + n0 + 4 * nq + c, RLX_AGENT)); sc[c] = cm > 0.f ? 127.0f / cm : 0.f; if (write_cs && kc == 0) cs[n0 + 4 * nq + c] = cm * (1.0f / 127.0f); }
    const int nb = n0 + 32 * (nq >> 3);
    const int rowb = pos_gen(nb) + ((4 * nq) & 31);
#pragma unroll
    for (int c = 0; c < 4; ++c) {
        u32x4 o;
        o.x = pack_i8((f32x4){v[0][c], v[1][c], v[2][c], v[3][c]} * sc[c]); o.y = pack_i8((f32x4){v[4][c], v[5][c], v[6][c], v[7][c]} * sc[c]);
        o.z = pack_i8((f32x4){v[8][c], v[9][c], v[10][c], v[11][c]} * sc[c]); o.w = pack_i8((f32x4){v[12][c], v[13][c], v[14][c], v[15][c]} * sc[c]);
        *(u32x4*)(WT + (size_t)(rowb + c) * D + k0 + 16 * kc) = o;
    }
}
template <int MODE, int POSK>
__device__ __forceinline__ void tr_tile(const float* W, int N, int k0, int n0, unsigned char* WT, int ldt_bytes, int dk0, const float* ks, float wscale, int lane, int rowadj = 0) {
    const int kc = lane >> 4, nq = lane & 15;
    f32x4 v[16];
#pragma unroll
    for (int i = 0; i < 16; ++i) { const int kk = MODE ? (16 * kc + i) : (32 * (i >> 3) + 8 * kc + (i & 7)); v[i] = *(const f32x4*)(W + (size_t)(k0 + kk) * N + n0 + 4 * nq); }
    if (ks) {
#pragma unroll
        for (int i = 0; i < 16; ++i) { const int kk = MODE ? (16 * kc + i) : (32 * (i >> 3) + 8 * kc + (i & 7)); v[i] = v[i] * (ks[k0 + kk] * wscale); }
    } else if (MODE) {
#pragma unroll
        for (int i = 0; i < 16; ++i) v[i] = v[i] * wscale;
    }
    const int nb = n0 + 32 * (nq >> 3);
    const int rowb = (POSK ? pos_gu(nb) : pos_gen(nb)) + ((4 * nq) & 31) + rowadj;
#pragma unroll
    for (int c = 0; c < 4; ++c) {
        unsigned char* rp = WT + (size_t)(rowb + c) * ldt_bytes;
        if (MODE == 0) {
#pragma unroll
            for (int p = 0; p < 2; ++p) { u32x4 o; o.x = pk2(v[8 * p + 0][c], v[8 * p + 1][c]); o.y = pk2(v[8 * p + 2][c], v[8 * p + 3][c]); o.z = pk2(v[8 * p + 4][c], v[8 * p + 5][c]); o.w = pk2(v[8 * p + 6][c], v[8 * p + 7][c]);
                *(u32x4*)(rp + (size_t)(dk0 + 32 * p + 8 * kc) * 2) = o; }
        } else {
            int w0 = 0, w1 = 0, w2 = 0, w3 = 0;
            w0 = __builtin_amdgcn_cvt_pk_fp8_f32(v[0][c], v[1][c], w0, false); w0 = __builtin_amdgcn_cvt_pk_fp8_f32(v[2][c], v[3][c], w0, true);
            w1 = __builtin_amdgcn_cvt_pk_fp8_f32(v[4][c], v[5][c], w1, false); w1 = __builtin_amdgcn_cvt_pk_fp8_f32(v[6][c], v[7][c], w1, true);
            w2 = __builtin_amdgcn_cvt_pk_fp8_f32(v[8][c], v[9][c], w2, false); w2 = __builtin_amdgcn_cvt_pk_fp8_f32(v[10][c], v[11][c], w2, true);
            w3 = __builtin_amdgcn_cvt_pk_fp8_f32(v[12][c], v[13][c], w3, false); w3 = __builtin_amdgcn_cvt_pk_fp8_f32(v[14][c], v[15][c], w3, true);
            *(u32x4*)(rp + (size_t)(dk0 + 16 * kc)) = (u32x4){(unsigned)w0, (unsigned)w1, (unsigned)w2, (unsigned)w3};
        }
    }
}

struct Args { const float* in[20]; float* out; unsigned char* ws; int ph_lo, ph_hi, li, pad; };

__global__ void __launch_bounds__(512, 2) moe_block_fwd(Args args) {
    extern __shared__ __attribute__((aligned(16))) unsigned char lds_raw[];
    LAS unsigned char* lds = (LAS unsigned char*)lds_raw;
    volatile LAS unsigned* MISC = (volatile LAS unsigned*)(lds + MISC_OFF);
    const int tid = threadIdx.x, lane = tid & 63, wave = __builtin_amdgcn_readfirstlane(tid >> 6);
    const int G = gridDim.x, bx = blockIdx.x;
    const int vcu = (G % 8 == 0) ? (bx % 8) * (G / 8) + bx / 8 : bx;
    unsigned char* ws = args.ws;
    gu32* ctl = (gu32*)(ws + WS_CTL);
    const float* x = args.in[0]; const float* norm1_g = args.in[1]; const float* w_in = args.in[2]; const float* q_norm_g = args.in[3]; const float* k_norm_g = args.in[4];
    const float* rel_bias = args.in[5]; const float* sg_ln_g = args.in[6]; const float* sg_ln_b = args.in[7]; const float* sg_w = args.in[8]; const float* sg_b = args.in[9];
    const float* w_branch_a = args.in[10]; const float* w_branch_b = args.in[11]; const float* w_out = args.in[12]; const float* norm2_g = args.in[13];
    const float* router_w = args.in[14]; const float* router_b = args.in[15]; const float* w_gate_up = args.in[16]; const float* b_gate_up = args.in[17];
    const float* w_down = args.in[18]; const float* b_down = args.in[19];
    float* out = args.out;
    bf16* WIN = (bf16*)(ws + WS_WIN); unsigned char* WIN8 = ws + WS_WIN8; float* HS = (float*)(ws + WS_HS); float* CS = (float*)(ws + WS_CS); unsigned char* H8 = ws + WS_H8; bf16* WAB = (bf16*)(ws + WS_WAB); bf16* WO = (bf16*)(ws + WS_WO); bf16* WRH = (bf16*)(ws + WS_WR); bf16* WRL = (bf16*)(ws + WS_WR + 65536); bf16* WM = (bf16*)(ws + WS_WM);
    int* LID = (int*)(ws + WS_LID); float* LRS = (float*)(ws + WS_LRS); float* LP = (float*)(ws + WS_LP);
    unsigned char* WGU = ws + WS_WGU; unsigned char* WD = ws + WS_WD;
    bf16* HB = (bf16*)(ws + WS_H); bf16* QB = (bf16*)(ws + WS_Q); bf16* KB = (bf16*)(ws + WS_K); bf16* VB = (bf16*)(ws + WS_V);
    bf16* UG = (bf16*)(ws + WS_UG); bf16* VG = (bf16*)(ws + WS_VG); unsigned char* GA = ws + WS_GA; bf16* GB = (bf16*)(ws + WS_GB);
    bf16* YCAT = (bf16*)(ws + WS_YCAT); unsigned char* X1Q = ws + WS_X1B; bf16* X1H = (bf16*)(ws + WS_X1H); unsigned char* ACT = ws + WS_ACT; unsigned char* YB = ws + WS_Y;

    for (int u = tid; u < (LDS_BYTES - LDSCTL_OFF) / 4; u += 512) ((LAS unsigned*)(lds + LDSCTL_OFF))[u] = 0u;
    __syncthreads();
    XcdBarrier bar; bar.bar = (unsigned*)(ctl + CW_BAR); bar.x = 0; bar.st = nullptr;
    if (MK_N_LAUNCHES == 1) bar = xcd_barrier_post((unsigned*)(ctl + CW_BAR), MISC + 8);
    const int lo = args.ph_lo, hi = args.ph_hi;
#define IN(k) (lo <= (k) && (k) < hi)
#define SEAM(k) do { if (IN(k) && IN((k) + 1)) xcd_barrier(bar); } while (0)
#define REPS(k) for (int rep_ = 0; rep_ < ((REP_PHASE == (k)) ? 2 : 1); ++rep_)
#define REPSEAM(k) do { if (REP_PHASE == (k) && rep_ == 0) xcd_barrier(bar); } while (0)
    const int gw = vcu * 8 + wave, NGW = G * 8;

    if (IN(0)) REPS(0) {
        constexpr int I_IN = 16 * 72, I_A = 8 * 16, I_O = 16 * 16, I_GU = 16 * 32, I_D = 16 * 16;
        constexpr int NITEMS = I_IN + 2 * I_A + I_O;
        for (int it = gw; it < NITEMS; it += NGW) {
            int r = it;
            if (r < I_IN) { const int kb = r / 72, nb = r % 72; win_absmax(w_in, 64 * kb, 64 * nb, (unsigned*)(ctl + CW_CMAX), (unsigned*)(ctl + CW_CCNT + nb), lane); continue; } r -= I_IN;
            if (r < I_A) { const int kb = r / 16, nb = r % 16; tr_tile<0, 0>(w_branch_a, D, 64 * kb, 64 * nb, (unsigned char*)WAB, D * 2, 64 * kb, nullptr, 1.f, lane); continue; } r -= I_A;
            if (r < I_A) { const int kb = r / 16, nb = r % 16; tr_tile<0, 0>(w_branch_b, D, 64 * kb, 64 * nb, (unsigned char*)WAB, D * 2, 512 + 64 * kb, nullptr, 1.f, lane); continue; } r -= I_A;
            { const int kb = r / 16, nb = r % 16; tr_tile<0, 0>(w_out, D, 64 * kb, 64 * nb, (unsigned char*)WO, D * 2, 64 * kb, nullptr, 1.f, lane); }
        }
        for (int i = gw * 64 + lane; i < 4 * 128 * 128; i += NGW * 64) { const int s = i & 127, t = (i >> 7) & 127; WM[i] = (bf16)f2bf(s <= t ? sg_w[i] : 0.f); }
        for (int i = gw * 64 + lane; i < NE * D; i += NGW * 64) { const int k = i & 1023, e = i >> 10; const float w = router_w[k * NE + e] * norm2_g[k]; const unsigned h_ = f2bf(w); WRH[i] = (bf16)h_; WRL[i] = (bf16)f2bf(w - bf2f((unsigned short)h_)); }
        for (int m = 2 * gw; m < T; m += 2 * NGW) {
            const f32x4* xr = (const f32x4*)(x + (size_t)m * D) + lane; const f32x4* gr = (const f32x4*)norm1_g + lane;
            f32x4 v[2][4]; float s0 = 0.f, s1 = 0.f, a0 = 0.f, a1 = 0.f;
#pragma unroll
            for (int j = 0; j < 4; ++j) { v[0][j] = xr[64 * j]; v[1][j] = xr[256 + 64 * j]; }
#pragma unroll
            for (int j = 0; j < 4; ++j) { const f32x4 gq = gr[64 * j];
                s0 += (v[0][j].x * v[0][j].x + v[0][j].y * v[0][j].y) + (v[0][j].z * v[0][j].z + v[0][j].w * v[0][j].w);
                s1 += (v[1][j].x * v[1][j].x + v[1][j].y * v[1][j].y) + (v[1][j].z * v[1][j].z + v[1][j].w * v[1][j].w);
                v[0][j] = v[0][j] * gq; v[1][j] = v[1][j] * gq;
                a0 = fmaxf(a0, fmaxf(fmaxf(fabsf(v[0][j].x), fabsf(v[0][j].y)), fmaxf(fabsf(v[0][j].z), fabsf(v[0][j].w))));
                a1 = fmaxf(a1, fmaxf(fmaxf(fabsf(v[1][j].x), fabsf(v[1][j].y)), fmaxf(fabsf(v[1][j].z), fabsf(v[1][j].w)))); }
            s0 = wave_sum(s0); s1 = wave_sum(s1);
#pragma unroll
            for (int o = 1; o < 64; o <<= 1) { a0 = fmaxf(a0, __shfl_xor(a0, o)); a1 = fmaxf(a1, __shfl_xor(a1, o)); }
            const float rs0 = 1.0f / sqrtf(s0 * (1.0f / D) + EPS), rs1 = 1.0f / sqrtf(s1 * (1.0f / D) + EPS);
            const float q0 = a0 > 0.f ? 127.0f / a0 : 0.f, q1 = a1 > 0.f ? 127.0f / a1 : 0.f;
            if (lane == 0) { HS[m] = rs0 * a0 * (1.0f / 127.0f); HS[m + 1] = rs1 * a1 * (1.0f / 127.0f); }
            unsigned* q8 = (unsigned*)(H8 + (size_t)m * D) + lane;
#pragma unroll
            for (int j = 0; j < 4; ++j) { q8[64 * j] = pack_i8(v[0][j] * q0); q8[256 + 64 * j] = pack_i8(v[1][j] * q1); }
        }
        for (int it = gw; it < I_IN; it += NGW) { const int kb = it / 72, nb = it % 72;
            win_quant(w_in, 64 * kb, 64 * nb, WIN8, (unsigned*)(ctl + CW_CMAX), (unsigned*)(ctl + CW_CCNT + nb), CS, kb == 0, (unsigned*)(ctl + CW_BAR) + XB_TMO, lane); }
        REPSEAM(0);
    }
    SEAM(0);

    if (IN(1)) REPS(1) {
        { PolIn P; P.so.init(T, INW, G, bx); P.A = H8; P.Bt = WIN8; P.ws = ws; P.qg = q_norm_g; P.kg = k_norm_g; P.hs = HS; P.cs = CS; P.shm = lds;
          pg8::gemm_phase<PolIn>(lds, P); }
        REPSEAM(1);
    }
    SEAM(1);

    if (IN(2)) REPS(2) {
        const MoeConv cv{w_gate_up, w_down, norm2_g, WGU, WD}; MoeConv::Regs sreg; int sctr = 0;
        for (int u = vcu; u < NB * NHEAD * 32; u += G) {
            const int cg = u & 31, bh = u >> 5;
            att::unit(bh >> 3, bh & 7, cg, QB, KB, VB, rel_bias, YCAT, lds, cv, sreg, sctr, gw, NGW);
        }
        sgu_load_wm(vcu & 3, WM, lds);
        for (int it = vcu; it < 4 * (T / 128); it += G) sgu_item(it, VG, UG, sg_ln_g, sg_ln_b, sg_b, YCAT, lds, cv, sreg, sctr, gw, NGW);
        cv.drain(sreg, sctr, gw, NGW, lane);
        REPSEAM(2);
    }
    SEAM(2);

    if (IN(3)) REPS(3) {
        PolMerge P; P.so.init(T, D, G, bx); P.A = YCAT; P.Bt = WAB; P.ga = GA; P.gb = (const unsigned char*)GB; P.out = HB;
        pg8::gemm_phase<PolMerge>(lds, P);
        REPSEAM(3);
    }
    SEAM(3);

    if (IN(4)) REPS(4) {
        PolOut P; P.so.init(T, D, G, bx); P.A = HB; P.Bt = WO; P.x = x; P.x1 = X1H; P.x1q = X1Q;
        pg8::gemm_phase<PolOut>(lds, P);
        REPSEAM(4);
    }
    SEAM(4);

    if (IN(5)) {
        LAS int* lcnt = (LAS int*)(lds + PARK_OFF); LAS int* gbase = lcnt + 32;
        if (tid < 64) lcnt[tid] = 0;
        for (int i = tid; i < 4096; i += 512) { const int e = i & 31, gq = (i >> 5) & 3, kq = i >> 7;
            *(LAS u32x4*)(lds + (size_t)i * 16) = *(const u32x4*)(WRH + (size_t)e * D + 32 * kq + 8 * gq); *(LAS u32x4*)(lds + 65536 + (size_t)i * 16) = *(const u32x4*)(WRL + (size_t)e * D + 32 * kq + 8 * gq); }
        __syncthreads();
        const int r = lane & 15, g = lane >> 4;
        int sel_e[4], sel_rank[4]; float sel_p[4]; float rs_row = 0.f; int tok = 0;
        for (int grp = bx * 8 + wave; grp < T / 16; grp += NGW) {
            const int row0 = grp * 16; tok = row0 + r;
            const bf16* xr = X1H + (size_t)(row0 + r) * D + 8 * g;
            const LAS unsigned char* wl_ = lds + (g * 32 + r) * 16;
            f32x4 a0 = (f32x4){0.f, 0.f, 0.f, 0.f}, a1 = a0; float ssq = 0.f;
            u32x4 xq[4][4];
#define P5_LOAD(S, ss) do { _Pragma("unroll") for (int q = 0; q < 4; ++q) xq[S][q] = *(const u32x4*)(xr + 128 * (ss) + 32 * q); } while (0)
#define P5_COMP(S, ss) do { _Pragma("unroll") for (int q = 0; q < 4; ++q) { const u32x4 w_ = xq[S][q]; const int ks = 4 * (ss) + q; \
                const bf16x8 wh_0 = *(const LAS bf16x8*)(wl_ + ks * 2048), wh_1 = *(const LAS bf16x8*)(wl_ + ks * 2048 + 256), wl_0 = *(const LAS bf16x8*)(wl_ + 65536 + ks * 2048), wl_1 = *(const LAS bf16x8*)(wl_ + 65536 + ks * 2048 + 256); \
                ssq += (bflo(w_.x) * bflo(w_.x) + bfhi(w_.x) * bfhi(w_.x)) + (bflo(w_.y) * bflo(w_.y) + bfhi(w_.y) * bfhi(w_.y)) + (bflo(w_.z) * bflo(w_.z) + bfhi(w_.z) * bfhi(w_.z)) + (bflo(w_.w) * bflo(w_.w) + bfhi(w_.w) * bfhi(w_.w)); \
                const bf16x8 xh = __builtin_bit_cast(bf16x8, w_); \
                a0 = __builtin_amdgcn_mfma_f32_16x16x32_bf16(wh_0, xh, a0, 0, 0, 0); a1 = __builtin_amdgcn_mfma_f32_16x16x32_bf16(wh_1, xh, a1, 0, 0, 0); \
                a0 = __builtin_amdgcn_mfma_f32_16x16x32_bf16(wl_0, xh, a0, 0, 0, 0); a1 = __builtin_amdgcn_mfma_f32_16x16x32_bf16(wl_1, xh, a1, 0, 0, 0); } } while (0)
            P5_LOAD(0, 0); P5_LOAD(1, 1); P5_LOAD(2, 2); P5_LOAD(3, 3);
            P5_COMP(0, 0); P5_LOAD(0, 4);
            P5_COMP(1, 1); P5_LOAD(1, 5);
            P5_COMP(2, 2); P5_LOAD(2, 6);
            P5_COMP(3, 3); P5_LOAD(3, 7);
            P5_COMP(0, 4); P5_COMP(1, 5); P5_COMP(2, 6); P5_COMP(3, 7);
#undef P5_LOAD
#undef P5_COMP
            ssq += __shfl_xor(ssq, 16); ssq += __shfl_xor(ssq, 32);
            const float rs = 1.0f / sqrtf(ssq * (1.0f / D) + EPS); rs_row = rs;
            float v[8];
#pragma unroll
            for (int j = 0; j < 4; ++j) { v[j] = a0[j] * rs + router_b[4 * g + j]; v[4 + j] = a1[j] * rs + router_b[16 + 4 * g + j]; }
            unsigned taken = 0u; float sel_v[4];
#pragma unroll
            for (int k = 0; k < 4; ++k) {
                float best = -INFINITY; int bi = 1 << 20;
#pragma unroll
                for (int i = 0; i < 8; ++i) { const int ei = (i >> 2) * 16 + 4 * g + (i & 3); if (!((taken >> i) & 1u) && v[i] > best) { best = v[i]; bi = ei; } }
#pragma unroll
                for (int m = 16; m <= 32; m <<= 1) { const float ob = __shfl_xor(best, m); const int oi = __shfl_xor(bi, m); if (ob > best || (ob == best && oi < bi)) { best = ob; bi = oi; } }
                sel_e[k] = bi; sel_v[k] = best;
                if (((bi & 15) >> 2) == g) taken |= 1u << (((bi >> 4) << 2) | (bi & 3));
            }
            float den = 0.f;
#pragma unroll
            for (int k = 0; k < 4; ++k) { sel_p[k] = __expf(sel_v[k] - sel_v[0]); den += sel_p[k]; }
            const float inv = 1.0f / den;
#pragma unroll
            for (int k = 0; k < 4; ++k) sel_p[k] *= inv;
            if (g == 0) {
#pragma unroll
                for (int k = 0; k < 4; ++k) sel_rank[k] = __hip_atomic_fetch_add(lcnt + sel_e[k], 1, __ATOMIC_RELAXED, __HIP_MEMORY_SCOPE_WORKGROUP);
            }
        }
        __syncthreads();
        if (tid < NE) gbase[tid] = (int)__hip_atomic_fetch_add((unsigned*)(ctl + CW_CNT + tid), (unsigned)lcnt[tid], RLX_AGENT);
        __syncthreads();
        if (g == 0 && (bx * 8 + wave) < T / 16) {
#pragma unroll
            for (int k = 0; k < 4; ++k) { const size_t pos = (size_t)sel_e[k] * LCAP + gbase[sel_e[k]] + sel_rank[k];
                LID[pos] = tok * 4 + k; LRS[pos] = rs_row; LP[pos] = sel_p[k]; }
        }
        __syncthreads();
    }
    SEAM(5);

    if (IN(6) || IN(7)) {
        LAS int* tb = (LAS int*)(lds + MOE_OFF);
        if (tid < NE) tb[33 + tid] = (int)__hip_atomic_load(ctl + CW_CNT + tid, RLX_AGENT);
        __syncthreads();
        if (tid == 0) { int acc = 0; for (int e = 0; e < NE; ++e) { tb[e] = acc; acc += (tb[33 + e] + 255) >> 8; } tb[32] = acc; }
        __syncthreads();
    }
    if (IN(6)) REPS(6) {
        PolGU P; P.mo.init((const LAS int*)(lds + MOE_OFF), 8, G, bx); P.A = X1Q; P.Bt = WGU; P.lid = LID; P.lrs = LRS; P.bgu = b_gate_up; P.act = ACT; P.shm = lds;
        pg8::gemm_phase<PolGU>(lds, P);
        REPSEAM(6);
    }
    SEAM(6);
    if (IN(7)) REPS(7) {
        PolDown P; P.mo.init((const LAS int*)(lds + MOE_OFF), 4, G, bx); P.A = ACT; P.Bt = WD; P.lid = LID; P.lp = LP; P.bd = b_down; P.y = YB; P.shm = lds;
        pg8::gemm_phase<PolDown>(lds, P);
        REPSEAM(7);
    }
    SEAM(7);
    if (IN(8)) {
        f32x4 xa[4], xb[4]; u32x4 ya[4], yb[4];
#define P8_LOAD(X, Y, m_) do { const bf16* xr_ = X1H + (size_t)(m_) * D + 16 * lane; { f32x4 a_, b_; ld8(xr_, a_, b_); X[0] = a_; X[1] = b_; ld8(xr_ + 8, a_, b_); X[2] = a_; X[3] = b_; } \
            _Pragma("unroll") for (int k = 0; k < 4; ++k) Y[k] = *(const u32x4*)(YB + ((size_t)(m_) * 4 + k) * D + 16 * lane); } while (0)
#define P8_DONE(X, Y, m_) do { _Pragma("unroll") for (int k = 0; k < 4; ++k) { const unsigned ww[4] = {Y[k].x, Y[k].y, Y[k].z, Y[k].w}; \
            _Pragma("unroll") for (int q = 0; q < 4; ++q) { const f32x2 lo_ = __builtin_amdgcn_cvt_pk_f32_fp8((int)ww[q], false), hi_ = __builtin_amdgcn_cvt_pk_f32_fp8((int)ww[q], true); \
                X[q][0] += lo_[0] * 0.0625f; X[q][1] += lo_[1] * 0.0625f; X[q][2] += hi_[0] * 0.0625f; X[q][3] += hi_[1] * 0.0625f; } } \
            float* or_ = out + (size_t)(m_) * D + 16 * lane; _Pragma("unroll") for (int j = 0; j < 4; ++j) *(f32x4*)(or_ + 4 * j) = X[j]; } while (0)
        for (int m = gw; m < T; m += 2 * NGW) { const int m2 = m + NGW;
            P8_LOAD(xa, ya, m); P8_LOAD(xb, yb, m2);
            P8_DONE(xa, ya, m); P8_DONE(xb, yb, m2); }
#undef P8_LOAD
#undef P8_DONE
    }
#undef IN
#undef SEAM
}

extern "C" void kernel_launch(void* const* d_in, const int* in_sizes, int n_in, void* d_out, int out_size, void* d_ws, size_t ws_size, hipStream_t stream) {
    static int grid = 0;
    if (grid == 0) {
        if (n_in != 20 || in_sizes[0] != T * D || out_size != T * D || ws_size < WS_END) { fprintf(stderr, "kernel_launch: unexpected shapes (n_in %d, ws %zu)\n", n_in, ws_size); grid = -1; return; }
        int dev = 0, cus = 0;
        if (hipGetDevice(&dev) != hipSuccess || hipDeviceGetAttribute(&cus, hipDeviceAttributeMultiprocessorCount, dev) != hipSuccess) { grid = -1; return; }
        if (hipFuncSetAttribute((const void*)moe_block_fwd, hipFuncAttributeMaxDynamicSharedMemorySize, LDS_BYTES) != hipSuccess) { fprintf(stderr, "kernel_launch: hipFuncSetAttribute failed\n"); grid = -1; return; }
        (void)hipGetLastError();
        grid = cus;
        if (grid != 256) { fprintf(stderr, "kernel_launch: built for a 256-CU device, got %d\n", cus); grid = -1; return; }
    }
    if (grid < 0) return;
    if (hipMemsetAsync((char*)d_ws + WS_CTL, 0, CTL_ZERO_BYTES, stream) != hipSuccess) return;
    Args a{};
    for (int i = 0; i < 20; ++i) a.in[i] = (const float*)d_in[i];
    a.out = (float*)d_out; a.ws = (unsigned char*)d_ws;
    constexpr int NPH = 9;
    for (int li = 0; li < MK_N_LAUNCHES; ++li) {
        a.ph_lo = (MK_N_LAUNCHES == 1) ? 0 : li; a.ph_hi = (MK_N_LAUNCHES == 1) ? NPH : li + 1; a.li = li;
        hipLaunchKernelGGL(moe_block_fwd, dim3(grid), dim3(512), LDS_BYTES, stream, a);
    }
}
```

```cpp
#include <hip/hip_runtime.h>
#include <cstdio>
#include <cstdint>

#ifndef MK_N_LAUNCHES
#define MK_N_LAUNCHES 1
#endif

#ifndef REP_PHASE
#define REP_PHASE -1
#endif
#define LAS __attribute__((address_space(3)))
#define GAS __attribute__((address_space(1)))
typedef unsigned short bf16;
typedef short bf16x8 __attribute__((ext_vector_type(8)));
typedef short s16x4 __attribute__((ext_vector_type(4)));
typedef float f32x2 __attribute__((ext_vector_type(2)));
typedef float f32x4 __attribute__((ext_vector_type(4)));
typedef float f32x16 __attribute__((ext_vector_type(16)));
typedef unsigned u32x2 __attribute__((ext_vector_type(2)));
typedef unsigned u32x4 __attribute__((ext_vector_type(4)));
typedef GAS unsigned gu32;

constexpr int NB = 4, SEQ = 8192, T = NB * SEQ, D = 1024, AW = 512, SGW = 512, INW = 4608, NE = 32, FF = 1024;
constexpr int NHEAD = 8, HD = 64, CHUNK = 64, NBACK = 8, NREL = 513;
constexpr int LCAP = 32768;
constexpr float LOG2E = 1.4426950408889634f;
constexpr float EPS = 1e-6f;

constexpr size_t MiB = 1u << 20;
constexpr size_t WS_CTL = 0, CTL_ZERO_BYTES = 1 * MiB;
constexpr size_t WS_WIN = 7 * MiB;
constexpr size_t WS_WAB = 11 * MiB;
constexpr size_t WS_WO = 13 * MiB;
constexpr size_t WS_WR = 15 * MiB;
constexpr size_t WS_WM = 15 * MiB + 256 * 1024;
constexpr size_t WS_WIN8 = 2 * MiB;
constexpr size_t WS_HS = 15 * MiB + 512 * 1024;
constexpr size_t WS_CS = 15 * MiB + 768 * 1024;
constexpr size_t WS_H8 = 976 * MiB;
constexpr size_t WS_LID = 16 * MiB;
constexpr size_t WS_LRS = 20 * MiB;
constexpr size_t WS_LP = 24 * MiB;
constexpr size_t WS_WGU = 28 * MiB;
constexpr size_t WS_WD = 156 * MiB;
constexpr size_t WS_H = 220 * MiB;
constexpr size_t WS_Q = 284 * MiB, WS_K = 316 * MiB, WS_V = 348 * MiB;
constexpr size_t WS_UG = 380 * MiB, WS_VG = 412 * MiB;
constexpr size_t WS_GA = 444 * MiB, WS_GB = 508 * MiB;
constexpr size_t WS_YCAT = 572 * MiB;
constexpr size_t WS_X1B = 636 * MiB;
constexpr size_t WS_ACT = 700 * MiB;
constexpr size_t WS_X1H = 380 * MiB;
constexpr size_t WS_Y = 220 * MiB;
constexpr size_t WS_END = 1008 * MiB;
constexpr int CW_TMO = 0, CW_CODE = 1;
constexpr int CW_CNT = 64;
constexpr int CW_BAR = 4096;
constexpr int CW_CMAX = 8192;
constexpr int CW_CCNT = 16384;

constexpr int RING_BYTES = 131072;
constexpr int LDSCTL_OFF = RING_BYTES, MISC_OFF = LDSCTL_OFF + 320;
constexpr int MOE_OFF = MISC_OFF + 128;
constexpr int PARK_OFF = LDSCTL_OFF + 1024;
constexpr int ROWS_OFF = LDSCTL_OFF + 9216, ROWS_BUF = 3072;
constexpr int LDS_BYTES = 147456;

#define LDS_WAIT() asm volatile("s_waitcnt lgkmcnt(0)" ::: "memory")
#define VM_WAIT() asm volatile("s_waitcnt vmcnt(0)" ::: "memory")
#define RLX_AGENT __ATOMIC_RELAXED, __HIP_MEMORY_SCOPE_AGENT

__device__ __forceinline__ unsigned f2bf(float f) { unsigned u = __builtin_bit_cast(unsigned, f); return (u + 0x7fffu + ((u >> 16) & 1u)) >> 16; }
__device__ __forceinline__ unsigned pk2(float lo, float hi) { return f2bf(lo) | (f2bf(hi) << 16); }
__device__ __forceinline__ float bf2f(unsigned short b) { return __builtin_bit_cast(float, (unsigned)b << 16); }
__device__ __forceinline__ float bflo(unsigned w) { return __builtin_bit_cast(float, w << 16); }
__device__ __forceinline__ float bfhi(unsigned w) { return __builtin_bit_cast(float, w & 0xffff0000u); }
__device__ __forceinline__ unsigned cvt_pk_bf16(float lo, float hi) { unsigned r; asm volatile("v_cvt_pk_bf16_f32 %0, %1, %2" : "=v"(r) : "v"(lo), "v"(hi)); return r; }
__device__ __forceinline__ float fast_rcp(float x) { return __builtin_amdgcn_rcpf(x); }
__device__ __forceinline__ float fast_exp2(float x) { return __builtin_amdgcn_exp2f(x); }
__device__ __forceinline__ float sigmoidf_(float x) { return fast_rcp(1.0f + fast_exp2(-LOG2E * x)); }
__device__ __forceinline__ float gelu_tanh(float x) {
    const float t = x * ((-LOG2E * 1.5957691216057308f) + (-LOG2E * 1.5957691216057308f * 0.044715f) * (x * x));
    return x * fast_rcp(1.0f + fast_exp2(t));
}

namespace pg8 {
constexpr int BM = 256, BK = 64, HALF = 128, HTB = HALF * BK * 2, STAGE_BYTES = 8 * HTB, NXCD = 8, WGM = 8;
__host__ __device__ __forceinline__ int lds_byte(int r, int c) { const int st = (r >> 4) * 2 + (c >> 5), rr = r & 15, cc = c & 31, ob = rr * 64 + cc * 2; return st * 1024 + (ob ^ (((ob >> 9) & 1) << 5)); }
__host__ __device__ __forceinline__ void stage_rc(int b, int& R, int& C) { const int st = b / 1024, sb = b % 1024, swz = sb ^ (((sb >> 9) & 1) << 5); R = (st >> 1) * 16 + swz / 64; C = (st & 1) * 32 + (swz % 64) / 2; }
__host__ __device__ __forceinline__ int perm32(int rho) { const int n = rho >> 4, i = rho & 15; return 8 * (i >> 2) + 4 * n + (i & 3); }

typedef int v4i_t __attribute__((ext_vector_type(4)));
typedef int v8i_t __attribute__((ext_vector_type(8)));
__device__ __forceinline__ v8i_t cat8(bf16x8 lo, bf16x8 hi) { return __builtin_shufflevector(__builtin_bit_cast(v4i_t, lo), __builtin_bit_cast(v4i_t, hi), 0, 1, 2, 3, 4, 5, 6, 7); }
struct Unit { int pm, pn, e, s0, cnt, idx; };

struct StaticOrder {
    int nM, nN, nwg, G, c;
    __device__ void init(int M, int N, int G_, int c_) { nM = M / BM; nN = N / BM; nwg = nM * nN; G = G_; c = c_; }
    __device__ bool tile(int i, int& pm, int& pn) const {
        const long L = (long)i * G + c; if (L >= nwg) return false;
        int wgid = (int)L; { const int q = nwg / NXCD, r = nwg % NXCD, xcd = wgid % NXCD, off = wgid / NXCD; wgid = (xcd < r ? xcd * (q + 1) : r * (q + 1) + (xcd - r) * q) + off; }
        const int nig = WGM * nN, gid = wgid / nig, fm = gid * WGM, gsz = (nM - fm) < WGM ? (nM - fm) : WGM;
        pm = fm + ((wgid % nig) % gsz); pn = (wgid % nig) / gsz; return true;
    }
};

template <class P>
__device__ __forceinline__ void gemm_phase(LAS unsigned char* lds, const P& S) {
    const int tid = threadIdx.x, wid = __builtin_amdgcn_readfirstlane(tid >> 6), lane = tid & 63, wr = wid >> 2, wc = wid & 3, fr = lane & 15, fq = lane >> 4;
    constexpr int nt = P::NT;
    unsigned vA[2][2], voffB[2];
    LAS u32x4* park = (LAS u32x4*)(lds + PARK_OFF) + tid;
#pragma unroll
    for (int i = 0; i < 2; ++i) { int R, C; stage_rc(tid * 16 + i * 8192, R, C); const int Rb = (R & ~31) + perm32(R & 31);
        vA[0][i] = (unsigned)(R * P::LDA + C) * 2u; vA[1][i] = (unsigned)((R + HALF) * P::LDA + C) * 2u; voffB[i] = (unsigned)(Rb * P::LDB + C) * 2u; }
    const size_t kstep = (size_t)(BK * 2);
    const size_t hstepB = (size_t)HALF * P::LDB * 2;
    const unsigned ldsw = (unsigned)wid * 1024u;
    const int aoff = lds_byte(wr * 64 + fr, fq * 8), boff = lds_byte(wc * 32 + fr, fq * 8);
#define PG8_SA(b, h) (((b) * 2 + (h)) * HTB)
#define PG8_SB(b, h) ((4 + (b) * 2 + (h)) * HTB)
#define PG8_STAGE2(bufoff, gbase, o0, o1) do { \
        __builtin_amdgcn_global_load_lds((const unsigned*)((const char*)(gbase) + (o0)), (LAS unsigned*)(lds + (bufoff) + ldsw), 16, 0, 0); \
        __builtin_amdgcn_global_load_lds((const unsigned*)((const char*)(gbase) + (o1)), (LAS unsigned*)(lds + (bufoff) + ldsw + 8192), 16, 0, 0); } while (0)
#define PG8_STAGEB(bufoff, gbase) PG8_STAGE2(bufoff, gbase, voffB[0], voffB[1])
#define PG8_LDA(dst, b, h) do { _Pragma("unroll") for (int m = 0; m < 4; ++m) _Pragma("unroll") for (int k = 0; k < 2; ++k) dst[m][k] = *(const LAS bf16x8*)(lds + PG8_SA(b, h) + aoff + m * 2048 + k * 1024); } while (0)
#define PG8_LDB(dst, b, h) do { _Pragma("unroll") for (int n = 0; n < 2; ++n) _Pragma("unroll") for (int k = 0; k < 2; ++k) dst[n][k] = *(const LAS bf16x8*)(lds + PG8_SB(b, h) + boff + n * 2048 + k * 1024); } while (0)
#define PG8_MMA(ai, bj, At, Bt) do { __builtin_amdgcn_s_setprio(1); _Pragma("unroll") for (int m = 0; m < 4; ++m) _Pragma("unroll") for (int n = 0; n < 2; ++n) { \
        if constexpr (P::I8) { _Pragma("unroll") for (int k = 0; k < 2; ++k) acc[ai][bj][m][n] = __builtin_bit_cast(f32x4, __builtin_amdgcn_mfma_i32_16x16x64_i8(__builtin_bit_cast(v4i_t, Bt[n][k]), __builtin_bit_cast(v4i_t, At[m][k]), __builtin_bit_cast(v4i_t, acc[ai][bj][m][n]), 0, 0, 0)); }     \
        else if constexpr (P::FP8) { acc[ai][bj][m][n] = __builtin_amdgcn_mfma_scale_f32_16x16x128_f8f6f4(cat8(Bt[n][0], Bt[n][1]), cat8(At[m][0], At[m][1]), acc[ai][bj][m][n], 0, 0, 0, 0, 0, 0); }     \
        else { _Pragma("unroll") for (int k = 0; k < 2; ++k) acc[ai][bj][m][n] = __builtin_amdgcn_mfma_f32_16x16x32_bf16(Bt[n][k], At[m][k], acc[ai][bj][m][n], 0, 0, 0); } } \
        __builtin_amdgcn_s_setprio(0); } while (0)
#define PG8_WAIT_V(n) asm volatile("s_waitcnt vmcnt(" #n ")" ::: "memory")
#define PG8_WAIT_L(n) asm volatile("s_waitcnt lgkmcnt(" #n ")" ::: "memory")
#define PG8_BAR __builtin_amdgcn_s_barrier()
#define PG8_SCHED __builtin_amdgcn_sched_barrier(0)
    Unit cur, nxt; int ui = 0;
    if (!S.next(0, cur)) return;
    if constexpr (P::GATHER) S.a_off(cur, tid, vA);
    f32x4 acc[2][2][4][2];
#pragma unroll
    for (int a = 0; a < 2; ++a)
#pragma unroll
        for (int b = 0; b < 2; ++b)
#pragma unroll
            for (int m = 0; m < 4; ++m)
#pragma unroll
                for (int n = 0; n < 2; ++n) acc[a][b][m][n] = (f32x4){0.f, 0.f, 0.f, 0.f};
    bf16x8 At[4][2], B0[2][2], B1[2][2];
    const char* cA = S.a_ptr(cur); const char* cB = S.b_ptr(cur);
    PG8_STAGEB(PG8_SB(0, 0), cB); PG8_STAGEB(PG8_SB(0, 1), cB + hstepB); PG8_STAGE2(PG8_SA(0, 0), cA, vA[0][0], vA[0][1]); PG8_STAGE2(PG8_SA(0, 1), cA, vA[1][0], vA[1][1]);
    if (wr == 1) PG8_BAR;
    PG8_WAIT_V(2); PG8_BAR;
    PG8_STAGEB(PG8_SB(1, 0), cB + kstep); PG8_STAGE2(PG8_SA(1, 0), cA + kstep, vA[0][0], vA[0][1]); PG8_STAGEB(PG8_SB(1, 1), cB + hstepB + kstep);
    PG8_WAIT_V(6); PG8_BAR;
    for (;;) {
        const bool has_next = S.next(ui + 1, nxt);
        if constexpr (P::ROWDMA) S.row_dma(cur, lds, wid, lane);
        const char* nA = has_next ? S.a_ptr(nxt) : cA; const char* nB = has_next ? S.b_ptr(nxt) : cB;
        if constexpr (P::IDDMA) { if (has_next) S.ids_dma(nxt, cur, lds, wid, lane); }
        else if constexpr (P::GATHER) {
            unsigned vn[2][2];
            if (has_next) S.a_off(nxt, tid, vn);
            else { vn[0][0] = vA[0][0]; vn[0][1] = vA[0][1]; vn[1][0] = vA[1][0]; vn[1][1] = vA[1][1]; }
            *park = (u32x4){vn[0][0], vn[0][1], vn[1][0], vn[1][1]};
        }
#pragma nounroll
        for (int t = 0; t < nt; t += 2) {
            const bool last = (t == nt - 2);
            asm volatile("" : "+v"(vA[0][0]), "+v"(vA[0][1]), "+v"(vA[1][0]), "+v"(vA[1][1]), "+v"(voffB[0]), "+v"(voffB[1]));
            const char* a1 = cA + (size_t)(t + 1) * kstep;
            const char* a2 = last ? nA : cA + (size_t)(t + 2) * kstep; const char* b2 = last ? nB : cB + (size_t)(t + 2) * kstep;
            const char* a3 = a2 + kstep; const char* b3 = b2 + kstep;
            PG8_LDB(B0, 0, 0); PG8_LDB(B1, 0, 1); PG8_SCHED; PG8_LDA(At, 0, 0); PG8_STAGE2(PG8_SA(1, 1), a1, vA[1][0], vA[1][1]);
            if constexpr (P::IDDMA) { if (last && has_next) S.a_off_lds(nxt, cur, tid, lds, vA); }
            else if constexpr (P::GATHER) { if (last) { const u32x4 nv = *park; vA[0][0] = nv.x; vA[0][1] = nv.y; vA[1][0] = nv.z; vA[1][1] = nv.w; } }
            PG8_WAIT_V(8); PG8_WAIT_L(0); PG8_BAR; PG8_MMA(0, 0, At, B0); PG8_MMA(0, 1, At, B1); PG8_BAR; PG8_SCHED;
            PG8_LDA(At, 0, 1); PG8_STAGEB(PG8_SB(0, 0), b2); PG8_STAGEB(PG8_SB(0, 1), b2 + hstepB); PG8_STAGE2(PG8_SA(0, 0), a2, vA[0][0], vA[0][1]);
            PG8_WAIT_V(8); PG8_WAIT_L(0); PG8_BAR; PG8_MMA(1, 0, At, B0); PG8_MMA(1, 1, At, B1); PG8_BAR; PG8_SCHED;
            PG8_LDB(B0, 1, 0); PG8_LDB(B1, 1, 1); PG8_SCHED; PG8_LDA(At, 1, 0); PG8_STAGE2(PG8_SA(0, 1), a2, vA[1][0], vA[1][1]);
            PG8_WAIT_V(8); PG8_WAIT_L(0); PG8_BAR; PG8_MMA(0, 0, At, B0); PG8_MMA(0, 1, At, B1); PG8_BAR; PG8_SCHED;
            PG8_LDA(At, 1, 1); PG8_STAGEB(PG8_SB(1, 0), b3); PG8_STAGEB(PG8_SB(1, 1), b3 + hstepB); PG8_STAGE2(PG8_SA(1, 0), a3, vA[0][0], vA[0][1]);
            PG8_WAIT_V(8); PG8_WAIT_L(0); PG8_BAR; PG8_MMA(1, 0, At, B0); PG8_MMA(1, 1, At, B1); PG8_BAR; PG8_SCHED;
        }
        if (wr == 0) PG8_BAR;
        int fr_ = fr, fq_ = fq; asm volatile("" : "+v"(fr_), "+v"(fq_));
        const bool keep = S.epi(acc, cur, wr, wc, fr_, fq_);
        if (!has_next) break;
        if (!keep) {
#pragma unroll
            for (int a = 0; a < 2; ++a)
#pragma unroll
                for (int b = 0; b < 2; ++b)
#pragma unroll
                    for (int m = 0; m < 4; ++m)
#pragma unroll
                        for (int n = 0; n < 2; ++n) acc[a][b][m][n] = (f32x4){0.f, 0.f, 0.f, 0.f};
        }
        cur = nxt; cA = nA; cB = nB; ++ui;
        if (wr == 1) PG8_BAR;
    }
    PG8_WAIT_V(0);
    PG8_BAR;
#undef PG8_SA
#undef PG8_SB
#undef PG8_STAGE2
#undef PG8_STAGEB
#undef PG8_LDA
#undef PG8_LDB
#undef PG8_MMA
#undef PG8_WAIT_V
#undef PG8_WAIT_L
#undef PG8_BAR
#undef PG8_SCHED
}
}
using pg8::Unit;

__device__ __forceinline__ void st8(bf16* p, const f32x4& a, const f32x4& b) {
    u32x4 w; w.x = cvt_pk_bf16(a[0], a[1]); w.y = cvt_pk_bf16(a[2], a[3]); w.z = cvt_pk_bf16(b[0], b[1]); w.w = cvt_pk_bf16(b[2], b[3]);
    *(u32x4*)p = w;
}
__device__ __forceinline__ void ld8(const bf16* p, f32x4& a, f32x4& b) {
    const u32x4 w = *(const u32x4*)p;
    a = (f32x4){bflo(w.x), bfhi(w.x), bflo(w.y), bfhi(w.y)}; b = (f32x4){bflo(w.z), bfhi(w.z), bflo(w.w), bfhi(w.w)};
}

__device__ __forceinline__ void st8q(unsigned char* p, const f32x4& a, const f32x4& b) {
    int w0 = 0, w1 = 0;
    w0 = __builtin_amdgcn_cvt_pk_fp8_f32(a[0], a[1], w0, false); w0 = __builtin_amdgcn_cvt_pk_fp8_f32(a[2], a[3], w0, true);
    w1 = __builtin_amdgcn_cvt_pk_fp8_f32(b[0], b[1], w1, false); w1 = __builtin_amdgcn_cvt_pk_fp8_f32(b[2], b[3], w1, true);
    *(u32x2*)p = (u32x2){(unsigned)w0, (unsigned)w1};
}
constexpr float WQ_SCALE = 32.0f, WQ_INV = 1.0f / 32.0f;

struct PolIn {
    static constexpr int NT = 8, LDA = 512, LDB = 512; static constexpr bool GATHER = false, FP8 = false, I8 = true, ROWDMA = true, IDDMA = false;
    pg8::StaticOrder so; const unsigned char* A; const unsigned char* Bt; unsigned char* ws; const float* qg; const float* kg; const float* hs; const float* cs; LAS unsigned char* shm;
    __device__ bool next(int i, Unit& u) const { u.e = 0; u.s0 = 0; u.cnt = 0; u.idx = i; return so.tile(i, u.pm, u.pn); }
    __device__ __forceinline__ void row_dma(const Unit& u, LAS unsigned char* lds, int wid, int lane) const {
        const unsigned* src = (wid < 4) ? (const unsigned*)(hs + u.pm * 256 + 64 * wid + lane) : (const unsigned*)(cs + u.pn * 256 + 64 * (wid & 3) + lane);
        __builtin_amdgcn_global_load_lds(src, (LAS unsigned*)(lds + ROWS_OFF + (u.idx & 1) * ROWS_BUF + 256 * wid), 4, 0, 0);
    }
    __device__ const char* a_ptr(const Unit& u) const { return (const char*)(A + (size_t)u.pm * 256 * 1024); }
    __device__ const char* b_ptr(const Unit& u) const { return (const char*)(Bt + (size_t)u.pn * 256 * 1024); }
    __device__ void a_off(const Unit&, int, unsigned (&)[2][2]) const {}
    __device__ __forceinline__ bool epi(f32x4 (&acc)[2][2][4][2], const Unit& u, int wr, int wc, int fr, int fq) const {
        const int pn = u.pn;
        {
            const LAS float* hsr = (const LAS float*)(shm + ROWS_OFF + (u.idx & 1) * ROWS_BUF) + wr * 64 + fr;
            const LAS float* csp = (const LAS float*)(shm + ROWS_OFF + (u.idx & 1) * ROWS_BUF + 1024) + 64 * wc + 8 * fq;
            float hv[2][4]; f32x4 cv[2][2];
#pragma unroll
            for (int a = 0; a < 2; ++a)
#pragma unroll
                for (int m = 0; m < 4; ++m) hv[a][m] = hsr[a * 128 + m * 16];
#pragma unroll
            for (int b = 0; b < 2; ++b)
#pragma unroll
                for (int n = 0; n < 2; ++n) cv[b][n] = *(const LAS f32x4*)(csp + 32 * b + 4 * n);
#pragma unroll
            for (int a = 0; a < 2; ++a)
#pragma unroll
                for (int b = 0; b < 2; ++b)
#pragma unroll
                    for (int m = 0; m < 4; ++m)
#pragma unroll
                        for (int n = 0; n < 2; ++n) { const pg8::v4i_t ia = __builtin_bit_cast(pg8::v4i_t, acc[a][b][m][n]);
                            acc[a][b][m][n] = (f32x4){(float)ia.x, (float)ia.y, (float)ia.z, (float)ia.w} * hv[a][m] * cv[b][n]; }
        }
        int kind, ld, tcol; size_t off;
        if (pn < 2) { kind = 0; off = WS_Q; ld = AW; tcol = pn; }
        else if (pn < 4) { kind = 1; off = WS_K; ld = AW; tcol = pn - 2; }
        else if (pn < 6) { kind = 2; off = WS_V; ld = AW; tcol = pn - 4; }
        else if (pn < 8) { kind = 3; off = WS_UG; ld = SGW; tcol = pn - 6; }
        else if (pn < 10) { kind = 3; off = WS_VG; ld = SGW; tcol = pn - 8; }
        else if (pn < 14) { kind = 4; off = WS_GA; ld = D; tcol = pn - 10; }
        else { kind = 4; off = WS_GB; ld = D; tcol = pn - 14; }
        bf16* base = (bf16*)(ws + off) + tcol * 256 + 64 * wc + 8 * fq;
        const int row0 = u.pm * 256 + wr * 64 + fr;
        if (kind <= 1) {
            const float* g = (kind == 0 ? qg : kg) + 8 * fq;
            const float sc = (kind == 0) ? (0.125f * LOG2E) : 1.0f;
            f32x4 gv[2][2];
#pragma unroll
            for (int bj = 0; bj < 2; ++bj)
#pragma unroll
                for (int n = 0; n < 2; ++n) gv[bj][n] = *(const f32x4*)(g + 32 * bj + 4 * n) * sc;
#pragma unroll
            for (int ai = 0; ai < 2; ++ai)
#pragma unroll
                for (int m = 0; m < 4; ++m) {
                    float ss = 0.f;
#pragma unroll
                    for (int bj = 0; bj < 2; ++bj)
#pragma unroll
                        for (int n = 0; n < 2; ++n) { const f32x4 v = acc[ai][bj][m][n]; ss += (v[0] * v[0] + v[1] * v[1]) + (v[2] * v[2] + v[3] * v[3]); }
                    ss += __shfl_xor(ss, 16); ss += __shfl_xor(ss, 32);
                    const float rs = 1.0f / sqrtf(ss * (1.0f / 64.0f) + EPS);
                    bf16* rowp = base + (size_t)(row0 + ai * 128 + m * 16) * ld;
#pragma unroll
                    for (int bj = 0; bj < 2; ++bj) st8(rowp + 32 * bj, acc[ai][bj][m][0] * rs * gv[bj][0], acc[ai][bj][m][1] * rs * gv[bj][1]);
                }
        } else if (kind == 2) {
#pragma unroll
            for (int ai = 0; ai < 2; ++ai)
#pragma unroll
                for (int m = 0; m < 4; ++m) { bf16* rowp = base + (size_t)(row0 + ai * 128 + m * 16) * ld;
#pragma unroll
                    for (int bj = 0; bj < 2; ++bj) st8(rowp + 32 * bj, acc[ai][bj][m][0], acc[ai][bj][m][1]); }
        } else if (kind == 4) {
            unsigned char* b8 = ws + off + tcol * 256 + 64 * wc + 8 * fq;
#pragma unroll
            for (int ai = 0; ai < 2; ++ai)
#pragma unroll
                for (int m = 0; m < 4; ++m) { unsigned char* rowp = b8 + (size_t)(row0 + ai * 128 + m * 16) * ld;
#pragma unroll
                    for (int bj = 0; bj < 2; ++bj) st8q(rowp + 32 * bj, acc[ai][bj][m][0], acc[ai][bj][m][1]); }
        } else {
#pragma unroll
            for (int ai = 0; ai < 2; ++ai)
#pragma unroll
                for (int m = 0; m < 4; ++m) { bf16* rowp = base + (size_t)(row0 + ai * 128 + m * 16) * ld;
#pragma unroll
                    for (int bj = 0; bj < 2; ++bj) { f32x4 a = acc[ai][bj][m][0], b = acc[ai][bj][m][1];
#pragma unroll
                        for (int j = 0; j < 4; ++j) { a[j] = gelu_tanh(a[j]); b[j] = gelu_tanh(b[j]); }
                        st8(rowp + 32 * bj, a, b); } }
        }
        return false;
    }
};

struct PolMerge {
    static constexpr int NT = 8, LDA = D, LDB = D; static constexpr bool GATHER = false, FP8 = false, I8 = false, ROWDMA = false, IDDMA = false;
    pg8::StaticOrder so; const bf16* A; const bf16* Bt; const unsigned char* ga; const unsigned char* gb; bf16* out;
    __device__ bool next(int i, Unit& u) const { u.e = i & 1; u.s0 = 0; u.cnt = 0; return so.tile(i >> 1, u.pm, u.pn); }
    __device__ const char* a_ptr(const Unit& u) const { return (const char*)(A + (size_t)u.pm * 256 * LDA + 512 * u.e); }
    __device__ const char* b_ptr(const Unit& u) const { return (const char*)(Bt + (size_t)u.pn * 256 * LDB + 512 * u.e); }
    __device__ void a_off(const Unit&, int, unsigned (&)[2][2]) const {}
    __device__ __forceinline__ bool epi(f32x4 (&acc)[2][2][4][2], const Unit& u, int wr, int wc, int fr, int fq) const {
        const int row0 = u.pm * 256 + wr * 64 + fr, col0 = u.pn * 256 + 64 * wc + 8 * fq;
#pragma unroll
        for (int ai = 0; ai < 2; ++ai) {
            u32x2 gbv[4][2]; u32x2 gav[4][2];
#pragma unroll
            for (int m = 0; m < 4; ++m) { const size_t o = (size_t)(row0 + ai * 128 + m * 16) * D + col0;
#pragma unroll
                for (int bj = 0; bj < 2; ++bj) { gbv[m][bj] = *(const u32x2*)(gb + o + 32 * bj); if (u.e == 0) gav[m][bj] = *(const u32x2*)(ga + o + 32 * bj); } }
#pragma unroll
            for (int m = 0; m < 4; ++m) { const size_t o = (size_t)(row0 + ai * 128 + m * 16) * D + col0;
#pragma unroll
                for (int bj = 0; bj < 2; ++bj) {
                    const u32x2 wb = gbv[m][bj];
                    const f32x2 p0 = __builtin_amdgcn_cvt_pk_f32_fp8((int)wb.x, false), p1 = __builtin_amdgcn_cvt_pk_f32_fp8((int)wb.x, true), p2 = __builtin_amdgcn_cvt_pk_f32_fp8((int)wb.y, false), p3 = __builtin_amdgcn_cvt_pk_f32_fp8((int)wb.y, true);
                    const f32x4 b0 = (f32x4){p0[0], p0[1], p1[0], p1[1]}, b1 = (f32x4){p2[0], p2[1], p3[0], p3[1]};
                    if (u.e == 0) {
                        const u32x2 wa = gav[m][bj];
                        const f32x2 q0 = __builtin_amdgcn_cvt_pk_f32_fp8((int)wa.x, false), q1 = __builtin_amdgcn_cvt_pk_f32_fp8((int)wa.x, true), q2 = __builtin_amdgcn_cvt_pk_f32_fp8((int)wa.y, false), q3 = __builtin_amdgcn_cvt_pk_f32_fp8((int)wa.y, true);
                        const f32x4 a0 = (f32x4){q0[0], q0[1], q1[0], q1[1]}, a1 = (f32x4){q2[0], q2[1], q3[0], q3[1]};
#pragma unroll
                        for (int j = 0; j < 4; ++j) {
                            acc[ai][bj][m][0][j] *= (1.0f + fast_exp2(-LOG2E * b0[j])) * fast_rcp(1.0f + fast_exp2(-LOG2E * a0[j]));
                            acc[ai][bj][m][1][j] *= (1.0f + fast_exp2(-LOG2E * b1[j])) * fast_rcp(1.0f + fast_exp2(-LOG2E * a1[j])); }
                    } else {
                        f32x4 r0, r1;
#pragma unroll
                        for (int j = 0; j < 4; ++j) { r0[j] = acc[ai][bj][m][0][j] * sigmoidf_(b0[j]); r1[j] = acc[ai][bj][m][1][j] * sigmoidf_(b1[j]); }
                        st8(out + o + 32 * bj, r0, r1);
                    }
                } }
        }
        return u.e == 0;
    }
};

struct PolOut {
    static constexpr int NT = 16, LDA = D, LDB = D; static constexpr bool GATHER = false, FP8 = false, I8 = false, ROWDMA = false, IDDMA = false;
    pg8::StaticOrder so; const bf16* A; const bf16* Bt; const float* x; bf16* x1; unsigned char* x1q;
    __device__ bool next(int i, Unit& u) const { u.e = 0; u.s0 = 0; u.cnt = 0; return so.tile(i, u.pm, u.pn); }
    __device__ const char* a_ptr(const Unit& u) const { return (const char*)(A + (size_t)u.pm * 256 * LDA); }
    __device__ const char* b_ptr(const Unit& u) const { return (const char*)(Bt + (size_t)u.pn * 256 * LDB); }
    __device__ void a_off(const Unit&, int, unsigned (&)[2][2]) const {}
    __device__ __forceinline__ bool epi(f32x4 (&acc)[2][2][4][2], const Unit& u, int wr, int wc, int fr, int fq) const {
        const int row0 = u.pm * 256 + wr * 64 + fr, col0 = u.pn * 256 + 64 * wc + 8 * fq;
#pragma unroll
        for (int ai = 0; ai < 2; ++ai) {
            f32x4 xv[4][2][2];
#pragma unroll
            for (int m = 0; m < 4; ++m) { const size_t o = (size_t)(row0 + ai * 128 + m * 16) * D + col0;
#pragma unroll
                for (int bj = 0; bj < 2; ++bj) { xv[m][bj][0] = *(const f32x4*)(x + o + 32 * bj); xv[m][bj][1] = *(const f32x4*)(x + o + 32 * bj + 4); } }
#pragma unroll
            for (int m = 0; m < 4; ++m) { const size_t o = (size_t)(row0 + ai * 128 + m * 16) * D + col0;
#pragma unroll
                for (int bj = 0; bj < 2; ++bj) {
                    const f32x4 r0 = xv[m][bj][0] + acc[ai][bj][m][0], r1 = xv[m][bj][1] + acc[ai][bj][m][1];
                    st8(x1 + o + 32 * bj, r0, r1); st8q(x1q + o + 32 * bj, r0, r1);
                } }
        }
        return false;
    }
};

struct MoeOrder {
    const LAS int* tb;
    int NN, nwg, G, c;
    __device__ void init(const LAS int* tb_, int NN_, int G_, int c_) { tb = tb_; NN = NN_; G = G_; c = c_; nwg = tb_[32] * NN_; }
    __device__ bool unit(int i, Unit& u) const {
        const long L = (long)i * G + c; if (L >= nwg) return false;
        int wgid = (int)L; { const int q = nwg / 8, r = nwg % 8, xcd = wgid % 8, off = wgid / 8; wgid = (xcd < r ? xcd * (q + 1) : r * (q + 1) + (xcd - r) * q) + off; }
        const int Mt = wgid / NN;
        const int ln = threadIdx.x & 63;
        const unsigned long long bal = __ballot(ln < NE && tb[ln & 31] <= Mt);
        const int e = __popcll(bal) - 1;
        u.idx = i; u.pm = __builtin_amdgcn_readfirstlane(Mt); u.pn = __builtin_amdgcn_readfirstlane(wgid % NN); u.e = __builtin_amdgcn_readfirstlane(e);
        u.s0 = __builtin_amdgcn_readfirstlane((Mt - tb[e]) * 256); u.cnt = __builtin_amdgcn_readfirstlane(tb[33 + e]);
        return true;
    }
};

struct PolGU {
    static constexpr int NT = 8, LDA = 512, LDB = 512; static constexpr bool GATHER = true, FP8 = true, I8 = false, ROWDMA = true, IDDMA = true;
    MoeOrder mo; const unsigned char* A; const unsigned char* Bt; const int* lid; const float* lrs; const float* bgu; unsigned char* act; LAS unsigned char* shm;
    __device__ __forceinline__ void row_dma(const Unit& u, LAS unsigned char* lds, int wid, int lane) const {
        const unsigned* src = (wid < 4) ? (const unsigned*)(lrs + (size_t)u.e * LCAP + u.s0 + 64 * wid + lane)
                                        : (const unsigned*)(bgu + (size_t)u.e * 2048 + u.pn * 128 + 1024 * ((wid >> 1) & 1) + 64 * (wid & 1) + lane);
        __builtin_amdgcn_global_load_lds(src, (LAS unsigned*)(lds + ROWS_OFF + (u.idx & 1) * ROWS_BUF + 256 * wid), 4, 0, 0);
    }
    __device__ bool next(int i, Unit& u) const { return mo.unit(i, u); }
    __device__ __forceinline__ void ids_dma(const Unit& nx, const Unit& cu, LAS unsigned char* lds, int wid, int lane) const {
        if (wid < 4) __builtin_amdgcn_global_load_lds((const unsigned*)(lid + (size_t)nx.e * LCAP + nx.s0 + 64 * wid + lane), (LAS unsigned*)(lds + ROWS_OFF + (cu.idx & 1) * ROWS_BUF + 2048 + 256 * wid), 4, 0, 0);
    }
    __device__ __forceinline__ void a_off_lds(const Unit& nx, const Unit& cu, int tid, LAS unsigned char* lds, unsigned (&v)[2][2]) const {
        const LAS int* l = (const LAS int*)(lds + ROWS_OFF + (cu.idx & 1) * ROWS_BUF + 2048);
#pragma unroll
        for (int i = 0; i < 2; ++i) { int R, C; pg8::stage_rc(tid * 16 + i * 8192, R, C);
#pragma unroll
            for (int h = 0; h < 2; ++h) { const int s = h * 128 + R; const int id = l[s]; const int tok = (nx.s0 + s < nx.cnt) ? (id >> 2) : 0; v[h][i] = (unsigned)(tok * LDA + C) * 2u; } }
    }
    __device__ const char* a_ptr(const Unit&) const { return (const char*)A; }
    __device__ const char* b_ptr(const Unit& u) const { return (const char*)(Bt + ((size_t)u.e * 2048 + (size_t)u.pn * 256) * 1024); }
    __device__ __forceinline__ void a_off(const Unit& u, int tid, unsigned (&v)[2][2]) const {
        const int* l = lid + (size_t)u.e * LCAP;
#pragma unroll
        for (int i = 0; i < 2; ++i) { int R, C; pg8::stage_rc(tid * 16 + i * 8192, R, C);
#pragma unroll
            for (int h = 0; h < 2; ++h) { const int s = u.s0 + h * 128 + R; const int id = l[s]; const int tok = (s < u.cnt) ? (id >> 2) : 0; v[h][i] = (unsigned)(tok * LDA + C) * 2u; } }
    }
    __device__ __forceinline__ bool epi(f32x4 (&acc)[2][2][4][2], const Unit& u, int wr, int wc, int fr, int fq) const {
        const LAS float* rsl = (const LAS float*)(shm + ROWS_OFF + (u.idx & 1) * ROWS_BUF);
        const LAS float* bg = (const LAS float*)(shm + ROWS_OFF + (u.idx & 1) * ROWS_BUF + 1024) + 32 * wc + 8 * fq;
        const f32x4 bg0 = *(const LAS f32x4*)bg, bg1 = *(const LAS f32x4*)(bg + 4), bu0 = *(const LAS f32x4*)(bg + 128), bu1 = *(const LAS f32x4*)(bg + 132);
        unsigned char* ob = act + (size_t)u.pm * 256 * FF + u.pn * 128 + 32 * wc + 8 * fq;
        float rsv[2][4];
#pragma unroll
        for (int ai = 0; ai < 2; ++ai)
#pragma unroll
            for (int m = 0; m < 4; ++m) { const int r = ai * 128 + wr * 64 + m * 16 + fr; const bool valid = (u.s0 + r < u.cnt); const float t_ = rsl[r]; rsv[ai][m] = valid ? t_ * WQ_INV : 0.f; }
#pragma unroll
        for (int ai = 0; ai < 2; ++ai)
#pragma unroll
            for (int m = 0; m < 4; ++m) { const int r = ai * 128 + wr * 64 + m * 16 + fr; const float rs = rsv[ai][m];
                f32x4 o[2];
#pragma unroll
                for (int n = 0; n < 2; ++n)
#pragma unroll
                    for (int h2 = 0; h2 < 2; ++h2) {
                        const f32x2 ag = {acc[ai][0][m][n][2 * h2], acc[ai][0][m][n][2 * h2 + 1]}, au = {acc[ai][1][m][n][2 * h2], acc[ai][1][m][n][2 * h2 + 1]};
                        const f32x2 bgv = n ? (f32x2){bg1[2 * h2], bg1[2 * h2 + 1]} : (f32x2){bg0[2 * h2], bg0[2 * h2 + 1]}, buv = n ? (f32x2){bu1[2 * h2], bu1[2 * h2 + 1]} : (f32x2){bu0[2 * h2], bu0[2 * h2 + 1]};
                        f32x2 g = ag * rs + bgv, up = au * rs + buv;
                        g = __builtin_elementwise_min(g, (f32x2){7.0f, 7.0f});
                        up.x = __builtin_amdgcn_fmed3f(up.x, -7.0f, 7.0f); up.y = __builtin_amdgcn_fmed3f(up.y, -7.0f, 7.0f);
                        const f32x2 t = g * (-1.702f * LOG2E);
                        f32x2 e; e.x = fast_exp2(t.x); e.y = fast_exp2(t.y);
                        const f32x2 den = e + 1.0f;
                        f32x2 rc; rc.x = fast_rcp(den.x); rc.y = fast_rcp(den.y);
                        const f32x2 res = (up + 1.0f) * (g * rc);
                        o[n][2 * h2] = res.x; o[n][2 * h2 + 1] = res.y; }
                st8q(ob + (size_t)r * FF, o[0], o[1]); }
        return false;
    }
};

struct PolDown {
    static constexpr int NT = 8, LDA = 512, LDB = 512; static constexpr bool GATHER = true, FP8 = true, I8 = false, ROWDMA = true, IDDMA = false;
    MoeOrder mo; const unsigned char* A; const unsigned char* Bt; const int* lid; const float* lp; const float* bd; unsigned char* y; LAS unsigned char* shm;
    __device__ __forceinline__ void row_dma(const Unit& u, LAS unsigned char* lds, int wid, int lane) const {
        const size_t o = (size_t)u.e * LCAP + u.s0 + 64 * (wid & 3) + lane;
        const unsigned* src = (wid < 4) ? (const unsigned*)(lid + o) : (const unsigned*)(lp + o);
        __builtin_amdgcn_global_load_lds(src, (LAS unsigned*)(lds + ROWS_OFF + (u.idx & 1) * ROWS_BUF + 256 * wid), 4, 0, 0);
        if (wid < 4) __builtin_amdgcn_global_load_lds((const unsigned*)(bd + (size_t)u.e * D + u.pn * 256 + 64 * wid + lane), (LAS unsigned*)(lds + ROWS_OFF + (u.idx & 1) * ROWS_BUF + 2048 + 256 * wid), 4, 0, 0);
    }
    __device__ bool next(int i, Unit& u) const { return mo.unit(i, u); }
    __device__ const char* a_ptr(const Unit& u) const { return (const char*)(A + (size_t)u.pm * 256 * 1024); }
    __device__ const char* b_ptr(const Unit& u) const { return (const char*)(Bt + ((size_t)u.e * 1024 + (size_t)u.pn * 256) * 1024); }
    __device__ __forceinline__ void a_off(const Unit&, int tid, unsigned (&v)[2][2]) const {
#pragma unroll
        for (int i = 0; i < 2; ++i) { int R, C; pg8::stage_rc(tid * 16 + i * 8192, R, C); v[0][i] = (unsigned)(R * LDA + C) * 2u; v[1][i] = (unsigned)((R + 128) * LDA + C) * 2u; }
    }
    __device__ __forceinline__ bool epi(f32x4 (&acc)[2][2][4][2], const Unit& u, int wr, int wc, int fr, int fq) const {
        const LAS int* idl = (const LAS int*)(shm + ROWS_OFF + (u.idx & 1) * ROWS_BUF); const LAS float* pl = (const LAS float*)(shm + ROWS_OFF + (u.idx & 1) * ROWS_BUF + 1024);
        const int col0 = u.pn * 256 + 64 * wc + 8 * fq;
        const LAS float* b = (const LAS float*)(shm + ROWS_OFF + (u.idx & 1) * ROWS_BUF + 2048) + 64 * wc + 8 * fq;
        int idv[2][4]; float pv_[2][4];
#pragma unroll
        for (int ai = 0; ai < 2; ++ai)
#pragma unroll
            for (int m = 0; m < 4; ++m) { const int r = ai * 128 + wr * 64 + m * 16 + fr; const bool valid = (u.s0 + r < u.cnt);
                const int t_ = idl[r]; const float q_ = pl[r]; idv[ai][m] = valid ? t_ : T * 4; pv_[ai][m] = q_; }
        f32x4 bv[2][2];
#pragma unroll
        for (int bj = 0; bj < 2; ++bj)
#pragma unroll
            for (int n = 0; n < 2; ++n) bv[bj][n] = *(const LAS f32x4*)(b + 32 * bj + 4 * n);
#pragma unroll
        for (int ai = 0; ai < 2; ++ai)
#pragma unroll
            for (int m = 0; m < 4; ++m) { const float p = pv_[ai][m] * 16.0f; unsigned char* op = y + (size_t)idv[ai][m] * D + col0;
#pragma unroll
                for (int bj = 0; bj < 2; ++bj) st8q(op + 32 * bj, (acc[ai][bj][m][0] * WQ_INV + bv[bj][0]) * p, (acc[ai][bj][m][1] * WQ_INV + bv[bj][1]) * p); }
        return false;
    }
};

constexpr int CONV_GU_ITEMS = NE * 16 * 32, CONV_D_ITEMS = NE * 16 * 16, CONV_ITEMS = CONV_GU_ITEMS + CONV_D_ITEMS, CONV_PER_WAVE = CONV_ITEMS / 2048;
static_assert(CONV_PER_WAVE * 2048 == CONV_ITEMS, "items divide over 2048 waves");
struct MoeConv {
    const float* wgu; const float* wd; const float* g2; unsigned char* WGU8; unsigned char* WD8;
    struct Regs { f32x4 v0, v1, v2, v3, v4, v5, v6, v7, v8, v9, v10, v11, v12, v13, v14, v15; };
    __device__ __forceinline__ void src_of(int item, const float*& W, int& N, int& k0, int& n0) const {
        if (item < CONV_GU_ITEMS) { const int e = item >> 9, q = item & 511; W = wgu + (size_t)e * D * 2048; N = 2048; k0 = 64 * (q >> 5); n0 = 64 * (q & 31); }
        else { const int r = item - CONV_GU_ITEMS, e = r >> 8, q = r & 255; W = wd + (size_t)e * FF * D; N = D; k0 = 64 * (q >> 4); n0 = 64 * (q & 15); }
    }
    __device__ __forceinline__ void finish(Regs& R, int item, int lane) const {
        const float* W; int N, k0, n0; src_of(item, W, N, k0, n0);
        const int kc = lane >> 4, nq = lane & 15; const bool gu = item < CONV_GU_ITEMS;
        float sc[16];
        if (gu) { const f32x4* gp = (const f32x4*)(g2 + k0 + 16 * kc);
#pragma unroll
            for (int q = 0; q < 4; ++q) { const f32x4 t = gp[q]; sc[4 * q] = t[0] * 32.0f; sc[4 * q + 1] = t[1] * 32.0f; sc[4 * q + 2] = t[2] * 32.0f; sc[4 * q + 3] = t[3] * 32.0f; } }
        else {
#pragma unroll
            for (int i = 0; i < 16; ++i) sc[i] = 32.0f; }
        const int nb = n0 + 32 * (nq >> 3);
        const int e = gu ? (item >> 9) : ((item - CONV_GU_ITEMS) >> 8);
        const int up = nb >= 1024, cc = nb & 1023;
        const int pos = gu ? ((cc >> 7) * 256 + up * 128 + ((cc >> 5) & 3) * 32) : ((nb & ~255) + ((nb >> 5) & 1) * 128 + ((nb >> 6) & 3) * 32);
        unsigned char* base = (gu ? (WGU8 + ((size_t)e * 2048 + pos + ((4 * nq) & 31)) * 1024) : (WD8 + ((size_t)e * 1024 + pos + ((4 * nq) & 31)) * 1024)) + k0 + 16 * kc;
#pragma unroll
        for (int c = 0; c < 4; ++c) {
            int w0 = 0, w1 = 0, w2 = 0, w3 = 0;
            w0 = __builtin_amdgcn_cvt_pk_fp8_f32(R.v0[c] * sc[0], R.v1[c] * sc[1], w0, false); w0 = __builtin_amdgcn_cvt_pk_fp8_f32(R.v2[c] * sc[2], R.v3[c] * sc[3], w0, true);
            w1 = __builtin_amdgcn_cvt_pk_fp8_f32(R.v4[c] * sc[4], R.v5[c] * sc[5], w1, false); w1 = __builtin_amdgcn_cvt_pk_fp8_f32(R.v6[c] * sc[6], R.v7[c] * sc[7], w1, true);
            w2 = __builtin_amdgcn_cvt_pk_fp8_f32(R.v8[c] * sc[8], R.v9[c] * sc[9], w2, false); w2 = __builtin_amdgcn_cvt_pk_fp8_f32(R.v10[c] * sc[10], R.v11[c] * sc[11], w2, true);
            w3 = __builtin_amdgcn_cvt_pk_fp8_f32(R.v12[c] * sc[12], R.v13[c] * sc[13], w3, false); w3 = __builtin_amdgcn_cvt_pk_fp8_f32(R.v14[c] * sc[14], R.v15[c] * sc[15], w3, true);
            *(u32x4*)(base + (size_t)c * 1024) = (u32x4){(unsigned)w0, (unsigned)w1, (unsigned)w2, (unsigned)w3};
        }
    }
    template <int SUB> __device__ __forceinline__ void sub(Regs& R, int& st, int item0, int istride, int lane) const {
        if (SUB == 0 && (st & 1)) { finish(R, item0 + ((st >> 1) - 1) * istride, lane); st &= ~1; }
        const int it = st >> 1;
        if (it < CONV_PER_WAVE) {
            const float* W; int N, k0, n0; src_of(item0 + it * istride, W, N, k0, n0);
            const float* p = W + (size_t)(k0 + 16 * (lane >> 4) + 4 * SUB) * N + n0 + 4 * (lane & 15);
            const f32x4 t0 = *(const f32x4*)p, t1 = *(const f32x4*)(p + N), t2 = *(const f32x4*)(p + 2 * (size_t)N), t3 = *(const f32x4*)(p + 3 * (size_t)N);
            if (SUB == 0) { R.v0 = t0; R.v1 = t1; R.v2 = t2; R.v3 = t3; }
            else if (SUB == 1) { R.v4 = t0; R.v5 = t1; R.v6 = t2; R.v7 = t3; }
            else if (SUB == 2) { R.v8 = t0; R.v9 = t1; R.v10 = t2; R.v11 = t3; }
            else { R.v12 = t0; R.v13 = t1; R.v14 = t2; R.v15 = t3; st = ((it + 1) << 1) | 1; }
        }
    }
    __device__ __forceinline__ void drain(Regs& R, int& st, int item0, int istride, int lane) const {
        if (st & 1) { finish(R, item0 + ((st >> 1) - 1) * istride, lane); st &= ~1; }
        for (int it = st >> 1; it < CONV_PER_WAVE; ++it) { sub<0>(R, st, item0, istride, lane); sub<1>(R, st, item0, istride, lane); sub<2>(R, st, item0, istride, lane); sub<3>(R, st, item0, istride, lane);
            finish(R, item0 + it * istride, lane); st &= ~1; }
    }
};

namespace att {
constexpr int PITCH = 512, SLOTB = 8192;
constexpr int L_K = 0, L_V = 2 * SLOTB, L_TBL = 4 * SLOTB, L_WS = L_TBL + 4096, L_OST = L_WS + 8 * 256, L_END = L_OST + 8 * 4096;
constexpr int NTBL = 832;
__device__ __forceinline__ int crow(int r, int hi) { return (r & 3) + 8 * (r >> 2) + 4 * hi; }
__device__ __forceinline__ void glds16(const void* gsrc, unsigned lds_dst) { unsigned keep;
    asm volatile("s_mov_b32 %0, m0\n\ts_mov_b32 m0, %2\n\ts_nop 0\n\tglobal_load_lds_dwordx4 %1, off\n\ts_mov_b32 m0, %0" : "=&s"(keep) : "v"(gsrc), "s"(lds_dst) : "memory"); }
__device__ __forceinline__ unsigned cvtpk_s(float lo, float hi) { typedef __bf16 bf16x2_t __attribute__((ext_vector_type(2))); f32x2 v = {lo, hi}; bf16x2_t b = __builtin_convertvector(v, bf16x2_t); return __builtin_bit_cast(unsigned, b); }
#define ATT_SBAR() __builtin_amdgcn_sched_barrier(0)
__device__ __forceinline__ void pv(f32x16* o, int vb, bf16x8 pa0, bf16x8 pa1, bf16x8 pa2, bf16x8 pa3) {
#pragma unroll
    for (int d0 = 0; d0 < 2; ++d0) { s16x4 lo[4], hi[4];
#pragma unroll
        for (int ks = 0; ks < 4; ++ks) {
            asm volatile("ds_read_b64_tr_b16 %0,%1 offset:%c2" : "=&v"(lo[ks]) : "v"(vb), "i"(d0 * 4096 + ks * 1024) : "memory");
            asm volatile("ds_read_b64_tr_b16 %0,%1 offset:%c2" : "=&v"(hi[ks]) : "v"(vb), "i"(d0 * 4096 + ks * 1024 + 512) : "memory"); }
        asm volatile("s_waitcnt lgkmcnt(0)" ::: "memory"); ATT_SBAR();
#define ATT_PK(k) (bf16x8){lo[k][0], lo[k][1], lo[k][2], lo[k][3], hi[k][0], hi[k][1], hi[k][2], hi[k][3]}
        o[d0] = __builtin_amdgcn_mfma_f32_32x32x16_bf16(pa0, ATT_PK(0), o[d0], 0, 0, 0);
        o[d0] = __builtin_amdgcn_mfma_f32_32x32x16_bf16(pa1, ATT_PK(1), o[d0], 0, 0, 0);
        o[d0] = __builtin_amdgcn_mfma_f32_32x32x16_bf16(pa2, ATT_PK(2), o[d0], 0, 0, 0);
        o[d0] = __builtin_amdgcn_mfma_f32_32x32x16_bf16(pa3, ATT_PK(3), o[d0], 0, 0, 0);
#undef ATT_PK
    }
}
__device__ __forceinline__ void unit(int b, int h, int cg, const bf16* Q, const bf16* K, const bf16* V, const float* relb, bf16* O  , LAS unsigned char* shm,
                                     const MoeConv& cv, MoeConv::Regs& sreg, int& sctr, int item0, int istride) {
    const int tid = threadIdx.x, lane = tid & 63, r32 = lane & 31, hi = lane >> 5; const int wid = __builtin_amdgcn_readfirstlane(tid >> 6);
    const long rowbase = (long)b * SEQ; const int cq = 4 * cg + (wid >> 1), wq = wid & 1;
    const bf16* Qw = Q + (rowbase + 64 * cq + 32 * wq) * PITCH + h * HD;
    const unsigned lds0 = (unsigned)(uintptr_t)shm;
    LAS float* tbl = (LAS float*)(shm + L_TBL);
    LAS float* wsf = (LAS float*)(shm + L_WS) + wid * 64;
    for (int i = tid; i < NTBL; i += 512) tbl[i] = relb[h * NREL + (i < 512 ? i : 512)] * LOG2E;
    const int srow = tid >> 3, sc = tid & 7;
    const bf16* ksrc = K + (rowbase + srow) * PITCH + h * HD + sc * 8;
    const bf16* vsrc = V + (rowbase + srow) * PITCH + h * HD + sc * 8;
    const int kwr = L_K + sc * 1024 + ((srow ^ sc) << 4);
    const int vwr = L_V + (4 * (sc >> 2) + (srow >> 4)) * 1024 + (srow & 15) * 64 + (sc & 3) * 16;
    const int vb0 = (int)(lds0 + L_V) + ((lane >> 4) & 1) * 32 + (lane & 3) * 8 + (4 * hi + ((lane & 15) >> 2)) * 64;
    int kra[4];
#pragma unroll
    for (int d0 = 0; d0 < 4; ++d0) kra[d0] = L_K + (2 * d0 + hi) * 1024 + ((r32 ^ (2 * d0 + hi)) << 4);
    bf16x8 qr[4];
#pragma unroll
    for (int d0 = 0; d0 < 4; ++d0) qr[d0] = *reinterpret_cast<const bf16x8*>(&Qw[(long)r32 * PITCH + d0 * 16 + hi * 8]);
    f32x16 o[2]; o[0] = f32x16{}; o[1] = f32x16{}; float l_reg = 0.f;
    const int j0 = (8 - 4 * cg) > 0 ? (8 - 4 * cg) : 0;
    u32x4 kreg, vreg;
    { const long ro = (long)(4 * cg - 8 + j0) * 64 * PITCH; kreg = *(const u32x4*)(ksrc + ro); vreg = *(const u32x4*)(vsrc + ro); }
#define ATT_STEP(JX, SUBP) do { const int j = (JX); \
        const int s = (j - j0) & 1; \
        *(LAS u32x4*)(shm + kwr + s * SLOTB) = kreg; *(LAS u32x4*)(shm + vwr + s * SLOTB) = vreg; \
        if (j < 11) { const long ro = (long)(4 * cg - 8 + j + 1) * 64 * PITCH; kreg = *(const u32x4*)(ksrc + ro); vreg = *(const u32x4*)(vsrc + ro); } \
        asm volatile("s_waitcnt lgkmcnt(0)\n\ts_barrier" ::: "memory"); \
        cv.template sub<SUBP>(sreg, sctr, item0, istride, lane);     \
        const int d = (wid >> 1) + 8 - j; \
        if (d >= 0 && d <= 8) { \
            f32x16 p0 = f32x16{}, p1 = f32x16{}; \
            const LAS unsigned char* kbs = shm + s * SLOTB; \
        _Pragma("unroll") \
            for (int d0 = 0; d0 < 4; ++d0) { \
                const bf16x8 b0 = *(const LAS bf16x8*)(kbs + kra[d0]), b1 = *(const LAS bf16x8*)(kbs + kra[d0] + 512); \
                p0 = __builtin_amdgcn_mfma_f32_32x32x16_bf16(b0, qr[d0], p0, 0, 0, 0); p1 = __builtin_amdgcn_mfma_f32_32x32x16_bf16(b1, qr[d0], p1, 0, 0, 0); } \
            const LAS float* tb = tbl + (256 + 64 * d + 32 * wq + r32 - 4 * hi - 63); \
            float sacc = 0.f; \
        _Pragma("unroll") \
            for (int r = 0; r < 16; ++r) { const int c = (r & 3) + 8 * (r >> 2); \
                p0[r] = fast_exp2(p0[r] + tb[63 - c]); p1[r] = fast_exp2(p1[r] + tb[31 - c]); sacc += p0[r] + p1[r]; } \
            l_reg += sacc; \
            u32x4 pw0, pw1, pw2, pw3; \
            pw0 = (u32x4){cvtpk_s(p0[0], p0[1]), cvtpk_s(p0[2], p0[3]), cvtpk_s(p0[4], p0[5]), cvtpk_s(p0[6], p0[7])}; \
            pw1 = (u32x4){cvtpk_s(p0[8], p0[9]), cvtpk_s(p0[10], p0[11]), cvtpk_s(p0[12], p0[13]), cvtpk_s(p0[14], p0[15])}; \
            pw2 = (u32x4){cvtpk_s(p1[0], p1[1]), cvtpk_s(p1[2], p1[3]), cvtpk_s(p1[4], p1[5]), cvtpk_s(p1[6], p1[7])}; \
            pw3 = (u32x4){cvtpk_s(p1[8], p1[9]), cvtpk_s(p1[10], p1[11]), cvtpk_s(p1[12], p1[13]), cvtpk_s(p1[14], p1[15])}; \
            ATT_SBAR(); \
            pv(o, vb0 + s * SLOTB, __builtin_bit_cast(bf16x8, pw0), __builtin_bit_cast(bf16x8, pw1), __builtin_bit_cast(bf16x8, pw2), __builtin_bit_cast(bf16x8, pw3)); \
        } \
    } while (0)
    for (int jb = j0; jb < 12; jb += 4) { ATT_STEP(jb, 0); ATT_STEP(jb + 1, 1); ATT_STEP(jb + 2, 2); ATT_STEP(jb + 3, 3); }
#undef ATT_STEP
    asm volatile("s_waitcnt lgkmcnt(0)\n\ts_barrier" ::: "memory");
    { auto rr = __builtin_amdgcn_permlane32_swap(__float_as_uint(l_reg), __float_as_uint(l_reg), false, false); l_reg = __uint_as_float(rr[0]) + __uint_as_float(rr[1]); }
    if (hi == 0) wsf[32 + r32] = l_reg; asm volatile("s_waitcnt lgkmcnt(0)" ::: "memory");
    float rli[16];
#pragma unroll
    for (int r = 0; r < 16; ++r) rli[r] = fast_rcp(wsf[32 + crow(r, hi)]);
    bf16* Ow = O + (rowbase + 64 * cq + 32 * wq) * D + h * HD;
    { LAS bf16* stg = (LAS bf16*)(shm + L_OST) + wid * 2048;
#pragma unroll
        for (int r = 0; r < 16; ++r) { const int orow = crow(r, hi);
#pragma unroll
            for (int d0 = 0; d0 < 2; ++d0) stg[orow * 64 + d0 * 32 + r32] = (bf16)f2bf(o[d0][r] * rli[r]); }
        asm volatile("s_waitcnt lgkmcnt(0)" ::: "memory");
#pragma unroll
        for (int i = 0; i < 4; ++i) { const int row = i * 8 + (lane >> 3), ch = lane & 7; const u32x4 v = *(const LAS u32x4*)(stg + row * 64 + ch * 8); *(u32x4*)(Ow + (long)row * D + ch * 8) = v; } }
    asm volatile("s_waitcnt lgkmcnt(0)\n\ts_barrier" ::: "memory");
}
#undef ATT_SBAR
}

constexpr int SGU_WM_OFF = 128 * 136 * 2;
__device__ __forceinline__ void sgu_load_wm(int g, const bf16* WM, LAS unsigned char* shm) {
    const int tid = threadIdx.x, t = tid >> 2, c0 = (tid & 3) * 32;
    const bf16* src = WM + ((size_t)g * 128 + t) * 128 + c0;
#pragma unroll
    for (int q = 0; q < 4; ++q) *(LAS u32x4*)(shm + SGU_WM_OFF + (t * 136 + c0 + 8 * q) * 2) = *(const u32x4*)(src + 8 * q);
}
__device__ __forceinline__ void sgu_item(int item, const bf16* VG, const bf16* UG, const float* lng, const float* lnb, const float* sgb, bf16* YC, LAS unsigned char* shm,
                                         const MoeConv& cv, MoeConv::Regs& sreg, int& sctr, int item0, int istride) {
    const int tid = threadIdx.x, lane = tid & 63; const int wid = __builtin_amdgcn_readfirstlane(tid >> 6);
    const int g = item & 3, blk = item >> 2;
    const long t0 = (long)blk * 128;
    LAS bf16* vt = (LAS bf16*)shm;
    const LAS bf16* wmL = (const LAS bf16*)(shm + SGU_WM_OFF);
    const int ch = tid & 15, fr = lane & 15, fq = lane >> 4;
    u32x4 vraw[4];
#pragma unroll
    for (int it = 0; it < 4; ++it) vraw[it] = *(const u32x4*)(VG + (t0 + (tid >> 4) + 32 * it) * SGW + g * 128 + ch * 8);
    u32x2 uw[8]; float bs[8];
#pragma unroll
    for (int tt = 0; tt < 8; ++tt) { const int t = 16 * tt + fr; uw[tt] = *(const u32x2*)(UG + (size_t)(t0 + t) * SGW + g * 128 + 16 * wid + 4 * fq); bs[tt] = sgb[g * 128 + t]; }
    const f32x4 gA = *(const f32x4*)(lng + g * 128 + ch * 8), gB = *(const f32x4*)(lng + g * 128 + ch * 8 + 4);
    const f32x4 bA = *(const f32x4*)(lnb + g * 128 + ch * 8), bB = *(const f32x4*)(lnb + g * 128 + ch * 8 + 4);
#pragma unroll
    for (int it = 0; it < 4; ++it) {
        const int s = (tid >> 4) + 32 * it;
        const u32x4 w = vraw[it];
        f32x4 a = (f32x4){bflo(w.x), bfhi(w.x), bflo(w.y), bfhi(w.y)}, b = (f32x4){bflo(w.z), bfhi(w.z), bflo(w.w), bfhi(w.w)};
        float sum = (a[0] + a[1]) + (a[2] + a[3]) + (b[0] + b[1]) + (b[2] + b[3]);
        sum += __shfl_xor(sum, 1); sum += __shfl_xor(sum, 2); sum += __shfl_xor(sum, 4); sum += __shfl_xor(sum, 8);
        const float mean = sum * (1.0f / 128.0f);
        a = a - mean; b = b - mean;
        float q = (a[0] * a[0] + a[1] * a[1]) + (a[2] * a[2] + a[3] * a[3]) + (b[0] * b[0] + b[1] * b[1]) + (b[2] * b[2] + b[3] * b[3]);
        q += __shfl_xor(q, 1); q += __shfl_xor(q, 2); q += __shfl_xor(q, 4); q += __shfl_xor(q, 8);
        const float rstd = 1.0f / sqrtf(q * (1.0f / 128.0f) + EPS);
        a = a * rstd * gA + bA; b = b * rstd * gB + bB;
#pragma unroll
        for (int j = 0; j < 4; ++j) { vt[(ch * 8 + j) * 136 + s] = (bf16)f2bf(a[j]); vt[(ch * 8 + 4 + j) * 136 + s] = (bf16)f2bf(b[j]); }
    }
    asm volatile("s_waitcnt lgkmcnt(0)\n\ts_barrier" ::: "memory");
    f32x4 acc[8];
#pragma unroll
    for (int tt = 0; tt < 8; ++tt) acc[tt] = (f32x4){0.f, 0.f, 0.f, 0.f};
#pragma unroll
    for (int ks = 0; ks < 4; ++ks) {
        const bf16x8 a = *(const LAS bf16x8*)(vt + (16 * wid + fr) * 136 + 32 * ks + 8 * fq);
#pragma unroll
        for (int tt = 0; tt < 8; ++tt) if (ks <= (tt >> 1)) {
            const bf16x8 bfrag = *(const LAS bf16x8*)(wmL + (16 * tt + fr) * 136 + 32 * ks + 8 * fq);
            acc[tt] = __builtin_amdgcn_mfma_f32_16x16x32_bf16(a, bfrag, acc[tt], 0, 0, 0); }
    }
#pragma unroll
    for (int tt = 0; tt < 8; ++tt) { const int t = 16 * tt + fr; const float b_ = bs[tt];
        const u32x2 u_ = uw[tt];
        u32x2 w; w.x = cvt_pk_bf16(bflo(u_.x) * (acc[tt][0] + b_), bfhi(u_.x) * (acc[tt][1] + b_)); w.y = cvt_pk_bf16(bflo(u_.y) * (acc[tt][2] + b_), bfhi(u_.y) * (acc[tt][3] + b_));
        *(u32x2*)(YC + (size_t)(t0 + t) * D + AW + g * 128 + 16 * wid + 4 * fq) = w; }
    asm volatile("s_waitcnt lgkmcnt(0)\n\ts_barrier" ::: "memory");
}

#define XB_TMO      128
#define XB_XCNT(j)  (256  + 64 * (j))
#define XB_XSUB(j)  (1280 + 64 * (j))
#define XB_XGEN(j)  (2304 + 64 * (j))
#define XB_TOP      3328
#define XB_TOPGEN   3392
#define XCD_BAR_WORDS 3456
#define XB_SPIN_CAP (1u << 18)
__device__ __forceinline__ unsigned xb_ld(unsigned* p)              { return __hip_atomic_load(p, __ATOMIC_RELAXED, __HIP_MEMORY_SCOPE_AGENT); }
__device__ __forceinline__ unsigned xb_add(unsigned* p, unsigned v) { return __hip_atomic_fetch_add(p, v, __ATOMIC_RELAXED, __HIP_MEMORY_SCOPE_AGENT); }
__device__ __forceinline__ unsigned xb_xcc_id() { return (unsigned)__builtin_amdgcn_s_getreg((3 << 11) | 20) & 0xFu; }
#define XB_SPIN(cond, bar) do { unsigned _sp = 0; while (cond) { __builtin_amdgcn_s_sleep(1); \
    if ((++_sp & 255u) == 0u) { if (xb_ld(&(bar)[XB_TMO])) break; if (_sp > XB_SPIN_CAP) { atomicAdd(&(bar)[XB_TMO], 1u); break; } } } } while (0)
struct XcdBarrier { unsigned* bar; unsigned x; volatile LAS unsigned* st; };
__device__ __forceinline__ XcdBarrier xcd_barrier_post(unsigned* bar, volatile LAS unsigned* st) {
    XcdBarrier b; b.bar = bar; b.x = xb_xcc_id(); b.st = st;
    if (threadIdx.x == 0) (void)xb_add(&bar[XB_XCNT(b.x)], 1u);
    return b;
}
__device__ __forceinline__ void xcd_barrier_complete(unsigned* bar, unsigned x, unsigned& nloc, unsigned& nx) {
    const unsigned G = gridDim.x * gridDim.y * gridDim.z;
    unsigned sum, cnt, mine, sp = 0u;
    for (;;) {
        sum = 0u; cnt = 0u; mine = 0u;
#pragma unroll
        for (unsigned j = 0; j < 16; ++j) { const unsigned c = xb_ld(&bar[XB_XCNT(j)]); sum += c; cnt += (c > 0u) ? 1u : 0u; mine = (j == x) ? c : mine; }
        if (sum == G) break;
        __builtin_amdgcn_s_sleep(1);
        if ((++sp & 255u) == 0u) { if (xb_ld(&bar[XB_TMO])) break; if (sp > XB_SPIN_CAP) { atomicAdd(&bar[XB_TMO], 1u); break; } }
    }
    nloc = mine > 0u ? mine : 1u; nx = cnt > 0u ? cnt : 1u;
}
__device__ __forceinline__ void xcd_barrier(const XcdBarrier& b) {
    asm volatile("s_waitcnt vmcnt(0)" ::: "memory");
    __syncthreads();
    if (threadIdx.x == 0) {
        unsigned* bar = b.bar;
        __builtin_amdgcn_s_waitcnt(0);
        unsigned nloc = b.st[0], nx = b.st[1];
        if (nloc == 0u) { xcd_barrier_complete(bar, b.x, nloc, nx); b.st[0] = nloc; b.st[1] = nx; }
        const unsigned old = xb_add(&bar[XB_XSUB(b.x)], 1u);
        const unsigned gen = old / nloc;
        if (old + 1u == (gen + 1u) * nloc) {
            __builtin_amdgcn_fence(__ATOMIC_RELEASE, "agent");
            asm volatile("s_waitcnt vmcnt(0)" ::: "memory");
            const unsigned og = xb_add(&bar[XB_TOP], 1u);
            const unsigned tg = og / nx;
            if (og + 1u == (tg + 1u) * nx) xb_add(&bar[XB_TOPGEN], 1u);
            else XB_SPIN(xb_ld(&bar[XB_TOPGEN]) == tg, bar);
            __builtin_amdgcn_fence(__ATOMIC_ACQUIRE, "agent");
            xb_add(&bar[XB_XGEN(b.x)], 1u);
            asm volatile("s_waitcnt vmcnt(0)" ::: "memory");
        } else {
            XB_SPIN(xb_ld(&bar[XB_XGEN(b.x)]) == gen, bar);
            __builtin_amdgcn_fence(__ATOMIC_ACQUIRE, "agent");
            asm volatile("s_waitcnt vmcnt(0)" ::: "memory");
        }
    }
    __syncthreads();
}

__device__ __forceinline__ float wave_sum(float v) {
#pragma unroll
    for (int o = 1; o < 64; o <<= 1) v += __shfl_xor(v, o);
    return v;
}
__device__ __forceinline__ int pos_gen(int n0) { return (n0 & ~255) + ((n0 >> 5) & 1) * 128 + ((n0 >> 6) & 3) * 32; }
__device__ __forceinline__ int pos_gu(int c0) { const int up = c0 >= 1024, cc = c0 & 1023; return (cc >> 7) * 256 + up * 128 + ((cc >> 5) & 3) * 32; }
__device__ __forceinline__ unsigned pack_i8(const f32x4& v) {
    const int a = (int)__builtin_rintf(v.x), b = (int)__builtin_rintf(v.y), c = (int)__builtin_rintf(v.z), d = (int)__builtin_rintf(v.w);
    return ((unsigned)a & 255u) | (((unsigned)b & 255u) << 8) | (((unsigned)c & 255u) << 16) | ((unsigned)d << 24);
}
__device__ __forceinline__ void win_absmax(const float* W, int k0, int n0, unsigned* cmax, unsigned* ccnt, int lane) {
    const int kc = lane >> 4, nq = lane & 15;
    f32x4 v[16];
#pragma unroll
    for (int i = 0; i < 16; ++i) v[i] = *(const f32x4*)(W + (size_t)(k0 + 16 * kc + i) * INW + n0 + 4 * nq);
    f32x4 mx = (f32x4){0.f, 0.f, 0.f, 0.f};
#pragma unroll
    for (int i = 0; i < 16; ++i) { mx.x = fmaxf(mx.x, fabsf(v[i].x)); mx.y = fmaxf(mx.y, fabsf(v[i].y)); mx.z = fmaxf(mx.z, fabsf(v[i].z)); mx.w = fmaxf(mx.w, fabsf(v[i].w)); }
#pragma unroll
    for (int c = 0; c < 4; ++c) { mx[c] = fmaxf(mx[c], __shfl_xor(mx[c], 16)); mx[c] = fmaxf(mx[c], __shfl_xor(mx[c], 32)); }
    if (kc == 0) {
#pragma unroll
        for (int c = 0; c < 4; ++c) (void)__hip_atomic_fetch_max(cmax + n0 + 4 * nq + c, __float_as_uint(mx[c]), RLX_AGENT);
    }
    asm volatile("s_waitcnt vmcnt(0)" ::: "memory");
    if (lane == 0) (void)__hip_atomic_fetch_add(ccnt, 1u, RLX_AGENT);
}
__device__ __forceinline__ void win_quant(const float* W, int k0, int n0, unsigned char* WT, unsigned* cmax, unsigned* ccnt, float* cs, bool write_cs, unsigned* tmo, int lane) {
    const int kc = lane >> 4, nq = lane & 15;
    f32x4 v[16];
#pragma unroll
    for (int i = 0; i < 16; ++i) v[i] = *(const f32x4*)(W + (size_t)(k0 + 16 * kc + i) * INW + n0 + 4 * nq);
    { unsigned sp = 0; while (__hip_atomic_load(ccnt, RLX_AGENT) < 16u) { __builtin_amdgcn_s_sleep(1);
        if ((++sp & 255u) == 0u) { if (__hip_atomic_load(tmo, RLX_AGENT)) break; if (sp > (1u << 18)) { atomicAdd(tmo, 1u); break; } } } }
    asm volatile("" ::: "memory");
    float sc[4];
#pragma unroll
    for (int c = 0; c < 4; ++c) { const float cm = __uint_as_float(__hip_atomic_load(cmax + n0 + 4 * nq + c, RLX_AGENT)); sc[c] = cm > 0.f ? 127.0f / cm : 0.f; if (write_cs && kc == 0) cs[n0 + 4 * nq + c] = cm * (1.0f / 127.0f); }
    const int nb = n0 + 32 * (nq >> 3);
    const int rowb = pos_gen(nb) + ((4 * nq) & 31);
#pragma unroll
    for (int c = 0; c < 4; ++c) {
        u32x4 o;
        o.x = pack_i8((f32x4){v[0][c], v[1][c], v[2][c], v[3][c]} * sc[c]); o.y = pack_i8((f32x4){v[4][c], v[5][c], v[6][c], v[7][c]} * sc[c]);
        o.z = pack_i8((f32x4){v[8][c], v[9][c], v[10][c], v[11][c]} * sc[c]); o.w = pack_i8((f32x4){v[12][c], v[13][c], v[14][c], v[15][c]} * sc[c]);
        *(u32x4*)(WT + (size_t)(rowb + c) * D + k0 + 16 * kc) = o;
    }
}
template <int MODE, int POSK>
__device__ __forceinline__ void tr_tile(const float* W, int N, int k0, int n0, unsigned char* WT, int ldt_bytes, int dk0, const float* ks, float wscale, int lane, int rowadj = 0) {
    const int kc = lane >> 4, nq = lane & 15;
    f32x4 v[16];
#pragma unroll
    for (int i = 0; i < 16; ++i) { const int kk = MODE ? (16 * kc + i) : (32 * (i >> 3) + 8 * kc + (i & 7)); v[i] = *(const f32x4*)(W + (size_t)(k0 + kk) * N + n0 + 4 * nq); }
    if (ks) {
#pragma unroll
        for (int i = 0; i < 16; ++i) { const int kk = MODE ? (16 * kc + i) : (32 * (i >> 3) + 8 * kc + (i & 7)); v[i] = v[i] * (ks[k0 + kk] * wscale); }
    } else if (MODE) {
#pragma unroll
        for (int i = 0; i < 16; ++i) v[i] = v[i] * wscale;
    }
    const int nb = n0 + 32 * (nq >> 3);
    const int rowb = (POSK ? pos_gu(nb) : pos_gen(nb)) + ((4 * nq) & 31) + rowadj;
#pragma unroll
    for (int c = 0; c < 4; ++c) {
        unsigned char* rp = WT + (size_t)(rowb + c) * ldt_bytes;
        if (MODE == 0) {
#pragma unroll
            for (int p = 0; p < 2; ++p) { u32x4 o; o.x = pk2(v[8 * p + 0][c], v[8 * p + 1][c]); o.y = pk2(v[8 * p + 2][c], v[8 * p + 3][c]); o.z = pk2(v[8 * p + 4][c], v[8 * p + 5][c]); o.w = pk2(v[8 * p + 6][c], v[8 * p + 7][c]);
                *(u32x4*)(rp + (size_t)(dk0 + 32 * p + 8 * kc) * 2) = o; }
        } else {
            int w0 = 0, w1 = 0, w2 = 0, w3 = 0;
            w0 = __builtin_amdgcn_cvt_pk_fp8_f32(v[0][c], v[1][c], w0, false); w0 = __builtin_amdgcn_cvt_pk_fp8_f32(v[2][c], v[3][c], w0, true);
            w1 = __builtin_amdgcn_cvt_pk_fp8_f32(v[4][c], v[5][c], w1, false); w1 = __builtin_amdgcn_cvt_pk_fp8_f32(v[6][c], v[7][c], w1, true);
            w2 = __builtin_amdgcn_cvt_pk_fp8_f32(v[8][c], v[9][c], w2, false); w2 = __builtin_amdgcn_cvt_pk_fp8_f32(v[10][c], v[11][c], w2, true);
            w3 = __builtin_amdgcn_cvt_pk_fp8_f32(v[12][c], v[13][c], w3, false); w3 = __builtin_amdgcn_cvt_pk_fp8_f32(v[14][c], v[15][c], w3, true);
            *(u32x4*)(rp + (size_t)(dk0 + 16 * kc)) = (u32x4){(unsigned)w0, (unsigned)w1, (unsigned)w2, (unsigned)w3};
        }
    }
}

struct Args { const float* in[20]; float* out; unsigned char* ws; int ph_lo, ph_hi, li, pad; };

__global__ void __launch_bounds__(512, 2) moe_block_fwd(Args args) {
    extern __shared__ __attribute__((aligned(16))) unsigned char lds_raw[];
    LAS unsigned char* lds = (LAS unsigned char*)lds_raw;
    volatile LAS unsigned* MISC = (volatile LAS unsigned*)(lds + MISC_OFF);
    const int tid = threadIdx.x, lane = tid & 63, wave = __builtin_amdgcn_readfirstlane(tid >> 6);
    const int G = gridDim.x, bx = blockIdx.x;
    const int vcu = (G % 8 == 0) ? (bx % 8) * (G / 8) + bx / 8 : bx;
    unsigned char* ws = args.ws;
    gu32* ctl = (gu32*)(ws + WS_CTL);
    const float* x = args.in[0]; const float* norm1_g = args.in[1]; const float* w_in = args.in[2]; const float* q_norm_g = args.in[3]; const float* k_norm_g = args.in[4];
    const float* rel_bias = args.in[5]; const float* sg_ln_g = args.in[6]; const float* sg_ln_b = args.in[7]; const float* sg_w = args.in[8]; const float* sg_b = args.in[9];
    const float* w_branch_a = args.in[10]; const float* w_branch_b = args.in[11]; const float* w_out = args.in[12]; const float* norm2_g = args.in[13];
    const float* router_w = args.in[14]; const float* router_b = args.in[15]; const float* w_gate_up = args.in[16]; const float* b_gate_up = args.in[17];
    const float* w_down = args.in[18]; const float* b_down = args.in[19];
    float* out = args.out;
    bf16* WIN = (bf16*)(ws + WS_WIN); unsigned char* WIN8 = ws + WS_WIN8; float* HS = (float*)(ws + WS_HS); float* CS = (float*)(ws + WS_CS); unsigned char* H8 = ws + WS_H8; bf16* WAB = (bf16*)(ws + WS_WAB); bf16* WO = (bf16*)(ws + WS_WO); bf16* WRH = (bf16*)(ws + WS_WR); bf16* WRL = (bf16*)(ws + WS_WR + 65536); bf16* WM = (bf16*)(ws + WS_WM);
    int* LID = (int*)(ws + WS_LID); float* LRS = (float*)(ws + WS_LRS); float* LP = (float*)(ws + WS_LP);
    unsigned char* WGU = ws + WS_WGU; unsigned char* WD = ws + WS_WD;
    bf16* HB = (bf16*)(ws + WS_H); bf16* QB = (bf16*)(ws + WS_Q); bf16* KB = (bf16*)(ws + WS_K); bf16* VB = (bf16*)(ws + WS_V);
    bf16* UG = (bf16*)(ws + WS_UG); bf16* VG = (bf16*)(ws + WS_VG); unsigned char* GA = ws + WS_GA; bf16* GB = (bf16*)(ws + WS_GB);
    bf16* YCAT = (bf16*)(ws + WS_YCAT); unsigned char* X1Q = ws + WS_X1B; bf16* X1H = (bf16*)(ws + WS_X1H); unsigned char* ACT = ws + WS_ACT; unsigned char* YB = ws + WS_Y;

    for (int u = tid; u < (LDS_BYTES - LDSCTL_OFF) / 4; u += 512) ((LAS unsigned*)(lds + LDSCTL_OFF))[u] = 0u;
    __syncthreads();
    XcdBarrier bar; bar.bar = (unsigned*)(ctl + CW_BAR); bar.x = 0; bar.st = nullptr;
    if (MK_N_LAUNCHES == 1) bar = xcd_barrier_post((unsigned*)(ctl + CW_BAR), MISC + 8);
    const int lo = args.ph_lo, hi = args.ph_hi;
#define IN(k) (lo <= (k) && (k) < hi)
#define SEAM(k) do { if (IN(k) && IN((k) + 1)) xcd_barrier(bar); } while (0)
#define REPS(k) for (int rep_ = 0; rep_ < ((REP_PHASE == (k)) ? 2 : 1); ++rep_)
#define REPSEAM(k) do { if (REP_PHASE == (k) && rep_ == 0) xcd_barrier(bar); } while (0)
    const int gw = vcu * 8 + wave, NGW = G * 8;

    if (IN(0)) REPS(0) {
        constexpr int I_IN = 16 * 72, I_A = 8 * 16, I_O = 16 * 16, I_GU = 16 * 32, I_D = 16 * 16;
        constexpr int NITEMS = I_IN + 2 * I_A + I_O;
        for (int it = gw; it < NITEMS; it += NGW) {
            int r = it;
            if (r < I_IN) { const int kb = r / 72, nb = r % 72; win_absmax(w_in, 64 * kb, 64 * nb, (unsigned*)(ctl + CW_CMAX), (unsigned*)(ctl + CW_CCNT + nb), lane); continue; } r -= I_IN;
            if (r < I_A) { const int kb = r / 16, nb = r % 16; tr_tile<0, 0>(w_branch_a, D, 64 * kb, 64 * nb, (unsigned char*)WAB, D * 2, 64 * kb, nullptr, 1.f, lane); continue; } r -= I_A;
            if (r < I_A) { const int kb = r / 16, nb = r % 16; tr_tile<0, 0>(w_branch_b, D, 64 * kb, 64 * nb, (unsigned char*)WAB, D * 2, 512 + 64 * kb, nullptr, 1.f, lane); continue; } r -= I_A;
            { const int kb = r / 16, nb = r % 16; tr_tile<0, 0>(w_out, D, 64 * kb, 64 * nb, (unsigned char*)WO, D * 2, 64 * kb, nullptr, 1.f, lane); }
        }
        for (int i = gw * 64 + lane; i < 4 * 128 * 128; i += NGW * 64) { const int s = i & 127, t = (i >> 7) & 127; WM[i] = (bf16)f2bf(s <= t ? sg_w[i] : 0.f); }
        for (int i = gw * 64 + lane; i < NE * D; i += NGW * 64) { const int k = i & 1023, e = i >> 10; const float w = router_w[k * NE + e] * norm2_g[k]; const unsigned h_ = f2bf(w); WRH[i] = (bf16)h_; WRL[i] = (bf16)f2bf(w - bf2f((unsigned short)h_)); }
        for (int m = 2 * gw; m < T; m += 2 * NGW) {
            const f32x4* xr = (const f32x4*)(x + (size_t)m * D) + lane; const f32x4* gr = (const f32x4*)norm1_g + lane;
            f32x4 v[2][4]; float s0 = 0.f, s1 = 0.f, a0 = 0.f, a1 = 0.f;
#pragma unroll
            for (int j = 0; j < 4; ++j) { v[0][j] = xr[64 * j]; v[1][j] = xr[256 + 64 * j]; }
#pragma unroll
            for (int j = 0; j < 4; ++j) { const f32x4 gq = gr[64 * j];
                s0 += (v[0][j].x * v[0][j].x + v[0][j].y * v[0][j].y) + (v[0][j].z * v[0][j].z + v[0][j].w * v[0][j].w);
                s1 += (v[1][j].x * v[1][j].x + v[1][j].y * v[1][j].y) + (v[1][j].z * v[1][j].z + v[1][j].w * v[1][j].w);
                v[0][j] = v[0][j] * gq; v[1][j] = v[1][j] * gq;
                a0 = fmaxf(a0, fmaxf(fmaxf(fabsf(v[0][j].x), fabsf(v[0][j].y)), fmaxf(fabsf(v[0][j].z), fabsf(v[0][j].w))));
                a1 = fmaxf(a1, fmaxf(fmaxf(fabsf(v[1][j].x), fabsf(v[1][j].y)), fmaxf(fabsf(v[1][j].z), fabsf(v[1][j].w)))); }
            s0 = wave_sum(s0); s1 = wave_sum(s1);
#pragma unroll
            for (int o = 1; o < 64; o <<= 1) { a0 = fmaxf(a0, __shfl_xor(a0, o)); a1 = fmaxf(a1, __shfl_xor(a1, o)); }
            const float rs0 = 1.0f / sqrtf(s0 * (1.0f / D) + EPS), rs1 = 1.0f / sqrtf(s1 * (1.0f / D) + EPS);
            const float q0 = a0 > 0.f ? 127.0f / a0 : 0.f, q1 = a1 > 0.f ? 127.0f / a1 : 0.f;
            if (lane == 0) { HS[m] = rs0 * a0 * (1.0f / 127.0f); HS[m + 1] = rs1 * a1 * (1.0f / 127.0f); }
            unsigned* q8 = (unsigned*)(H8 + (size_t)m * D) + lane;
#pragma unroll
            for (int j = 0; j < 4; ++j) { q8[64 * j] = pack_i8(v[0][j] * q0); q8[256 + 64 * j] = pack_i8(v[1][j] * q1); }
        }
        for (int it = gw; it < I_IN; it += NGW) { const int kb = it / 72, nb = it % 72;
            win_quant(w_in, 64 * kb, 64 * nb, WIN8, (unsigned*)(ctl + CW_CMAX), (unsigned*)(ctl + CW_CCNT + nb), CS, kb == 0, (unsigned*)(ctl + CW_BAR) + XB_TMO, lane); }
        REPSEAM(0);
    }
    SEAM(0);

    if (IN(1)) REPS(1) {
        { PolIn P; P.so.init(T, INW, G, bx); P.A = H8; P.Bt = WIN8; P.ws = ws; P.qg = q_norm_g; P.kg = k_norm_g; P.hs = HS; P.cs = CS; P.shm = lds;
          pg8::gemm_phase<PolIn>(lds, P); }
        REPSEAM(1);
    }
    SEAM(1);

    if (IN(2)) REPS(2) {
        const MoeConv cv{w_gate_up, w_down, norm2_g, WGU, WD}; MoeConv::Regs sreg; int sctr = 0;
        for (int u = vcu; u < NB * NHEAD * 32; u += G) {
            const int cg = u & 31, bh = u >> 5;
            att::unit(bh >> 3, bh & 7, cg, QB, KB, VB, rel_bias, YCAT, lds, cv, sreg, sctr, gw, NGW);
        }
        sgu_load_wm(vcu & 3, WM, lds);
        for (int it = vcu; it < 4 * (T / 128); it += G) sgu_item(it, VG, UG, sg_ln_g, sg_ln_b, sg_b, YCAT, lds, cv, sreg, sctr, gw, NGW);
        cv.drain(sreg, sctr, gw, NGW, lane);
        REPSEAM(2);
    }
    SEAM(2);

    if (IN(3)) REPS(3) {
        PolMerge P; P.so.init(T, D, G, bx); P.A = YCAT; P.Bt = WAB; P.ga = GA; P.gb = (const unsigned char*)GB; P.out = HB;
        pg8::gemm_phase<PolMerge>(lds, P);
        REPSEAM(3);
    }
    SEAM(3);

    if (IN(4)) REPS(4) {
        PolOut P; P.so.init(T, D, G, bx); P.A = HB; P.Bt = WO; P.x = x; P.x1 = X1H; P.x1q = X1Q;
        pg8::gemm_phase<PolOut>(lds, P);
        REPSEAM(4);
    }
    SEAM(4);

    if (IN(5)) {
        LAS int* lcnt = (LAS int*)(lds + PARK_OFF); LAS int* gbase = lcnt + 32;
        if (tid < 64) lcnt[tid] = 0;
        for (int i = tid; i < 4096; i += 512) { const int e = i & 31, gq = (i >> 5) & 3, kq = i >> 7;
            *(LAS u32x4*)(lds + (size_t)i * 16) = *(const u32x4*)(WRH + (size_t)e * D + 32 * kq + 8 * gq); *(LAS u32x4*)(lds + 65536 + (size_t)i * 16) = *(const u32x4*)(WRL + (size_t)e * D + 32 * kq + 8 * gq); }
        __syncthreads();
        const int r = lane & 15, g = lane >> 4;
        int sel_e[4], sel_rank[4]; float sel_p[4]; float rs_row = 0.f; int tok = 0;
        for (int grp = bx * 8 + wave; grp < T / 16; grp += NGW) {
            const int row0 = grp * 16; tok = row0 + r;
            const bf16* xr = X1H + (size_t)(row0 + r) * D + 8 * g;
            const LAS unsigned char* wl_ = lds + (g * 32 + r) * 16;
            f32x4 a0 = (f32x4){0.f, 0.f, 0.f, 0.f}, a1 = a0; float ssq = 0.f;
            u32x4 xq[4][4];
#define P5_LOAD(S, ss) do { _Pragma("unroll") for (int q = 0; q < 4; ++q) xq[S][q] = *(const u32x4*)(xr + 128 * (ss) + 32 * q); } while (0)
#define P5_COMP(S, ss) do { _Pragma("unroll") for (int q = 0; q < 4; ++q) { const u32x4 w_ = xq[S][q]; const int ks = 4 * (ss) + q; \
                const bf16x8 wh_0 = *(const LAS bf16x8*)(wl_ + ks * 2048), wh_1 = *(const LAS bf16x8*)(wl_ + ks * 2048 + 256), wl_0 = *(const LAS bf16x8*)(wl_ + 65536 + ks * 2048), wl_1 = *(const LAS bf16x8*)(wl_ + 65536 + ks * 2048 + 256); \
                ssq += (bflo(w_.x) * bflo(w_.x) + bfhi(w_.x) * bfhi(w_.x)) + (bflo(w_.y) * bflo(w_.y) + bfhi(w_.y) * bfhi(w_.y)) + (bflo(w_.z) * bflo(w_.z) + bfhi(w_.z) * bfhi(w_.z)) + (bflo(w_.w) * bflo(w_.w) + bfhi(w_.w) * bfhi(w_.w)); \
                const bf16x8 xh = __builtin_bit_cast(bf16x8, w_); \
                a0 = __builtin_amdgcn_mfma_f32_16x16x32_bf16(wh_0, xh, a0, 0, 0, 0); a1 = __builtin_amdgcn_mfma_f32_16x16x32_bf16(wh_1, xh, a1, 0, 0, 0); \
                a0 = __builtin_amdgcn_mfma_f32_16x16x32_bf16(wl_0, xh, a0, 0, 0, 0); a1 = __builtin_amdgcn_mfma_f32_16x16x32_bf16(wl_1, xh, a1, 0, 0, 0); } } while (0)
            P5_LOAD(0, 0); P5_LOAD(1, 1); P5_LOAD(2, 2); P5_LOAD(3, 3);
            P5_COMP(0, 0); P5_LOAD(0, 4);
            P5_COMP(1, 1); P5_LOAD(1, 5);
            P5_COMP(2, 2); P5_LOAD(2, 6);
            P5_COMP(3, 3); P5_LOAD(3, 7);
            P5_COMP(0, 4); P5_COMP(1, 5); P5_COMP(2, 6); P5_COMP(3, 7);
#undef P5_LOAD
#undef P5_COMP
            ssq += __shfl_xor(ssq, 16); ssq += __shfl_xor(ssq, 32);
            const float rs = 1.0f / sqrtf(ssq * (1.0f / D) + EPS); rs_row = rs;
            float v[8];
#pragma unroll
            for (int j = 0; j < 4; ++j) { v[j] = a0[j] * rs + router_b[4 * g + j]; v[4 + j] = a1[j] * rs + router_b[16 + 4 * g + j]; }
            unsigned taken = 0u; float sel_v[4];
#pragma unroll
            for (int k = 0; k < 4; ++k) {
                float best = -INFINITY; int bi = 1 << 20;
#pragma unroll
                for (int i = 0; i < 8; ++i) { const int ei = (i >> 2) * 16 + 4 * g + (i & 3); if (!((taken >> i) & 1u) && v[i] > best) { best = v[i]; bi = ei; } }
#pragma unroll
                for (int m = 16; m <= 32; m <<= 1) { const float ob = __shfl_xor(best, m); const int oi = __shfl_xor(bi, m); if (ob > best || (ob == best && oi < bi)) { best = ob; bi = oi; } }
                sel_e[k] = bi; sel_v[k] = best;
                if (((bi & 15) >> 2) == g) taken |= 1u << (((bi >> 4) << 2) | (bi & 3));
            }
            float den = 0.f;
#pragma unroll
            for (int k = 0; k < 4; ++k) { sel_p[k] = __expf(sel_v[k] - sel_v[0]); den += sel_p[k]; }
            const float inv = 1.0f / den;
#pragma unroll
            for (int k = 0; k < 4; ++k) sel_p[k] *= inv;
            if (g == 0) {
#pragma unroll
                for (int k = 0; k < 4; ++k) sel_rank[k] = __hip_atomic_fetch_add(lcnt + sel_e[k], 1, __ATOMIC_RELAXED, __HIP_MEMORY_SCOPE_WORKGROUP);
            }
        }
        __syncthreads();
        if (tid < NE) gbase[tid] = (int)__hip_atomic_fetch_add((unsigned*)(ctl + CW_CNT + tid), (unsigned)lcnt[tid], RLX_AGENT);
        __syncthreads();
        if (g == 0 && (bx * 8 + wave) < T / 16) {
#pragma unroll
            for (int k = 0; k < 4; ++k) { const size_t pos = (size_t)sel_e[k] * LCAP + gbase[sel_e[k]] + sel_rank[k];
                LID[pos] = tok * 4 + k; LRS[pos] = rs_row; LP[pos] = sel_p[k]; }
        }
        __syncthreads();
    }
    SEAM(5);

    if (IN(6) || IN(7)) {
        LAS int* tb = (LAS int*)(lds + MOE_OFF);
        if (tid < NE) tb[33 + tid] = (int)__hip_atomic_load(ctl + CW_CNT + tid, RLX_AGENT);
        __syncthreads();
        if (tid == 0) { int acc = 0; for (int e = 0; e < NE; ++e) { tb[e] = acc; acc += (tb[33 + e] + 255) >> 8; } tb[32] = acc; }
        __syncthreads();
    }
    if (IN(6)) REPS(6) {
        PolGU P; P.mo.init((const LAS int*)(lds + MOE_OFF), 8, G, bx); P.A = X1Q; P.Bt = WGU; P.lid = LID; P.lrs = LRS; P.bgu = b_gate_up; P.act = ACT; P.shm = lds;
        pg8::gemm_phase<PolGU>(lds, P);
        REPSEAM(6);
    }
    SEAM(6);
    if (IN(7)) REPS(7) {
        PolDown P; P.mo.init((const LAS int*)(lds + MOE_OFF), 4, G, bx); P.A = ACT; P.Bt = WD; P.lid = LID; P.lp = LP; P.bd = b_down; P.y = YB; P.shm = lds;
        pg8::gemm_phase<PolDown>(lds, P);
        REPSEAM(7);
    }
    SEAM(7);
    if (IN(8)) {
        f32x4 xa[4], xb[4]; u32x4 ya[4], yb[4];
#define P8_LOAD(X, Y, m_) do { const bf16* xr_ = X1H + (size_t)(m_) * D + 16 * lane; { f32x4 a_, b_; ld8(xr_, a_, b_); X[0] = a_; X[1] = b_; ld8(xr_ + 8, a_, b_); X[2] = a_; X[3] = b_; } \
            _Pragma("unroll") for (int k = 0; k < 4; ++k) Y[k] = *(const u32x4*)(YB + ((size_t)(m_) * 4 + k) * D + 16 * lane); } while (0)
#define P8_DONE(X, Y, m_) do { _Pragma("unroll") for (int k = 0; k < 4; ++k) { const unsigned ww[4] = {Y[k].x, Y[k].y, Y[k].z, Y[k].w}; \
            _Pragma("unroll") for (int q = 0; q < 4; ++q) { const f32x2 lo_ = __builtin_amdgcn_cvt_pk_f32_fp8((int)ww[q], false), hi_ = __builtin_amdgcn_cvt_pk_f32_fp8((int)ww[q], true); \
                X[q][0] += lo_[0] * 0.0625f; X[q][1] += lo_[1] * 0.0625f; X[q][2] += hi_[0] * 0.0625f; X[q][3] += hi_[1] * 0.0625f; } } \
            float* or_ = out + (size_t)(m_) * D + 16 * lane; _Pragma("unroll") for (int j = 0; j < 4; ++j) *(f32x4*)(or_ + 4 * j) = X[j]; } while (0)
        for (int m = gw; m < T; m += 2 * NGW) { const int m2 = m + NGW;
            P8_LOAD(xa, ya, m); P8_LOAD(xb, yb, m2);
            P8_DONE(xa, ya, m); P8_DONE(xb, yb, m2); }
#undef P8_LOAD
#undef P8_DONE
    }
#undef IN
#undef SEAM
}

extern "C" void kernel_launch(void* const* d_in, const int* in_sizes, int n_in, void* d_out, int out_size, void* d_ws, size_t ws_size, hipStream_t stream) {
    static int grid = 0;
    if (grid == 0) {
        if (n_in != 20 || in_sizes[0] != T * D || out_size != T * D || ws_size < WS_END) { fprintf(stderr, "kernel_launch: unexpected shapes (n_in %d, ws %zu)\n", n_in, ws_size); grid = -1; return; }
        int dev = 0, cus = 0;
        if (hipGetDevice(&dev) != hipSuccess || hipDeviceGetAttribute(&cus, hipDeviceAttributeMultiprocessorCount, dev) != hipSuccess) { grid = -1; return; }
        if (hipFuncSetAttribute((const void*)moe_block_fwd, hipFuncAttributeMaxDynamicSharedMemorySize, LDS_BYTES) != hipSuccess) { fprintf(stderr, "kernel_launch: hipFuncSetAttribute failed\n"); grid = -1; return; }
        (void)hipGetLastError();
        grid = cus;
        if (grid != 256) { fprintf(stderr, "kernel_launch: built for a 256-CU device, got %d\n", cus); grid = -1; return; }
    }
    if (grid < 0) return;
    if (hipMemsetAsync((char*)d_ws + WS_CTL, 0, CTL_ZERO_BYTES, stream) != hipSuccess) return;
    Args a{};
    for (int i = 0; i < 20; ++i) a.in[i] = (const float*)d_in[i];
    a.out = (float*)d_out; a.ws = (unsigned char*)d_ws;
    constexpr int NPH = 9;
    for (int li = 0; li < MK_N_LAUNCHES; ++li) {
        a.ph_lo = (MK_N_LAUNCHES == 1) ? 0 : li; a.ph_hi = (MK_N_LAUNCHES == 1) ? NPH : li + 1; a.li = li;
        hipLaunchKernelGGL(moe_block_fwd, dim3(grid), dim3(512), LDS_BYTES, stream, a);
    }
}
```

```cpp
#include <hip/hip_runtime.h>
#include <cstdio>
#include <cstdint>

#ifndef MK_N_LAUNCHES
#define MK_N_LAUNCHES 1
#endif

#ifndef REP_PHASE
#define REP_PHASE -1
#endif
#define LAS __attribute__((address_space(3)))
#define GAS __attribute__((address_space(1)))
typedef unsigned short bf16;
typedef short bf16x8 __attribute__((ext_vector_type(8)));
typedef short s16x4 __attribute__((ext_vector_type(4)));
typedef float f32x2 __attribute__((ext_vector_type(2)));
typedef float f32x4 __attribute__((ext_vector_type(4)));
typedef float f32x16 __attribute__((ext_vector_type(16)));
typedef unsigned u32x2 __attribute__((ext_vector_type(2)));
typedef unsigned u32x4 __attribute__((ext_vector_type(4)));
typedef GAS unsigned gu32;

constexpr int NB = 4, SEQ = 8192, T = NB * SEQ, D = 1024, AW = 512, SGW = 512, INW = 4608, NE = 32, FF = 1024;
constexpr int NHEAD = 8, HD = 64, CHUNK = 64, NBACK = 8, NREL = 513;
constexpr int LCAP = 32768;
constexpr float LOG2E = 1.4426950408889634f;
constexpr float EPS = 1e-6f;

constexpr size_t MiB = 1u << 20;
constexpr size_t WS_CTL = 0, CTL_ZERO_BYTES = 1 * MiB;
constexpr size_t WS_WIN = 7 * MiB;
constexpr size_t WS_WAB = 11 * MiB;
constexpr size_t WS_WO = 13 * MiB;
constexpr size_t WS_WR = 15 * MiB;
constexpr size_t WS_WM = 15 * MiB + 256 * 1024;
constexpr size_t WS_WIN8 = 2 * MiB;
constexpr size_t WS_HS = 15 * MiB + 512 * 1024;
constexpr size_t WS_CS = 15 * MiB + 768 * 1024;
constexpr size_t WS_H8 = 976 * MiB;
constexpr size_t WS_LID = 16 * MiB;
constexpr size_t WS_LRS = 20 * MiB;
constexpr size_t WS_LP = 24 * MiB;
constexpr size_t WS_WGU = 28 * MiB;
constexpr size_t WS_WD = 156 * MiB;
constexpr size_t WS_H = 220 * MiB;
constexpr size_t WS_Q = 284 * MiB, WS_K = 316 * MiB, WS_V = 348 * MiB;
constexpr size_t WS_UG = 380 * MiB, WS_VG = 412 * MiB;
constexpr size_t WS_GA = 444 * MiB, WS_GB = 508 * MiB;
constexpr size_t WS_YCAT = 572 * MiB;
constexpr size_t WS_X1B = 636 * MiB;
constexpr size_t WS_ACT = 700 * MiB;
constexpr size_t WS_X1H = 380 * MiB;
constexpr size_t WS_Y = 220 * MiB;
constexpr size_t WS_END = 1008 * MiB;
constexpr int CW_TMO = 0, CW_CODE = 1;
constexpr int CW_CNT = 64;
constexpr int CW_BAR = 4096;
constexpr int CW_CMAX = 8192;
constexpr int CW_CCNT = 16384;

constexpr int RING_BYTES = 131072;
constexpr int LDSCTL_OFF = RING_BYTES, MISC_OFF = LDSCTL_OFF + 320;
constexpr int MOE_OFF = MISC_OFF + 128;
constexpr int PARK_OFF = LDSCTL_OFF + 1024;
constexpr int ROWS_OFF = LDSCTL_OFF + 9216, ROWS_BUF = 3072;
constexpr int LDS_BYTES = 147456;

#define LDS_WAIT() asm volatile("s_waitcnt lgkmcnt(0)" ::: "memory")
#define VM_WAIT() asm volatile("s_waitcnt vmcnt(0)" ::: "memory")
#define RLX_AGENT __ATOMIC_RELAXED, __HIP_MEMORY_SCOPE_AGENT

__device__ __forceinline__ unsigned f2bf(float f) { unsigned u = __builtin_bit_cast(unsigned, f); return (u + 0x7fffu + ((u >> 16) & 1u)) >> 16; }
__device__ __forceinline__ unsigned pk2(float lo, float hi) { return f2bf(lo) | (f2bf(hi) << 16); }
__device__ __forceinline__ float bf2f(unsigned short b) { return __builtin_bit_cast(float, (unsigned)b << 16); }
__device__ __forceinline__ float bflo(unsigned w) { return __builtin_bit_cast(float, w << 16); }
__device__ __forceinline__ float bfhi(unsigned w) { return __builtin_bit_cast(float, w & 0xffff0000u); }
__device__ __forceinline__ unsigned cvt_pk_bf16(float lo, float hi) { unsigned r; asm volatile("v_cvt_pk_bf16_f32 %0, %1, %2" : "=v"(r) : "v"(lo), "v"(hi)); return r; }
__device__ __forceinline__ float fast_rcp(float x) { return __builtin_amdgcn_rcpf(x); }
__device__ __forceinline__ float fast_exp2(float x) { return __builtin_amdgcn_exp2f(x); }
__device__ __forceinline__ float sigmoidf_(float x) { return fast_rcp(1.0f + fast_exp2(-LOG2E * x)); }
__device__ __forceinline__ float gelu_tanh(float x) {
    const float t = x * ((-LOG2E * 1.5957691216057308f) + (-LOG2E * 1.5957691216057308f * 0.044715f) * (x * x));
    return x * fast_rcp(1.0f + fast_exp2(t));
}

namespace pg8 {
constexpr int BM = 256, BK = 64, HALF = 128, HTB = HALF * BK * 2, STAGE_BYTES = 8 * HTB, NXCD = 8, WGM = 8;
__host__ __device__ __forceinline__ int lds_byte(int r, int c) { const int st = (r >> 4) * 2 + (c >> 5), rr = r & 15, cc = c & 31, ob = rr * 64 + cc * 2; return st * 1024 + (ob ^ (((ob >> 9) & 1) << 5)); }
__host__ __device__ __forceinline__ void stage_rc(int b, int& R, int& C) { const int st = b / 1024, sb = b % 1024, swz = sb ^ (((sb >> 9) & 1) << 5); R = (st >> 1) * 16 + swz / 64; C = (st & 1) * 32 + (swz % 64) / 2; }
__host__ __device__ __forceinline__ int perm32(int rho) { const int n = rho >> 4, i = rho & 15; return 8 * (i >> 2) + 4 * n + (i & 3); }

typedef int v4i_t __attribute__((ext_vector_type(4)));
typedef int v8i_t __attribute__((ext_vector_type(8)));
__device__ __forceinline__ v8i_t cat8(bf16x8 lo, bf16x8 hi) { return __builtin_shufflevector(__builtin_bit_cast(v4i_t, lo), __builtin_bit_cast(v4i_t, hi), 0, 1, 2, 3, 4, 5, 6, 7); }
struct Unit { int pm, pn, e, s0, cnt, idx; };

struct StaticOrder {
    int nM, nN, nwg, G, c;
    __device__ void init(int M, int N, int G_, int c_) { nM = M / BM; nN = N / BM; nwg = nM * nN; G = G_; c = c_; }
    __device__ bool tile(int i, int& pm, int& pn) const {
        const long L = (long)i * G + c; if (L >= nwg) return false;
        int wgid = (int)L; { const int q = nwg / NXCD, r = nwg % NXCD, xcd = wgid % NXCD, off = wgid / NXCD; wgid = (xcd < r ? xcd * (q + 1) : r * (q + 1) + (xcd - r) * q) + off; }
        const int nig = WGM * nN, gid = wgid / nig, fm = gid * WGM, gsz = (nM - fm) < WGM ? (nM - fm) : WGM;
        pm = fm + ((wgid % nig) % gsz); pn = (wgid % nig) / gsz; return true;
    }
};

template <class P>
__device__ __forceinline__ void gemm_phase(LAS unsigned char* lds, const P& S) {
    const int tid = threadIdx.x, wid = __builtin_amdgcn_readfirstlane(tid >> 6), lane = tid & 63, wr = wid >> 2, wc = wid & 3, fr = lane & 15, fq = lane >> 4;
    constexpr int nt = P::NT;
    unsigned vA[2][2], voffB[2];
    LAS u32x4* park = (LAS u32x4*)(lds + PARK_OFF) + tid;
#pragma unroll
    for (int i = 0; i < 2; ++i) { int R, C; stage_rc(tid * 16 + i * 8192, R, C); const int Rb = (R & ~31) + perm32(R & 31);
        vA[0][i] = (unsigned)(R * P::LDA + C) * 2u; vA[1][i] = (unsigned)((R + HALF) * P::LDA + C) * 2u; voffB[i] = (unsigned)(Rb * P::LDB + C) * 2u; }
    const size_t kstep = (size_t)(BK * 2);
    const size_t hstepB = (size_t)HALF * P::LDB * 2;
    const unsigned ldsw = (unsigned)wid * 1024u;
    const int aoff = lds_byte(wr * 64 + fr, fq * 8), boff = lds_byte(wc * 32 + fr, fq * 8);
#define PG8_SA(b, h) (((b) * 2 + (h)) * HTB)
#define PG8_SB(b, h) ((4 + (b) * 2 + (h)) * HTB)
#define PG8_STAGE2(bufoff, gbase, o0, o1) do { \
        __builtin_amdgcn_global_load_lds((const unsigned*)((const char*)(gbase) + (o0)), (LAS unsigned*)(lds + (bufoff) + ldsw), 16, 0, 0); \
        __builtin_amdgcn_global_load_lds((const unsigned*)((const char*)(gbase) + (o1)), (LAS unsigned*)(lds + (bufoff) + ldsw + 8192), 16, 0, 0); } while (0)
#define PG8_STAGEB(bufoff, gbase) PG8_STAGE2(bufoff, gbase, voffB[0], voffB[1])
#define PG8_LDA(dst, b, h) do { _Pragma("unroll") for (int m = 0; m < 4; ++m) _Pragma("unroll") for (int k = 0; k < 2; ++k) dst[m][k] = *(const LAS bf16x8*)(lds + PG8_SA(b, h) + aoff + m * 2048 + k * 1024); } while (0)
#define PG8_LDB(dst, b, h) do { _Pragma("unroll") for (int n = 0; n < 2; ++n) _Pragma("unroll") for (int k = 0; k < 2; ++k) dst[n][k] = *(const LAS bf16x8*)(lds + PG8_SB(b, h) + boff + n * 2048 + k * 1024); } while (0)
#define PG8_MMA(ai, bj, At, Bt) do { __builtin_amdgcn_s_setprio(1); _Pragma("unroll") for (int m = 0; m < 4; ++m) _Pragma("unroll") for (int n = 0; n < 2; ++n) { \
        if constexpr (P::I8) { _Pragma("unroll") for (int k = 0; k < 2; ++k) acc[ai][bj][m][n] = __builtin_bit_cast(f32x4, __builtin_amdgcn_mfma_i32_16x16x64_i8(__builtin_bit_cast(v4i_t, Bt[n][k]), __builtin_bit_cast(v4i_t, At[m][k]), __builtin_bit_cast(v4i_t, acc[ai][bj][m][n]), 0, 0, 0)); }     \
        else if constexpr (P::FP8) { acc[ai][bj][m][n] = __builtin_amdgcn_mfma_scale_f32_16x16x128_f8f6f4(cat8(Bt[n][0], Bt[n][1]), cat8(At[m][0], At[m][1]), acc[ai][bj][m][n], 0, 0, 0, 0, 0, 0); }     \
        else { _Pragma("unroll") for (int k = 0; k < 2; ++k) acc[ai][bj][m][n] = __builtin_amdgcn_mfma_f32_16x16x32_bf16(Bt[n][k], At[m][k], acc[ai][bj][m][n], 0, 0, 0); } } \
        __builtin_amdgcn_s_setprio(0); } while (0)
#define PG8_WAIT_V(n) asm volatile("s_waitcnt vmcnt(" #n ")" ::: "memory")
#define PG8_WAIT_L(n) asm volatile("s_waitcnt lgkmcnt(" #n ")" ::: "memory")
#define PG8_BAR __builtin_amdgcn_s_barrier()
#define PG8_SCHED __builtin_amdgcn_sched_barrier(0)
    Unit cur, nxt; int ui = 0;
    if (!S.next(0, cur)) return;
    if constexpr (P::GATHER) S.a_off(cur, tid, vA);
    f32x4 acc[2][2][4][2];
#pragma unroll
    for (int a = 0; a < 2; ++a)
#pragma unroll
        for (int b = 0; b < 2; ++b)
#pragma unroll
            for (int m = 0; m < 4; ++m)
#pragma unroll
                for (int n = 0; n < 2; ++n) acc[a][b][m][n] = (f32x4){0.f, 0.f, 0.f, 0.f};
    bf16x8 At[4][2], B0[2][2], B1[2][2];
    const char* cA = S.a_ptr(cur); const char* cB = S.b_ptr(cur);
    PG8_STAGEB(PG8_SB(0, 0), cB); PG8_STAGEB(PG8_SB(0, 1), cB + hstepB); PG8_STAGE2(PG8_SA(0, 0), cA, vA[0][0], vA[0][1]); PG8_STAGE2(PG8_SA(0, 1), cA, vA[1][0], vA[1][1]);
    if (wr == 1) PG8_BAR;
    PG8_WAIT_V(2); PG8_BAR;
    PG8_STAGEB(PG8_SB(1, 0), cB + kstep); PG8_STAGE2(PG8_SA(1, 0), cA + kstep, vA[0][0], vA[0][1]); PG8_STAGEB(PG8_SB(1, 1), cB + hstepB + kstep);
    PG8_WAIT_V(6); PG8_BAR;
    for (;;) {
        const bool has_next = S.next(ui + 1, nxt);
        if constexpr (P::ROWDMA) S.row_dma(cur, lds, wid, lane);
        const char* nA = has_next ? S.a_ptr(nxt) : cA; const char* nB = has_next ? S.b_ptr(nxt) : cB;
        if constexpr (P::IDDMA) { if (has_next) S.ids_dma(nxt, cur, lds, wid, lane); }
        else if constexpr (P::GATHER) {
            unsigned vn[2][2];
            if (has_next) S.a_off(nxt, tid, vn);
            else { vn[0][0] = vA[0][0]; vn[0][1] = vA[0][1]; vn[1][0] = vA[1][0]; vn[1][1] = vA[1][1]; }
            *park = (u32x4){vn[0][0], vn[0][1], vn[1][0], vn[1][1]};
        }
#pragma nounroll
        for (int t = 0; t < nt; t += 2) {
            const bool last = (t == nt - 2);
            asm volatile("" : "+v"(vA[0][0]), "+v"(vA[0][1]), "+v"(vA[1][0]), "+v"(vA[1][1]), "+v"(voffB[0]), "+v"(voffB[1]));
            const char* a1 = cA + (size_t)(t + 1) * kstep;
            const char* a2 = last ? nA : cA + (size_t)(t + 2) * kstep; const char* b2 = last ? nB : cB + (size_t)(t + 2) * kstep;
            const char* a3 = a2 + kstep; const char* b3 = b2 + kstep;
            PG8_LDB(B0, 0, 0); PG8_LDB(B1, 0, 1); PG8_SCHED; PG8_LDA(At, 0, 0); PG8_STAGE2(PG8_SA(1, 1), a1, vA[1][0], vA[1][1]);
            if constexpr (P::IDDMA) { if (last && has_next) S.a_off_lds(nxt, cur, tid, lds, vA); }
            else if constexpr (P::GATHER) { if (last) { const u32x4 nv = *park; vA[0][0] = nv.x; vA[0][1] = nv.y; vA[1][0] = nv.z; vA[1][1] = nv.w; } }
            PG8_WAIT_V(8); PG8_WAIT_L(0); PG8_BAR; PG8_MMA(0, 0, At, B0); PG8_MMA(0, 1, At, B1); PG8_BAR; PG8_SCHED;
            PG8_LDA(At, 0, 1); PG8_STAGEB(PG8_SB(0, 0), b2); PG8_STAGEB(PG8_SB(0, 1), b2 + hstepB); PG8_STAGE2(PG8_SA(0, 0), a2, vA[0][0], vA[0][1]);
            PG8_WAIT_V(8); PG8_WAIT_L(0); PG8_BAR; PG8_MMA(1, 0, At, B0); PG8_MMA(1, 1, At, B1); PG8_BAR; PG8_SCHED;
            PG8_LDB(B0, 1, 0); PG8_LDB(B1, 1, 1); PG8_SCHED; PG8_LDA(At, 1, 0); PG8_STAGE2(PG8_SA(0, 1), a2, vA[1][0], vA[1][1]);
            PG8_WAIT_V(8); PG8_WAIT_L(0); PG8_BAR; PG8_MMA(0, 0, At, B0); PG8_MMA(0, 1, At, B1); PG8_BAR; PG8_SCHED;
            PG8_LDA(At, 1, 1); PG8_STAGEB(PG8_SB(1, 0), b3); PG8_STAGEB(PG8_SB(1, 1), b3 + hstepB); PG8_STAGE2(PG8_SA(1, 0), a3, vA[0][0], vA[0][1]);
            PG8_WAIT_V(8); PG8_WAIT_L(0); PG8_BAR; PG8_MMA(1, 0, At, B0); PG8_MMA(1, 1, At, B1); PG8_BAR; PG8_SCHED;
        }
        if (wr == 0) PG8_BAR;
        int fr_ = fr, fq_ = fq; asm volatile("" : "+v"(fr_), "+v"(fq_));
        const bool keep = S.epi(acc, cur, wr, wc, fr_, fq_);
        if (!has_next) break;
        if (!keep) {
#pragma unroll
            for (int a = 0; a < 2; ++a)
#pragma unroll
                for (int b = 0; b < 2; ++b)
#pragma unroll
                    for (int m = 0; m < 4; ++m)
#pragma unroll
                        for (int n = 0; n < 2; ++n) acc[a][b][m][n] = (f32x4){0.f, 0.f, 0.f, 0.f};
        }
        cur = nxt; cA = nA; cB = nB; ++ui;
        if (wr == 1) PG8_BAR;
    }
    PG8_WAIT_V(0);
    PG8_BAR;
#undef PG8_SA
#undef PG8_SB
#undef PG8_STAGE2
#undef PG8_STAGEB
#undef PG8_LDA
#undef PG8_LDB
#undef PG8_MMA
#undef PG8_WAIT_V
#undef PG8_WAIT_L
#undef PG8_BAR
#undef PG8_SCHED
}
}
using pg8::Unit;

__device__ __forceinline__ void st8(bf16* p, const f32x4& a, const f32x4& b) {
    u32x4 w; w.x = cvt_pk_bf16(a[0], a[1]); w.y = cvt_pk_bf16(a[2], a[3]); w.z = cvt_pk_bf16(b[0], b[1]); w.w = cvt_pk_bf16(b[2], b[3]);
    *(u32x4*)p = w;
}
__device__ __forceinline__ void ld8(const bf16* p, f32x4& a, f32x4& b) {
    const u32x4 w = *(const u32x4*)p;
    a = (f32x4){bflo(w.x), bfhi(w.x), bflo(w.y), bfhi(w.y)}; b = (f32x4){bflo(w.z), bfhi(w.z), bflo(w.w), bfhi(w.w)};
}

__device__ __forceinline__ void st8q(unsigned char* p, const f32x4& a, const f32x4& b) {
    int w0 = 0, w1 = 0;
    w0 = __builtin_amdgcn_cvt_pk_fp8_f32(a[0], a[1], w0, false); w0 = __builtin_amdgcn_cvt_pk_fp8_f32(a[2], a[3], w0, true);
    w1 = __builtin_amdgcn_cvt_pk_fp8_f32(b[0], b[1], w1, false); w1 = __builtin_amdgcn_cvt_pk_fp8_f32(b[2], b[3], w1, true);
    *(u32x2*)p = (u32x2){(unsigned)w0, (unsigned)w1};
}
constexpr float WQ_SCALE = 32.0f, WQ_INV = 1.0f / 32.0f;

struct PolIn {
    static constexpr int NT = 8, LDA = 512, LDB = 512; static constexpr bool GATHER = false, FP8 = false, I8 = true, ROWDMA = true, IDDMA = false;
    pg8::StaticOrder so; const unsigned char* A; const unsigned char* Bt; unsigned char* ws; const float* qg; const float* kg; const float* hs; const float* cs; LAS unsigned char* shm;
    __device__ bool next(int i, Unit& u) const { u.e = 0; u.s0 = 0; u.cnt = 0; u.idx = i; return so.tile(i, u.pm, u.pn); }
    __device__ __forceinline__ void row_dma(const Unit& u, LAS unsigned char* lds, int wid, int lane) const {
        const unsigned* src = (wid < 4) ? (const unsigned*)(hs + u.pm * 256 + 64 * wid + lane) : (const unsigned*)(cs + u.pn * 256 + 64 * (wid & 3) + lane);
        __builtin_amdgcn_global_load_lds(src, (LAS unsigned*)(lds + ROWS_OFF + (u.idx & 1) * ROWS_BUF + 256 * wid), 4, 0, 0);
    }
    __device__ const char* a_ptr(const Unit& u) const { return (const char*)(A + (size_t)u.pm * 256 * 1024); }
    __device__ const char* b_ptr(const Unit& u) const { return (const char*)(Bt + (size_t)u.pn * 256 * 1024); }
    __device__ void a_off(const Unit&, int, unsigned (&)[2][2]) const {}
    __device__ __forceinline__ bool epi(f32x4 (&acc)[2][2][4][2], const Unit& u, int wr, int wc, int fr, int fq) const {
        const int pn = u.pn;
        {
            const LAS float* hsr = (const LAS float*)(shm + ROWS_OFF + (u.idx & 1) * ROWS_BUF) + wr * 64 + fr;
            const LAS float* csp = (const LAS float*)(shm + ROWS_OFF + (u.idx & 1) * ROWS_BUF + 1024) + 64 * wc + 8 * fq;
            float hv[2][4]; f32x4 cv[2][2];
#pragma unroll
            for (int a = 0; a < 2; ++a)
#pragma unroll
                for (int m = 0; m < 4; ++m) hv[a][m] = hsr[a * 128 + m * 16];
#pragma unroll
            for (int b = 0; b < 2; ++b)
#pragma unroll
                for (int n = 0; n < 2; ++n) cv[b][n] = *(const LAS f32x4*)(csp + 32 * b + 4 * n);
#pragma unroll
            for (int a = 0; a < 2; ++a)
#pragma unroll
                for (int b = 0; b < 2; ++b)
#pragma unroll
                    for (int m = 0; m < 4; ++m)
#pragma unroll
                        for (int n = 0; n < 2; ++n) { const pg8::v4i_t ia = __builtin_bit_cast(pg8::v4i_t, acc[a][b][m][n]);
                            acc[a][b][m][n] = (f32x4){(float)ia.x, (float)ia.y, (float)ia.z, (float)ia.w} * hv[a][m] * cv[b][n]; }
        }
        int kind, ld, tcol; size_t off;
        if (pn < 2) { kind = 0; off = WS_Q; ld = AW; tcol = pn; }
        else if (pn < 4) { kind = 1; off = WS_K; ld = AW; tcol = pn - 2; }
        else if (pn < 6) { kind = 2; off = WS_V; ld = AW; tcol = pn - 4; }
        else if (pn < 8) { kind = 3; off = WS_UG; ld = SGW; tcol = pn - 6; }
        else if (pn < 10) { kind = 3; off = WS_VG; ld = SGW; tcol = pn - 8; }
        else if (pn < 14) { kind = 4; off = WS_GA; ld = D; tcol = pn - 10; }
        else { kind = 4; off = WS_GB; ld = D; tcol = pn - 14; }
        bf16* base = (bf16*)(ws + off) + tcol * 256 + 64 * wc + 8 * fq;
        const int row0 = u.pm * 256 + wr * 64 + fr;
        if (kind <= 1) {
            const float* g = (kind == 0 ? qg : kg) + 8 * fq;
            const float sc = (kind == 0) ? (0.125f * LOG2E) : 1.0f;
            f32x4 gv[2][2];
#pragma unroll
            for (int bj = 0; bj < 2; ++bj)
#pragma unroll
                for (int n = 0; n < 2; ++n) gv[bj][n] = *(const f32x4*)(g + 32 * bj + 4 * n) * sc;
#pragma unroll
            for (int ai = 0; ai < 2; ++ai)
#pragma unroll
                for (int m = 0; m < 4; ++m) {
                    float ss = 0.f;
#pragma unroll
                    for (int bj = 0; bj < 2; ++bj)
#pragma unroll
                        for (int n = 0; n < 2; ++n) { const f32x4 v = acc[ai][bj][m][n]; ss += (v[0] * v[0] + v[1] * v[1]) + (v[2] * v[2] + v[3] * v[3]); }
                    ss += __shfl_xor(ss, 16); ss += __shfl_xor(ss, 32);
                    const float rs = 1.0f / sqrtf(ss * (1.0f / 64.0f) + EPS);
                    bf16* rowp = base + (size_t)(row0 + ai * 128 + m * 16) * ld;
#pragma unroll
                    for (int bj = 0; bj < 2; ++bj) st8(rowp + 32 * bj, acc[ai][bj][m][0] * rs * gv[bj][0], acc[ai][bj][m][1] * rs * gv[bj][1]);
                }
        } else if (kind == 2) {
#pragma unroll
            for (int ai = 0; ai < 2; ++ai)
#pragma unroll
                for (int m = 0; m < 4; ++m) { bf16* rowp = base + (size_t)(row0 + ai * 128 + m * 16) * ld;
#pragma unroll
                    for (int bj = 0; bj < 2; ++bj) st8(rowp + 32 * bj, acc[ai][bj][m][0], acc[ai][bj][m][1]); }
        } else if (kind == 4) {
            unsigned char* b8 = ws + off + tcol * 256 + 64 * wc + 8 * fq;
#pragma unroll
            for (int ai = 0; ai < 2; ++ai)
#pragma unroll
                for (int m = 0; m < 4; ++m) { unsigned char* rowp = b8 + (size_t)(row0 + ai * 128 + m * 16) * ld;
#pragma unroll
                    for (int bj = 0; bj < 2; ++bj) st8q(rowp + 32 * bj, acc[ai][bj][m][0], acc[ai][bj][m][1]); }
        } else {
#pragma unroll
            for (int ai = 0; ai < 2; ++ai)
#pragma unroll
                for (int m = 0; m < 4; ++m) { bf16* rowp = base + (size_t)(row0 + ai * 128 + m * 16) * ld;
#pragma unroll
                    for (int bj = 0; bj < 2; ++bj) { f32x4 a = acc[ai][bj][m][0], b = acc[ai][bj][m][1];
#pragma unroll
                        for (int j = 0; j < 4; ++j) { a[j] = gelu_tanh(a[j]); b[j] = gelu_tanh(b[j]); }
                        st8(rowp + 32 * bj, a, b); } }
        }
        return false;
    }
};

struct PolMerge {
    static constexpr int NT = 8, LDA = D, LDB = D; static constexpr bool GATHER = false, FP8 = false, I8 = false, ROWDMA = false, IDDMA = false;
    pg8::StaticOrder so; const bf16* A; const bf16* Bt; const unsigned char* ga; const unsigned char* gb; bf16* out;
    __device__ bool next(int i, Unit& u) const { u.e = i & 1; u.s0 = 0; u.cnt = 0; return so.tile(i >> 1, u.pm, u.pn); }
    __device__ const char* a_ptr(const Unit& u) const { return (const char*)(A + (size_t)u.pm * 256 * LDA + 512 * u.e); }
    __device__ const char* b_ptr(const Unit& u) const { return (const char*)(Bt + (size_t)u.pn * 256 * LDB + 512 * u.e); }
    __device__ void a_off(const Unit&, int, unsigned (&)[2][2]) const {}
    __device__ __forceinline__ bool epi(f32x4 (&acc)[2][2][4][2], const Unit& u, int wr, int wc, int fr, int fq) const {
        const int row0 = u.pm * 256 + wr * 64 + fr, col0 = u.pn * 256 + 64 * wc + 8 * fq;
#pragma unroll
        for (int ai = 0; ai < 2; ++ai) {
            u32x2 gbv[4][2]; u32x2 gav[4][2];
#pragma unroll
            for (int m = 0; m < 4; ++m) { const size_t o = (size_t)(row0 + ai * 128 + m * 16) * D + col0;
#pragma unroll
                for (int bj = 0; bj < 2; ++bj) { gbv[m][bj] = *(const u32x2*)(gb + o + 32 * bj); if (u.e == 0) gav[m][bj] = *(const u32x2*)(ga + o + 32 * bj); } }
#pragma unroll
            for (int m = 0; m < 4; ++m) { const size_t o = (size_t)(row0 + ai * 128 + m * 16) * D + col0;
#pragma unroll
                for (int bj = 0; bj < 2; ++bj) {
                    const u32x2 wb = gbv[m][bj];
                    const f32x2 p0 = __builtin_amdgcn_cvt_pk_f32_fp8((int)wb.x, false), p1 = __builtin_amdgcn_cvt_pk_f32_fp8((int)wb.x, true), p2 = __builtin_amdgcn_cvt_pk_f32_fp8((int)wb.y, false), p3 = __builtin_amdgcn_cvt_pk_f32_fp8((int)wb.y, true);
                    const f32x4 b0 = (f32x4){p0[0], p0[1], p1[0], p1[1]}, b1 = (f32x4){p2[0], p2[1], p3[0], p3[1]};
                    if (u.e == 0) {
                        const u32x2 wa = gav[m][bj];
                        const f32x2 q0 = __builtin_amdgcn_cvt_pk_f32_fp8((int)wa.x, false), q1 = __builtin_amdgcn_cvt_pk_f32_fp8((int)wa.x, true), q2 = __builtin_amdgcn_cvt_pk_f32_fp8((int)wa.y, false), q3 = __builtin_amdgcn_cvt_pk_f32_fp8((int)wa.y, true);
                        const f32x4 a0 = (f32x4){q0[0], q0[1], q1[0], q1[1]}, a1 = (f32x4){q2[0], q2[1], q3[0], q3[1]};
#pragma unroll
                        for (int j = 0; j < 4; ++j) {
                            acc[ai][bj][m][0][j] *= (1.0f + fast_exp2(-LOG2E * b0[j])) * fast_rcp(1.0f + fast_exp2(-LOG2E * a0[j]));
                            acc[ai][bj][m][1][j] *= (1.0f + fast_exp2(-LOG2E * b1[j])) * fast_rcp(1.0f + fast_exp2(-LOG2E * a1[j])); }
                    } else {
                        f32x4 r0, r1;
#pragma unroll
                        for (int j = 0; j < 4; ++j) { r0[j] = acc[ai][bj][m][0][j] * sigmoidf_(b0[j]); r1[j] = acc[ai][bj][m][1][j] * sigmoidf_(b1[j]); }
                        st8(out + o + 32 * bj, r0, r1);
                    }
                } }
        }
        return u.e == 0;
    }
};

struct PolOut {
    static constexpr int NT = 16, LDA = D, LDB = D; static constexpr bool GATHER = false, FP8 = false, I8 = false, ROWDMA = false, IDDMA = false;
    pg8::StaticOrder so; const bf16* A; const bf16* Bt; const float* x; bf16* x1; unsigned char* x1q;
    __device__ bool next(int i, Unit& u) const { u.e = 0; u.s0 = 0; u.cnt = 0; return so.tile(i, u.pm, u.pn); }
    __device__ const char* a_ptr(const Unit& u) const { return (const char*)(A + (size_t)u.pm * 256 * LDA); }
    __device__ const char* b_ptr(const Unit& u) const { return (const char*)(Bt + (size_t)u.pn * 256 * LDB); }
    __device__ void a_off(const Unit&, int, unsigned (&)[2][2]) const {}
    __device__ __forceinline__ bool epi(f32x4 (&acc)[2][2][4][2], const Unit& u, int wr, int wc, int fr, int fq) const {
        const int row0 = u.pm * 256 + wr * 64 + fr, col0 = u.pn * 256 + 64 * wc + 8 * fq;
#pragma unroll
        for (int ai = 0; ai < 2; ++ai) {
            f32x4 xv[4][2][2];
#pragma unroll
            for (int m = 0; m < 4; ++m) { const size_t o = (size_t)(row0 + ai * 128 + m * 16) * D + col0;
#pragma unroll
                for (int bj = 0; bj < 2; ++bj) { xv[m][bj][0] = *(const f32x4*)(x + o + 32 * bj); xv[m][bj][1] = *(const f32x4*)(x + o + 32 * bj + 4); } }
#pragma unroll
            for (int m = 0; m < 4; ++m) { const size_t o = (size_t)(row0 + ai * 128 + m * 16) * D + col0;
#pragma unroll
                for (int bj = 0; bj < 2; ++bj) {
                    const f32x4 r0 = xv[m][bj][0] + acc[ai][bj][m][0], r1 = xv[m][bj][1] + acc[ai][bj][m][1];
                    st8(x1 + o + 32 * bj, r0, r1); st8q(x1q + o + 32 * bj, r0, r1);
                } }
        }
        return false;
    }
};

struct MoeOrder {
    const LAS int* tb;
    int NN, nwg, G, c;
    __device__ void init(const LAS int* tb_, int NN_, int G_, int c_) { tb = tb_; NN = NN_; G = G_; c = c_; nwg = tb_[32] * NN_; }
    __device__ bool unit(int i, Unit& u) const {
        const long L = (long)i * G + c; if (L >= nwg) return false;
        int wgid = (int)L; { const int q = nwg / 8, r = nwg % 8, xcd = wgid % 8, off = wgid / 8; wgid = (xcd < r ? xcd * (q + 1) : r * (q + 1) + (xcd - r) * q) + off; }
        const int Mt = wgid / NN;
        const int ln = threadIdx.x & 63;
        const unsigned long long bal = __ballot(ln < NE && tb[ln & 31] <= Mt);
        const int e = __popcll(bal) - 1;
        u.idx = i; u.pm = __builtin_amdgcn_readfirstlane(Mt); u.pn = __builtin_amdgcn_readfirstlane(wgid % NN); u.e = __builtin_amdgcn_readfirstlane(e);
        u.s0 = __builtin_amdgcn_readfirstlane((Mt - tb[e]) * 256); u.cnt = __builtin_amdgcn_readfirstlane(tb[33 + e]);
        return true;
    }
};

struct PolGU {
    static constexpr int NT = 8, LDA = 512, LDB = 512; static constexpr bool GATHER = true, FP8 = true, I8 = false, ROWDMA = true, IDDMA = true;
    MoeOrder mo; const unsigned char* A; const unsigned char* Bt; const int* lid; const float* lrs; const float* bgu; unsigned char* act; LAS unsigned char* shm;
    __device__ __forceinline__ void row_dma(const Unit& u, LAS unsigned char* lds, int wid, int lane) const {
        const unsigned* src = (wid < 4) ? (const unsigned*)(lrs + (size_t)u.e * LCAP + u.s0 + 64 * wid + lane)
                                        : (const unsigned*)(bgu + (size_t)u.e * 2048 + u.pn * 128 + 1024 * ((wid >> 1) & 1) + 64 * (wid & 1) + lane);
        __builtin_amdgcn_global_load_lds(src, (LAS unsigned*)(lds + ROWS_OFF + (u.idx & 1) * ROWS_BUF + 256 * wid), 4, 0, 0);
    }
    __device__ bool next(int i, Unit& u) const { return mo.unit(i, u); }
    __device__ __forceinline__ void ids_dma(const Unit& nx, const Unit& cu, LAS unsigned char* lds, int wid, int lane) const {
        if (wid < 4) __builtin_amdgcn_global_load_lds((const unsigned*)(lid + (size_t)nx.e * LCAP + nx.s0 + 64 * wid + lane), (LAS unsigned*)(lds + ROWS_OFF + (cu.idx & 1) * ROWS_BUF + 2048 + 256 * wid), 4, 0, 0);
    }
    __device__ __forceinline__ void a_off_lds(const Unit& nx, const Unit& cu, int tid, LAS unsigned char* lds, unsigned (&v)[2][2]) const {
        const LAS int* l = (const LAS int*)(lds + ROWS_OFF + (cu.idx & 1) * ROWS_BUF + 2048);
#pragma unroll
        for (int i = 0; i < 2; ++i) { int R, C; pg8::stage_rc(tid * 16 + i * 8192, R, C);
#pragma unroll
            for (int h = 0; h < 2; ++h) { const int s = h * 128 + R; const int id = l[s]; const int tok = (nx.s0 + s < nx.cnt) ? (id >> 2) : 0; v[h][i] = (unsigned)(tok * LDA + C) * 2u; } }
    }
    __device__ const char* a_ptr(const Unit&) const { return (const char*)A; }
    __device__ const char* b_ptr(const Unit& u) const { return (const char*)(Bt + ((size_t)u.e * 2048 + (size_t)u.pn * 256) * 1024); }
    __device__ __forceinline__ void a_off(const Unit& u, int tid, unsigned (&v)[2][2]) const {
        const int* l = lid + (size_t)u.e * LCAP;
#pragma unroll
        for (int i = 0; i < 2; ++i) { int R, C; pg8::stage_rc(tid * 16 + i * 8192, R, C);
#pragma unroll
            for (int h = 0; h < 2; ++h) { const int s = u.s0 + h * 128 + R; const int id = l[s]; const int tok = (s < u.cnt) ? (id >> 2) : 0; v[h][i] = (unsigned)(tok * LDA + C) * 2u; } }
    }
    __device__ __forceinline__ bool epi(f32x4 (&acc)[2][2][4][2], const Unit& u, int wr, int wc, int fr, int fq) const {
        const LAS float* rsl = (const LAS float*)(shm + ROWS_OFF + (u.idx & 1) * ROWS_BUF);
        const LAS float* bg = (const LAS float*)(shm + ROWS_OFF + (u.idx & 1) * ROWS_BUF + 1024) + 32 * wc + 8 * fq;
        const f32x4 bg0 = *(const LAS f32x4*)bg, bg1 = *(const LAS f32x4*)(bg + 4), bu0 = *(const LAS f32x4*)(bg + 128), bu1 = *(const LAS f32x4*)(bg + 132);
        unsigned char* ob = act + (size_t)u.pm * 256 * FF + u.pn * 128 + 32 * wc + 8 * fq;
        float rsv[2][4];
#pragma unroll
        for (int ai = 0; ai < 2; ++ai)
#pragma unroll
            for (int m = 0; m < 4; ++m) { const int r = ai * 128 + wr * 64 + m * 16 + fr; const bool valid = (u.s0 + r < u.cnt); const float t_ = rsl[r]; rsv[ai][m] = valid ? t_ * WQ_INV : 0.f; }
#pragma unroll
        for (int ai = 0; ai < 2; ++ai)
#pragma unroll
            for (int m = 0; m < 4; ++m) { const int r = ai * 128 + wr * 64 + m * 16 + fr; const float rs = rsv[ai][m];
                f32x4 o[2];
#pragma unroll
                for (int n = 0; n < 2; ++n)
#pragma unroll
                    for (int h2 = 0; h2 < 2; ++h2) {
                        const f32x2 ag = {acc[ai][0][m][n][2 * h2], acc[ai][0][m][n][2 * h2 + 1]}, au = {acc[ai][1][m][n][2 * h2], acc[ai][1][m][n][2 * h2 + 1]};
                        const f32x2 bgv = n ? (f32x2){bg1[2 * h2], bg1[2 * h2 + 1]} : (f32x2){bg0[2 * h2], bg0[2 * h2 + 1]}, buv = n ? (f32x2){bu1[2 * h2], bu1[2 * h2 + 1]} : (f32x2){bu0[2 * h2], bu0[2 * h2 + 1]};
                        f32x2 g = ag * rs + bgv, up = au * rs + buv;
                        g = __builtin_elementwise_min(g, (f32x2){7.0f, 7.0f});
                        up.x = __builtin_amdgcn_fmed3f(up.x, -7.0f, 7.0f); up.y = __builtin_amdgcn_fmed3f(up.y, -7.0f, 7.0f);
                        const f32x2 t = g * (-1.702f * LOG2E);
                        f32x2 e; e.x = fast_exp2(t.x); e.y = fast_exp2(t.y);
                        const f32x2 den = e + 1.0f;
                        f32x2 rc; rc.x = fast_rcp(den.x); rc.y = fast_rcp(den.y);
                        const f32x2 res = (up + 1.0f) * (g * rc);
                        o[n][2 * h2] = res.x; o[n][2 * h2 + 1] = res.y; }
                st8q(ob + (size_t)r * FF, o[0], o[1]); }
        return false;
    }
};

struct PolDown {
    static constexpr int NT = 8, LDA = 512, LDB = 512; static constexpr bool GATHER = true, FP8 = true, I8 = false, ROWDMA = true, IDDMA = false;
    MoeOrder mo; const unsigned char* A; const unsigned char* Bt; const int* lid; const float* lp; const float* bd; unsigned char* y; LAS unsigned char* shm;
    __device__ __forceinline__ void row_dma(const Unit& u, LAS unsigned char* lds, int wid, int lane) const {
        const size_t o = (size_t)u.e * LCAP + u.s0 + 64 * (wid & 3) + lane;
        const unsigned* src = (wid < 4) ? (const unsigned*)(lid + o) : (const unsigned*)(lp + o);
        __builtin_amdgcn_global_load_lds(src, (LAS unsigned*)(lds + ROWS_OFF + (u.idx & 1) * ROWS_BUF + 256 * wid), 4, 0, 0);
        if (wid < 4) __builtin_amdgcn_global_load_lds((const unsigned*)(bd + (size_t)u.e * D + u.pn * 256 + 64 * wid + lane), (LAS unsigned*)(lds + ROWS_OFF + (u.idx & 1) * ROWS_BUF + 2048 + 256 * wid), 4, 0, 0);
    }
    __device__ bool next(int i, Unit& u) const { return mo.unit(i, u); }
    __device__ const char* a_ptr(const Unit& u) const { return (const char*)(A + (size_t)u.pm * 256 * 1024); }
    __device__ const char* b_ptr(const Unit& u) const { return (const char*)(Bt + ((size_t)u.e * 1024 + (size_t)u.pn * 256) * 1024); }
    __device__ __forceinline__ void a_off(const Unit&, int tid, unsigned (&v)[2][2]) const {
#pragma unroll
        for (int i = 0; i < 2; ++i) { int R, C; pg8::stage_rc(tid * 16 + i * 8192, R, C); v[0][i] = (unsigned)(R * LDA + C) * 2u; v[1][i] = (unsigned)((R + 128) * LDA + C) * 2u; }
    }
    __device__ __forceinline__ bool epi(f32x4 (&acc)[2][2][4][2], const Unit& u, int wr, int wc, int fr, int fq) const {
        const LAS int* idl = (const LAS int*)(shm + ROWS_OFF + (u.idx & 1) * ROWS_BUF); const LAS float* pl = (const LAS float*)(shm + ROWS_OFF + (u.idx & 1) * ROWS_BUF + 1024);
        const int col0 = u.pn * 256 + 64 * wc + 8 * fq;
        const LAS float* b = (const LAS float*)(shm + ROWS_OFF + (u.idx & 1) * ROWS_BUF + 2048) + 64 * wc + 8 * fq;
        int idv[2][4]; float pv_[2][4];
#pragma unroll
        for (int ai = 0; ai < 2; ++ai)
#pragma unroll
            for (int m = 0; m < 4; ++m) { const int r = ai * 128 + wr * 64 + m * 16 + fr; const bool valid = (u.s0 + r < u.cnt);
                const int t_ = idl[r]; const float q_ = pl[r]; idv[ai][m] = valid ? t_ : T * 4; pv_[ai][m] = q_; }
        f32x4 bv[2][2];
#pragma unroll
        for (int bj = 0; bj < 2; ++bj)
#pragma unroll
            for (int n = 0; n < 2; ++n) bv[bj][n] = *(const LAS f32x4*)(b + 32 * bj + 4 * n);
#pragma unroll
        for (int ai = 0; ai < 2; ++ai)
#pragma unroll
            for (int m = 0; m < 4; ++m) { const float p = pv_[ai][m] * 16.0f; unsigned char* op = y + (size_t)idv[ai][m] * D + col0;
#pragma unroll
                for (int bj = 0; bj < 2; ++bj) st8q(op + 32 * bj, (acc[ai][bj][m][0] * WQ_INV + bv[bj][0]) * p, (acc[ai][bj][m][1] * WQ_INV + bv[bj][1]) * p); }
        return false;
    }
};

constexpr int CONV_GU_ITEMS = NE * 16 * 32, CONV_D_ITEMS = NE * 16 * 16, CONV_ITEMS = CONV_GU_ITEMS + CONV_D_ITEMS, CONV_PER_WAVE = CONV_ITEMS / 2048;
static_assert(CONV_PER_WAVE * 2048 == CONV_ITEMS, "items divide over 2048 waves");
struct MoeConv {
    const float* wgu; const float* wd; const float* g2; unsigned char* WGU8; unsigned char* WD8;
    struct Regs { f32x4 v0, v1, v2, v3, v4, v5, v6, v7, v8, v9, v10, v11, v12, v13, v14, v15; };
    __device__ __forceinline__ void src_of(int item, const float*& W, int& N, int& k0, int& n0) const {
        if (item < CONV_GU_ITEMS) { const int e = item >> 9, q = item & 511; W = wgu + (size_t)e * D * 2048; N = 2048; k0 = 64 * (q >> 5); n0 = 64 * (q & 31); }
        else { const int r = item - CONV_GU_ITEMS, e = r >> 8, q = r & 255; W = wd + (size_t)e * FF * D; N = D; k0 = 64 * (q >> 4); n0 = 64 * (q & 15); }
    }
    __device__ __forceinline__ void finish(Regs& R, int item, int lane) const {
        const float* W; int N, k0, n0; src_of(item, W, N, k0, n0);
        const int kc = lane >> 4, nq = lane & 15; const bool gu = item < CONV_GU_ITEMS;
        float sc[16];
        if (gu) { const f32x4* gp = (const f32x4*)(g2 + k0 + 16 * kc);
#pragma unroll
            for (int q = 0; q < 4; ++q) { const f32x4 t = gp[q]; sc[4 * q] = t[0] * 32.0f; sc[4 * q + 1] = t[1] * 32.0f; sc[4 * q + 2] = t[2] * 32.0f; sc[4 * q + 3] = t[3] * 32.0f; } }
        else {
#pragma unroll
            for (int i = 0; i < 16; ++i) sc[i] = 32.0f; }
        const int nb = n0 + 32 * (nq >> 3);
        const int e = gu ? (item >> 9) : ((item - CONV_GU_ITEMS) >> 8);
        const int up = nb >= 1024, cc = nb & 1023;
        const int pos = gu ? ((cc >> 7) * 256 + up * 128 + ((cc >> 5) & 3) * 32) : ((nb & ~255) + ((nb >> 5) & 1) * 128 + ((nb >> 6) & 3) * 32);
        unsigned char* base = (gu ? (WGU8 + ((size_t)e * 2048 + pos + ((4 * nq) & 31)) * 1024) : (WD8 + ((size_t)e * 1024 + pos + ((4 * nq) & 31)) * 1024)) + k0 + 16 * kc;
#pragma unroll
        for (int c = 0; c < 4; ++c) {
            int w0 = 0, w1 = 0, w2 = 0, w3 = 0;
            w0 = __builtin_amdgcn_cvt_pk_fp8_f32(R.v0[c] * sc[0], R.v1[c] * sc[1], w0, false); w0 = __builtin_amdgcn_cvt_pk_fp8_f32(R.v2[c] * sc[2], R.v3[c] * sc[3], w0, true);
            w1 = __builtin_amdgcn_cvt_pk_fp8_f32(R.v4[c] * sc[4], R.v5[c] * sc[5], w1, false); w1 = __builtin_amdgcn_cvt_pk_fp8_f32(R.v6[c] * sc[6], R.v7[c] * sc[7], w1, true);
            w2 = __builtin_amdgcn_cvt_pk_fp8_f32(R.v8[c] * sc[8], R.v9[c] * sc[9], w2, false); w2 = __builtin_amdgcn_cvt_pk_fp8_f32(R.v10[c] * sc[10], R.v11[c] * sc[11], w2, true);
            w3 = __builtin_amdgcn_cvt_pk_fp8_f32(R.v12[c] * sc[12], R.v13[c] * sc[13], w3, false); w3 = __builtin_amdgcn_cvt_pk_fp8_f32(R.v14[c] * sc[14], R.v15[c] * sc[15], w3, true);
            *(u32x4*)(base + (size_t)c * 1024) = (u32x4){(unsigned)w0, (unsigned)w1, (unsigned)w2, (unsigned)w3};
        }
    }
    template <int SUB> __device__ __forceinline__ void sub(Regs& R, int& st, int item0, int istride, int lane) const {
        if (SUB == 0 && (st & 1)) { finish(R, item0 + ((st >> 1) - 1) * istride, lane); st &= ~1; }
        const int it = st >> 1;
        if (it < CONV_PER_WAVE) {
            const float* W; int N, k0, n0; src_of(item0 + it * istride, W, N, k0, n0);
            const float* p = W + (size_t)(k0 + 16 * (lane >> 4) + 4 * SUB) * N + n0 + 4 * (lane & 15);
            const f32x4 t0 = *(const f32x4*)p, t1 = *(const f32x4*)(p + N), t2 = *(const f32x4*)(p + 2 * (size_t)N), t3 = *(const f32x4*)(p + 3 * (size_t)N);
            if (SUB == 0) { R.v0 = t0; R.v1 = t1; R.v2 = t2; R.v3 = t3; }
            else if (SUB == 1) { R.v4 = t0; R.v5 = t1; R.v6 = t2; R.v7 = t3; }
            else if (SUB == 2) { R.v8 = t0; R.v9 = t1; R.v10 = t2; R.v11 = t3; }
            else { R.v12 = t0; R.v13 = t1; R.v14 = t2; R.v15 = t3; st = ((it + 1) << 1) | 1; }
        }
    }
    __device__ __forceinline__ void drain(Regs& R, int& st, int item0, int istride, int lane) const {
        if (st & 1) { finish(R, item0 + ((st >> 1) - 1) * istride, lane); st &= ~1; }
        for (int it = st >> 1; it < CONV_PER_WAVE; ++it) { sub<0>(R, st, item0, istride, lane); sub<1>(R, st, item0, istride, lane); sub<2>(R, st, item0, istride, lane); sub<3>(R, st, item0, istride, lane);
            finish(R, item0 + it * istride, lane); st &= ~1; }
    }
};

namespace att {
constexpr int PITCH = 512, SLOTB = 8192;
constexpr int L_K = 0, L_V = 2 * SLOTB, L_TBL = 4 * SLOTB, L_WS = L_TBL + 4096, L_OST = L_WS + 8 * 256, L_END = L_OST + 8 * 4096;
constexpr int NTBL = 832;
__device__ __forceinline__ int crow(int r, int hi) { return (r & 3) + 8 * (r >> 2) + 4 * hi; }
__device__ __forceinline__ void glds16(const void* gsrc, unsigned lds_dst) { unsigned keep;
    asm volatile("s_mov_b32 %0, m0\n\ts_mov_b32 m0, %2\n\ts_nop 0\n\tglobal_load_lds_dwordx4 %1, off\n\ts_mov_b32 m0, %0" : "=&s"(keep) : "v"(gsrc), "s"(lds_dst) : "memory"); }
__device__ __forceinline__ unsigned cvtpk_s(float lo, float hi) { typedef __bf16 bf16x2_t __attribute__((ext_vector_type(2))); f32x2 v = {lo, hi}; bf16x2_t b = __builtin_convertvector(v, bf16x2_t); return __builtin_bit_cast(unsigned, b); }
#define ATT_SBAR() __builtin_amdgcn_sched_barrier(0)
__device__ __forceinline__ void pv(f32x16* o, int vb, bf16x8 pa0, bf16x8 pa1, bf16x8 pa2, bf16x8 pa3) {
#pragma unroll
    for (int d0 = 0; d0 < 2; ++d0) { s16x4 lo[4], hi[4];
#pragma unroll
        for (int ks = 0; ks < 4; ++ks) {
            asm volatile("ds_read_b64_tr_b16 %0,%1 offset:%c2" : "=&v"(lo[ks]) : "v"(vb), "i"(d0 * 4096 + ks * 1024) : "memory");
            asm volatile("ds_read_b64_tr_b16 %0,%1 offset:%c2" : "=&v"(hi[ks]) : "v"(vb), "i"(d0 * 4096 + ks * 1024 + 512) : "memory"); }
        asm volatile("s_waitcnt lgkmcnt(0)" ::: "memory"); ATT_SBAR();
#define ATT_PK(k) (bf16x8){lo[k][0], lo[k][1], lo[k][2], lo[k][3], hi[k][0], hi[k][1], hi[k][2], hi[k][3]}
        o[d0] = __builtin_amdgcn_mfma_f32_32x32x16_bf16(pa0, ATT_PK(0), o[d0], 0, 0, 0);
        o[d0] = __builtin_amdgcn_mfma_f32_32x32x16_bf16(pa1, ATT_PK(1), o[d0], 0, 0, 0);
        o[d0] = __builtin_amdgcn_mfma_f32_32x32x16_bf16(pa2, ATT_PK(2), o[d0], 0, 0, 0);
        o[d0] = __builtin_amdgcn_mfma_f32_32x32x16_bf16(pa3, ATT_PK(3), o[d0], 0, 0, 0);
#undef ATT_PK
    }
}
__device__ __forceinline__ void unit(int b, int h, int cg, const bf16* Q, const bf16* K, const bf16* V, const float* relb, bf16* O  , LAS unsigned char* shm,
                                     const MoeConv& cv, MoeConv::Regs& sreg, int& sctr, int item0, int istride) {
    const int tid = threadIdx.x, lane = tid & 63, r32 = lane & 31, hi = lane >> 5; const int wid = __builtin_amdgcn_readfirstlane(tid >> 6);
    const long rowbase = (long)b * SEQ; const int cq = 4 * cg + (wid >> 1), wq = wid & 1;
    const bf16* Qw = Q + (rowbase + 64 * cq + 32 * wq) * PITCH + h * HD;
    const unsigned lds0 = (unsigned)(uintptr_t)shm;
    LAS float* tbl = (LAS float*)(shm + L_TBL);
    LAS float* wsf = (LAS float*)(shm + L_WS) + wid * 64;
    for (int i = tid; i < NTBL; i += 512) tbl[i] = relb[h * NREL + (i < 512 ? i : 512)] * LOG2E;
    const int srow = tid >> 3, sc = tid & 7;
    const bf16* ksrc = K + (rowbase + srow) * PITCH + h * HD + sc * 8;
    const bf16* vsrc = V + (rowbase + srow) * PITCH + h * HD + sc * 8;
    const int kwr = L_K + sc * 1024 + ((srow ^ sc) << 4);
    const int vwr = L_V + (4 * (sc >> 2) + (srow >> 4)) * 1024 + (srow & 15) * 64 + (sc & 3) * 16;
    const int vb0 = (int)(lds0 + L_V) + ((lane >> 4) & 1) * 32 + (lane & 3) * 8 + (4 * hi + ((lane & 15) >> 2)) * 64;
    int kra[4];
#pragma unroll
    for (int d0 = 0; d0 < 4; ++d0) kra[d0] = L_K + (2 * d0 + hi) * 1024 + ((r32 ^ (2 * d0 + hi)) << 4);
    bf16x8 qr[4];
#pragma unroll
    for (int d0 = 0; d0 < 4; ++d0) qr[d0] = *reinterpret_cast<const bf16x8*>(&Qw[(long)r32 * PITCH + d0 * 16 + hi * 8]);
    f32x16 o[2]; o[0] = f32x16{}; o[1] = f32x16{}; float l_reg = 0.f;
    const int j0 = (8 - 4 * cg) > 0 ? (8 - 4 * cg) : 0;
    u32x4 kreg, vreg;
    { const long ro = (long)(4 * cg - 8 + j0) * 64 * PITCH; kreg = *(const u32x4*)(ksrc + ro); vreg = *(const u32x4*)(vsrc + ro); }
#define ATT_STEP(JX, SUBP) do { const int j = (JX); \
        const int s = (j - j0) & 1; \
        *(LAS u32x4*)(shm + kwr + s * SLOTB) = kreg; *(LAS u32x4*)(shm + vwr + s * SLOTB) = vreg; \
        if (j < 11) { const long ro = (long)(4 * cg - 8 + j + 1) * 64 * PITCH; kreg = *(const u32x4*)(ksrc + ro); vreg = *(const u32x4*)(vsrc + ro); } \
        asm volatile("s_waitcnt lgkmcnt(0)\n\ts_barrier" ::: "memory"); \
        cv.template sub<SUBP>(sreg, sctr, item0, istride, lane);     \
        const int d = (wid >> 1) + 8 - j; \
        if (d >= 0 && d <= 8) { \
            f32x16 p0 = f32x16{}, p1 = f32x16{}; \
            const LAS unsigned char* kbs = shm + s * SLOTB; \
        _Pragma("unroll") \
            for (int d0 = 0; d0 < 4; ++d0) { \
                const bf16x8 b0 = *(const LAS bf16x8*)(kbs + kra[d0]), b1 = *(const LAS bf16x8*)(kbs + kra[d0] + 512); \
                p0 = __builtin_amdgcn_mfma_f32_32x32x16_bf16(b0, qr[d0], p0, 0, 0, 0); p1 = __builtin_amdgcn_mfma_f32_32x32x16_bf16(b1, qr[d0], p1, 0, 0, 0); } \
            const LAS float* tb = tbl + (256 + 64 * d + 32 * wq + r32 - 4 * hi - 63); \
            float sacc = 0.f; \
        _Pragma("unroll") \
            for (int r = 0; r < 16; ++r) { const int c = (r & 3) + 8 * (r >> 2); \
                p0[r] = fast_exp2(p0[r] + tb[63 - c]); p1[r] = fast_exp2(p1[r] + tb[31 - c]); sacc += p0[r] + p1[r]; } \
            l_reg += sacc; \
            u32x4 pw0, pw1, pw2, pw3; \
            pw0 = (u32x4){cvtpk_s(p0[0], p0[1]), cvtpk_s(p0[2], p0[3]), cvtpk_s(p0[4], p0[5]), cvtpk_s(p0[6], p0[7])}; \
            pw1 = (u32x4){cvtpk_s(p0[8], p0[9]), cvtpk_s(p0[10], p0[11]), cvtpk_s(p0[12], p0[13]), cvtpk_s(p0[14], p0[15])}; \
            pw2 = (u32x4){cvtpk_s(p1[0], p1[1]), cvtpk_s(p1[2], p1[3]), cvtpk_s(p1[4], p1[5]), cvtpk_s(p1[6], p1[7])}; \
            pw3 = (u32x4){cvtpk_s(p1[8], p1[9]), cvtpk_s(p1[10], p1[11]), cvtpk_s(p1[12], p1[13]), cvtpk_s(p1[14], p1[15])}; \
            ATT_SBAR(); \
            pv(o, vb0 + s * SLOTB, __builtin_bit_cast(bf16x8, pw0), __builtin_bit_cast(bf16x8, pw1), __builtin_bit_cast(bf16x8, pw2), __builtin_bit_cast(bf16x8, pw3)); \
        } \
    } while (0)
    for (int jb = j0; jb < 12; jb += 4) { ATT_STEP(jb, 0); ATT_STEP(jb + 1, 1); ATT_STEP(jb + 2, 2); ATT_STEP(jb + 3, 3); }
#undef ATT_STEP
    asm volatile("s_waitcnt lgkmcnt(0)\n\ts_barrier" ::: "memory");
    { auto rr = __builtin_amdgcn_permlane32_swap(__float_as_uint(l_reg), __float_as_uint(l_reg), false, false); l_reg = __uint_as_float(rr[0]) + __uint_as_float(rr[1]); }
    if (hi == 0) wsf[32 + r32] = l_reg; asm volatile("s_waitcnt lgkmcnt(0)" ::: "memory");
    float rli[16];
#pragma unroll
    for (int r = 0; r < 16; ++r) rli[r] = fast_rcp(wsf[32 + crow(r, hi)]);
    bf16* Ow = O + (rowbase + 64 * cq + 32 * wq) * D + h * HD;
    { LAS bf16* stg = (LAS bf16*)(shm + L_OST) + wid * 2048;
#pragma unroll
        for (int r = 0; r < 16; ++r) { const int orow = crow(r, hi);
#pragma unroll
            for (int d0 = 0; d0 < 2; ++d0) stg[orow * 64 + d0 * 32 + r32] = (bf16)f2bf(o[d0][r] * rli[r]); }
        asm volatile("s_waitcnt lgkmcnt(0)" ::: "memory");
#pragma unroll
        for (int i = 0; i < 4; ++i) { const int row = i * 8 + (lane >> 3), ch = lane & 7; const u32x4 v = *(const LAS u32x4*)(stg + row * 64 + ch * 8); *(u32x4*)(Ow + (long)row * D + ch * 8) = v; } }
    asm volatile("s_waitcnt lgkmcnt(0)\n\ts_barrier" ::: "memory");
}
#undef ATT_SBAR
}

constexpr int SGU_WM_OFF = 128 * 136 * 2;
__device__ __forceinline__ void sgu_load_wm(int g, const bf16* WM, LAS unsigned char* shm) {
    const int tid = threadIdx.x, t = tid >> 2, c0 = (tid & 3) * 32;
    const bf16* src = WM + ((size_t)g * 128 + t) * 128 + c0;
#pragma unroll
    for (int q = 0; q < 4; ++q) *(LAS u32x4*)(shm + SGU_WM_OFF + (t * 136 + c0 + 8 * q) * 2) = *(const u32x4*)(src + 8 * q);
}
__device__ __forceinline__ void sgu_item(int item, const bf16* VG, const bf16* UG, const float* lng, const float* lnb, const float* sgb, bf16* YC, LAS unsigned char* shm,
                                         const MoeConv& cv, MoeConv::Regs& sreg, int& sctr, int item0, int istride) {
    const int tid = threadIdx.x, lane = tid & 63; const int wid = __builtin_amdgcn_readfirstlane(tid >> 6);
    const int g = item & 3, blk = item >> 2;
    const long t0 = (long)blk * 128;
    LAS bf16* vt = (LAS bf16*)shm;
    const LAS bf16* wmL = (const LAS bf16*)(shm + SGU_WM_OFF);
    const int ch = tid & 15, fr = lane & 15, fq = lane >> 4;
    u32x4 vraw[4];
#pragma unroll
    for (int it = 0; it < 4; ++it) vraw[it] = *(const u32x4*)(VG + (t0 + (tid >> 4) + 32 * it) * SGW + g * 128 + ch * 8);
    u32x2 uw[8]; float bs[8];
#pragma unroll
    for (int tt = 0; tt < 8; ++tt) { const int t = 16 * tt + fr; uw[tt] = *(const u32x2*)(UG + (size_t)(t0 + t) * SGW + g * 128 + 16 * wid + 4 * fq); bs[tt] = sgb[g * 128 + t]; }
    const f32x4 gA = *(const f32x4*)(lng + g * 128 + ch * 8), gB = *(const f32x4*)(lng + g * 128 + ch * 8 + 4);
    const f32x4 bA = *(const f32x4*)(lnb + g * 128 + ch * 8), bB = *(const f32x4*)(lnb + g * 128 + ch * 8 + 4);
#pragma unroll
    for (int it = 0; it < 4; ++it) {
        const int s = (tid >> 4) + 32 * it;
        const u32x4 w = vraw[it];
        f32x4 a = (f32x4){bflo(w.x), bfhi(w.x), bflo(w.y), bfhi(w.y)}, b = (f32x4){bflo(w.z), bfhi(w.z), bflo(w.w), bfhi(w.w)};
        float sum = (a[0] + a[1]) + (a[2] + a[3]) + (b[0] + b[1]) + (b[2] + b[3]);
        sum += __shfl_xor(sum, 1); sum += __shfl_xor(sum, 2); sum += __shfl_xor(sum, 4); sum += __shfl_xor(sum, 8);
        const float mean = sum * (1.0f / 128.0f);
        a = a - mean; b = b - mean;
        float q = (a[0] * a[0] + a[1] * a[1]) + (a[2] * a[2] + a[3] * a[3]) + (b[0] * b[0] + b[1] * b[1]) + (b[2] * b[2] + b[3] * b[3]);
        q += __shfl_xor(q, 1); q += __shfl_xor(q, 2); q += __shfl_xor(q, 4); q += __shfl_xor(q, 8);
        const float rstd = 1.0f / sqrtf(q * (1.0f / 128.0f) + EPS);
        a = a * rstd * gA + bA; b = b * rstd * gB + bB;
#pragma unroll
        for (int j = 0; j < 4; ++j) { vt[(j * 16 + ch) * 136 + s] = (bf16)f2bf(a[j]); vt[((4 + j) * 16 + ch) * 136 + s] = (bf16)f2bf(b[j]); }
    }
    asm volatile("s_waitcnt lgkmcnt(0)\n\ts_barrier" ::: "memory");
    f32x4 acc[8];
#pragma unroll
    for (int tt = 0; tt < 8; ++tt) acc[tt] = (f32x4){0.f, 0.f, 0.f, 0.f};
#pragma unroll
    for (int ks = 0; ks < 4; ++ks) {
        const bf16x8 a = *(const LAS bf16x8*)(vt + ((fr & 7) * 16 + 2 * wid + (fr >> 3)) * 136 + 32 * ks + 8 * fq);
#pragma unroll
        for (int tt = 0; tt < 8; ++tt) if (ks <= (tt >> 1)) {
            const bf16x8 bfrag = *(const LAS bf16x8*)(wmL + (16 * tt + fr) * 136 + 32 * ks + 8 * fq);
            acc[tt] = __builtin_amdgcn_mfma_f32_16x16x32_bf16(a, bfrag, acc[tt], 0, 0, 0); }
    }
#pragma unroll
    for (int tt = 0; tt < 8; ++tt) { const int t = 16 * tt + fr; const float b_ = bs[tt];
        const u32x2 u_ = uw[tt];
        u32x2 w; w.x = cvt_pk_bf16(bflo(u_.x) * (acc[tt][0] + b_), bfhi(u_.x) * (acc[tt][1] + b_)); w.y = cvt_pk_bf16(bflo(u_.y) * (acc[tt][2] + b_), bfhi(u_.y) * (acc[tt][3] + b_));
        *(u32x2*)(YC + (size_t)(t0 + t) * D + AW + g * 128 + 16 * wid + 4 * fq) = w; }
    asm volatile("s_waitcnt lgkmcnt(0)\n\ts_barrier" ::: "memory");
}

#define XB_TMO      128
#define XB_XCNT(j)  (256  + 64 * (j))
#define XB_XSUB(j)  (1280 + 64 * (j))
#define XB_XGEN(j)  (2304 + 64 * (j))
#define XB_TOP      3328
#define XB_TOPGEN   3392
#define XCD_BAR_WORDS 3456
#define XB_SPIN_CAP (1u << 18)
__device__ __forceinline__ unsigned xb_ld(unsigned* p)              { return __hip_atomic_load(p, __ATOMIC_RELAXED, __HIP_MEMORY_SCOPE_AGENT); }
__device__ __forceinline__ unsigned xb_add(unsigned* p, unsigned v) { return __hip_atomic_fetch_add(p, v, __ATOMIC_RELAXED, __HIP_MEMORY_SCOPE_AGENT); }
__device__ __forceinline__ unsigned xb_xcc_id() { return (unsigned)__builtin_amdgcn_s_getreg((3 << 11) | 20) & 0xFu; }
#define XB_SPIN(cond, bar) do { unsigned _sp = 0; while (cond) { __builtin_amdgcn_s_sleep(1); \
    if ((++_sp & 255u) == 0u) { if (xb_ld(&(bar)[XB_TMO])) break; if (_sp > XB_SPIN_CAP) { atomicAdd(&(bar)[XB_TMO], 1u); break; } } } } while (0)
struct XcdBarrier { unsigned* bar; unsigned x; volatile LAS unsigned* st; };
__device__ __forceinline__ XcdBarrier xcd_barrier_post(unsigned* bar, volatile LAS unsigned* st) {
    XcdBarrier b; b.bar = bar; b.x = xb_xcc_id(); b.st = st;
    if (threadIdx.x == 0) (void)xb_add(&bar[XB_XCNT(b.x)], 1u);
    return b;
}
__device__ __forceinline__ void xcd_barrier_complete(unsigned* bar, unsigned x, unsigned& nloc, unsigned& nx) {
    const unsigned G = gridDim.x * gridDim.y * gridDim.z;
    unsigned sum, cnt, mine, sp = 0u;
    for (;;) {
        sum = 0u; cnt = 0u; mine = 0u;
#pragma unroll
        for (unsigned j = 0; j < 16; ++j) { const unsigned c = xb_ld(&bar[XB_XCNT(j)]); sum += c; cnt += (c > 0u) ? 1u : 0u; mine = (j == x) ? c : mine; }
        if (sum == G) break;
        __builtin_amdgcn_s_sleep(1);
        if ((++sp & 255u) == 0u) { if (xb_ld(&bar[XB_TMO])) break; if (sp > XB_SPIN_CAP) { atomicAdd(&bar[XB_TMO], 1u); break; } }
    }
    nloc = mine > 0u ? mine : 1u; nx = cnt > 0u ? cnt : 1u;
}
__device__ __forceinline__ void xcd_barrier(const XcdBarrier& b) {
    asm volatile("s_waitcnt vmcnt(0)" ::: "memory");
    __syncthreads();
    if (threadIdx.x == 0) {
        unsigned* bar = b.bar;
        __builtin_amdgcn_s_waitcnt(0);
        unsigned nloc = b.st[0], nx = b.st[1];
        if (nloc == 0u) { xcd_barrier_complete(bar, b.x, nloc, nx); b.st[0] = nloc; b.st[1] = nx; }
        const unsigned old = xb_add(&bar[XB_XSUB(b.x)], 1u);
        const unsigned gen = old / nloc;
        if (old + 1u == (gen + 1u) * nloc) {
            __builtin_amdgcn_fence(__ATOMIC_RELEASE, "agent");
            asm volatile("s_waitcnt vmcnt(0)" ::: "memory");
            const unsigned og = xb_add(&bar[XB_TOP], 1u);
            const unsigned tg = og / nx;
            if (og + 1u == (tg + 1u) * nx) xb_add(&bar[XB_TOPGEN], 1u);
            else XB_SPIN(xb_ld(&bar[XB_TOPGEN]) == tg, bar);
            __builtin_amdgcn_fence(__ATOMIC_ACQUIRE, "agent");
            xb_add(&bar[XB_XGEN(b.x)], 1u);
            asm volatile("s_waitcnt vmcnt(0)" ::: "memory");
        } else {
            XB_SPIN(xb_ld(&bar[XB_XGEN(b.x)]) == gen, bar);
            __builtin_amdgcn_fence(__ATOMIC_ACQUIRE, "agent");
            asm volatile("s_waitcnt vmcnt(0)" ::: "memory");
        }
    }
    __syncthreads();
}

__device__ __forceinline__ float wave_sum(float v) {
#pragma unroll
    for (int o = 1; o < 64; o <<= 1) v += __shfl_xor(v, o);
    return v;
}
__device__ __forceinline__ int pos_gen(int n0) { return (n0 & ~255) + ((n0 >> 5) & 1) * 128 + ((n0 >> 6) & 3) * 32; }
__device__ __forceinline__ int pos_gu(int c0) { const int up = c0 >= 1024, cc = c0 & 1023; return (cc >> 7) * 256 + up * 128 + ((cc >> 5) & 3) * 32; }
__device__ __forceinline__ unsigned pack_i8(const f32x4& v) {
    const int a = (int)__builtin_rintf(v.x), b = (int)__builtin_rintf(v.y), c = (int)__builtin_rintf(v.z), d = (int)__builtin_rintf(v.w);
    return ((unsigned)a & 255u) | (((unsigned)b & 255u) << 8) | (((unsigned)c & 255u) << 16) | ((unsigned)d << 24);
}
__device__ __forceinline__ void win_absmax(const float* W, int k0, int n0, unsigned* cmax, unsigned* ccnt, int lane) {
    const int kc = lane >> 4, nq = lane & 15;
    f32x4 v[16];
#pragma unroll
    for (int i = 0; i < 16; ++i) v[i] = *(const f32x4*)(W + (size_t)(k0 + 16 * kc + i) * INW + n0 + 4 * nq);
    f32x4 mx = (f32x4){0.f, 0.f, 0.f, 0.f};
#pragma unroll
    for (int i = 0; i < 16; ++i) { mx.x = fmaxf(mx.x, fabsf(v[i].x)); mx.y = fmaxf(mx.y, fabsf(v[i].y)); mx.z = fmaxf(mx.z, fabsf(v[i].z)); mx.w = fmaxf(mx.w, fabsf(v[i].w)); }
#pragma unroll
    for (int c = 0; c < 4; ++c) { mx[c] = fmaxf(mx[c], __shfl_xor(mx[c], 16)); mx[c] = fmaxf(mx[c], __shfl_xor(mx[c], 32)); }
    if (kc == 0) {
#pragma unroll
        for (int c = 0; c < 4; ++c) (void)__hip_atomic_fetch_max(cmax + n0 + 4 * nq + c, __float_as_uint(mx[c]), RLX_AGENT);
    }
    asm volatile("s_waitcnt vmcnt(0)" ::: "memory");
    if (lane == 0) (void)__hip_atomic_fetch_add(ccnt, 1u, RLX_AGENT);
}
__device__ __forceinline__ void win_quant(const float* W, int k0, int n0, unsigned char* WT, unsigned* cmax, unsigned* ccnt, float* cs, bool write_cs, unsigned* tmo, int lane) {
    const int kc = lane >> 4, nq = lane & 15;
    f32x4 v[16];
#pragma unroll
    for (int i = 0; i < 16; ++i) v[i] = *(const f32x4*)(W + (size_t)(k0 + 16 * kc + i) * INW + n0 + 4 * nq);
    { unsigned sp = 0; while (__hip_atomic_load(ccnt, RLX_AGENT) < 16u) { __builtin_amdgcn_s_sleep(1);
        if ((++sp & 255u) == 0u) { if (__hip_atomic_load(tmo, RLX_AGENT)) break; if (sp > (1u << 18)) { atomicAdd(tmo, 1u); break; } } } }
    asm volatile("" ::: "memory");
    float sc[4];
#pragma unroll
    for (int c = 0; c < 4; ++c) { const float cm = __uint_as_float(__hip_atomic_load(cmax + n0 + 4 * nq + c, RLX_AGENT)); sc[c] = cm > 0.f ? 127.0f / cm : 0.f; if (write_cs && kc == 0) cs[n0 + 4 * nq + c] = cm * (1.0f / 127.0f); }
    const int nb = n0 + 32 * (nq >> 3);
    const int rowb = pos_gen(nb) + ((4 * nq) & 31);
#pragma unroll
    for (int c = 0; c < 4; ++c) {
        u32x4 o;
        o.x = pack_i8((f32x4){v[0][c], v[1][c], v[2][c], v[3][c]} * sc[c]); o.y = pack_i8((f32x4){v[4][c], v[5][c], v[6][c], v[7][c]} * sc[c]);
        o.z = pack_i8((f32x4){v[8][c], v[9][c], v[10][c], v[11][c]} * sc[c]); o.w = pack_i8((f32x4){v[12][c], v[13][c], v[14][c], v[15][c]} * sc[c]);
        *(u32x4*)(WT + (size_t)(rowb + c) * D + k0 + 16 * kc) = o;
    }
}
template <int MODE, int POSK>
__device__ __forceinline__ void tr_tile(const float* W, int N, int k0, int n0, unsigned char* WT, int ldt_bytes, int dk0, const float* ks, float wscale, int lane, int rowadj = 0) {
    const int kc = lane >> 4, nq = lane & 15;
    f32x4 v[16];
#pragma unroll
    for (int i = 0; i < 16; ++i) { const int kk = MODE ? (16 * kc + i) : (32 * (i >> 3) + 8 * kc + (i & 7)); v[i] = *(const f32x4*)(W + (size_t)(k0 + kk) * N + n0 + 4 * nq); }
    if (ks) {
#pragma unroll
        for (int i = 0; i < 16; ++i) { const int kk = MODE ? (16 * kc + i) : (32 * (i >> 3) + 8 * kc + (i & 7)); v[i] = v[i] * (ks[k0 + kk] * wscale); }
    } else if (MODE) {
#pragma unroll
        for (int i = 0; i < 16; ++i) v[i] = v[i] * wscale;
    }
    const int nb = n0 + 32 * (nq >> 3);
    const int rowb = (POSK ? pos_gu(nb) : pos_gen(nb)) + ((4 * nq) & 31) + rowadj;
#pragma unroll
    for (int c = 0; c < 4; ++c) {
        unsigned char* rp = WT + (size_t)(rowb + c) * ldt_bytes;
        if (MODE == 0) {
#pragma unroll
            for (int p = 0; p < 2; ++p) { u32x4 o; o.x = pk2(v[8 * p + 0][c], v[8 * p + 1][c]); o.y = pk2(v[8 * p + 2][c], v[8 * p + 3][c]); o.z = pk2(v[8 * p + 4][c], v[8 * p + 5][c]); o.w = pk2(v[8 * p + 6][c], v[8 * p + 7][c]);
                *(u32x4*)(rp + (size_t)(dk0 + 32 * p + 8 * kc) * 2) = o; }
        } else {
            int w0 = 0, w1 = 0, w2 = 0, w3 = 0;
            w0 = __builtin_amdgcn_cvt_pk_fp8_f32(v[0][c], v[1][c], w0, false); w0 = __builtin_amdgcn_cvt_pk_fp8_f32(v[2][c], v[3][c], w0, true);
            w1 = __builtin_amdgcn_cvt_pk_fp8_f32(v[4][c], v[5][c], w1, false); w1 = __builtin_amdgcn_cvt_pk_fp8_f32(v[6][c], v[7][c], w1, true);
            w2 = __builtin_amdgcn_cvt_pk_fp8_f32(v[8][c], v[9][c], w2, false); w2 = __builtin_amdgcn_cvt_pk_fp8_f32(v[10][c], v[11][c], w2, true);
            w3 = __builtin_amdgcn_cvt_pk_fp8_f32(v[12][c], v[13][c], w3, false); w3 = __builtin_amdgcn_cvt_pk_fp8_f32(v[14][c], v[15][c], w3, true);
            *(u32x4*)(rp + (size_t)(dk0 + 16 * kc)) = (u32x4){(unsigned)w0, (unsigned)w1, (unsigned)w2, (unsigned)w3};
        }
    }
}

struct Args { const float* in[20]; float* out; unsigned char* ws; int ph_lo, ph_hi, li, pad; };

__global__ void __launch_bounds__(512, 2) moe_block_fwd(Args args) {
    extern __shared__ __attribute__((aligned(16))) unsigned char lds_raw[];
    LAS unsigned char* lds = (LAS unsigned char*)lds_raw;
    volatile LAS unsigned* MISC = (volatile LAS unsigned*)(lds + MISC_OFF);
    const int tid = threadIdx.x, lane = tid & 63, wave = __builtin_amdgcn_readfirstlane(tid >> 6);
    const int G = gridDim.x, bx = blockIdx.x;
    const int vcu = (G % 8 == 0) ? (bx % 8) * (G / 8) + bx / 8 : bx;
    unsigned char* ws = args.ws;
    gu32* ctl = (gu32*)(ws + WS_CTL);
    const float* x = args.in[0]; const float* norm1_g = args.in[1]; const float* w_in = args.in[2]; const float* q_norm_g = args.in[3]; const float* k_norm_g = args.in[4];
    const float* rel_bias = args.in[5]; const float* sg_ln_g = args.in[6]; const float* sg_ln_b = args.in[7]; const float* sg_w = args.in[8]; const float* sg_b = args.in[9];
    const float* w_branch_a = args.in[10]; const float* w_branch_b = args.in[11]; const float* w_out = args.in[12]; const float* norm2_g = args.in[13];
    const float* router_w = args.in[14]; const float* router_b = args.in[15]; const float* w_gate_up = args.in[16]; const float* b_gate_up = args.in[17];
    const float* w_down = args.in[18]; const float* b_down = args.in[19];
    float* out = args.out;
    bf16* WIN = (bf16*)(ws + WS_WIN); unsigned char* WIN8 = ws + WS_WIN8; float* HS = (float*)(ws + WS_HS); float* CS = (float*)(ws + WS_CS); unsigned char* H8 = ws + WS_H8; bf16* WAB = (bf16*)(ws + WS_WAB); bf16* WO = (bf16*)(ws + WS_WO); bf16* WRH = (bf16*)(ws + WS_WR); bf16* WRL = (bf16*)(ws + WS_WR + 65536); bf16* WM = (bf16*)(ws + WS_WM);
    int* LID = (int*)(ws + WS_LID); float* LRS = (float*)(ws + WS_LRS); float* LP = (float*)(ws + WS_LP);
    unsigned char* WGU = ws + WS_WGU; unsigned char* WD = ws + WS_WD;
    bf16* HB = (bf16*)(ws + WS_H); bf16* QB = (bf16*)(ws + WS_Q); bf16* KB = (bf16*)(ws + WS_K); bf16* VB = (bf16*)(ws + WS_V);
    bf16* UG = (bf16*)(ws + WS_UG); bf16* VG = (bf16*)(ws + WS_VG); unsigned char* GA = ws + WS_GA; bf16* GB = (bf16*)(ws + WS_GB);
    bf16* YCAT = (bf16*)(ws + WS_YCAT); unsigned char* X1Q = ws + WS_X1B; bf16* X1H = (bf16*)(ws + WS_X1H); unsigned char* ACT = ws + WS_ACT; unsigned char* YB = ws + WS_Y;

    for (int u = tid; u < (LDS_BYTES - LDSCTL_OFF) / 4; u += 512) ((LAS unsigned*)(lds + LDSCTL_OFF))[u] = 0u;
    __syncthreads();
    XcdBarrier bar; bar.bar = (unsigned*)(ctl + CW_BAR); bar.x = 0; bar.st = nullptr;
    if (MK_N_LAUNCHES == 1) bar = xcd_barrier_post((unsigned*)(ctl + CW_BAR), MISC + 8);
    const int lo = args.ph_lo, hi = args.ph_hi;
#define IN(k) (lo <= (k) && (k) < hi)
#define SEAM(k) do { if (IN(k) && IN((k) + 1)) xcd_barrier(bar); } while (0)
#define REPS(k) for (int rep_ = 0; rep_ < ((REP_PHASE == (k)) ? 2 : 1); ++rep_)
#define REPSEAM(k) do { if (REP_PHASE == (k) && rep_ == 0) xcd_barrier(bar); } while (0)
    const int gw = vcu * 8 + wave, NGW = G * 8;

    if (IN(0)) REPS(0) {
        constexpr int I_IN = 16 * 72, I_A = 8 * 16, I_O = 16 * 16, I_GU = 16 * 32, I_D = 16 * 16;
        constexpr int NITEMS = I_IN + 2 * I_A + I_O;
        for (int it = gw; it < NITEMS; it += NGW) {
            int r = it;
            if (r < I_IN) { const int kb = r / 72, nb = r % 72; win_absmax(w_in, 64 * kb, 64 * nb, (unsigned*)(ctl + CW_CMAX), (unsigned*)(ctl + CW_CCNT + nb), lane); continue; } r -= I_IN;
            if (r < I_A) { const int kb = r / 16, nb = r % 16; tr_tile<0, 0>(w_branch_a, D, 64 * kb, 64 * nb, (unsigned char*)WAB, D * 2, 64 * kb, nullptr, 1.f, lane); continue; } r -= I_A;
            if (r < I_A) { const int kb = r / 16, nb = r % 16; tr_tile<0, 0>(w_branch_b, D, 64 * kb, 64 * nb, (unsigned char*)WAB, D * 2, 512 + 64 * kb, nullptr, 1.f, lane); continue; } r -= I_A;
            { const int kb = r / 16, nb = r % 16; tr_tile<0, 0>(w_out, D, 64 * kb, 64 * nb, (unsigned char*)WO, D * 2, 64 * kb, nullptr, 1.f, lane); }
        }
        for (int i = gw * 64 + lane; i < 4 * 128 * 128; i += NGW * 64) { const int s = i & 127, t = (i >> 7) & 127; WM[i] = (bf16)f2bf(s <= t ? sg_w[i] : 0.f); }
        for (int i = gw * 64 + lane; i < NE * D; i += NGW * 64) { const int k = i & 1023, e = i >> 10; const float w = router_w[k * NE + e] * norm2_g[k]; const unsigned h_ = f2bf(w); WRH[i] = (bf16)h_; WRL[i] = (bf16)f2bf(w - bf2f((unsigned short)h_)); }
        for (int m = 2 * gw; m < T; m += 2 * NGW) {
            const f32x4* xr = (const f32x4*)(x + (size_t)m * D) + lane; const f32x4* gr = (const f32x4*)norm1_g + lane;
            f32x4 v[2][4]; float s0 = 0.f, s1 = 0.f, a0 = 0.f, a1 = 0.f;
#pragma unroll
            for (int j = 0; j < 4; ++j) { v[0][j] = xr[64 * j]; v[1][j] = xr[256 + 64 * j]; }
#pragma unroll
            for (int j = 0; j < 4; ++j) { const f32x4 gq = gr[64 * j];
                s0 += (v[0][j].x * v[0][j].x + v[0][j].y * v[0][j].y) + (v[0][j].z * v[0][j].z + v[0][j].w * v[0][j].w);
                s1 += (v[1][j].x * v[1][j].x + v[1][j].y * v[1][j].y) + (v[1][j].z * v[1][j].z + v[1][j].w * v[1][j].w);
                v[0][j] = v[0][j] * gq; v[1][j] = v[1][j] * gq;
                a0 = fmaxf(a0, fmaxf(fmaxf(fabsf(v[0][j].x), fabsf(v[0][j].y)), fmaxf(fabsf(v[0][j].z), fabsf(v[0][j].w))));
                a1 = fmaxf(a1, fmaxf(fmaxf(fabsf(v[1][j].x), fabsf(v[1][j].y)), fmaxf(fabsf(v[1][j].z), fabsf(v[1][j].w)))); }
            s0 = wave_sum(s0); s1 = wave_sum(s1);
#pragma unroll
            for (int o = 1; o < 64; o <<= 1) { a0 = fmaxf(a0, __shfl_xor(a0, o)); a1 = fmaxf(a1, __shfl_xor(a1, o)); }
            const float rs0 = 1.0f / sqrtf(s0 * (1.0f / D) + EPS), rs1 = 1.0f / sqrtf(s1 * (1.0f / D) + EPS);
            const float q0 = a0 > 0.f ? 127.0f / a0 : 0.f, q1 = a1 > 0.f ? 127.0f / a1 : 0.f;
            if (lane == 0) { HS[m] = rs0 * a0 * (1.0f / 127.0f); HS[m + 1] = rs1 * a1 * (1.0f / 127.0f); }
            unsigned* q8 = (unsigned*)(H8 + (size_t)m * D) + lane;
#pragma unroll
            for (int j = 0; j < 4; ++j) { q8[64 * j] = pack_i8(v[0][j] * q0); q8[256 + 64 * j] = pack_i8(v[1][j] * q1); }
        }
        for (int it = gw; it < I_IN; it += NGW) { const int kb = it / 72, nb = it % 72;
            win_quant(w_in, 64 * kb, 64 * nb, WIN8, (unsigned*)(ctl + CW_CMAX), (unsigned*)(ctl + CW_CCNT + nb), CS, kb == 0, (unsigned*)(ctl + CW_BAR) + XB_TMO, lane); }
        REPSEAM(0);
    }
    SEAM(0);

    if (IN(1)) REPS(1) {
        { PolIn P; P.so.init(T, INW, G, bx); P.A = H8; P.Bt = WIN8; P.ws = ws; P.qg = q_norm_g; P.kg = k_norm_g; P.hs = HS; P.cs = CS; P.shm = lds;
          pg8::gemm_phase<PolIn>(lds, P); }
        REPSEAM(1);
    }
    SEAM(1);

    if (IN(2)) REPS(2) {
        const MoeConv cv{w_gate_up, w_down, norm2_g, WGU, WD}; MoeConv::Regs sreg; int sctr = 0;
        for (int u = vcu; u < NB * NHEAD * 32; u += G) {
            const int cg = u & 31, bh = u >> 5;
            att::unit(bh >> 3, bh & 7, cg, QB, KB, VB, rel_bias, YCAT, lds, cv, sreg, sctr, gw, NGW);
        }
        sgu_load_wm(vcu & 3, WM, lds);
        for (int it = vcu; it < 4 * (T / 128); it += G) sgu_item(it, VG, UG, sg_ln_g, sg_ln_b, sg_b, YCAT, lds, cv, sreg, sctr, gw, NGW);
        cv.drain(sreg, sctr, gw, NGW, lane);
        REPSEAM(2);
    }
    SEAM(2);

    if (IN(3)) REPS(3) {
        PolMerge P; P.so.init(T, D, G, bx); P.A = YCAT; P.Bt = WAB; P.ga = GA; P.gb = (const unsigned char*)GB; P.out = HB;
        pg8::gemm_phase<PolMerge>(lds, P);
        REPSEAM(3);
    }
    SEAM(3);

    if (IN(4)) REPS(4) {
        PolOut P; P.so.init(T, D, G, bx); P.A = HB; P.Bt = WO; P.x = x; P.x1 = X1H; P.x1q = X1Q;
        pg8::gemm_phase<PolOut>(lds, P);
        REPSEAM(4);
    }
    SEAM(4);

    if (IN(5)) {
        LAS int* lcnt = (LAS int*)(lds + PARK_OFF); LAS int* gbase = lcnt + 32;
        if (tid < 64) lcnt[tid] = 0;
        for (int i = tid; i < 4096; i += 512) { const int e = i & 31, gq = (i >> 5) & 3, kq = i >> 7;
            *(LAS u32x4*)(lds + (size_t)i * 16) = *(const u32x4*)(WRH + (size_t)e * D + 32 * kq + 8 * gq); *(LAS u32x4*)(lds + 65536 + (size_t)i * 16) = *(const u32x4*)(WRL + (size_t)e * D + 32 * kq + 8 * gq); }
        __syncthreads();
        const int r = lane & 15, g = lane >> 4;
        int sel_e[4], sel_rank[4]; float sel_p[4]; float rs_row = 0.f; int tok = 0;
        for (int grp = bx * 8 + wave; grp < T / 16; grp += NGW) {
            const int row0 = grp * 16; tok = row0 + r;
            const bf16* xr = X1H + (size_t)(row0 + r) * D + 8 * g;
            const LAS unsigned char* wl_ = lds + (g * 32 + r) * 16;
            f32x4 a0 = (f32x4){0.f, 0.f, 0.f, 0.f}, a1 = a0; float ssq = 0.f;
            u32x4 xq[4][4];
#define P5_LOAD(S, ss) do { _Pragma("unroll") for (int q = 0; q < 4; ++q) xq[S][q] = *(const u32x4*)(xr + 128 * (ss) + 32 * q); } while (0)
#define P5_COMP(S, ss) do { _Pragma("unroll") for (int q = 0; q < 4; ++q) { const u32x4 w_ = xq[S][q]; const int ks = 4 * (ss) + q; \
                const bf16x8 wh_0 = *(const LAS bf16x8*)(wl_ + ks * 2048), wh_1 = *(const LAS bf16x8*)(wl_ + ks * 2048 + 256), wl_0 = *(const LAS bf16x8*)(wl_ + 65536 + ks * 2048), wl_1 = *(const LAS bf16x8*)(wl_ + 65536 + ks * 2048 + 256); \
                ssq += (bflo(w_.x) * bflo(w_.x) + bfhi(w_.x) * bfhi(w_.x)) + (bflo(w_.y) * bflo(w_.y) + bfhi(w_.y) * bfhi(w_.y)) + (bflo(w_.z) * bflo(w_.z) + bfhi(w_.z) * bfhi(w_.z)) + (bflo(w_.w) * bflo(w_.w) + bfhi(w_.w) * bfhi(w_.w)); \
                const bf16x8 xh = __builtin_bit_cast(bf16x8, w_); \
                a0 = __builtin_amdgcn_mfma_f32_16x16x32_bf16(wh_0, xh, a0, 0, 0, 0); a1 = __builtin_amdgcn_mfma_f32_16x16x32_bf16(wh_1, xh, a1, 0, 0, 0); \
                a0 = __builtin_amdgcn_mfma_f32_16x16x32_bf16(wl_0, xh, a0, 0, 0, 0); a1 = __builtin_amdgcn_mfma_f32_16x16x32_bf16(wl_1, xh, a1, 0, 0, 0); } } while (0)
            P5_LOAD(0, 0); P5_LOAD(1, 1); P5_LOAD(2, 2); P5_LOAD(3, 3);
            P5_COMP(0, 0); P5_LOAD(0, 4);
            P5_COMP(1, 1); P5_LOAD(1, 5);
            P5_COMP(2, 2); P5_LOAD(2, 6);
            P5_COMP(3, 3); P5_LOAD(3, 7);
            P5_COMP(0, 4); P5_COMP(1, 5); P5_COMP(2, 6); P5_COMP(3, 7);
#undef P5_LOAD
#undef P5_COMP
            ssq += __shfl_xor(ssq, 16); ssq += __shfl_xor(ssq, 32);
            const float rs = 1.0f / sqrtf(ssq * (1.0f / D) + EPS); rs_row = rs;
            float v[8];
#pragma unroll
            for (int j = 0; j < 4; ++j) { v[j] = a0[j] * rs + router_b[4 * g + j]; v[4 + j] = a1[j] * rs + router_b[16 + 4 * g + j]; }
            unsigned taken = 0u; float sel_v[4];
#pragma unroll
            for (int k = 0; k < 4; ++k) {
                float best = -INFINITY; int bi = 1 << 20;
#pragma unroll
                for (int i = 0; i < 8; ++i) { const int ei = (i >> 2) * 16 + 4 * g + (i & 3); if (!((taken >> i) & 1u) && v[i] > best) { best = v[i]; bi = ei; } }
#pragma unroll
                for (int m = 16; m <= 32; m <<= 1) { const float ob = __shfl_xor(best, m); const int oi = __shfl_xor(bi, m); if (ob > best || (ob == best && oi < bi)) { best = ob; bi = oi; } }
                sel_e[k] = bi; sel_v[k] = best;
                if (((bi & 15) >> 2) == g) taken |= 1u << (((bi >> 4) << 2) | (bi & 3));
            }
            float den = 0.f;
#pragma unroll
            for (int k = 0; k < 4; ++k) { sel_p[k] = __expf(sel_v[k] - sel_v[0]); den += sel_p[k]; }
            const float inv = 1.0f / den;
#pragma unroll
            for (int k = 0; k < 4; ++k) sel_p[k] *= inv;
            if (g == 0) {
#pragma unroll
                for (int k = 0; k < 4; ++k) sel_rank[k] = __hip_atomic_fetch_add(lcnt + sel_e[k], 1, __ATOMIC_RELAXED, __HIP_MEMORY_SCOPE_WORKGROUP);
            }
        }
        __syncthreads();
        if (tid < NE) gbase[tid] = (int)__hip_atomic_fetch_add((unsigned*)(ctl + CW_CNT + tid), (unsigned)lcnt[tid], RLX_AGENT);
        __syncthreads();
        if (g == 0 && (bx * 8 + wave) < T / 16) {
#pragma unroll
            for (int k = 0; k < 4; ++k) { const size_t pos = (size_t)sel_e[k] * LCAP + gbase[sel_e[k]] + sel_rank[k];
                LID[pos] = tok * 4 + k; LRS[pos] = rs_row; LP[pos] = sel_p[k]; }
        }
        __syncthreads();
    }
    SEAM(5);

    if (IN(6) || IN(7)) {
        LAS int* tb = (LAS int*)(lds + MOE_OFF);
        if (tid < NE) tb[33 + tid] = (int)__hip_atomic_load(ctl + CW_CNT + tid, RLX_AGENT);
        __syncthreads();
        if (tid == 0) { int acc = 0; for (int e = 0; e < NE; ++e) { tb[e] = acc; acc += (tb[33 + e] + 255) >> 8; } tb[32] = acc; }
        __syncthreads();
    }
    if (IN(6)) REPS(6) {
        PolGU P; P.mo.init((const LAS int*)(lds + MOE_OFF), 8, G, bx); P.A = X1Q; P.Bt = WGU; P.lid = LID; P.lrs = LRS; P.bgu = b_gate_up; P.act = ACT; P.shm = lds;
        pg8::gemm_phase<PolGU>(lds, P);
        REPSEAM(6);
    }
    SEAM(6);
    if (IN(7)) REPS(7) {
        PolDown P; P.mo.init((const LAS int*)(lds + MOE_OFF), 4, G, bx); P.A = ACT; P.Bt = WD; P.lid = LID; P.lp = LP; P.bd = b_down; P.y = YB; P.shm = lds;
        pg8::gemm_phase<PolDown>(lds, P);
        REPSEAM(7);
    }
    SEAM(7);
    if (IN(8)) {
        f32x4 xa[4], xb[4]; u32x4 ya[4], yb[4];
#define P8_LOAD(X, Y, m_) do { const bf16* xr_ = X1H + (size_t)(m_) * D + 16 * lane; { f32x4 a_, b_; ld8(xr_, a_, b_); X[0] = a_; X[1] = b_; ld8(xr_ + 8, a_, b_); X[2] = a_; X[3] = b_; } \
            _Pragma("unroll") for (int k = 0; k < 4; ++k) Y[k] = *(const u32x4*)(YB + ((size_t)(m_) * 4 + k) * D + 16 * lane); } while (0)
#define P8_DONE(X, Y, m_) do { _Pragma("unroll") for (int k = 0; k < 4; ++k) { const unsigned ww[4] = {Y[k].x, Y[k].y, Y[k].z, Y[k].w}; \
            _Pragma("unroll") for (int q = 0; q < 4; ++q) { const f32x2 lo_ = __builtin_amdgcn_cvt_pk_f32_fp8((int)ww[q], false), hi_ = __builtin_amdgcn_cvt_pk_f32_fp8((int)ww[q], true); \
                X[q][0] += lo_[0] * 0.0625f; X[q][1] += lo_[1] * 0.0625f; X[q][2] += hi_[0] * 0.0625f; X[q][3] += hi_[1] * 0.0625f; } } \
            float* or_ = out + (size_t)(m_) * D + 16 * lane; _Pragma("unroll") for (int j = 0; j < 4; ++j) *(f32x4*)(or_ + 4 * j) = X[j]; } while (0)
        for (int m = gw; m < T; m += 2 * NGW) { const int m2 = m + NGW;
            P8_LOAD(xa, ya, m); P8_LOAD(xb, yb, m2);
            P8_DONE(xa, ya, m); P8_DONE(xb, yb, m2); }
#undef P8_LOAD
#undef P8_DONE
    }
#undef IN
#undef SEAM
}

extern "C" void kernel_launch(void* const* d_in, const int* in_sizes, int n_in, void* d_out, int out_size, void* d_ws, size_t ws_size, hipStream_t stream) {
    static int grid = 0;
    if (grid == 0) {
        if (n_in != 20 || in_sizes[0] != T * D || out_size != T * D || ws_size < WS_END) { fprintf(stderr, "kernel_launch: unexpected shapes (n_in %d, ws %zu)\n", n_in, ws_size); grid = -1; return; }
        int dev = 0, cus = 0;
        if (hipGetDevice(&dev) != hipSuccess || hipDeviceGetAttribute(&cus, hipDeviceAttributeMultiprocessorCount, dev) != hipSuccess) { grid = -1; return; }
        if (hipFuncSetAttribute((const void*)moe_block_fwd, hipFuncAttributeMaxDynamicSharedMemorySize, LDS_BYTES) != hipSuccess) { fprintf(stderr, "kernel_launch: hipFuncSetAttribute failed\n"); grid = -1; return; }
        (void)hipGetLastError();
        grid = cus;
        if (grid != 256) { fprintf(stderr, "kernel_launch: built for a 256-CU device, got %d\n", cus); grid = -1; return; }
    }
    if (grid < 0) return;
    if (hipMemsetAsync((char*)d_ws + WS_CTL, 0, CTL_ZERO_BYTES, stream) != hipSuccess) return;
    Args a{};
    for (int i = 0; i < 20; ++i) a.in[i] = (const float*)d_in[i];
    a.out = (float*)d_out; a.ws = (unsigned char*)d_ws;
    constexpr int NPH = 9;
    for (int li = 0; li < MK_N_LAUNCHES; ++li) {
        a.ph_lo = (MK_N_LAUNCHES == 1) ? 0 : li; a.ph_hi = (MK_N_LAUNCHES == 1) ? NPH : li + 1; a.li = li;
        hipLaunchKernelGGL(moe_block_fwd, dim3(grid), dim3(512), LDS_BYTES, stream, a);
    }
}
```

```cpp
#include <hip/hip_runtime.h>
#include <cstdio>
#include <cstdint>

#ifndef MK_N_LAUNCHES
#define MK_N_LAUNCHES 1
#endif

#ifndef REP_PHASE
#define REP_PHASE -1
#endif
#define LAS __attribute__((address_space(3)))
#define GAS __attribute__((address_space(1)))
typedef unsigned short bf16;
typedef short bf16x8 __attribute__((ext_vector_type(8)));
typedef short s16x4 __attribute__((ext_vector_type(4)));
typedef float f32x2 __attribute__((ext_vector_type(2)));
typedef float f32x4 __attribute__((ext_vector_type(4)));
typedef float f32x16 __attribute__((ext_vector_type(16)));
typedef unsigned u32x2 __attribute__((ext_vector_type(2)));
typedef unsigned u32x4 __attribute__((ext_vector_type(4)));
typedef GAS unsigned gu32;

constexpr int NB = 4, SEQ = 8192, T = NB * SEQ, D = 1024, AW = 512, SGW = 512, INW = 4608, NE = 32, FF = 1024;
constexpr int NHEAD = 8, HD = 64, CHUNK = 64, NBACK = 8, NREL = 513;
constexpr int LCAP = 32768;
constexpr float LOG2E = 1.4426950408889634f;
constexpr float EPS = 1e-6f;

constexpr size_t MiB = 1u << 20;
constexpr size_t WS_CTL = 0, CTL_ZERO_BYTES = 1 * MiB;
constexpr size_t WS_WIN = 7 * MiB;
constexpr size_t WS_WAB = 11 * MiB;
constexpr size_t WS_WO = 13 * MiB;
constexpr size_t WS_WR = 15 * MiB;
constexpr size_t WS_WM = 15 * MiB + 256 * 1024;
constexpr size_t WS_WIN8 = 2 * MiB;
constexpr size_t WS_HS = 15 * MiB + 512 * 1024;
constexpr size_t WS_CS = 15 * MiB + 768 * 1024;
constexpr size_t WS_H8 = 976 * MiB;
constexpr size_t WS_LID = 16 * MiB;
constexpr size_t WS_LRS = 20 * MiB;
constexpr size_t WS_LP = 24 * MiB;
constexpr size_t WS_WGU = 28 * MiB;
constexpr size_t WS_WD = 156 * MiB;
constexpr size_t WS_H = 220 * MiB;
constexpr size_t WS_Q = 284 * MiB, WS_K = 316 * MiB, WS_V = 348 * MiB;
constexpr size_t WS_UG = 380 * MiB, WS_VG = 412 * MiB;
constexpr size_t WS_GA = 444 * MiB, WS_GB = 508 * MiB;
constexpr size_t WS_YCAT = 572 * MiB;
constexpr size_t WS_X1B = 636 * MiB;
constexpr size_t WS_ACT = 700 * MiB;
constexpr size_t WS_X1H = 380 * MiB;
constexpr size_t WS_Y = 220 * MiB;
constexpr size_t WS_END = 1008 * MiB;
constexpr int CW_TMO = 0, CW_CODE = 1;
constexpr int CW_CNT = 64;
constexpr int CW_BAR = 4096;
constexpr int CW_CMAX = 8192;
constexpr int CW_CCNT = 16384;

constexpr int RING_BYTES = 131072;
constexpr int LDSCTL_OFF = RING_BYTES, MISC_OFF = LDSCTL_OFF + 320;
constexpr int MOE_OFF = MISC_OFF + 128;
constexpr int PARK_OFF = LDSCTL_OFF + 1024;
constexpr int ROWS_OFF = LDSCTL_OFF + 9216, ROWS_BUF = 3072;
constexpr int LDS_BYTES = 147456;

#define LDS_WAIT() asm volatile("s_waitcnt lgkmcnt(0)" ::: "memory")
#define VM_WAIT() asm volatile("s_waitcnt vmcnt(0)" ::: "memory")
#define RLX_AGENT __ATOMIC_RELAXED, __HIP_MEMORY_SCOPE_AGENT

__device__ __forceinline__ unsigned f2bf(float f) { unsigned u = __builtin_bit_cast(unsigned, f); return (u + 0x7fffu + ((u >> 16) & 1u)) >> 16; }
__device__ __forceinline__ unsigned pk2(float lo, float hi) { return f2bf(lo) | (f2bf(hi) << 16); }
__device__ __forceinline__ float bf2f(unsigned short b) { return __builtin_bit_cast(float, (unsigned)b << 16); }
__device__ __forceinline__ float bflo(unsigned w) { return __builtin_bit_cast(float, w << 16); }
__device__ __forceinline__ float bfhi(unsigned w) { return __builtin_bit_cast(float, w & 0xffff0000u); }
__device__ __forceinline__ unsigned cvt_pk_bf16(float lo, float hi) { unsigned r; asm volatile("v_cvt_pk_bf16_f32 %0, %1, %2" : "=v"(r) : "v"(lo), "v"(hi)); return r; }
__device__ __forceinline__ float fast_rcp(float x) { return __builtin_amdgcn_rcpf(x); }
__device__ __forceinline__ float fast_exp2(float x) { return __builtin_amdgcn_exp2f(x); }
__device__ __forceinline__ float sigmoidf_(float x) { return fast_rcp(1.0f + fast_exp2(-LOG2E * x)); }
__device__ __forceinline__ float gelu_tanh(float x) {
    const float t = x * ((-LOG2E * 1.5957691216057308f) + (-LOG2E * 1.5957691216057308f * 0.044715f) * (x * x));
    return x * fast_rcp(1.0f + fast_exp2(t));
}

namespace pg8 {
constexpr int BM = 256, BK = 64, HALF = 128, HTB = HALF * BK * 2, STAGE_BYTES = 8 * HTB, NXCD = 8, WGM = 8;
__host__ __device__ __forceinline__ int lds_byte(int r, int c) { const int st = (r >> 4) * 2 + (c >> 5), rr = r & 15, cc = c & 31, ob = rr * 64 + cc * 2; return st * 1024 + (ob ^ (((ob >> 9) & 1) << 5)); }
__host__ __device__ __forceinline__ void stage_rc(int b, int& R, int& C) { const int st = b / 1024, sb = b % 1024, swz = sb ^ (((sb >> 9) & 1) << 5); R = (st >> 1) * 16 + swz / 64; C = (st & 1) * 32 + (swz % 64) / 2; }
__host__ __device__ __forceinline__ int perm32(int rho) { const int n = rho >> 4, i = rho & 15; return 8 * (i >> 2) + 4 * n + (i & 3); }

typedef int v4i_t __attribute__((ext_vector_type(4)));
typedef int v8i_t __attribute__((ext_vector_type(8)));
__device__ __forceinline__ v8i_t cat8(bf16x8 lo, bf16x8 hi) { return __builtin_shufflevector(__builtin_bit_cast(v4i_t, lo), __builtin_bit_cast(v4i_t, hi), 0, 1, 2, 3, 4, 5, 6, 7); }
struct Unit { int pm, pn, e, s0, cnt, idx; };

struct StaticOrder {
    int nM, nN, nwg, G, c;
    __device__ void init(int M, int N, int G_, int c_) { nM = M / BM; nN = N / BM; nwg = nM * nN; G = G_; c = c_; }
    __device__ bool tile(int i, int& pm, int& pn) const {
        const long L = (long)i * G + c; if (L >= nwg) return false;
        int wgid = (int)L; { const int q = nwg / NXCD, r = nwg % NXCD, xcd = wgid % NXCD, off = wgid / NXCD; wgid = (xcd < r ? xcd * (q + 1) : r * (q + 1) + (xcd - r) * q) + off; }
        const int nig = WGM * nN, gid = wgid / nig, fm = gid * WGM, gsz = (nM - fm) < WGM ? (nM - fm) : WGM;
        pm = fm + ((wgid % nig) % gsz); pn = (wgid % nig) / gsz; return true;
    }
};

template <class P>
__device__ __forceinline__ void gemm_phase(LAS unsigned char* lds, const P& S) {
    const int tid = threadIdx.x, wid = __builtin_amdgcn_readfirstlane(tid >> 6), lane = tid & 63, wr = wid >> 2, wc = wid & 3, fr = lane & 15, fq = lane >> 4;
    constexpr int nt = P::NT;
    unsigned vA[2][2], voffB[2];
    LAS u32x4* park = (LAS u32x4*)(lds + PARK_OFF) + tid;
#pragma unroll
    for (int i = 0; i < 2; ++i) { int R, C; stage_rc(tid * 16 + i * 8192, R, C); const int Rb = (R & ~31) + perm32(R & 31);
        vA[0][i] = (unsigned)(R * P::LDA + C) * 2u; vA[1][i] = (unsigned)((R + HALF) * P::LDA + C) * 2u; voffB[i] = (unsigned)(Rb * P::LDB + C) * 2u; }
    const size_t kstep = (size_t)(BK * 2);
    const size_t hstepB = (size_t)HALF * P::LDB * 2;
    const unsigned ldsw = (unsigned)wid * 1024u;
    const int aoff = lds_byte(wr * 64 + fr, fq * 8), boff = lds_byte(wc * 32 + fr, fq * 8);
#define PG8_SA(b, h) (((b) * 2 + (h)) * HTB)
#define PG8_SB(b, h) ((4 + (b) * 2 + (h)) * HTB)
#define PG8_STAGE2(bufoff, gbase, o0, o1) do { \
        __builtin_amdgcn_global_load_lds((const unsigned*)((const char*)(gbase) + (o0)), (LAS unsigned*)(lds + (bufoff) + ldsw), 16, 0, 0); \
        __builtin_amdgcn_global_load_lds((const unsigned*)((const char*)(gbase) + (o1)), (LAS unsigned*)(lds + (bufoff) + ldsw + 8192), 16, 0, 0); } while (0)
#define PG8_STAGEB(bufoff, gbase) PG8_STAGE2(bufoff, gbase, voffB[0], voffB[1])
#define PG8_LDA(dst, b, h) do { _Pragma("unroll") for (int m = 0; m < 4; ++m) _Pragma("unroll") for (int k = 0; k < 2; ++k) dst[m][k] = *(const LAS bf16x8*)(lds + PG8_SA(b, h) + aoff + m * 2048 + k * 1024); } while (0)
#define PG8_LDB(dst, b, h) do { _Pragma("unroll") for (int n = 0; n < 2; ++n) _Pragma("unroll") for (int k = 0; k < 2; ++k) dst[n][k] = *(const LAS bf16x8*)(lds + PG8_SB(b, h) + boff + n * 2048 + k * 1024); } while (0)
#define PG8_MMA(ai, bj, At, Bt) do { __builtin_amdgcn_s_setprio(1); _Pragma("unroll") for (int m = 0; m < 4; ++m) _Pragma("unroll") for (int n = 0; n < 2; ++n) { \
        if constexpr (P::I8) { _Pragma("unroll") for (int k = 0; k < 2; ++k) acc[ai][bj][m][n] = __builtin_bit_cast(f32x4, __builtin_amdgcn_mfma_i32_16x16x64_i8(__builtin_bit_cast(v4i_t, Bt[n][k]), __builtin_bit_cast(v4i_t, At[m][k]), __builtin_bit_cast(v4i_t, acc[ai][bj][m][n]), 0, 0, 0)); }     \
        else if constexpr (P::FP8) { acc[ai][bj][m][n] = __builtin_amdgcn_mfma_scale_f32_16x16x128_f8f6f4(cat8(Bt[n][0], Bt[n][1]), cat8(At[m][0], At[m][1]), acc[ai][bj][m][n], 0, 0, 0, 0, 0, 0); }     \
        else { _Pragma("unroll") for (int k = 0; k < 2; ++k) acc[ai][bj][m][n] = __builtin_amdgcn_mfma_f32_16x16x32_bf16(Bt[n][k], At[m][k], acc[ai][bj][m][n], 0, 0, 0); } } \
        __builtin_amdgcn_s_setprio(0); } while (0)
#define PG8_WAIT_V(n) asm volatile("s_waitcnt vmcnt(" #n ")" ::: "memory")
#define PG8_WAIT_L(n) asm volatile("s_waitcnt lgkmcnt(" #n ")" ::: "memory")
#define PG8_BAR __builtin_amdgcn_s_barrier()
#define PG8_SCHED __builtin_amdgcn_sched_barrier(0)
    Unit cur, nxt; int ui = 0;
    if (!S.next(0, cur)) return;
    if constexpr (P::GATHER) S.a_off(cur, tid, vA);
    f32x4 acc[2][2][4][2];
#pragma unroll
    for (int a = 0; a < 2; ++a)
#pragma unroll
        for (int b = 0; b < 2; ++b)
#pragma unroll
            for (int m = 0; m < 4; ++m)
#pragma unroll
                for (int n = 0; n < 2; ++n) acc[a][b][m][n] = (f32x4){0.f, 0.f, 0.f, 0.f};
    bf16x8 At[4][2], B0[2][2], B1[2][2];
    const char* cA = S.a_ptr(cur); const char* cB = S.b_ptr(cur);
    PG8_STAGEB(PG8_SB(0, 0), cB); PG8_STAGEB(PG8_SB(0, 1), cB + hstepB); PG8_STAGE2(PG8_SA(0, 0), cA, vA[0][0], vA[0][1]); PG8_STAGE2(PG8_SA(0, 1), cA, vA[1][0], vA[1][1]);
    if (wr == 1) PG8_BAR;
    PG8_WAIT_V(2); PG8_BAR;
    PG8_STAGEB(PG8_SB(1, 0), cB + kstep); PG8_STAGE2(PG8_SA(1, 0), cA + kstep, vA[0][0], vA[0][1]); PG8_STAGEB(PG8_SB(1, 1), cB + hstepB + kstep);
    PG8_WAIT_V(6); PG8_BAR;
    for (;;) {
        const bool has_next = S.next(ui + 1, nxt);
        if constexpr (P::ROWDMA) S.row_dma(cur, lds, wid, lane);
        const char* nA = has_next ? S.a_ptr(nxt) : cA; const char* nB = has_next ? S.b_ptr(nxt) : cB;
        if constexpr (P::IDDMA) { if (has_next) S.ids_dma(nxt, cur, lds, wid, lane); }
        else if constexpr (P::GATHER) {
            unsigned vn[2][2];
            if (has_next) S.a_off(nxt, tid, vn);
            else { vn[0][0] = vA[0][0]; vn[0][1] = vA[0][1]; vn[1][0] = vA[1][0]; vn[1][1] = vA[1][1]; }
            *park = (u32x4){vn[0][0], vn[0][1], vn[1][0], vn[1][1]};
        }
#pragma nounroll
        for (int t = 0; t < nt; t += 2) {
            const bool last = (t == nt - 2);
            asm volatile("" : "+v"(vA[0][0]), "+v"(vA[0][1]), "+v"(vA[1][0]), "+v"(vA[1][1]), "+v"(voffB[0]), "+v"(voffB[1]));
            const char* a1 = cA + (size_t)(t + 1) * kstep;
            const char* a2 = last ? nA : cA + (size_t)(t + 2) * kstep; const char* b2 = last ? nB : cB + (size_t)(t + 2) * kstep;
            const char* a3 = a2 + kstep; const char* b3 = b2 + kstep;
            PG8_LDB(B0, 0, 0); PG8_LDB(B1, 0, 1); PG8_SCHED; PG8_LDA(At, 0, 0); PG8_STAGE2(PG8_SA(1, 1), a1, vA[1][0], vA[1][1]);
            if constexpr (P::IDDMA) { if (last && has_next) S.a_off_lds(nxt, cur, tid, lds, vA); }
            else if constexpr (P::GATHER) { if (last) { const u32x4 nv = *park; vA[0][0] = nv.x; vA[0][1] = nv.y; vA[1][0] = nv.z; vA[1][1] = nv.w; } }
            PG8_WAIT_V(8); PG8_WAIT_L(0); PG8_BAR; PG8_MMA(0, 0, At, B0); PG8_MMA(0, 1, At, B1); PG8_BAR; PG8_SCHED;
            PG8_LDA(At, 0, 1); PG8_STAGEB(PG8_SB(0, 0), b2); PG8_STAGEB(PG8_SB(0, 1), b2 + hstepB); PG8_STAGE2(PG8_SA(0, 0), a2, vA[0][0], vA[0][1]);
            PG8_WAIT_V(8); PG8_WAIT_L(0); PG8_BAR; PG8_MMA(1, 0, At, B0); PG8_MMA(1, 1, At, B1); PG8_BAR; PG8_SCHED;
            PG8_LDB(B0, 1, 0); PG8_LDB(B1, 1, 1); PG8_SCHED; PG8_LDA(At, 1, 0); PG8_STAGE2(PG8_SA(0, 1), a2, vA[1][0], vA[1][1]);
            PG8_WAIT_V(8); PG8_WAIT_L(0); PG8_BAR; PG8_MMA(0, 0, At, B0); PG8_MMA(0, 1, At, B1); PG8_BAR; PG8_SCHED;
            PG8_LDA(At, 1, 1); PG8_STAGEB(PG8_SB(1, 0), b3); PG8_STAGEB(PG8_SB(1, 1), b3 + hstepB); PG8_STAGE2(PG8_SA(1, 0), a3, vA[0][0], vA[0][1]);
            PG8_WAIT_V(8); PG8_WAIT_L(0); PG8_BAR; PG8_MMA(1, 0, At, B0); PG8_MMA(1, 1, At, B1); PG8_BAR; PG8_SCHED;
        }
        if (wr == 0) PG8_BAR;
        int fr_ = fr, fq_ = fq; asm volatile("" : "+v"(fr_), "+v"(fq_));
        const bool keep = S.epi(acc, cur, wr, wc, fr_, fq_);
        if (!has_next) break;
        if (!keep) {
#pragma unroll
            for (int a = 0; a < 2; ++a)
#pragma unroll
                for (int b = 0; b < 2; ++b)
#pragma unroll
                    for (int m = 0; m < 4; ++m)
#pragma unroll
                        for (int n = 0; n < 2; ++n) acc[a][b][m][n] = (f32x4){0.f, 0.f, 0.f, 0.f};
        }
        cur = nxt; cA = nA; cB = nB; ++ui;
        if (wr == 1) PG8_BAR;
    }
    PG8_WAIT_V(0);
    PG8_BAR;
#undef PG8_SA
#undef PG8_SB
#undef PG8_STAGE2
#undef PG8_STAGEB
#undef PG8_LDA
#undef PG8_LDB
#undef PG8_MMA
#undef PG8_WAIT_V
#undef PG8_WAIT_L
#undef PG8_BAR
#undef PG8_SCHED
}
}
using pg8::Unit;

__device__ __forceinline__ void st8(bf16* p, const f32x4& a, const f32x4& b) {
    u32x4 w; w.x = cvt_pk_bf16(a[0], a[1]); w.y = cvt_pk_bf16(a[2], a[3]); w.z = cvt_pk_bf16(b[0], b[1]); w.w = cvt_pk_bf16(b[2], b[3]);
    *(u32x4*)p = w;
}
__device__ __forceinline__ void ld8(const bf16* p, f32x4& a, f32x4& b) {
    const u32x4 w = *(const u32x4*)p;
    a = (f32x4){bflo(w.x), bfhi(w.x), bflo(w.y), bfhi(w.y)}; b = (f32x4){bflo(w.z), bfhi(w.z), bflo(w.w), bfhi(w.w)};
}

__device__ __forceinline__ void st8q(unsigned char* p, const f32x4& a, const f32x4& b) {
    int w0 = 0, w1 = 0;
    w0 = __builtin_amdgcn_cvt_pk_fp8_f32(a[0], a[1], w0, false); w0 = __builtin_amdgcn_cvt_pk_fp8_f32(a[2], a[3], w0, true);
    w1 = __builtin_amdgcn_cvt_pk_fp8_f32(b[0], b[1], w1, false); w1 = __builtin_amdgcn_cvt_pk_fp8_f32(b[2], b[3], w1, true);
    *(u32x2*)p = (u32x2){(unsigned)w0, (unsigned)w1};
}
constexpr float WQ_SCALE = 32.0f, WQ_INV = 1.0f / 32.0f;

struct PolIn {
    static constexpr int NT = 8, LDA = 512, LDB = 512; static constexpr bool GATHER = false, FP8 = false, I8 = true, ROWDMA = true, IDDMA = false;
    pg8::StaticOrder so; const unsigned char* A; const unsigned char* Bt; unsigned char* ws; const float* qg; const float* kg; const float* hs; const float* cs; LAS unsigned char* shm;
    __device__ bool next(int i, Unit& u) const { u.e = 0; u.s0 = 0; u.cnt = 0; u.idx = i; return so.tile(i, u.pm, u.pn); }
    __device__ __forceinline__ void row_dma(const Unit& u, LAS unsigned char* lds, int wid, int lane) const {
        const unsigned* src = (wid < 4) ? (const unsigned*)(hs + u.pm * 256 + 64 * wid + lane) : (const unsigned*)(cs + u.pn * 256 + 64 * (wid & 3) + lane);
        __builtin_amdgcn_global_load_lds(src, (LAS unsigned*)(lds + ROWS_OFF + (u.idx & 1) * ROWS_BUF + 256 * wid), 4, 0, 0);
    }
    __device__ const char* a_ptr(const Unit& u) const { return (const char*)(A + (size_t)u.pm * 256 * 1024); }
    __device__ const char* b_ptr(const Unit& u) const { return (const char*)(Bt + (size_t)u.pn * 256 * 1024); }
    __device__ void a_off(const Unit&, int, unsigned (&)[2][2]) const {}
    __device__ __forceinline__ bool epi(f32x4 (&acc)[2][2][4][2], const Unit& u, int wr, int wc, int fr, int fq) const {
        const int pn = u.pn;
        {
            const LAS float* hsr = (const LAS float*)(shm + ROWS_OFF + (u.idx & 1) * ROWS_BUF) + wr * 64 + fr;
            const LAS float* csp = (const LAS float*)(shm + ROWS_OFF + (u.idx & 1) * ROWS_BUF + 1024) + 64 * wc + 8 * fq;
            float hv[2][4]; f32x4 cv[2][2];
#pragma unroll
            for (int a = 0; a < 2; ++a)
#pragma unroll
                for (int m = 0; m < 4; ++m) hv[a][m] = hsr[a * 128 + m * 16];
#pragma unroll
            for (int b = 0; b < 2; ++b)
#pragma unroll
                for (int n = 0; n < 2; ++n) cv[b][n] = *(const LAS f32x4*)(csp + 32 * b + 4 * n);
#pragma unroll
            for (int a = 0; a < 2; ++a)
#pragma unroll
                for (int b = 0; b < 2; ++b)
#pragma unroll
                    for (int m = 0; m < 4; ++m)
#pragma unroll
                        for (int n = 0; n < 2; ++n) { const pg8::v4i_t ia = __builtin_bit_cast(pg8::v4i_t, acc[a][b][m][n]);
                            acc[a][b][m][n] = (f32x4){(float)ia.x, (float)ia.y, (float)ia.z, (float)ia.w} * hv[a][m] * cv[b][n]; }
        }
        int kind, ld, tcol; size_t off;
        if (pn < 2) { kind = 0; off = WS_Q; ld = AW; tcol = pn; }
        else if (pn < 4) { kind = 1; off = WS_K; ld = AW; tcol = pn - 2; }
        else if (pn < 6) { kind = 2; off = WS_V; ld = AW; tcol = pn - 4; }
        else if (pn < 8) { kind = 3; off = WS_UG; ld = SGW; tcol = pn - 6; }
        else if (pn < 10) { kind = 3; off = WS_VG; ld = SGW; tcol = pn - 8; }
        else if (pn < 14) { kind = 4; off = WS_GA; ld = D; tcol = pn - 10; }
        else { kind = 4; off = WS_GB; ld = D; tcol = pn - 14; }
        bf16* base = (bf16*)(ws + off) + tcol * 256 + 64 * wc + 8 * fq;
        const int row0 = u.pm * 256 + wr * 64 + fr;
        if (kind <= 1) {
            const float* g = (kind == 0 ? qg : kg) + 8 * fq;
            const float sc = (kind == 0) ? (0.125f * LOG2E) : 1.0f;
            f32x4 gv[2][2];
#pragma unroll
            for (int bj = 0; bj < 2; ++bj)
#pragma unroll
                for (int n = 0; n < 2; ++n) gv[bj][n] = *(const f32x4*)(g + 32 * bj + 4 * n) * sc;
#pragma unroll
            for (int ai = 0; ai < 2; ++ai)
#pragma unroll
                for (int m = 0; m < 4; ++m) {
                    float ss = 0.f;
#pragma unroll
                    for (int bj = 0; bj < 2; ++bj)
#pragma unroll
                        for (int n = 0; n < 2; ++n) { const f32x4 v = acc[ai][bj][m][n]; ss += (v[0] * v[0] + v[1] * v[1]) + (v[2] * v[2] + v[3] * v[3]); }
                    ss += __shfl_xor(ss, 16); ss += __shfl_xor(ss, 32);
                    const float rs = 1.0f / sqrtf(ss * (1.0f / 64.0f) + EPS);
                    bf16* rowp = base + (size_t)(row0 + ai * 128 + m * 16) * ld;
#pragma unroll
                    for (int bj = 0; bj < 2; ++bj) st8(rowp + 32 * bj, acc[ai][bj][m][0] * rs * gv[bj][0], acc[ai][bj][m][1] * rs * gv[bj][1]);
                }
        } else if (kind == 2) {
#pragma unroll
            for (int ai = 0; ai < 2; ++ai)
#pragma unroll
                for (int m = 0; m < 4; ++m) { bf16* rowp = base + (size_t)(row0 + ai * 128 + m * 16) * ld;
#pragma unroll
                    for (int bj = 0; bj < 2; ++bj) st8(rowp + 32 * bj, acc[ai][bj][m][0], acc[ai][bj][m][1]); }
        } else if (kind == 4) {
            unsigned char* b8 = ws + off + tcol * 256 + 64 * wc + 8 * fq;
#pragma unroll
            for (int ai = 0; ai < 2; ++ai)
#pragma unroll
                for (int m = 0; m < 4; ++m) { unsigned char* rowp = b8 + (size_t)(row0 + ai * 128 + m * 16) * ld;
#pragma unroll
                    for (int bj = 0; bj < 2; ++bj) st8q(rowp + 32 * bj, acc[ai][bj][m][0], acc[ai][bj][m][1]); }
        } else {
#pragma unroll
            for (int ai = 0; ai < 2; ++ai)
#pragma unroll
                for (int m = 0; m < 4; ++m) { bf16* rowp = base + (size_t)(row0 + ai * 128 + m * 16) * ld;
#pragma unroll
                    for (int bj = 0; bj < 2; ++bj) { f32x4 a = acc[ai][bj][m][0], b = acc[ai][bj][m][1];
#pragma unroll
                        for (int j = 0; j < 4; ++j) { a[j] = gelu_tanh(a[j]); b[j] = gelu_tanh(b[j]); }
                        st8(rowp + 32 * bj, a, b); } }
        }
        return false;
    }
};

struct PolMerge {
    static constexpr int NT = 8, LDA = D, LDB = D; static constexpr bool GATHER = false, FP8 = false, I8 = false, ROWDMA = false, IDDMA = false;
    pg8::StaticOrder so; const bf16* A; const bf16* Bt; const unsigned char* ga; const unsigned char* gb; bf16* out;
    __device__ bool next(int i, Unit& u) const { u.e = i & 1; u.s0 = 0; u.cnt = 0; return so.tile(i >> 1, u.pm, u.pn); }
    __device__ const char* a_ptr(const Unit& u) const { return (const char*)(A + (size_t)u.pm * 256 * LDA + 512 * u.e); }
    __device__ const char* b_ptr(const Unit& u) const { return (const char*)(Bt + (size_t)u.pn * 256 * LDB + 512 * u.e); }
    __device__ void a_off(const Unit&, int, unsigned (&)[2][2]) const {}
    __device__ __forceinline__ bool epi(f32x4 (&acc)[2][2][4][2], const Unit& u, int wr, int wc, int fr, int fq) const {
        const int row0 = u.pm * 256 + wr * 64 + fr, col0 = u.pn * 256 + 64 * wc + 8 * fq;
#pragma unroll
        for (int ai = 0; ai < 2; ++ai) {
            u32x2 gbv[4][2]; u32x2 gav[4][2];
#pragma unroll
            for (int m = 0; m < 4; ++m) { const size_t o = (size_t)(row0 + ai * 128 + m * 16) * D + col0;
#pragma unroll
                for (int bj = 0; bj < 2; ++bj) { gbv[m][bj] = *(const u32x2*)(gb + o + 32 * bj); if (u.e == 0) gav[m][bj] = *(const u32x2*)(ga + o + 32 * bj); } }
#pragma unroll
            for (int m = 0; m < 4; ++m) { const size_t o = (size_t)(row0 + ai * 128 + m * 16) * D + col0;
#pragma unroll
                for (int bj = 0; bj < 2; ++bj) {
                    const u32x2 wb = gbv[m][bj];
                    const f32x2 p0 = __builtin_amdgcn_cvt_pk_f32_fp8((int)wb.x, false), p1 = __builtin_amdgcn_cvt_pk_f32_fp8((int)wb.x, true), p2 = __builtin_amdgcn_cvt_pk_f32_fp8((int)wb.y, false), p3 = __builtin_amdgcn_cvt_pk_f32_fp8((int)wb.y, true);
                    const f32x4 b0 = (f32x4){p0[0], p0[1], p1[0], p1[1]}, b1 = (f32x4){p2[0], p2[1], p3[0], p3[1]};
                    if (u.e == 0) {
                        const u32x2 wa = gav[m][bj];
                        const f32x2 q0 = __builtin_amdgcn_cvt_pk_f32_fp8((int)wa.x, false), q1 = __builtin_amdgcn_cvt_pk_f32_fp8((int)wa.x, true), q2 = __builtin_amdgcn_cvt_pk_f32_fp8((int)wa.y, false), q3 = __builtin_amdgcn_cvt_pk_f32_fp8((int)wa.y, true);
                        const f32x4 a0 = (f32x4){q0[0], q0[1], q1[0], q1[1]}, a1 = (f32x4){q2[0], q2[1], q3[0], q3[1]};
#pragma unroll
                        for (int j = 0; j < 4; ++j) {
                            acc[ai][bj][m][0][j] *= (1.0f + fast_exp2(-LOG2E * b0[j])) * fast_rcp(1.0f + fast_exp2(-LOG2E * a0[j]));
                            acc[ai][bj][m][1][j] *= (1.0f + fast_exp2(-LOG2E * b1[j])) * fast_rcp(1.0f + fast_exp2(-LOG2E * a1[j])); }
                    } else {
                        f32x4 r0, r1;
#pragma unroll
                        for (int j = 0; j < 4; ++j) { r0[j] = acc[ai][bj][m][0][j] * sigmoidf_(b0[j]); r1[j] = acc[ai][bj][m][1][j] * sigmoidf_(b1[j]); }
                        st8(out + o + 32 * bj, r0, r1);
                    }
                } }
        }
        return u.e == 0;
    }
};

struct PolOut {
    static constexpr int NT = 16, LDA = D, LDB = D; static constexpr bool GATHER = false, FP8 = false, I8 = false, ROWDMA = false, IDDMA = false;
    pg8::StaticOrder so; const bf16* A; const bf16* Bt; const float* x; bf16* x1; unsigned char* x1q;
    __device__ bool next(int i, Unit& u) const { u.e = 0; u.s0 = 0; u.cnt = 0; return so.tile(i, u.pm, u.pn); }
    __device__ const char* a_ptr(const Unit& u) const { return (const char*)(A + (size_t)u.pm * 256 * LDA); }
    __device__ const char* b_ptr(const Unit& u) const { return (const char*)(Bt + (size_t)u.pn * 256 * LDB); }
    __device__ void a_off(const Unit&, int, unsigned (&)[2][2]) const {}
    __device__ __forceinline__ bool epi(f32x4 (&acc)[2][2][4][2], const Unit& u, int wr, int wc, int fr, int fq) const {
        const int row0 = u.pm * 256 + wr * 64 + fr, col0 = u.pn * 256 + 64 * wc + 8 * fq;
#pragma unroll
        for (int ai = 0; ai < 2; ++ai) {
            f32x4 xv[4][2][2];
#pragma unroll
            for (int m = 0; m < 4; ++m) { const size_t o = (size_t)(row0 + ai * 128 + m * 16) * D + col0;
#pragma unroll
                for (int bj = 0; bj < 2; ++bj) { xv[m][bj][0] = *(const f32x4*)(x + o + 32 * bj); xv[m][bj][1] = *(const f32x4*)(x + o + 32 * bj + 4); } }
#pragma unroll
            for (int m = 0; m < 4; ++m) { const size_t o = (size_t)(row0 + ai * 128 + m * 16) * D + col0;
#pragma unroll
                for (int bj = 0; bj < 2; ++bj) {
                    const f32x4 r0 = xv[m][bj][0] + acc[ai][bj][m][0], r1 = xv[m][bj][1] + acc[ai][bj][m][1];
                    st8(x1 + o + 32 * bj, r0, r1); st8q(x1q + o + 32 * bj, r0, r1);
                } }
        }
        return false;
    }
};

struct MoeOrder {
    const LAS int* tb;
    int NN, nwg, G, c;
    __device__ void init(const LAS int* tb_, int NN_, int G_, int c_) { tb = tb_; NN = NN_; G = G_; c = c_; nwg = tb_[32] * NN_; }
    __device__ bool unit(int i, Unit& u) const {
        const long L = (long)i * G + c; if (L >= nwg) return false;
        int wgid = (int)L; { const int q = nwg / 8, r = nwg % 8, xcd = wgid % 8, off = wgid / 8; wgid = (xcd < r ? xcd * (q + 1) : r * (q + 1) + (xcd - r) * q) + off; }
        const int Mt = wgid / NN;
        const int ln = threadIdx.x & 63;
        const unsigned long long bal = __ballot(ln < NE && tb[ln & 31] <= Mt);
        const int e = __popcll(bal) - 1;
        u.idx = i; u.pm = __builtin_amdgcn_readfirstlane(Mt); u.pn = __builtin_amdgcn_readfirstlane(wgid % NN); u.e = __builtin_amdgcn_readfirstlane(e);
        u.s0 = __builtin_amdgcn_readfirstlane((Mt - tb[e]) * 256); u.cnt = __builtin_amdgcn_readfirstlane(tb[33 + e]);
        return true;
    }
};

struct PolGU {
    static constexpr int NT = 8, LDA = 512, LDB = 512; static constexpr bool GATHER = true, FP8 = true, I8 = false, ROWDMA = true, IDDMA = true;
    MoeOrder mo; const unsigned char* A; const unsigned char* Bt; const int* lid; const float* lrs; const float* bgu; unsigned char* act; LAS unsigned char* shm;
    __device__ __forceinline__ void row_dma(const Unit& u, LAS unsigned char* lds, int wid, int lane) const {
        const unsigned* src = (wid < 4) ? (const unsigned*)(lrs + (size_t)u.e * LCAP + u.s0 + 64 * wid + lane)
                                        : (const unsigned*)(bgu + (size_t)u.e * 2048 + u.pn * 128 + 1024 * ((wid >> 1) & 1) + 64 * (wid & 1) + lane);
        __builtin_amdgcn_global_load_lds(src, (LAS unsigned*)(lds + ROWS_OFF + (u.idx & 1) * ROWS_BUF + 256 * wid), 4, 0, 0);
    }
    __device__ bool next(int i, Unit& u) const { return mo.unit(i, u); }
    __device__ __forceinline__ void ids_dma(const Unit& nx, const Unit& cu, LAS unsigned char* lds, int wid, int lane) const {
        if (wid < 4) __builtin_amdgcn_global_load_lds((const unsigned*)(lid + (size_t)nx.e * LCAP + nx.s0 + 64 * wid + lane), (LAS unsigned*)(lds + ROWS_OFF + (cu.idx & 1) * ROWS_BUF + 2048 + 256 * wid), 4, 0, 0);
    }
    __device__ __forceinline__ void a_off_lds(const Unit& nx, const Unit& cu, int tid, LAS unsigned char* lds, unsigned (&v)[2][2]) const {
        const LAS int* l = (const LAS int*)(lds + ROWS_OFF + (cu.idx & 1) * ROWS_BUF + 2048);
#pragma unroll
        for (int i = 0; i < 2; ++i) { int R, C; pg8::stage_rc(tid * 16 + i * 8192, R, C);
#pragma unroll
            for (int h = 0; h < 2; ++h) { const int s = h * 128 + R; const int id = l[s]; const int tok = (nx.s0 + s < nx.cnt) ? (id >> 2) : 0; v[h][i] = (unsigned)(tok * LDA + C) * 2u; } }
    }
    __device__ const char* a_ptr(const Unit&) const { return (const char*)A; }
    __device__ const char* b_ptr(const Unit& u) const { return (const char*)(Bt + ((size_t)u.e * 2048 + (size_t)u.pn * 256) * 1024); }
    __device__ __forceinline__ void a_off(const Unit& u, int tid, unsigned (&v)[2][2]) const {
        const int* l = lid + (size_t)u.e * LCAP;
#pragma unroll
        for (int i = 0; i < 2; ++i) { int R, C; pg8::stage_rc(tid * 16 + i * 8192, R, C);
#pragma unroll
            for (int h = 0; h < 2; ++h) { const int s = u.s0 + h * 128 + R; const int id = l[s]; const int tok = (s < u.cnt) ? (id >> 2) : 0; v[h][i] = (unsigned)(tok * LDA + C) * 2u; } }
    }
    __device__ __forceinline__ bool epi(f32x4 (&acc)[2][2][4][2], const Unit& u, int wr, int wc, int fr, int fq) const {
        const LAS float* rsl = (const LAS float*)(shm + ROWS_OFF + (u.idx & 1) * ROWS_BUF);
        const LAS float* bg = (const LAS float*)(shm + ROWS_OFF + (u.idx & 1) * ROWS_BUF + 1024) + 32 * wc + 8 * fq;
        const f32x4 bg0 = *(const LAS f32x4*)bg, bg1 = *(const LAS f32x4*)(bg + 4), bu0 = *(const LAS f32x4*)(bg + 128), bu1 = *(const LAS f32x4*)(bg + 132);
        unsigned char* ob = act + (size_t)u.pm * 256 * FF + u.pn * 128 + 32 * wc + 8 * fq;
        float rsv[2][4];
#pragma unroll
        for (int ai = 0; ai < 2; ++ai)
#pragma unroll
            for (int m = 0; m < 4; ++m) { const int r = ai * 128 + wr * 64 + m * 16 + fr; const bool valid = (u.s0 + r < u.cnt); const float t_ = rsl[r]; rsv[ai][m] = valid ? t_ * WQ_INV : 0.f; }
#pragma unroll
        for (int ai = 0; ai < 2; ++ai)
#pragma unroll
            for (int m = 0; m < 4; ++m) { const int r = ai * 128 + wr * 64 + m * 16 + fr; const float rs = rsv[ai][m];
                f32x4 o[2];
#pragma unroll
                for (int n = 0; n < 2; ++n)
#pragma unroll
                    for (int h2 = 0; h2 < 2; ++h2) {
                        const f32x2 ag = {acc[ai][0][m][n][2 * h2], acc[ai][0][m][n][2 * h2 + 1]}, au = {acc[ai][1][m][n][2 * h2], acc[ai][1][m][n][2 * h2 + 1]};
                        const f32x2 bgv = n ? (f32x2){bg1[2 * h2], bg1[2 * h2 + 1]} : (f32x2){bg0[2 * h2], bg0[2 * h2 + 1]}, buv = n ? (f32x2){bu1[2 * h2], bu1[2 * h2 + 1]} : (f32x2){bu0[2 * h2], bu0[2 * h2 + 1]};
                        f32x2 g = ag * rs + bgv, up = au * rs + buv;
                        g = __builtin_elementwise_min(g, (f32x2){7.0f, 7.0f});
                        up.x = __builtin_amdgcn_fmed3f(up.x, -7.0f, 7.0f); up.y = __builtin_amdgcn_fmed3f(up.y, -7.0f, 7.0f);
                        const f32x2 t = g * (-1.702f * LOG2E);
                        f32x2 e; e.x = fast_exp2(t.x); e.y = fast_exp2(t.y);
                        const f32x2 den = e + 1.0f;
                        f32x2 rc; rc.x = fast_rcp(den.x); rc.y = fast_rcp(den.y);
                        const f32x2 res = (up + 1.0f) * (g * rc);
                        o[n][2 * h2] = res.x; o[n][2 * h2 + 1] = res.y; }
                st8q(ob + (size_t)r * FF, o[0], o[1]); }
        return false;
    }
};

struct PolDown {
    static constexpr int NT = 8, LDA = 512, LDB = 512; static constexpr bool GATHER = true, FP8 = true, I8 = false, ROWDMA = true, IDDMA = false;
    MoeOrder mo; const unsigned char* A; const unsigned char* Bt; const int* lid; const float* lp; const float* bd; unsigned char* y; LAS unsigned char* shm;
    __device__ __forceinline__ void row_dma(const Unit& u, LAS unsigned char* lds, int wid, int lane) const {
        const size_t o = (size_t)u.e * LCAP + u.s0 + 64 * (wid & 3) + lane;
        const unsigned* src = (wid < 4) ? (const unsigned*)(lid + o) : (const unsigned*)(lp + o);
        __builtin_amdgcn_global_load_lds(src, (LAS unsigned*)(lds + ROWS_OFF + (u.idx & 1) * ROWS_BUF + 256 * wid), 4, 0, 0);
        if (wid < 4) __builtin_amdgcn_global_load_lds((const unsigned*)(bd + (size_t)u.e * D + u.pn * 256 + 64 * wid + lane), (LAS unsigned*)(lds + ROWS_OFF + (u.idx & 1) * ROWS_BUF + 2048 + 256 * wid), 4, 0, 0);
    }
    __device__ bool next(int i, Unit& u) const { return mo.unit(i, u); }
    __device__ const char* a_ptr(const Unit& u) const { return (const char*)(A + (size_t)u.pm * 256 * 1024); }
    __device__ const char* b_ptr(const Unit& u) const { return (const char*)(Bt + ((size_t)u.e * 1024 + (size_t)u.pn * 256) * 1024); }
    __device__ __forceinline__ void a_off(const Unit&, int tid, unsigned (&v)[2][2]) const {
#pragma unroll
        for (int i = 0; i < 2; ++i) { int R, C; pg8::stage_rc(tid * 16 + i * 8192, R, C); v[0][i] = (unsigned)(R * LDA + C) * 2u; v[1][i] = (unsigned)((R + 128) * LDA + C) * 2u; }
    }
    __device__ __forceinline__ bool epi(f32x4 (&acc)[2][2][4][2], const Unit& u, int wr, int wc, int fr, int fq) const {
        const LAS int* idl = (const LAS int*)(shm + ROWS_OFF + (u.idx & 1) * ROWS_BUF); const LAS float* pl = (const LAS float*)(shm + ROWS_OFF + (u.idx & 1) * ROWS_BUF + 1024);
        const int col0 = u.pn * 256 + 64 * wc + 8 * fq;
        const LAS float* b = (const LAS float*)(shm + ROWS_OFF + (u.idx & 1) * ROWS_BUF + 2048) + 64 * wc + 8 * fq;
        int idv[2][4]; float pv_[2][4];
#pragma unroll
        for (int ai = 0; ai < 2; ++ai)
#pragma unroll
            for (int m = 0; m < 4; ++m) { const int r = ai * 128 + wr * 64 + m * 16 + fr; const bool valid = (u.s0 + r < u.cnt);
                const int t_ = idl[r]; const float q_ = pl[r]; idv[ai][m] = valid ? t_ : T * 4; pv_[ai][m] = q_; }
        f32x4 bv[2][2];
#pragma unroll
        for (int bj = 0; bj < 2; ++bj)
#pragma unroll
            for (int n = 0; n < 2; ++n) bv[bj][n] = *(const LAS f32x4*)(b + 32 * bj + 4 * n);
#pragma unroll
        for (int ai = 0; ai < 2; ++ai)
#pragma unroll
            for (int m = 0; m < 4; ++m) { const float p = pv_[ai][m] * 16.0f; unsigned char* op = y + (size_t)idv[ai][m] * D + col0;
#pragma unroll
                for (int bj = 0; bj < 2; ++bj) st8q(op + 32 * bj, (acc[ai][bj][m][0] * WQ_INV + bv[bj][0]) * p, (acc[ai][bj][m][1] * WQ_INV + bv[bj][1]) * p); }
        return false;
    }
};

constexpr int CONV_GU_ITEMS = NE * 16 * 32, CONV_D_ITEMS = NE * 16 * 16, CONV_ITEMS = CONV_GU_ITEMS + CONV_D_ITEMS, CONV_PER_WAVE = CONV_ITEMS / 2048;
static_assert(CONV_PER_WAVE * 2048 == CONV_ITEMS, "items divide over 2048 waves");
struct MoeConv {
    const float* wgu; const float* wd; const float* g2; unsigned char* WGU8; unsigned char* WD8;
    struct Regs { f32x4 v0, v1, v2, v3, v4, v5, v6, v7, v8, v9, v10, v11, v12, v13, v14, v15; };
    __device__ __forceinline__ void src_of(int item, const float*& W, int& N, int& k0, int& n0) const {
        if (item < CONV_GU_ITEMS) { const int e = item >> 9, q = item & 511; W = wgu + (size_t)e * D * 2048; N = 2048; k0 = 64 * (q >> 5); n0 = 64 * (q & 31); }
        else { const int r = item - CONV_GU_ITEMS, e = r >> 8, q = r & 255; W = wd + (size_t)e * FF * D; N = D; k0 = 64 * (q >> 4); n0 = 64 * (q & 15); }
    }
    __device__ __forceinline__ void finish(Regs& R, int item, int lane) const {
        const float* W; int N, k0, n0; src_of(item, W, N, k0, n0);
        const int kc = lane >> 4, nq = lane & 15; const bool gu = item < CONV_GU_ITEMS;
        float sc[16];
        if (gu) { const f32x4* gp = (const f32x4*)(g2 + k0 + 16 * kc);
#pragma unroll
            for (int q = 0; q < 4; ++q) { const f32x4 t = gp[q]; sc[4 * q] = t[0] * 32.0f; sc[4 * q + 1] = t[1] * 32.0f; sc[4 * q + 2] = t[2] * 32.0f; sc[4 * q + 3] = t[3] * 32.0f; } }
        else {
#pragma unroll
            for (int i = 0; i < 16; ++i) sc[i] = 32.0f; }
        const int nb = n0 + 32 * (nq >> 3);
        const int e = gu ? (item >> 9) : ((item - CONV_GU_ITEMS) >> 8);
        const int up = nb >= 1024, cc = nb & 1023;
        const int pos = gu ? ((cc >> 7) * 256 + up * 128 + ((cc >> 5) & 3) * 32) : ((nb & ~255) + ((nb >> 5) & 1) * 128 + ((nb >> 6) & 3) * 32);
        unsigned char* base = (gu ? (WGU8 + ((size_t)e * 2048 + pos + ((4 * nq) & 31)) * 1024) : (WD8 + ((size_t)e * 1024 + pos + ((4 * nq) & 31)) * 1024)) + k0 + 16 * kc;
#pragma unroll
        for (int c = 0; c < 4; ++c) {
            int w0 = 0, w1 = 0, w2 = 0, w3 = 0;
            w0 = __builtin_amdgcn_cvt_pk_fp8_f32(R.v0[c] * sc[0], R.v1[c] * sc[1], w0, false); w0 = __builtin_amdgcn_cvt_pk_fp8_f32(R.v2[c] * sc[2], R.v3[c] * sc[3], w0, true);
            w1 = __builtin_amdgcn_cvt_pk_fp8_f32(R.v4[c] * sc[4], R.v5[c] * sc[5], w1, false); w1 = __builtin_amdgcn_cvt_pk_fp8_f32(R.v6[c] * sc[6], R.v7[c] * sc[7], w1, true);
            w2 = __builtin_amdgcn_cvt_pk_fp8_f32(R.v8[c] * sc[8], R.v9[c] * sc[9], w2, false); w2 = __builtin_amdgcn_cvt_pk_fp8_f32(R.v10[c] * sc[10], R.v11[c] * sc[11], w2, true);
            w3 = __builtin_amdgcn_cvt_pk_fp8_f32(R.v12[c] * sc[12], R.v13[c] * sc[13], w3, false); w3 = __builtin_amdgcn_cvt_pk_fp8_f32(R.v14[c] * sc[14], R.v15[c] * sc[15], w3, true);
            *(u32x4*)(base + (size_t)c * 1024) = (u32x4){(unsigned)w0, (unsigned)w1, (unsigned)w2, (unsigned)w3};
        }
    }
    template <int SUB> __device__ __forceinline__ void sub(Regs& R, int& st, int item0, int istride, int lane) const {
        if (SUB == 0 && (st & 1)) { finish(R, item0 + ((st >> 1) - 1) * istride, lane); st &= ~1; }
        const int it = st >> 1;
        {
            const int itc = it < CONV_PER_WAVE ? it : CONV_PER_WAVE - 1;
            const float* W; int N, k0, n0; src_of(item0 + itc * istride, W, N, k0, n0);
            const float* p = W + (size_t)(k0 + 16 * (lane >> 4) + 4 * SUB) * N + n0 + 4 * (lane & 15);
            const f32x4 t0 = *(const f32x4*)p, t1 = *(const f32x4*)(p + N), t2 = *(const f32x4*)(p + 2 * (size_t)N), t3 = *(const f32x4*)(p + 3 * (size_t)N);
            if (SUB == 0) { R.v0 = t0; R.v1 = t1; R.v2 = t2; R.v3 = t3; }
            else if (SUB == 1) { R.v4 = t0; R.v5 = t1; R.v6 = t2; R.v7 = t3; }
            else if (SUB == 2) { R.v8 = t0; R.v9 = t1; R.v10 = t2; R.v11 = t3; }
            else { R.v12 = t0; R.v13 = t1; R.v14 = t2; R.v15 = t3; if (it < CONV_PER_WAVE) st = ((it + 1) << 1) | 1; }
        }
    }
    __device__ __forceinline__ void drain(Regs& R, int& st, int item0, int istride, int lane) const {
        if (st & 1) { finish(R, item0 + ((st >> 1) - 1) * istride, lane); st &= ~1; }
        for (int it = st >> 1; it < CONV_PER_WAVE; ++it) { sub<0>(R, st, item0, istride, lane); sub<1>(R, st, item0, istride, lane); sub<2>(R, st, item0, istride, lane); sub<3>(R, st, item0, istride, lane);
            finish(R, item0 + it * istride, lane); st &= ~1; }
    }
};

namespace att {
constexpr int PITCH = 512, SLOTB = 8192;
constexpr int L_K = 0, L_V = 2 * SLOTB, L_TBL = 4 * SLOTB, L_WS = L_TBL + 4096, L_OST = L_WS + 8 * 256, L_END = L_OST + 8 * 4096;
constexpr int NTBL = 832;
__device__ __forceinline__ int crow(int r, int hi) { return (r & 3) + 8 * (r >> 2) + 4 * hi; }
__device__ __forceinline__ void glds16(const void* gsrc, unsigned lds_dst) { unsigned keep;
    asm volatile("s_mov_b32 %0, m0\n\ts_mov_b32 m0, %2\n\ts_nop 0\n\tglobal_load_lds_dwordx4 %1, off\n\ts_mov_b32 m0, %0" : "=&s"(keep) : "v"(gsrc), "s"(lds_dst) : "memory"); }
__device__ __forceinline__ unsigned cvtpk_s(float lo, float hi) { typedef __bf16 bf16x2_t __attribute__((ext_vector_type(2))); f32x2 v = {lo, hi}; bf16x2_t b = __builtin_convertvector(v, bf16x2_t); return __builtin_bit_cast(unsigned, b); }
#define ATT_SBAR() __builtin_amdgcn_sched_barrier(0)
__device__ __forceinline__ void pv(f32x16* o, int vb, bf16x8 pa0, bf16x8 pa1, bf16x8 pa2, bf16x8 pa3) {
#pragma unroll
    for (int d0 = 0; d0 < 2; ++d0) { s16x4 lo[4], hi[4];
#pragma unroll
        for (int ks = 0; ks < 4; ++ks) {
            asm volatile("ds_read_b64_tr_b16 %0,%1 offset:%c2" : "=&v"(lo[ks]) : "v"(vb), "i"(d0 * 4096 + ks * 1024) : "memory");
            asm volatile("ds_read_b64_tr_b16 %0,%1 offset:%c2" : "=&v"(hi[ks]) : "v"(vb), "i"(d0 * 4096 + ks * 1024 + 512) : "memory"); }
        asm volatile("s_waitcnt lgkmcnt(0)" ::: "memory"); ATT_SBAR();
#define ATT_PK(k) (bf16x8){lo[k][0], lo[k][1], lo[k][2], lo[k][3], hi[k][0], hi[k][1], hi[k][2], hi[k][3]}
        o[d0] = __builtin_amdgcn_mfma_f32_32x32x16_bf16(pa0, ATT_PK(0), o[d0], 0, 0, 0);
        o[d0] = __builtin_amdgcn_mfma_f32_32x32x16_bf16(pa1, ATT_PK(1), o[d0], 0, 0, 0);
        o[d0] = __builtin_amdgcn_mfma_f32_32x32x16_bf16(pa2, ATT_PK(2), o[d0], 0, 0, 0);
        o[d0] = __builtin_amdgcn_mfma_f32_32x32x16_bf16(pa3, ATT_PK(3), o[d0], 0, 0, 0);
#undef ATT_PK
    }
}
__device__ __forceinline__ void unit(int b, int h, int cg, const bf16* Q, const bf16* K, const bf16* V, const float* relb, bf16* O  , LAS unsigned char* shm,
                                     const MoeConv& cv, MoeConv::Regs& sreg, int& sctr, int item0, int istride) {
    const int tid = threadIdx.x, lane = tid & 63, r32 = lane & 31, hi = lane >> 5; const int wid = __builtin_amdgcn_readfirstlane(tid >> 6);
    const long rowbase = (long)b * SEQ; const int cq = 4 * cg + (wid >> 1), wq = wid & 1;
    const bf16* Qw = Q + (rowbase + 64 * cq + 32 * wq) * PITCH + h * HD;
    const unsigned lds0 = (unsigned)(uintptr_t)shm;
    LAS float* tbl = (LAS float*)(shm + L_TBL);
    LAS float* wsf = (LAS float*)(shm + L_WS) + wid * 64;
    for (int i = tid; i < NTBL; i += 512) tbl[i] = relb[h * NREL + (i < 512 ? i : 512)] * LOG2E;
    const int srow = tid >> 3, sc = tid & 7;
    const bf16* ksrc = K + (rowbase + srow) * PITCH + h * HD + sc * 8;
    const bf16* vsrc = V + (rowbase + srow) * PITCH + h * HD + sc * 8;
    const int kwr = L_K + sc * 1024 + ((srow ^ sc) << 4);
    const int vwr = L_V + (4 * (sc >> 2) + (srow >> 4)) * 1024 + (srow & 15) * 64 + (sc & 3) * 16;
    const int vb0 = (int)(lds0 + L_V) + ((lane >> 4) & 1) * 32 + (lane & 3) * 8 + (4 * hi + ((lane & 15) >> 2)) * 64;
    int kra[4];
#pragma unroll
    for (int d0 = 0; d0 < 4; ++d0) kra[d0] = L_K + (2 * d0 + hi) * 1024 + ((r32 ^ (2 * d0 + hi)) << 4);
    bf16x8 qr[4];
#pragma unroll
    for (int d0 = 0; d0 < 4; ++d0) qr[d0] = *reinterpret_cast<const bf16x8*>(&Qw[(long)r32 * PITCH + d0 * 16 + hi * 8]);
    f32x16 o[2]; o[0] = f32x16{}; o[1] = f32x16{}; float l_reg = 0.f;
    const int j0 = (8 - 4 * cg) > 0 ? (8 - 4 * cg) : 0;
    u32x4 kA_, vA_, kB_, vB_;
    { const long ro = (long)(4 * cg - 8 + j0) * 64 * PITCH; kA_ = *(const u32x4*)(ksrc + ro); vA_ = *(const u32x4*)(vsrc + ro); kB_ = *(const u32x4*)(ksrc + ro + 64 * PITCH); vB_ = *(const u32x4*)(vsrc + ro + 64 * PITCH); }
#define ATT_STEP(JX, SUBP, KR, VR) do { const int j = (JX); \
        const int s = (j - j0) & 1; \
        *(LAS u32x4*)(shm + kwr + s * SLOTB) = KR; *(LAS u32x4*)(shm + vwr + s * SLOTB) = VR; \
        if (j < 10) { const long ro = (long)(4 * cg - 8 + j + 2) * 64 * PITCH; KR = *(const u32x4*)(ksrc + ro); VR = *(const u32x4*)(vsrc + ro); } \
        asm volatile("s_waitcnt lgkmcnt(0)\n\ts_barrier" ::: "memory"); \
        cv.template sub<SUBP>(sreg, sctr, item0, istride, lane);     \
        const int d = (wid >> 1) + 8 - j; \
        if (d >= 0 && d <= 8) { \
            f32x16 p0 = f32x16{}, p1 = f32x16{}; \
            const LAS unsigned char* kbs = shm + s * SLOTB; \
        _Pragma("unroll") \
            for (int d0 = 0; d0 < 4; ++d0) { \
                const bf16x8 b0 = *(const LAS bf16x8*)(kbs + kra[d0]), b1 = *(const LAS bf16x8*)(kbs + kra[d0] + 512); \
                p0 = __builtin_amdgcn_mfma_f32_32x32x16_bf16(b0, qr[d0], p0, 0, 0, 0); p1 = __builtin_amdgcn_mfma_f32_32x32x16_bf16(b1, qr[d0], p1, 0, 0, 0); } \
            const LAS float* tb = tbl + (256 + 64 * d + 32 * wq + r32 - 4 * hi - 63); \
            float sacc = 0.f; \
        _Pragma("unroll") \
            for (int r = 0; r < 16; ++r) { const int c = (r & 3) + 8 * (r >> 2); \
                p0[r] = fast_exp2(p0[r] + tb[63 - c]); p1[r] = fast_exp2(p1[r] + tb[31 - c]); sacc += p0[r] + p1[r]; } \
            l_reg += sacc; \
            u32x4 pw0, pw1, pw2, pw3; \
            pw0 = (u32x4){cvtpk_s(p0[0], p0[1]), cvtpk_s(p0[2], p0[3]), cvtpk_s(p0[4], p0[5]), cvtpk_s(p0[6], p0[7])}; \
            pw1 = (u32x4){cvtpk_s(p0[8], p0[9]), cvtpk_s(p0[10], p0[11]), cvtpk_s(p0[12], p0[13]), cvtpk_s(p0[14], p0[15])}; \
            pw2 = (u32x4){cvtpk_s(p1[0], p1[1]), cvtpk_s(p1[2], p1[3]), cvtpk_s(p1[4], p1[5]), cvtpk_s(p1[6], p1[7])}; \
            pw3 = (u32x4){cvtpk_s(p1[8], p1[9]), cvtpk_s(p1[10], p1[11]), cvtpk_s(p1[12], p1[13]), cvtpk_s(p1[14], p1[15])}; \
            ATT_SBAR(); \
            pv(o, vb0 + s * SLOTB, __builtin_bit_cast(bf16x8, pw0), __builtin_bit_cast(bf16x8, pw1), __builtin_bit_cast(bf16x8, pw2), __builtin_bit_cast(bf16x8, pw3)); \
        } \
    } while (0)
    for (int jb = j0; jb < 12; jb += 4) { ATT_STEP(jb, 0, kA_, vA_); ATT_STEP(jb + 1, 1, kB_, vB_); ATT_STEP(jb + 2, 2, kA_, vA_); ATT_STEP(jb + 3, 3, kB_, vB_); }
#undef ATT_STEP
    asm volatile("s_waitcnt lgkmcnt(0)\n\ts_barrier" ::: "memory");
    { auto rr = __builtin_amdgcn_permlane32_swap(__float_as_uint(l_reg), __float_as_uint(l_reg), false, false); l_reg = __uint_as_float(rr[0]) + __uint_as_float(rr[1]); }
    if (hi == 0) wsf[32 + r32] = l_reg; asm volatile("s_waitcnt lgkmcnt(0)" ::: "memory");
    float rli[16];
#pragma unroll
    for (int r = 0; r < 16; ++r) rli[r] = fast_rcp(wsf[32 + crow(r, hi)]);
    bf16* Ow = O + (rowbase + 64 * cq + 32 * wq) * D + h * HD;
    { LAS bf16* stg = (LAS bf16*)(shm + L_OST) + wid * 2048;
#pragma unroll
        for (int r = 0; r < 16; ++r) { const int orow = crow(r, hi);
#pragma unroll
            for (int d0 = 0; d0 < 2; ++d0) stg[orow * 64 + d0 * 32 + r32] = (bf16)f2bf(o[d0][r] * rli[r]); }
        asm volatile("s_waitcnt lgkmcnt(0)" ::: "memory");
#pragma unroll
        for (int i = 0; i < 4; ++i) { const int row = i * 8 + (lane >> 3), ch = lane & 7; const u32x4 v = *(const LAS u32x4*)(stg + row * 64 + ch * 8); *(u32x4*)(Ow + (long)row * D + ch * 8) = v; } }
    asm volatile("s_waitcnt lgkmcnt(0)\n\ts_barrier" ::: "memory");
}
#undef ATT_SBAR
}

constexpr int SGU_WM_OFF = 128 * 136 * 2;
__device__ __forceinline__ void sgu_load_wm(int g, const bf16* WM, LAS unsigned char* shm) {
    const int tid = threadIdx.x, t = tid >> 2, c0 = (tid & 3) * 32;
    const bf16* src = WM + ((size_t)g * 128 + t) * 128 + c0;
#pragma unroll
    for (int q = 0; q < 4; ++q) *(LAS u32x4*)(shm + SGU_WM_OFF + (t * 136 + c0 + 8 * q) * 2) = *(const u32x4*)(src + 8 * q);
}
__device__ __forceinline__ void sgu_item(int item, const bf16* VG, const bf16* UG, const float* lng, const float* lnb, const float* sgb, bf16* YC, LAS unsigned char* shm,
                                         const MoeConv& cv, MoeConv::Regs& sreg, int& sctr, int item0, int istride) {
    const int tid = threadIdx.x, lane = tid & 63; const int wid = __builtin_amdgcn_readfirstlane(tid >> 6);
    const int g = item & 3, blk = item >> 2;
    const long t0 = (long)blk * 128;
    LAS bf16* vt = (LAS bf16*)shm;
    const LAS bf16* wmL = (const LAS bf16*)(shm + SGU_WM_OFF);
    const int ch = tid & 15, fr = lane & 15, fq = lane >> 4;
    u32x4 vraw[4];
#pragma unroll
    for (int it = 0; it < 4; ++it) vraw[it] = *(const u32x4*)(VG + (t0 + (tid >> 4) + 32 * it) * SGW + g * 128 + ch * 8);
    u32x2 uw[8]; float bs[8];
#pragma unroll
    for (int tt = 0; tt < 8; ++tt) { const int t = 16 * tt + fr; uw[tt] = *(const u32x2*)(UG + (size_t)(t0 + t) * SGW + g * 128 + 16 * wid + 4 * fq); bs[tt] = sgb[g * 128 + t]; }
    const f32x4 gA = *(const f32x4*)(lng + g * 128 + ch * 8), gB = *(const f32x4*)(lng + g * 128 + ch * 8 + 4);
    const f32x4 bA = *(const f32x4*)(lnb + g * 128 + ch * 8), bB = *(const f32x4*)(lnb + g * 128 + ch * 8 + 4);
#pragma unroll
    for (int it = 0; it < 4; ++it) {
        const int s = (tid >> 4) + 32 * it;
        const u32x4 w = vraw[it];
        f32x4 a = (f32x4){bflo(w.x), bfhi(w.x), bflo(w.y), bfhi(w.y)}, b = (f32x4){bflo(w.z), bfhi(w.z), bflo(w.w), bfhi(w.w)};
        float sum = (a[0] + a[1]) + (a[2] + a[3]) + (b[0] + b[1]) + (b[2] + b[3]);
        sum += __shfl_xor(sum, 1); sum += __shfl_xor(sum, 2); sum += __shfl_xor(sum, 4); sum += __shfl_xor(sum, 8);
        const float mean = sum * (1.0f / 128.0f);
        a = a - mean; b = b - mean;
        float q = (a[0] * a[0] + a[1] * a[1]) + (a[2] * a[2] + a[3] * a[3]) + (b[0] * b[0] + b[1] * b[1]) + (b[2] * b[2] + b[3] * b[3]);
        q += __shfl_xor(q, 1); q += __shfl_xor(q, 2); q += __shfl_xor(q, 4); q += __shfl_xor(q, 8);
        const float rstd = 1.0f / sqrtf(q * (1.0f / 128.0f) + EPS);
        a = a * rstd * gA + bA; b = b * rstd * gB + bB;
#pragma unroll
        for (int j = 0; j < 4; ++j) { vt[(j * 16 + ch) * 136 + s] = (bf16)f2bf(a[j]); vt[((4 + j) * 16 + ch) * 136 + s] = (bf16)f2bf(b[j]); }
    }
    asm volatile("s_waitcnt lgkmcnt(0)\n\ts_barrier" ::: "memory");
    f32x4 acc[8];
#pragma unroll
    for (int tt = 0; tt < 8; ++tt) acc[tt] = (f32x4){0.f, 0.f, 0.f, 0.f};
#pragma unroll
    for (int ks = 0; ks < 4; ++ks) {
        const bf16x8 a = *(const LAS bf16x8*)(vt + ((fr & 7) * 16 + 2 * wid + (fr >> 3)) * 136 + 32 * ks + 8 * fq);
#pragma unroll
        for (int tt = 0; tt < 8; ++tt) if (ks <= (tt >> 1)) {
            const bf16x8 bfrag = *(const LAS bf16x8*)(wmL + (16 * tt + fr) * 136 + 32 * ks + 8 * fq);
            acc[tt] = __builtin_amdgcn_mfma_f32_16x16x32_bf16(a, bfrag, acc[tt], 0, 0, 0); }
    }
#pragma unroll
    for (int tt = 0; tt < 8; ++tt) { const int t = 16 * tt + fr; const float b_ = bs[tt];
        const u32x2 u_ = uw[tt];
        u32x2 w; w.x = cvt_pk_bf16(bflo(u_.x) * (acc[tt][0] + b_), bfhi(u_.x) * (acc[tt][1] + b_)); w.y = cvt_pk_bf16(bflo(u_.y) * (acc[tt][2] + b_), bfhi(u_.y) * (acc[tt][3] + b_));
        *(u32x2*)(YC + (size_t)(t0 + t) * D + AW + g * 128 + 16 * wid + 4 * fq) = w; }
    asm volatile("s_waitcnt lgkmcnt(0)\n\ts_barrier" ::: "memory");
}

#define XB_TMO      128
#define XB_XCNT(j)  (256  + 64 * (j))
#define XB_XSUB(j)  (1280 + 64 * (j))
#define XB_XGEN(j)  (2304 + 64 * (j))
#define XB_TOP      3328
#define XB_TOPGEN   3392
#define XCD_BAR_WORDS 3456
#define XB_SPIN_CAP (1u << 18)
__device__ __forceinline__ unsigned xb_ld(unsigned* p)              { return __hip_atomic_load(p, __ATOMIC_RELAXED, __HIP_MEMORY_SCOPE_AGENT); }
__device__ __forceinline__ unsigned xb_add(unsigned* p, unsigned v) { return __hip_atomic_fetch_add(p, v, __ATOMIC_RELAXED, __HIP_MEMORY_SCOPE_AGENT); }
__device__ __forceinline__ unsigned xb_xcc_id() { return (unsigned)__builtin_amdgcn_s_getreg((3 << 11) | 20) & 0xFu; }
#define XB_SPIN(cond, bar) do { unsigned _sp = 0; while (cond) { __builtin_amdgcn_s_sleep(1); \
    if ((++_sp & 255u) == 0u) { if (xb_ld(&(bar)[XB_TMO])) break; if (_sp > XB_SPIN_CAP) { atomicAdd(&(bar)[XB_TMO], 1u); break; } } } } while (0)
struct XcdBarrier { unsigned* bar; unsigned x; volatile LAS unsigned* st; };
__device__ __forceinline__ XcdBarrier xcd_barrier_post(unsigned* bar, volatile LAS unsigned* st) {
    XcdBarrier b; b.bar = bar; b.x = xb_xcc_id(); b.st = st;
    if (threadIdx.x == 0) (void)xb_add(&bar[XB_XCNT(b.x)], 1u);
    return b;
}
__device__ __forceinline__ void xcd_barrier_complete(unsigned* bar, unsigned x, unsigned& nloc, unsigned& nx) {
    const unsigned G = gridDim.x * gridDim.y * gridDim.z;
    unsigned sum, cnt, mine, sp = 0u;
    for (;;) {
        sum = 0u; cnt = 0u; mine = 0u;
#pragma unroll
        for (unsigned j = 0; j < 16; ++j) { const unsigned c = xb_ld(&bar[XB_XCNT(j)]); sum += c; cnt += (c > 0u) ? 1u : 0u; mine = (j == x) ? c : mine; }
        if (sum == G) break;
        __builtin_amdgcn_s_sleep(1);
        if ((++sp & 255u) == 0u) { if (xb_ld(&bar[XB_TMO])) break; if (sp > XB_SPIN_CAP) { atomicAdd(&bar[XB_TMO], 1u); break; } }
    }
    nloc = mine > 0u ? mine : 1u; nx = cnt > 0u ? cnt : 1u;
}
__device__ __forceinline__ void xcd_barrier(const XcdBarrier& b) {
    asm volatile("s_waitcnt vmcnt(0)" ::: "memory");
    __syncthreads();
    if (threadIdx.x == 0) {
        unsigned* bar = b.bar;
        __builtin_amdgcn_s_waitcnt(0);
        unsigned nloc = b.st[0], nx = b.st[1];
        if (nloc == 0u) { xcd_barrier_complete(bar, b.x, nloc, nx); b.st[0] = nloc; b.st[1] = nx; }
        const unsigned old = xb_add(&bar[XB_XSUB(b.x)], 1u);
        const unsigned gen = old / nloc;
        if (old + 1u == (gen + 1u) * nloc) {
            __builtin_amdgcn_fence(__ATOMIC_RELEASE, "agent");
            asm volatile("s_waitcnt vmcnt(0)" ::: "memory");
            const unsigned og = xb_add(&bar[XB_TOP], 1u);
            const unsigned tg = og / nx;
            if (og + 1u == (tg + 1u) * nx) xb_add(&bar[XB_TOPGEN], 1u);
            else XB_SPIN(xb_ld(&bar[XB_TOPGEN]) == tg, bar);
            __builtin_amdgcn_fence(__ATOMIC_ACQUIRE, "agent");
            xb_add(&bar[XB_XGEN(b.x)], 1u);
            asm volatile("s_waitcnt vmcnt(0)" ::: "memory");
        } else {
            XB_SPIN(xb_ld(&bar[XB_XGEN(b.x)]) == gen, bar);
            __builtin_amdgcn_fence(__ATOMIC_ACQUIRE, "agent");
            asm volatile("s_waitcnt vmcnt(0)" ::: "memory");
        }
    }
    __syncthreads();
}

__device__ __forceinline__ float wave_sum(float v) {
#pragma unroll
    for (int o = 1; o < 64; o <<= 1) v += __shfl_xor(v, o);
    return v;
}
__device__ __forceinline__ int pos_gen(int n0) { return (n0 & ~255) + ((n0 >> 5) & 1) * 128 + ((n0 >> 6) & 3) * 32; }
__device__ __forceinline__ int pos_gu(int c0) { const int up = c0 >= 1024, cc = c0 & 1023; return (cc >> 7) * 256 + up * 128 + ((cc >> 5) & 3) * 32; }
__device__ __forceinline__ unsigned pack_i8(const f32x4& v) {
    const int a = (int)__builtin_rintf(v.x), b = (int)__builtin_rintf(v.y), c = (int)__builtin_rintf(v.z), d = (int)__builtin_rintf(v.w);
    return ((unsigned)a & 255u) | (((unsigned)b & 255u) << 8) | (((unsigned)c & 255u) << 16) | ((unsigned)d << 24);
}
__device__ __forceinline__ void win_absmax(const float* W, int k0, int n0, unsigned* cmax, unsigned* ccnt, int lane) {
    const int kc = lane >> 4, nq = lane & 15;
    f32x4 v[16];
#pragma unroll
    for (int i = 0; i < 16; ++i) v[i] = *(const f32x4*)(W + (size_t)(k0 + 16 * kc + i) * INW + n0 + 4 * nq);
    f32x4 mx = (f32x4){0.f, 0.f, 0.f, 0.f};
#pragma unroll
    for (int i = 0; i < 16; ++i) { mx.x = fmaxf(mx.x, fabsf(v[i].x)); mx.y = fmaxf(mx.y, fabsf(v[i].y)); mx.z = fmaxf(mx.z, fabsf(v[i].z)); mx.w = fmaxf(mx.w, fabsf(v[i].w)); }
#pragma unroll
    for (int c = 0; c < 4; ++c) { mx[c] = fmaxf(mx[c], __shfl_xor(mx[c], 16)); mx[c] = fmaxf(mx[c], __shfl_xor(mx[c], 32)); }
    if (kc == 0) {
#pragma unroll
        for (int c = 0; c < 4; ++c) (void)__hip_atomic_fetch_max(cmax + n0 + 4 * nq + c, __float_as_uint(mx[c]), RLX_AGENT);
    }
    asm volatile("s_waitcnt vmcnt(0)" ::: "memory");
    if (lane == 0) (void)__hip_atomic_fetch_add(ccnt, 1u, RLX_AGENT);
}
__device__ __forceinline__ void win_quant(const float* W, int k0, int n0, unsigned char* WT, unsigned* cmax, unsigned* ccnt, float* cs, bool write_cs, unsigned* tmo, int lane) {
    const int kc = lane >> 4, nq = lane & 15;
    f32x4 v[16];
#pragma unroll
    for (int i = 0; i < 16; ++i) v[i] = *(const f32x4*)(W + (size_t)(k0 + 16 * kc + i) * INW + n0 + 4 * nq);
    { unsigned sp = 0; while (__hip_atomic_load(ccnt, RLX_AGENT) < 16u) { __builtin_amdgcn_s_sleep(1);
        if ((++sp & 255u) == 0u) { if (__hip_atomic_load(tmo, RLX_AGENT)) break; if (sp > (1u << 18)) { atomicAdd(tmo, 1u); break; } } } }
    asm volatile("" ::: "memory");
    float sc[4];
#pragma unroll
    for (int c = 0; c < 4; ++c) { const float cm = __uint_as_float(__hip_atomic_load(cmax + n0 + 4 * nq + c, RLX_AGENT)); sc[c] = cm > 0.f ? 127.0f / cm : 0.f; if (write_cs && kc == 0) cs[n0 + 4 * nq + c] = cm * (1.0f / 127.0f); }
    const int nb = n0 + 32 * (nq >> 3);
    const int rowb = pos_gen(nb) + ((4 * nq) & 31);
#pragma unroll
    for (int c = 0; c < 4; ++c) {
        u32x4 o;
        o.x = pack_i8((f32x4){v[0][c], v[1][c], v[2][c], v[3][c]} * sc[c]); o.y = pack_i8((f32x4){v[4][c], v[5][c], v[6][c], v[7][c]} * sc[c]);
        o.z = pack_i8((f32x4){v[8][c], v[9][c], v[10][c], v[11][c]} * sc[c]); o.w = pack_i8((f32x4){v[12][c], v[13][c], v[14][c], v[15][c]} * sc[c]);
        *(u32x4*)(WT + (size_t)(rowb + c) * D + k0 + 16 * kc) = o;
    }
}
template <int MODE, int POSK>
__device__ __forceinline__ void tr_tile(const float* W, int N, int k0, int n0, unsigned char* WT, int ldt_bytes, int dk0, const float* ks, float wscale, int lane, int rowadj = 0) {
    const int kc = lane >> 4, nq = lane & 15;
    f32x4 v[16];
#pragma unroll
    for (int i = 0; i < 16; ++i) { const int kk = MODE ? (16 * kc + i) : (32 * (i >> 3) + 8 * kc + (i & 7)); v[i] = *(const f32x4*)(W + (size_t)(k0 + kk) * N + n0 + 4 * nq); }
    if (ks) {
#pragma unroll
        for (int i = 0; i < 16; ++i) { const int kk = MODE ? (16 * kc + i) : (32 * (i >> 3) + 8 * kc + (i & 7)); v[i] = v[i] * (ks[k0 + kk] * wscale); }
    } else if (MODE) {
#pragma unroll
        for (int i = 0; i < 16; ++i) v[i] = v[i] * wscale;
    }
    const int nb = n0 + 32 * (nq >> 3);
    const int rowb = (POSK ? pos_gu(nb) : pos_gen(nb)) + ((4 * nq) & 31) + rowadj;
#pragma unroll
    for (int c = 0; c < 4; ++c) {
        unsigned char* rp = WT + (size_t)(rowb + c) * ldt_bytes;
        if (MODE == 0) {
#pragma unroll
            for (int p = 0; p < 2; ++p) { u32x4 o; o.x = pk2(v[8 * p + 0][c], v[8 * p + 1][c]); o.y = pk2(v[8 * p + 2][c], v[8 * p + 3][c]); o.z = pk2(v[8 * p + 4][c], v[8 * p + 5][c]); o.w = pk2(v[8 * p + 6][c], v[8 * p + 7][c]);
                *(u32x4*)(rp + (size_t)(dk0 + 32 * p + 8 * kc) * 2) = o; }
        } else {
            int w0 = 0, w1 = 0, w2 = 0, w3 = 0;
            w0 = __builtin_amdgcn_cvt_pk_fp8_f32(v[0][c], v[1][c], w0, false); w0 = __builtin_amdgcn_cvt_pk_fp8_f32(v[2][c], v[3][c], w0, true);
            w1 = __builtin_amdgcn_cvt_pk_fp8_f32(v[4][c], v[5][c], w1, false); w1 = __builtin_amdgcn_cvt_pk_fp8_f32(v[6][c], v[7][c], w1, true);
            w2 = __builtin_amdgcn_cvt_pk_fp8_f32(v[8][c], v[9][c], w2, false); w2 = __builtin_amdgcn_cvt_pk_fp8_f32(v[10][c], v[11][c], w2, true);
            w3 = __builtin_amdgcn_cvt_pk_fp8_f32(v[12][c], v[13][c], w3, false); w3 = __builtin_amdgcn_cvt_pk_fp8_f32(v[14][c], v[15][c], w3, true);
            *(u32x4*)(rp + (size_t)(dk0 + 16 * kc)) = (u32x4){(unsigned)w0, (unsigned)w1, (unsigned)w2, (unsigned)w3};
        }
    }
}

struct Args { const float* in[20]; float* out; unsigned char* ws; int ph_lo, ph_hi, li, pad; };

__global__ void __launch_bounds__(512, 2) moe_block_fwd(Args args) {
    extern __shared__ __attribute__((aligned(16))) unsigned char lds_raw[];
    LAS unsigned char* lds = (LAS unsigned char*)lds_raw;
    volatile LAS unsigned* MISC = (volatile LAS unsigned*)(lds + MISC_OFF);
    const int tid = threadIdx.x, lane = tid & 63, wave = __builtin_amdgcn_readfirstlane(tid >> 6);
    const int G = gridDim.x, bx = blockIdx.x;
    const int vcu = (G % 8 == 0) ? (bx % 8) * (G / 8) + bx / 8 : bx;
    unsigned char* ws = args.ws;
    gu32* ctl = (gu32*)(ws + WS_CTL);
    const float* x = args.in[0]; const float* norm1_g = args.in[1]; const float* w_in = args.in[2]; const float* q_norm_g = args.in[3]; const float* k_norm_g = args.in[4];
    const float* rel_bias = args.in[5]; const float* sg_ln_g = args.in[6]; const float* sg_ln_b = args.in[7]; const float* sg_w = args.in[8]; const float* sg_b = args.in[9];
    const float* w_branch_a = args.in[10]; const float* w_branch_b = args.in[11]; const float* w_out = args.in[12]; const float* norm2_g = args.in[13];
    const float* router_w = args.in[14]; const float* router_b = args.in[15]; const float* w_gate_up = args.in[16]; const float* b_gate_up = args.in[17];
    const float* w_down = args.in[18]; const float* b_down = args.in[19];
    float* out = args.out;
    bf16* WIN = (bf16*)(ws + WS_WIN); unsigned char* WIN8 = ws + WS_WIN8; float* HS = (float*)(ws + WS_HS); float* CS = (float*)(ws + WS_CS); unsigned char* H8 = ws + WS_H8; bf16* WAB = (bf16*)(ws + WS_WAB); bf16* WO = (bf16*)(ws + WS_WO); bf16* WRH = (bf16*)(ws + WS_WR); bf16* WRL = (bf16*)(ws + WS_WR + 65536); bf16* WM = (bf16*)(ws + WS_WM);
    int* LID = (int*)(ws + WS_LID); float* LRS = (float*)(ws + WS_LRS); float* LP = (float*)(ws + WS_LP);
    unsigned char* WGU = ws + WS_WGU; unsigned char* WD = ws + WS_WD;
    bf16* HB = (bf16*)(ws + WS_H); bf16* QB = (bf16*)(ws + WS_Q); bf16* KB = (bf16*)(ws + WS_K); bf16* VB = (bf16*)(ws + WS_V);
    bf16* UG = (bf16*)(ws + WS_UG); bf16* VG = (bf16*)(ws + WS_VG); unsigned char* GA = ws + WS_GA; bf16* GB = (bf16*)(ws + WS_GB);
    bf16* YCAT = (bf16*)(ws + WS_YCAT); unsigned char* X1Q = ws + WS_X1B; bf16* X1H = (bf16*)(ws + WS_X1H); unsigned char* ACT = ws + WS_ACT; unsigned char* YB = ws + WS_Y;

    for (int u = tid; u < (LDS_BYTES - LDSCTL_OFF) / 4; u += 512) ((LAS unsigned*)(lds + LDSCTL_OFF))[u] = 0u;
    __syncthreads();
    XcdBarrier bar; bar.bar = (unsigned*)(ctl + CW_BAR); bar.x = 0; bar.st = nullptr;
    if (MK_N_LAUNCHES == 1) bar = xcd_barrier_post((unsigned*)(ctl + CW_BAR), MISC + 8);
    const int lo = args.ph_lo, hi = args.ph_hi;
#define IN(k) (lo <= (k) && (k) < hi)
#define SEAM(k) do { if (IN(k) && IN((k) + 1)) xcd_barrier(bar); } while (0)
#define REPS(k) for (int rep_ = 0; rep_ < ((REP_PHASE == (k)) ? 2 : 1); ++rep_)
#define REPSEAM(k) do { if (REP_PHASE == (k) && rep_ == 0) xcd_barrier(bar); } while (0)
    const int gw = vcu * 8 + wave, NGW = G * 8;

    if (IN(0)) REPS(0) {
        constexpr int I_IN = 16 * 72, I_A = 8 * 16, I_O = 16 * 16, I_GU = 16 * 32, I_D = 16 * 16;
        constexpr int NITEMS = I_IN + 2 * I_A + I_O;
        for (int it = gw; it < NITEMS; it += NGW) {
            int r = it;
            if (r < I_IN) { const int kb = r / 72, nb = r % 72; win_absmax(w_in, 64 * kb, 64 * nb, (unsigned*)(ctl + CW_CMAX), (unsigned*)(ctl + CW_CCNT + nb), lane); continue; } r -= I_IN;
            if (r < I_A) { const int kb = r / 16, nb = r % 16; tr_tile<0, 0>(w_branch_a, D, 64 * kb, 64 * nb, (unsigned char*)WAB, D * 2, 64 * kb, nullptr, 1.f, lane); continue; } r -= I_A;
            if (r < I_A) { const int kb = r / 16, nb = r % 16; tr_tile<0, 0>(w_branch_b, D, 64 * kb, 64 * nb, (unsigned char*)WAB, D * 2, 512 + 64 * kb, nullptr, 1.f, lane); continue; } r -= I_A;
            { const int kb = r / 16, nb = r % 16; tr_tile<0, 0>(w_out, D, 64 * kb, 64 * nb, (unsigned char*)WO, D * 2, 64 * kb, nullptr, 1.f, lane); }
        }
        for (int i = gw * 64 + lane; i < 4 * 128 * 128; i += NGW * 64) { const int s = i & 127, t = (i >> 7) & 127; WM[i] = (bf16)f2bf(s <= t ? sg_w[i] : 0.f); }
        for (int i = gw * 64 + lane; i < NE * D; i += NGW * 64) { const int k = i & 1023, e = i >> 10; const float w = router_w[k * NE + e] * norm2_g[k]; const unsigned h_ = f2bf(w); WRH[i] = (bf16)h_; WRL[i] = (bf16)f2bf(w - bf2f((unsigned short)h_)); }
        for (int m = 2 * gw; m < T; m += 2 * NGW) {
            const f32x4* xr = (const f32x4*)(x + (size_t)m * D) + lane; const f32x4* gr = (const f32x4*)norm1_g + lane;
            f32x4 v[2][4]; float s0 = 0.f, s1 = 0.f, a0 = 0.f, a1 = 0.f;
#pragma unroll
            for (int j = 0; j < 4; ++j) { v[0][j] = xr[64 * j]; v[1][j] = xr[256 + 64 * j]; }
#pragma unroll
            for (int j = 0; j < 4; ++j) { const f32x4 gq = gr[64 * j];
                s0 += (v[0][j].x * v[0][j].x + v[0][j].y * v[0][j].y) + (v[0][j].z * v[0][j].z + v[0][j].w * v[0][j].w);
                s1 += (v[1][j].x * v[1][j].x + v[1][j].y * v[1][j].y) + (v[1][j].z * v[1][j].z + v[1][j].w * v[1][j].w);
                v[0][j] = v[0][j] * gq; v[1][j] = v[1][j] * gq;
                a0 = fmaxf(a0, fmaxf(fmaxf(fabsf(v[0][j].x), fabsf(v[0][j].y)), fmaxf(fabsf(v[0][j].z), fabsf(v[0][j].w))));
                a1 = fmaxf(a1, fmaxf(fmaxf(fabsf(v[1][j].x), fabsf(v[1][j].y)), fmaxf(fabsf(v[1][j].z), fabsf(v[1][j].w)))); }
            s0 = wave_sum(s0); s1 = wave_sum(s1);
#pragma unroll
            for (int o = 1; o < 64; o <<= 1) { a0 = fmaxf(a0, __shfl_xor(a0, o)); a1 = fmaxf(a1, __shfl_xor(a1, o)); }
            const float rs0 = 1.0f / sqrtf(s0 * (1.0f / D) + EPS), rs1 = 1.0f / sqrtf(s1 * (1.0f / D) + EPS);
            const float q0 = a0 > 0.f ? 127.0f / a0 : 0.f, q1 = a1 > 0.f ? 127.0f / a1 : 0.f;
            if (lane == 0) { HS[m] = rs0 * a0 * (1.0f / 127.0f); HS[m + 1] = rs1 * a1 * (1.0f / 127.0f); }
            unsigned* q8 = (unsigned*)(H8 + (size_t)m * D) + lane;
#pragma unroll
            for (int j = 0; j < 4; ++j) { q8[64 * j] = pack_i8(v[0][j] * q0); q8[256 + 64 * j] = pack_i8(v[1][j] * q1); }
        }
        for (int it = gw; it < I_IN; it += NGW) { const int kb = it / 72, nb = it % 72;
            win_quant(w_in, 64 * kb, 64 * nb, WIN8, (unsigned*)(ctl + CW_CMAX), (unsigned*)(ctl + CW_CCNT + nb), CS, kb == 0, (unsigned*)(ctl + CW_BAR) + XB_TMO, lane); }
        REPSEAM(0);
    }
    SEAM(0);

    if (IN(1)) REPS(1) {
        { PolIn P; P.so.init(T, INW, G, bx); P.A = H8; P.Bt = WIN8; P.ws = ws; P.qg = q_norm_g; P.kg = k_norm_g; P.hs = HS; P.cs = CS; P.shm = lds;
          pg8::gemm_phase<PolIn>(lds, P); }
        REPSEAM(1);
    }
    SEAM(1);

    if (IN(2)) REPS(2) {
        const MoeConv cv{w_gate_up, w_down, norm2_g, WGU, WD}; MoeConv::Regs sreg; int sctr = 0;
        for (int u = vcu; u < NB * NHEAD * 32; u += G) {
            const int cg = u & 31, bh = u >> 5;
            att::unit(bh >> 3, bh & 7, cg, QB, KB, VB, rel_bias, YCAT, lds, cv, sreg, sctr, gw, NGW);
        }
        sgu_load_wm(vcu & 3, WM, lds);
        for (int it = vcu; it < 4 * (T / 128); it += G) sgu_item(it, VG, UG, sg_ln_g, sg_ln_b, sg_b, YCAT, lds, cv, sreg, sctr, gw, NGW);
        cv.drain(sreg, sctr, gw, NGW, lane);
        REPSEAM(2);
    }
    SEAM(2);

    if (IN(3)) REPS(3) {
        PolMerge P; P.so.init(T, D, G, bx); P.A = YCAT; P.Bt = WAB; P.ga = GA; P.gb = (const unsigned char*)GB; P.out = HB;
        pg8::gemm_phase<PolMerge>(lds, P);
        REPSEAM(3);
    }
    SEAM(3);

    if (IN(4)) REPS(4) {
        PolOut P; P.so.init(T, D, G, bx); P.A = HB; P.Bt = WO; P.x = x; P.x1 = X1H; P.x1q = X1Q;
        pg8::gemm_phase<PolOut>(lds, P);
        REPSEAM(4);
    }
    SEAM(4);

    if (IN(5)) {
        LAS int* lcnt = (LAS int*)(lds + PARK_OFF); LAS int* gbase = lcnt + 32;
        if (tid < 64) lcnt[tid] = 0;
        for (int i = tid; i < 4096; i += 512) { const int e = i & 31, gq = (i >> 5) & 3, kq = i >> 7;
            *(LAS u32x4*)(lds + (size_t)i * 16) = *(const u32x4*)(WRH + (size_t)e * D + 32 * kq + 8 * gq); *(LAS u32x4*)(lds + 65536 + (size_t)i * 16) = *(const u32x4*)(WRL + (size_t)e * D + 32 * kq + 8 * gq); }
        __syncthreads();
        const int r = lane & 15, g = lane >> 4;
        int sel_e[4], sel_rank[4]; float sel_p[4]; float rs_row = 0.f; int tok = 0;
        for (int grp = bx * 8 + wave; grp < T / 16; grp += NGW) {
            const int row0 = grp * 16; tok = row0 + r;
            const bf16* xr = X1H + (size_t)(row0 + r) * D + 8 * g;
            const LAS unsigned char* wl_ = lds + (g * 32 + r) * 16;
            f32x4 a0 = (f32x4){0.f, 0.f, 0.f, 0.f}, a1 = a0; float ssq = 0.f;
            u32x4 xq[4][4];
#define P5_LOAD(S, ss) do { _Pragma("unroll") for (int q = 0; q < 4; ++q) xq[S][q] = *(const u32x4*)(xr + 128 * (ss) + 32 * q); } while (0)
#define P5_COMP(S, ss) do { _Pragma("unroll") for (int q = 0; q < 4; ++q) { const u32x4 w_ = xq[S][q]; const int ks = 4 * (ss) + q; \
                const bf16x8 wh_0 = *(const LAS bf16x8*)(wl_ + ks * 2048), wh_1 = *(const LAS bf16x8*)(wl_ + ks * 2048 + 256), wl_0 = *(const LAS bf16x8*)(wl_ + 65536 + ks * 2048), wl_1 = *(const LAS bf16x8*)(wl_ + 65536 + ks * 2048 + 256); \
                ssq += (bflo(w_.x) * bflo(w_.x) + bfhi(w_.x) * bfhi(w_.x)) + (bflo(w_.y) * bflo(w_.y) + bfhi(w_.y) * bfhi(w_.y)) + (bflo(w_.z) * bflo(w_.z) + bfhi(w_.z) * bfhi(w_.z)) + (bflo(w_.w) * bflo(w_.w) + bfhi(w_.w) * bfhi(w_.w)); \
                const bf16x8 xh = __builtin_bit_cast(bf16x8, w_); \
                a0 = __builtin_amdgcn_mfma_f32_16x16x32_bf16(wh_0, xh, a0, 0, 0, 0); a1 = __builtin_amdgcn_mfma_f32_16x16x32_bf16(wh_1, xh, a1, 0, 0, 0); \
                a0 = __builtin_amdgcn_mfma_f32_16x16x32_bf16(wl_0, xh, a0, 0, 0, 0); a1 = __builtin_amdgcn_mfma_f32_16x16x32_bf16(wl_1, xh, a1, 0, 0, 0); } } while (0)
            P5_LOAD(0, 0); P5_LOAD(1, 1); P5_LOAD(2, 2); P5_LOAD(3, 3);
            P5_COMP(0, 0); P5_LOAD(0, 4);
            P5_COMP(1, 1); P5_LOAD(1, 5);
            P5_COMP(2, 2); P5_LOAD(2, 6);
            P5_COMP(3, 3); P5_LOAD(3, 7);
            P5_COMP(0, 4); P5_COMP(1, 5); P5_COMP(2, 6); P5_COMP(3, 7);
#undef P5_LOAD
#undef P5_COMP
            ssq += __shfl_xor(ssq, 16); ssq += __shfl_xor(ssq, 32);
            const float rs = 1.0f / sqrtf(ssq * (1.0f / D) + EPS); rs_row = rs;
            float v[8];
#pragma unroll
            for (int j = 0; j < 4; ++j) { v[j] = a0[j] * rs + router_b[4 * g + j]; v[4 + j] = a1[j] * rs + router_b[16 + 4 * g + j]; }
            unsigned taken = 0u; float sel_v[4];
#pragma unroll
            for (int k = 0; k < 4; ++k) {
                float best = -INFINITY; int bi = 1 << 20;
#pragma unroll
                for (int i = 0; i < 8; ++i) { const int ei = (i >> 2) * 16 + 4 * g + (i & 3); if (!((taken >> i) & 1u) && v[i] > best) { best = v[i]; bi = ei; } }
#pragma unroll
                for (int m = 16; m <= 32; m <<= 1) { const float ob = __shfl_xor(best, m); const int oi = __shfl_xor(bi, m); if (ob > best || (ob == best && oi < bi)) { best = ob; bi = oi; } }
                sel_e[k] = bi; sel_v[k] = best;
                if (((bi & 15) >> 2) == g) taken |= 1u << (((bi >> 4) << 2) | (bi & 3));
            }
            float den = 0.f;
#pragma unroll
            for (int k = 0; k < 4; ++k) { sel_p[k] = __expf(sel_v[k] - sel_v[0]); den += sel_p[k]; }
            const float inv = 1.0f / den;
#pragma unroll
            for (int k = 0; k < 4; ++k) sel_p[k] *= inv;
            if (g == 0) {
#pragma unroll
                for (int k = 0; k < 4; ++k) sel_rank[k] = __hip_atomic_fetch_add(lcnt + sel_e[k], 1, __ATOMIC_RELAXED, __HIP_MEMORY_SCOPE_WORKGROUP);
            }
        }
        __syncthreads();
        if (tid < NE) gbase[tid] = (int)__hip_atomic_fetch_add((unsigned*)(ctl + CW_CNT + tid), (unsigned)lcnt[tid], RLX_AGENT);
        __syncthreads();
        if (g == 0 && (bx * 8 + wave) < T / 16) {
#pragma unroll
            for (int k = 0; k < 4; ++k) { const size_t pos = (size_t)sel_e[k] * LCAP + gbase[sel_e[k]] + sel_rank[k];
                LID[pos] = tok * 4 + k; LRS[pos] = rs_row; LP[pos] = sel_p[k]; }
        }
        __syncthreads();
    }
    SEAM(5);

    if (IN(6) || IN(7)) {
        LAS int* tb = (LAS int*)(lds + MOE_OFF);
        if (tid < NE) tb[33 + tid] = (int)__hip_atomic_load(ctl + CW_CNT + tid, RLX_AGENT);
        __syncthreads();
        if (tid == 0) { int acc = 0; for (int e = 0; e < NE; ++e) { tb[e] = acc; acc += (tb[33 + e] + 255) >> 8; } tb[32] = acc; }
        __syncthreads();
    }
    if (IN(6)) REPS(6) {
        PolGU P; P.mo.init((const LAS int*)(lds + MOE_OFF), 8, G, bx); P.A = X1Q; P.Bt = WGU; P.lid = LID; P.lrs = LRS; P.bgu = b_gate_up; P.act = ACT; P.shm = lds;
        pg8::gemm_phase<PolGU>(lds, P);
        REPSEAM(6);
    }
    SEAM(6);
    if (IN(7)) REPS(7) {
        PolDown P; P.mo.init((const LAS int*)(lds + MOE_OFF), 4, G, bx); P.A = ACT; P.Bt = WD; P.lid = LID; P.lp = LP; P.bd = b_down; P.y = YB; P.shm = lds;
        pg8::gemm_phase<PolDown>(lds, P);
        REPSEAM(7);
    }
    SEAM(7);
    if (IN(8)) {
        f32x4 xa[4], xb[4]; u32x4 ya[4], yb[4];
#define P8_LOAD(X, Y, m_) do { const bf16* xr_ = X1H + (size_t)(m_) * D + 16 * lane; { f32x4 a_, b_; ld8(xr_, a_, b_); X[0] = a_; X[1] = b_; ld8(xr_ + 8, a_, b_); X[2] = a_; X[3] = b_; } \
            _Pragma("unroll") for (int k = 0; k < 4; ++k) Y[k] = *(const u32x4*)(YB + ((size_t)(m_) * 4 + k) * D + 16 * lane); } while (0)
#define P8_DONE(X, Y, m_) do { _Pragma("unroll") for (int k = 0; k < 4; ++k) { const unsigned ww[4] = {Y[k].x, Y[k].y, Y[k].z, Y[k].w}; \
            _Pragma("unroll") for (int q = 0; q < 4; ++q) { const f32x2 lo_ = __builtin_amdgcn_cvt_pk_f32_fp8((int)ww[q], false), hi_ = __builtin_amdgcn_cvt_pk_f32_fp8((int)ww[q], true); \
                X[q][0] += lo_[0] * 0.0625f; X[q][1] += lo_[1] * 0.0625f; X[q][2] += hi_[0] * 0.0625f; X[q][3] += hi_[1] * 0.0625f; } } \
            float* or_ = out + (size_t)(m_) * D + 16 * lane; _Pragma("unroll") for (int j = 0; j < 4; ++j) *(f32x4*)(or_ + 4 * j) = X[j]; } while (0)
        for (int m = gw; m < T; m += 2 * NGW) { const int m2 = m + NGW;
            P8_LOAD(xa, ya, m); P8_LOAD(xb, yb, m2);
            P8_DONE(xa, ya, m); P8_DONE(xb, yb, m2); }
#undef P8_LOAD
#undef P8_DONE
    }
#undef IN
#undef SEAM
}

extern "C" void kernel_launch(void* const* d_in, const int* in_sizes, int n_in, void* d_out, int out_size, void* d_ws, size_t ws_size, hipStream_t stream) {
    static int grid = 0;
    if (grid == 0) {
        if (n_in != 20 || in_sizes[0] != T * D || out_size != T * D || ws_size < WS_END) { fprintf(stderr, "kernel_launch: unexpected shapes (n_in %d, ws %zu)\n", n_in, ws_size); grid = -1; return; }
        int dev = 0, cus = 0;
        if (hipGetDevice(&dev) != hipSuccess || hipDeviceGetAttribute(&cus, hipDeviceAttributeMultiprocessorCount, dev) != hipSuccess) { grid = -1; return; }
        if (hipFuncSetAttribute((const void*)moe_block_fwd, hipFuncAttributeMaxDynamicSharedMemorySize, LDS_BYTES) != hipSuccess) { fprintf(stderr, "kernel_launch: hipFuncSetAttribute failed\n"); grid = -1; return; }
        (void)hipGetLastError();
        grid = cus;
        if (grid != 256) { fprintf(stderr, "kernel_launch: built for a 256-CU device, got %d\n", cus); grid = -1; return; }
    }
    if (grid < 0) return;
    if (hipMemsetAsync((char*)d_ws + WS_CTL, 0, CTL_ZERO_BYTES, stream) != hipSuccess) return;
    Args a{};
    for (int i = 0; i < 20; ++i) a.in[i] = (const float*)d_in[i];
    a.out = (float*)d_out; a.ws = (unsigned char*)d_ws;
    constexpr int NPH = 9;
    for (int li = 0; li < MK_N_LAUNCHES; ++li) {
        a.ph_lo = (MK_N_LAUNCHES == 1) ? 0 : li; a.ph_hi = (MK_N_LAUNCHES == 1) ? NPH : li + 1; a.li = li;
        hipLaunchKernelGGL(moe_block_fwd, dim3(grid), dim3(512), LDS_BYTES, stream, a);
    }
}
```

```cpp
#include <hip/hip_runtime.h>
#include <cstdio>
#include <cstdint>

#ifndef MK_N_LAUNCHES
#define MK_N_LAUNCHES 1
#endif

#ifndef REP_PHASE
#define REP_PHASE -1
#endif
#define LAS __attribute__((address_space(3)))
#define GAS __attribute__((address_space(1)))
typedef unsigned short bf16;
typedef short bf16x8 __attribute__((ext_vector_type(8)));
typedef short s16x4 __attribute__((ext_vector_type(4)));
typedef float f32x2 __attribute__((ext_vector_type(2)));
typedef float f32x4 __attribute__((ext_vector_type(4)));
typedef float f32x16 __attribute__((ext_vector_type(16)));
typedef unsigned u32x2 __attribute__((ext_vector_type(2)));
typedef unsigned u32x4 __attribute__((ext_vector_type(4)));
typedef GAS unsigned gu32;

constexpr int NB = 4, SEQ = 8192, T = NB * SEQ, D = 1024, AW = 512, SGW = 512, INW = 4608, NE = 32, FF = 1024;
constexpr int NHEAD = 8, HD = 64, CHUNK = 64, NBACK = 8, NREL = 513;
constexpr int LCAP = 32768;
constexpr float LOG2E = 1.4426950408889634f;
constexpr float EPS = 1e-6f;

constexpr size_t MiB = 1u << 20;
constexpr size_t WS_CTL = 0, CTL_ZERO_BYTES = 1 * MiB;
constexpr size_t WS_WIN = 7 * MiB;
constexpr size_t WS_WAB = 11 * MiB;
constexpr size_t WS_WO = 13 * MiB;
constexpr size_t WS_WR = 15 * MiB;
constexpr size_t WS_WM = 15 * MiB + 256 * 1024;
constexpr size_t WS_WIN8 = 2 * MiB;
constexpr size_t WS_HS = 15 * MiB + 512 * 1024;
constexpr size_t WS_CS = 15 * MiB + 768 * 1024;
constexpr size_t WS_H8 = 976 * MiB;
constexpr size_t WS_LID = 16 * MiB;
constexpr size_t WS_LRS = 20 * MiB;
constexpr size_t WS_LP = 24 * MiB;
constexpr size_t WS_WGU = 28 * MiB;
constexpr size_t WS_WD = 156 * MiB;
constexpr size_t WS_H = 220 * MiB;
constexpr size_t WS_Q = 284 * MiB, WS_K = 316 * MiB, WS_V = 348 * MiB;
constexpr size_t WS_UG = 380 * MiB, WS_VG = 412 * MiB;
constexpr size_t WS_GA = 444 * MiB, WS_GB = 508 * MiB;
constexpr size_t WS_YCAT = 572 * MiB;
constexpr size_t WS_X1B = 636 * MiB;
constexpr size_t WS_ACT = 700 * MiB;
constexpr size_t WS_X1H = 380 * MiB;
constexpr size_t WS_Y = 220 * MiB;
constexpr size_t WS_END = 1008 * MiB;
constexpr int CW_TMO = 0, CW_CODE = 1;
constexpr int CW_CNT = 64;
constexpr int CW_BAR = 4096;
constexpr int CW_CMAX = 8192;
constexpr int CW_CCNT = 16384;

constexpr int RING_BYTES = 131072;
constexpr int LDSCTL_OFF = RING_BYTES, MISC_OFF = LDSCTL_OFF + 320;
constexpr int MOE_OFF = MISC_OFF + 128;
constexpr int PARK_OFF = LDSCTL_OFF + 1024;
constexpr int ROWS_OFF = LDSCTL_OFF + 9216, ROWS_BUF = 3072;
constexpr int LDS_BYTES = 147456;

#define LDS_WAIT() asm volatile("s_waitcnt lgkmcnt(0)" ::: "memory")
#define VM_WAIT() asm volatile("s_waitcnt vmcnt(0)" ::: "memory")
#define RLX_AGENT __ATOMIC_RELAXED, __HIP_MEMORY_SCOPE_AGENT

__device__ __forceinline__ unsigned f2bf(float f) { unsigned u = __builtin_bit_cast(unsigned, f); return (u + 0x7fffu + ((u >> 16) & 1u)) >> 16; }
__device__ __forceinline__ unsigned pk2(float lo, float hi) { return f2bf(lo) | (f2bf(hi) << 16); }
__device__ __forceinline__ float bf2f(unsigned short b) { return __builtin_bit_cast(float, (unsigned)b << 16); }
__device__ __forceinline__ float bflo(unsigned w) { return __builtin_bit_cast(float, w << 16); }
__device__ __forceinline__ float bfhi(unsigned w) { return __builtin_bit_cast(float, w & 0xffff0000u); }
__device__ __forceinline__ unsigned cvt_pk_bf16(float lo, float hi) { unsigned r; asm volatile("v_cvt_pk_bf16_f32 %0, %1, %2" : "=v"(r) : "v"(lo), "v"(hi)); return r; }
__device__ __forceinline__ float fast_rcp(float x) { return __builtin_amdgcn_rcpf(x); }
__device__ __forceinline__ float fast_exp2(float x) { return __builtin_amdgcn_exp2f(x); }
__device__ __forceinline__ float sigmoidf_(float x) { return fast_rcp(1.0f + fast_exp2(-LOG2E * x)); }
__device__ __forceinline__ float gelu_tanh(float x) {
    const float t = x * ((-LOG2E * 1.5957691216057308f) + (-LOG2E * 1.5957691216057308f * 0.044715f) * (x * x));
    return x * fast_rcp(1.0f + fast_exp2(t));
}

namespace pg8 {
constexpr int BM = 256, BK = 64, HALF = 128, HTB = HALF * BK * 2, STAGE_BYTES = 8 * HTB, NXCD = 8, WGM = 8;
__host__ __device__ __forceinline__ int lds_byte(int r, int c) { const int st = (r >> 4) * 2 + (c >> 5), rr = r & 15, cc = c & 31, ob = rr * 64 + cc * 2; return st * 1024 + (ob ^ (((ob >> 9) & 1) << 5)); }
__host__ __device__ __forceinline__ void stage_rc(int b, int& R, int& C) { const int st = b / 1024, sb = b % 1024, swz = sb ^ (((sb >> 9) & 1) << 5); R = (st >> 1) * 16 + swz / 64; C = (st & 1) * 32 + (swz % 64) / 2; }
__host__ __device__ __forceinline__ int perm32(int rho) { const int n = rho >> 4, i = rho & 15; return 8 * (i >> 2) + 4 * n + (i & 3); }

typedef int v4i_t __attribute__((ext_vector_type(4)));
typedef int v8i_t __attribute__((ext_vector_type(8)));
__device__ __forceinline__ v8i_t cat8(bf16x8 lo, bf16x8 hi) { return __builtin_shufflevector(__builtin_bit_cast(v4i_t, lo), __builtin_bit_cast(v4i_t, hi), 0, 1, 2, 3, 4, 5, 6, 7); }
struct Unit { int pm, pn, e, s0, cnt, idx; };

struct StaticOrder {
    int nM, nN, nwg, G, c;
    __device__ void init(int M, int N, int G_, int c_) { nM = M / BM; nN = N / BM; nwg = nM * nN; G = G_; c = c_; }
    __device__ bool tile(int i, int& pm, int& pn) const {
        const long L = (long)i * G + c; if (L >= nwg) return false;
        int wgid = (int)L; { const int q = nwg / NXCD, r = nwg % NXCD, xcd = wgid % NXCD, off = wgid / NXCD; wgid = (xcd < r ? xcd * (q + 1) : r * (q + 1) + (xcd - r) * q) + off; }
        const int nig = WGM * nN, gid = wgid / nig, fm = gid * WGM, gsz = (nM - fm) < WGM ? (nM - fm) : WGM;
        pm = fm + ((wgid % nig) % gsz); pn = (wgid % nig) / gsz; return true;
    }
};

template <class P>
__device__ __forceinline__ void gemm_phase(LAS unsigned char* lds, const P& S) {
    const int tid = threadIdx.x, wid = __builtin_amdgcn_readfirstlane(tid >> 6), lane = tid & 63, wr = wid >> 2, wc = wid & 3, fr = lane & 15, fq = lane >> 4;
    constexpr int nt = P::NT;
    unsigned vA[2][2], voffB[2];
    LAS u32x4* park = (LAS u32x4*)(lds + PARK_OFF) + tid;
#pragma unroll
    for (int i = 0; i < 2; ++i) { int R, C; stage_rc(tid * 16 + i * 8192, R, C); const int Rb = (R & ~31) + perm32(R & 31);
        vA[0][i] = (unsigned)(R * P::LDA + C) * 2u; vA[1][i] = (unsigned)((R + HALF) * P::LDA + C) * 2u; voffB[i] = (unsigned)(Rb * P::LDB + C) * 2u; }
    const size_t kstep = (size_t)(BK * 2);
    const size_t hstepB = (size_t)HALF * P::LDB * 2;
    const unsigned ldsw = (unsigned)wid * 1024u;
    const int aoff = lds_byte(wr * 64 + fr, fq * 8), boff = lds_byte(wc * 32 + fr, fq * 8);
#define PG8_SA(b, h) (((b) * 2 + (h)) * HTB)
#define PG8_SB(b, h) ((4 + (b) * 2 + (h)) * HTB)
#define PG8_STAGE2(bufoff, gbase, o0, o1) do { \
        __builtin_amdgcn_global_load_lds((const unsigned*)((const char*)(gbase) + (o0)), (LAS unsigned*)(lds + (bufoff) + ldsw), 16, 0, 0); \
        __builtin_amdgcn_global_load_lds((const unsigned*)((const char*)(gbase) + (o1)), (LAS unsigned*)(lds + (bufoff) + ldsw + 8192), 16, 0, 0); } while (0)
#define PG8_STAGEB(bufoff, gbase) PG8_STAGE2(bufoff, gbase, voffB[0], voffB[1])
#define PG8_LDA(dst, b, h) do { _Pragma("unroll") for (int m = 0; m < 4; ++m) _Pragma("unroll") for (int k = 0; k < 2; ++k) dst[m][k] = *(const LAS bf16x8*)(lds + PG8_SA(b, h) + aoff + m * 2048 + k * 1024); } while (0)
#define PG8_LDB(dst, b, h) do { _Pragma("unroll") for (int n = 0; n < 2; ++n) _Pragma("unroll") for (int k = 0; k < 2; ++k) dst[n][k] = *(const LAS bf16x8*)(lds + PG8_SB(b, h) + boff + n * 2048 + k * 1024); } while (0)
#define PG8_MMA(ai, bj, At, Bt) do { __builtin_amdgcn_s_setprio(1); _Pragma("unroll") for (int m = 0; m < 4; ++m) _Pragma("unroll") for (int n = 0; n < 2; ++n) { \
        if constexpr (P::I8) { _Pragma("unroll") for (int k = 0; k < 2; ++k) acc[ai][bj][m][n] = __builtin_bit_cast(f32x4, __builtin_amdgcn_mfma_i32_16x16x64_i8(__builtin_bit_cast(v4i_t, Bt[n][k]), __builtin_bit_cast(v4i_t, At[m][k]), __builtin_bit_cast(v4i_t, acc[ai][bj][m][n]), 0, 0, 0)); }     \
        else if constexpr (P::FP8) { acc[ai][bj][m][n] = __builtin_amdgcn_mfma_scale_f32_16x16x128_f8f6f4(cat8(Bt[n][0], Bt[n][1]), cat8(At[m][0], At[m][1]), acc[ai][bj][m][n], 0, 0, 0, 0, 0, 0); }     \
        else { _Pragma("unroll") for (int k = 0; k < 2; ++k) acc[ai][bj][m][n] = __builtin_amdgcn_mfma_f32_16x16x32_bf16(Bt[n][k], At[m][k], acc[ai][bj][m][n], 0, 0, 0); } } \
        __builtin_amdgcn_s_setprio(0); } while (0)
#define PG8_WAIT_V(n) asm volatile("s_waitcnt vmcnt(" #n ")" ::: "memory")
#define PG8_WAIT_L(n) asm volatile("s_waitcnt lgkmcnt(" #n ")" ::: "memory")
#define PG8_BAR __builtin_amdgcn_s_barrier()
#define PG8_SCHED __builtin_amdgcn_sched_barrier(0)
    Unit cur, nxt; int ui = 0;
    if (!S.next(0, cur)) return;
    if constexpr (P::GATHER) S.a_off(cur, tid, vA);
    f32x4 acc[2][2][4][2];
#pragma unroll
    for (int a = 0; a < 2; ++a)
#pragma unroll
        for (int b = 0; b < 2; ++b)
#pragma unroll
            for (int m = 0; m < 4; ++m)
#pragma unroll
                for (int n = 0; n < 2; ++n) acc[a][b][m][n] = (f32x4){0.f, 0.f, 0.f, 0.f};
    bf16x8 At[4][2], B0[2][2], B1[2][2];
    const char* cA = S.a_ptr(cur); const char* cB = S.b_ptr(cur);
    PG8_STAGEB(PG8_SB(0, 0), cB); PG8_STAGEB(PG8_SB(0, 1), cB + hstepB); PG8_STAGE2(PG8_SA(0, 0), cA, vA[0][0], vA[0][1]); PG8_STAGE2(PG8_SA(0, 1), cA, vA[1][0], vA[1][1]);
    if (wr == 1) PG8_BAR;
    PG8_WAIT_V(2); PG8_BAR;
    PG8_STAGEB(PG8_SB(1, 0), cB + kstep); PG8_STAGE2(PG8_SA(1, 0), cA + kstep, vA[0][0], vA[0][1]); PG8_STAGEB(PG8_SB(1, 1), cB + hstepB + kstep);
    PG8_WAIT_V(6); PG8_BAR;
    for (;;) {
        const bool has_next = S.next(ui + 1, nxt);
        if constexpr (P::ROWDMA) S.row_dma(cur, lds, wid, lane);
        const char* nA = has_next ? S.a_ptr(nxt) : cA; const char* nB = has_next ? S.b_ptr(nxt) : cB;
        if constexpr (P::IDDMA) { if (has_next) S.ids_dma(nxt, cur, lds, wid, lane); }
        else if constexpr (P::GATHER) {
            unsigned vn[2][2];
            if (has_next) S.a_off(nxt, tid, vn);
            else { vn[0][0] = vA[0][0]; vn[0][1] = vA[0][1]; vn[1][0] = vA[1][0]; vn[1][1] = vA[1][1]; }
            *park = (u32x4){vn[0][0], vn[0][1], vn[1][0], vn[1][1]};
        }
#pragma nounroll
        for (int t = 0; t < nt; t += 2) {
            const bool last = (t == nt - 2);
            asm volatile("" : "+v"(vA[0][0]), "+v"(vA[0][1]), "+v"(vA[1][0]), "+v"(vA[1][1]), "+v"(voffB[0]), "+v"(voffB[1]));
            const char* a1 = cA + (size_t)(t + 1) * kstep;
            const char* a2 = last ? nA : cA + (size_t)(t + 2) * kstep; const char* b2 = last ? nB : cB + (size_t)(t + 2) * kstep;
            const char* a3 = a2 + kstep; const char* b3 = b2 + kstep;
            PG8_LDB(B0, 0, 0); PG8_LDB(B1, 0, 1); PG8_SCHED; PG8_LDA(At, 0, 0); PG8_STAGE2(PG8_SA(1, 1), a1, vA[1][0], vA[1][1]);
            if constexpr (P::IDDMA) { if (last && has_next) S.a_off_lds(nxt, cur, tid, lds, vA); }
            else if constexpr (P::GATHER) { if (last) { const u32x4 nv = *park; vA[0][0] = nv.x; vA[0][1] = nv.y; vA[1][0] = nv.z; vA[1][1] = nv.w; } }
            PG8_WAIT_V(8); PG8_WAIT_L(0); PG8_BAR; PG8_MMA(0, 0, At, B0); PG8_MMA(0, 1, At, B1); PG8_BAR; PG8_SCHED;
            PG8_LDA(At, 0, 1); PG8_STAGEB(PG8_SB(0, 0), b2); PG8_STAGEB(PG8_SB(0, 1), b2 + hstepB); PG8_STAGE2(PG8_SA(0, 0), a2, vA[0][0], vA[0][1]);
            PG8_WAIT_V(8); PG8_WAIT_L(0); PG8_BAR; PG8_MMA(1, 0, At, B0); PG8_MMA(1, 1, At, B1); PG8_BAR; PG8_SCHED;
            PG8_LDB(B0, 1, 0); PG8_LDB(B1, 1, 1); PG8_SCHED; PG8_LDA(At, 1, 0); PG8_STAGE2(PG8_SA(0, 1), a2, vA[1][0], vA[1][1]);
            PG8_WAIT_V(8); PG8_WAIT_L(0); PG8_BAR; PG8_MMA(0, 0, At, B0); PG8_MMA(0, 1, At, B1); PG8_BAR; PG8_SCHED;
            PG8_LDA(At, 1, 1); PG8_STAGEB(PG8_SB(1, 0), b3); PG8_STAGEB(PG8_SB(1, 1), b3 + hstepB); PG8_STAGE2(PG8_SA(1, 0), a3, vA[0][0], vA[0][1]);
            PG8_WAIT_V(8); PG8_WAIT_L(0); PG8_BAR; PG8_MMA(1, 0, At, B0); PG8_MMA(1, 1, At, B1); PG8_BAR; PG8_SCHED;
        }
        if (wr == 0) PG8_BAR;
        int fr_ = fr, fq_ = fq; asm volatile("" : "+v"(fr_), "+v"(fq_));
        const bool keep = S.epi(acc, cur, wr, wc, fr_, fq_);
        if (!has_next) break;
        if (!keep) {
#pragma unroll
            for (int a = 0; a < 2; ++a)
#pragma unroll
                for (int b = 0; b < 2; ++b)
#pragma unroll
                    for (int m = 0; m < 4; ++m)
#pragma unroll
                        for (int n = 0; n < 2; ++n) acc[a][b][m][n] = (f32x4){0.f, 0.f, 0.f, 0.f};
        }
        cur = nxt; cA = nA; cB = nB; ++ui;
        if (wr == 1) PG8_BAR;
    }
    PG8_WAIT_V(0);
    PG8_BAR;
#undef PG8_SA
#undef PG8_SB
#undef PG8_STAGE2
#undef PG8_STAGEB
#undef PG8_LDA
#undef PG8_LDB
#undef PG8_MMA
#undef PG8_WAIT_V
#undef PG8_WAIT_L
#undef PG8_BAR
#undef PG8_SCHED
}
}
using pg8::Unit;

__device__ __forceinline__ void st8(bf16* p, const f32x4& a, const f32x4& b) {
    u32x4 w; w.x = cvt_pk_bf16(a[0], a[1]); w.y = cvt_pk_bf16(a[2], a[3]); w.z = cvt_pk_bf16(b[0], b[1]); w.w = cvt_pk_bf16(b[2], b[3]);
    *(u32x4*)p = w;
}
__device__ __forceinline__ void ld8(const bf16* p, f32x4& a, f32x4& b) {
    const u32x4 w = *(const u32x4*)p;
    a = (f32x4){bflo(w.x), bfhi(w.x), bflo(w.y), bfhi(w.y)}; b = (f32x4){bflo(w.z), bfhi(w.z), bflo(w.w), bfhi(w.w)};
}

__device__ __forceinline__ void st8q(unsigned char* p, const f32x4& a, const f32x4& b) {
    int w0 = 0, w1 = 0;
    w0 = __builtin_amdgcn_cvt_pk_fp8_f32(a[0], a[1], w0, false); w0 = __builtin_amdgcn_cvt_pk_fp8_f32(a[2], a[3], w0, true);
    w1 = __builtin_amdgcn_cvt_pk_fp8_f32(b[0], b[1], w1, false); w1 = __builtin_amdgcn_cvt_pk_fp8_f32(b[2], b[3], w1, true);
    *(u32x2*)p = (u32x2){(unsigned)w0, (unsigned)w1};
}
__device__ __forceinline__ u32x2 pack8q(const f32x4& a, const f32x4& b) {
    int w0 = 0, w1 = 0;
    w0 = __builtin_amdgcn_cvt_pk_fp8_f32(a[0], a[1], w0, false); w0 = __builtin_amdgcn_cvt_pk_fp8_f32(a[2], a[3], w0, true);
    w1 = __builtin_amdgcn_cvt_pk_fp8_f32(b[0], b[1], w1, false); w1 = __builtin_amdgcn_cvt_pk_fp8_f32(b[2], b[3], w1, true);
    return (u32x2){(unsigned)w0, (unsigned)w1};
}
__device__ __forceinline__ u32x4 pair16(const u32x2& e0, const u32x2& e1, bool oddq) {
    const u32x2 snd = oddq ? e0 : e1;
    u32x2 rcv; rcv.x = (unsigned)__shfl_xor((int)snd.x, 16); rcv.y = (unsigned)__shfl_xor((int)snd.y, 16);
    return oddq ? (u32x4){rcv.x, rcv.y, e1.x, e1.y} : (u32x4){e0.x, e0.y, rcv.x, rcv.y};
}
constexpr float WQ_SCALE = 32.0f, WQ_INV = 1.0f / 32.0f;

struct PolIn {
    static constexpr int NT = 8, LDA = 512, LDB = 512; static constexpr bool GATHER = false, FP8 = false, I8 = true, ROWDMA = true, IDDMA = false;
    pg8::StaticOrder so; const unsigned char* A; const unsigned char* Bt; unsigned char* ws; const float* qg; const float* kg; const float* hs; const float* cs; LAS unsigned char* shm;
    __device__ bool next(int i, Unit& u) const { u.e = 0; u.s0 = 0; u.cnt = 0; u.idx = i; return so.tile(i, u.pm, u.pn); }
    __device__ __forceinline__ void row_dma(const Unit& u, LAS unsigned char* lds, int wid, int lane) const {
        const unsigned* src = (wid < 4) ? (const unsigned*)(hs + u.pm * 256 + 64 * wid + lane) : (const unsigned*)(cs + u.pn * 256 + 64 * (wid & 3) + lane);
        __builtin_amdgcn_global_load_lds(src, (LAS unsigned*)(lds + ROWS_OFF + (u.idx & 1) * ROWS_BUF + 256 * wid), 4, 0, 0);
    }
    __device__ const char* a_ptr(const Unit& u) const { return (const char*)(A + (size_t)u.pm * 256 * 1024); }
    __device__ const char* b_ptr(const Unit& u) const { return (const char*)(Bt + (size_t)u.pn * 256 * 1024); }
    __device__ void a_off(const Unit&, int, unsigned (&)[2][2]) const {}
    __device__ __forceinline__ bool epi(f32x4 (&acc)[2][2][4][2], const Unit& u, int wr, int wc, int fr, int fq) const {
        const int pn = u.pn;
        {
            const LAS float* hsr = (const LAS float*)(shm + ROWS_OFF + (u.idx & 1) * ROWS_BUF) + wr * 64 + fr;
            const LAS float* csp = (const LAS float*)(shm + ROWS_OFF + (u.idx & 1) * ROWS_BUF + 1024) + 64 * wc + 8 * fq;
            float hv[2][4]; f32x4 cv[2][2];
#pragma unroll
            for (int a = 0; a < 2; ++a)
#pragma unroll
                for (int m = 0; m < 4; ++m) hv[a][m] = hsr[a * 128 + m * 16];
#pragma unroll
            for (int b = 0; b < 2; ++b)
#pragma unroll
                for (int n = 0; n < 2; ++n) cv[b][n] = *(const LAS f32x4*)(csp + 32 * b + 4 * n);
#pragma unroll
            for (int a = 0; a < 2; ++a)
#pragma unroll
                for (int b = 0; b < 2; ++b)
#pragma unroll
                    for (int m = 0; m < 4; ++m)
#pragma unroll
                        for (int n = 0; n < 2; ++n) { const pg8::v4i_t ia = __builtin_bit_cast(pg8::v4i_t, acc[a][b][m][n]);
                            acc[a][b][m][n] = (f32x4){(float)ia.x, (float)ia.y, (float)ia.z, (float)ia.w} * hv[a][m] * cv[b][n]; }
        }
        int kind, ld, tcol; size_t off;
        if (pn < 2) { kind = 0; off = WS_Q; ld = AW; tcol = pn; }
        else if (pn < 4) { kind = 1; off = WS_K; ld = AW; tcol = pn - 2; }
        else if (pn < 6) { kind = 2; off = WS_V; ld = AW; tcol = pn - 4; }
        else if (pn < 8) { kind = 3; off = WS_UG; ld = SGW; tcol = pn - 6; }
        else if (pn < 10) { kind = 3; off = WS_VG; ld = SGW; tcol = pn - 8; }
        else if (pn < 14) { kind = 4; off = WS_GA; ld = D; tcol = pn - 10; }
        else { kind = 4; off = WS_GB; ld = D; tcol = pn - 14; }
        bf16* base = (bf16*)(ws + off) + tcol * 256 + 64 * wc + 8 * fq;
        const int row0 = u.pm * 256 + wr * 64 + fr;
        if (kind <= 1) {
            const float* g = (kind == 0 ? qg : kg) + 8 * fq;
            const float sc = (kind == 0) ? (0.125f * LOG2E) : 1.0f;
            f32x4 gv[2][2];
#pragma unroll
            for (int bj = 0; bj < 2; ++bj)
#pragma unroll
                for (int n = 0; n < 2; ++n) gv[bj][n] = *(const f32x4*)(g + 32 * bj + 4 * n) * sc;
#pragma unroll
            for (int ai = 0; ai < 2; ++ai)
#pragma unroll
                for (int m = 0; m < 4; ++m) {
                    float ss = 0.f;
#pragma unroll
                    for (int bj = 0; bj < 2; ++bj)
#pragma unroll
                        for (int n = 0; n < 2; ++n) { const f32x4 v = acc[ai][bj][m][n]; ss += (v[0] * v[0] + v[1] * v[1]) + (v[2] * v[2] + v[3] * v[3]); }
                    ss += __shfl_xor(ss, 16); ss += __shfl_xor(ss, 32);
                    const float rs = 1.0f / sqrtf(ss * (1.0f / 64.0f) + EPS);
                    bf16* rowp = base + (size_t)(row0 + ai * 128 + m * 16) * ld;
#pragma unroll
                    for (int bj = 0; bj < 2; ++bj) st8(rowp + 32 * bj, acc[ai][bj][m][0] * rs * gv[bj][0], acc[ai][bj][m][1] * rs * gv[bj][1]);
                }
        } else if (kind == 2) {
#pragma unroll
            for (int ai = 0; ai < 2; ++ai)
#pragma unroll
                for (int m = 0; m < 4; ++m) { bf16* rowp = base + (size_t)(row0 + ai * 128 + m * 16) * ld;
#pragma unroll
                    for (int bj = 0; bj < 2; ++bj) st8(rowp + 32 * bj, acc[ai][bj][m][0], acc[ai][bj][m][1]); }
        } else if (kind == 4) {
            unsigned char* b8 = ws + off + tcol * 256 + 64 * wc + 8 * fq;
#pragma unroll
            for (int ai = 0; ai < 2; ++ai)
#pragma unroll
                for (int mp = 0; mp < 2; ++mp) { const bool oddq = (fq & 1) != 0;
                    unsigned char* rowp = b8 + (size_t)(row0 + ai * 128 + (2 * mp + (oddq ? 1 : 0)) * 16) * ld - (oddq ? 8 : 0);
#pragma unroll
                    for (int bj = 0; bj < 2; ++bj) *(u32x4*)(rowp + 32 * bj) = pair16(pack8q(acc[ai][bj][2 * mp][0], acc[ai][bj][2 * mp][1]), pack8q(acc[ai][bj][2 * mp + 1][0], acc[ai][bj][2 * mp + 1][1]), oddq); }
        } else {
#pragma unroll
            for (int ai = 0; ai < 2; ++ai)
#pragma unroll
                for (int m = 0; m < 4; ++m) { bf16* rowp = base + (size_t)(row0 + ai * 128 + m * 16) * ld;
#pragma unroll
                    for (int bj = 0; bj < 2; ++bj) { f32x4 a = acc[ai][bj][m][0], b = acc[ai][bj][m][1];
#pragma unroll
                        for (int j = 0; j < 4; ++j) { a[j] = gelu_tanh(a[j]); b[j] = gelu_tanh(b[j]); }
                        st8(rowp + 32 * bj, a, b); } }
        }
        return false;
    }
};

struct PolMerge {
    static constexpr int NT = 8, LDA = D, LDB = D; static constexpr bool GATHER = false, FP8 = false, I8 = false, ROWDMA = false, IDDMA = false;
    pg8::StaticOrder so; const bf16* A; const bf16* Bt; const unsigned char* ga; const unsigned char* gb; bf16* out;
    __device__ bool next(int i, Unit& u) const { u.e = i & 1; u.s0 = 0; u.cnt = 0; return so.tile(i >> 1, u.pm, u.pn); }
    __device__ const char* a_ptr(const Unit& u) const { return (const char*)(A + (size_t)u.pm * 256 * LDA + 512 * u.e); }
    __device__ const char* b_ptr(const Unit& u) const { return (const char*)(Bt + (size_t)u.pn * 256 * LDB + 512 * u.e); }
    __device__ void a_off(const Unit&, int, unsigned (&)[2][2]) const {}
    __device__ __forceinline__ bool epi(f32x4 (&acc)[2][2][4][2], const Unit& u, int wr, int wc, int fr, int fq) const {
        const int row0 = u.pm * 256 + wr * 64 + fr, col0 = u.pn * 256 + 64 * wc + 8 * fq;
#pragma unroll
        for (int ai = 0; ai < 2; ++ai) {
            u32x2 gbv[4][2]; u32x2 gav[4][2];
#pragma unroll
            for (int m = 0; m < 4; ++m) { const size_t o = (size_t)(row0 + ai * 128 + m * 16) * D + col0;
#pragma unroll
                for (int bj = 0; bj < 2; ++bj) { gbv[m][bj] = *(const u32x2*)(gb + o + 32 * bj); if (u.e == 0) gav[m][bj] = *(const u32x2*)(ga + o + 32 * bj); } }
#pragma unroll
            for (int m = 0; m < 4; ++m) { const size_t o = (size_t)(row0 + ai * 128 + m * 16) * D + col0;
#pragma unroll
                for (int bj = 0; bj < 2; ++bj) {
                    const u32x2 wb = gbv[m][bj];
                    const f32x2 p0 = __builtin_amdgcn_cvt_pk_f32_fp8((int)wb.x, false), p1 = __builtin_amdgcn_cvt_pk_f32_fp8((int)wb.x, true), p2 = __builtin_amdgcn_cvt_pk_f32_fp8((int)wb.y, false), p3 = __builtin_amdgcn_cvt_pk_f32_fp8((int)wb.y, true);
                    const f32x4 b0 = (f32x4){p0[0], p0[1], p1[0], p1[1]}, b1 = (f32x4){p2[0], p2[1], p3[0], p3[1]};
                    if (u.e == 0) {
                        const u32x2 wa = gav[m][bj];
                        const f32x2 q0 = __builtin_amdgcn_cvt_pk_f32_fp8((int)wa.x, false), q1 = __builtin_amdgcn_cvt_pk_f32_fp8((int)wa.x, true), q2 = __builtin_amdgcn_cvt_pk_f32_fp8((int)wa.y, false), q3 = __builtin_amdgcn_cvt_pk_f32_fp8((int)wa.y, true);
                        const f32x4 a0 = (f32x4){q0[0], q0[1], q1[0], q1[1]}, a1 = (f32x4){q2[0], q2[1], q3[0], q3[1]};
#pragma unroll
                        for (int j = 0; j < 4; ++j) {
                            acc[ai][bj][m][0][j] *= (1.0f + fast_exp2(-LOG2E * b0[j])) * fast_rcp(1.0f + fast_exp2(-LOG2E * a0[j]));
                            acc[ai][bj][m][1][j] *= (1.0f + fast_exp2(-LOG2E * b1[j])) * fast_rcp(1.0f + fast_exp2(-LOG2E * a1[j])); }
                    } else {
                        f32x4 r0, r1;
#pragma unroll
                        for (int j = 0; j < 4; ++j) { r0[j] = acc[ai][bj][m][0][j] * sigmoidf_(b0[j]); r1[j] = acc[ai][bj][m][1][j] * sigmoidf_(b1[j]); }
                        st8(out + o + 32 * bj, r0, r1);
                    }
                } }
        }
        return u.e == 0;
    }
};

struct PolOut {
    static constexpr int NT = 16, LDA = D, LDB = D; static constexpr bool GATHER = false, FP8 = false, I8 = false, ROWDMA = false, IDDMA = false;
    pg8::StaticOrder so; const bf16* A; const bf16* Bt; const float* x; bf16* x1; unsigned char* x1q;
    __device__ bool next(int i, Unit& u) const { u.e = 0; u.s0 = 0; u.cnt = 0; return so.tile(i, u.pm, u.pn); }
    __device__ const char* a_ptr(const Unit& u) const { return (const char*)(A + (size_t)u.pm * 256 * LDA); }
    __device__ const char* b_ptr(const Unit& u) const { return (const char*)(Bt + (size_t)u.pn * 256 * LDB); }
    __device__ void a_off(const Unit&, int, unsigned (&)[2][2]) const {}
    __device__ __forceinline__ bool epi(f32x4 (&acc)[2][2][4][2], const Unit& u, int wr, int wc, int fr, int fq) const {
        const int row0 = u.pm * 256 + wr * 64 + fr, col0 = u.pn * 256 + 64 * wc + 8 * fq;
#pragma unroll
        for (int ai = 0; ai < 2; ++ai) {
            f32x4 xv[4][2][2];
            u32x2 xqp[2][2]; const bool oddq = (fq & 1) != 0;
#pragma unroll
            for (int m = 0; m < 4; ++m) { const size_t o = (size_t)(row0 + ai * 128 + m * 16) * D + col0;
#pragma unroll
                for (int bj = 0; bj < 2; ++bj) { xv[m][bj][0] = *(const f32x4*)(x + o + 32 * bj); xv[m][bj][1] = *(const f32x4*)(x + o + 32 * bj + 4); } }
#pragma unroll
            for (int m = 0; m < 4; ++m) { const size_t o = (size_t)(row0 + ai * 128 + m * 16) * D + col0;
#pragma unroll
                for (int bj = 0; bj < 2; ++bj) {
                    const f32x4 r0 = xv[m][bj][0] + acc[ai][bj][m][0], r1 = xv[m][bj][1] + acc[ai][bj][m][1];
                    st8(x1 + o + 32 * bj, r0, r1); xqp[m & 1][bj] = pack8q(r0, r1);
                    if (m & 1) *(u32x4*)(x1q + o - (oddq ? 0 : 16 * D) - (oddq ? 8 : 0) + 32 * bj) = pair16(xqp[0][bj], xqp[1][bj], oddq);
                } }
        }
        return false;
    }
};

struct MoeOrder {
    const LAS int* tb;
    int NN, nwg, G, c;
    __device__ void init(const LAS int* tb_, int NN_, int G_, int c_) { tb = tb_; NN = NN_; G = G_; c = c_; nwg = tb_[32] * NN_; }
    __device__ bool unit(int i, Unit& u) const {
        const long L = (long)i * G + c; if (L >= nwg) return false;
        int wgid = (int)L; { const int q = nwg / 8, r = nwg % 8, xcd = wgid % 8, off = wgid / 8; wgid = (xcd < r ? xcd * (q + 1) : r * (q + 1) + (xcd - r) * q) + off; }
        const int Mt = wgid / NN;
        const int ln = threadIdx.x & 63;
        const unsigned long long bal = __ballot(ln < NE && tb[ln & 31] <= Mt);
        const int e = __popcll(bal) - 1;
        u.idx = i; u.pm = __builtin_amdgcn_readfirstlane(Mt); u.pn = __builtin_amdgcn_readfirstlane(wgid % NN); u.e = __builtin_amdgcn_readfirstlane(e);
        u.s0 = __builtin_amdgcn_readfirstlane((Mt - tb[e]) * 256); u.cnt = __builtin_amdgcn_readfirstlane(tb[33 + e]);
        return true;
    }
};

struct PolGU {
    static constexpr int NT = 8, LDA = 512, LDB = 512; static constexpr bool GATHER = true, FP8 = true, I8 = false, ROWDMA = true, IDDMA = true;
    MoeOrder mo; const unsigned char* A; const unsigned char* Bt; const int* lid; const float* lrs; const float* bgu; unsigned char* act; LAS unsigned char* shm;
    __device__ __forceinline__ void row_dma(const Unit& u, LAS unsigned char* lds, int wid, int lane) const {
        const unsigned* src = (wid < 4) ? (const unsigned*)(lrs + (size_t)u.e * LCAP + u.s0 + 64 * wid + lane)
                                        : (const unsigned*)(bgu + (size_t)u.e * 2048 + u.pn * 128 + 1024 * ((wid >> 1) & 1) + 64 * (wid & 1) + lane);
        __builtin_amdgcn_global_load_lds(src, (LAS unsigned*)(lds + ROWS_OFF + (u.idx & 1) * ROWS_BUF + 256 * wid), 4, 0, 0);
    }
    __device__ bool next(int i, Unit& u) const { return mo.unit(i, u); }
    __device__ __forceinline__ void ids_dma(const Unit& nx, const Unit& cu, LAS unsigned char* lds, int wid, int lane) const {
        if (wid < 4) __builtin_amdgcn_global_load_lds((const unsigned*)(lid + (size_t)nx.e * LCAP + nx.s0 + 64 * wid + lane), (LAS unsigned*)(lds + ROWS_OFF + (cu.idx & 1) * ROWS_BUF + 2048 + 256 * wid), 4, 0, 0);
    }
    __device__ __forceinline__ void a_off_lds(const Unit& nx, const Unit& cu, int tid, LAS unsigned char* lds, unsigned (&v)[2][2]) const {
        const LAS int* l = (const LAS int*)(lds + ROWS_OFF + (cu.idx & 1) * ROWS_BUF + 2048);
#pragma unroll
        for (int i = 0; i < 2; ++i) { int R, C; pg8::stage_rc(tid * 16 + i * 8192, R, C);
#pragma unroll
            for (int h = 0; h < 2; ++h) { const int s = h * 128 + R; const int id = l[s]; const int tok = (nx.s0 + s < nx.cnt) ? (id >> 2) : 0; v[h][i] = (unsigned)(tok * LDA + C) * 2u; } }
    }
    __device__ const char* a_ptr(const Unit&) const { return (const char*)A; }
    __device__ const char* b_ptr(const Unit& u) const { return (const char*)(Bt + ((size_t)u.e * 2048 + (size_t)u.pn * 256) * 1024); }
    __device__ __forceinline__ void a_off(const Unit& u, int tid, unsigned (&v)[2][2]) const {
        const int* l = lid + (size_t)u.e * LCAP;
#pragma unroll
        for (int i = 0; i < 2; ++i) { int R, C; pg8::stage_rc(tid * 16 + i * 8192, R, C);
#pragma unroll
            for (int h = 0; h < 2; ++h) { const int s = u.s0 + h * 128 + R; const int id = l[s]; const int tok = (s < u.cnt) ? (id >> 2) : 0; v[h][i] = (unsigned)(tok * LDA + C) * 2u; } }
    }
    __device__ __forceinline__ bool epi(f32x4 (&acc)[2][2][4][2], const Unit& u, int wr, int wc, int fr, int fq) const {
        const LAS float* rsl = (const LAS float*)(shm + ROWS_OFF + (u.idx & 1) * ROWS_BUF);
        const LAS float* bg = (const LAS float*)(shm + ROWS_OFF + (u.idx & 1) * ROWS_BUF + 1024) + 32 * wc + 8 * fq;
        const f32x4 bg0 = *(const LAS f32x4*)bg, bg1 = *(const LAS f32x4*)(bg + 4), bu0 = *(const LAS f32x4*)(bg + 128), bu1 = *(const LAS f32x4*)(bg + 132);
        unsigned char* ob = act + (size_t)u.pm * 256 * FF + u.pn * 128 + 32 * wc + 8 * fq;
        float rsv[2][4];
#pragma unroll
        for (int ai = 0; ai < 2; ++ai)
#pragma unroll
            for (int m = 0; m < 4; ++m) { const int r = ai * 128 + wr * 64 + m * 16 + fr; const bool valid = (u.s0 + r < u.cnt); const float t_ = rsl[r]; rsv[ai][m] = valid ? t_ * WQ_INV : 0.f; }
        const bool oddq = (fq & 1) != 0; u32x2 pkq[2];
#pragma unroll
        for (int ai = 0; ai < 2; ++ai)
#pragma unroll
            for (int m = 0; m < 4; ++m) { const int r = ai * 128 + wr * 64 + m * 16 + fr; const float rs = rsv[ai][m];
                f32x4 o[2];
#pragma unroll
                for (int n = 0; n < 2; ++n)
#pragma unroll
                    for (int h2 = 0; h2 < 2; ++h2) {
                        const f32x2 ag = {acc[ai][0][m][n][2 * h2], acc[ai][0][m][n][2 * h2 + 1]}, au = {acc[ai][1][m][n][2 * h2], acc[ai][1][m][n][2 * h2 + 1]};
                        const f32x2 bgv = n ? (f32x2){bg1[2 * h2], bg1[2 * h2 + 1]} : (f32x2){bg0[2 * h2], bg0[2 * h2 + 1]}, buv = n ? (f32x2){bu1[2 * h2], bu1[2 * h2 + 1]} : (f32x2){bu0[2 * h2], bu0[2 * h2 + 1]};
                        f32x2 g = ag * rs + bgv, up = au * rs + buv;
                        g = __builtin_elementwise_min(g, (f32x2){7.0f, 7.0f});
                        up.x = __builtin_amdgcn_fmed3f(up.x, -7.0f, 7.0f); up.y = __builtin_amdgcn_fmed3f(up.y, -7.0f, 7.0f);
                        const f32x2 t = g * (-1.702f * LOG2E);
                        f32x2 e; e.x = fast_exp2(t.x); e.y = fast_exp2(t.y);
                        const f32x2 den = e + 1.0f;
                        f32x2 rc; rc.x = fast_rcp(den.x); rc.y = fast_rcp(den.y);
                        const f32x2 res = (up + 1.0f) * (g * rc);
                        o[n][2 * h2] = res.x; o[n][2 * h2 + 1] = res.y; }
                pkq[m & 1] = pack8q(o[0], o[1]);
                if (m & 1) *(u32x4*)(ob + (size_t)(r - (oddq ? 0 : 16)) * FF - (oddq ? 8 : 0)) = pair16(pkq[0], pkq[1], oddq); }
        return false;
    }
};

struct PolDown {
    static constexpr int NT = 8, LDA = 512, LDB = 512; static constexpr bool GATHER = true, FP8 = true, I8 = false, ROWDMA = true, IDDMA = false;
    MoeOrder mo; const unsigned char* A; const unsigned char* Bt; const int* lid; const float* lp; const float* bd; unsigned char* y; LAS unsigned char* shm;
    __device__ __forceinline__ void row_dma(const Unit& u, LAS unsigned char* lds, int wid, int lane) const {
        const size_t o = (size_t)u.e * LCAP + u.s0 + 64 * (wid & 3) + lane;
        const unsigned* src = (wid < 4) ? (const unsigned*)(lid + o) : (const unsigned*)(lp + o);
        __builtin_amdgcn_global_load_lds(src, (LAS unsigned*)(lds + ROWS_OFF + (u.idx & 1) * ROWS_BUF + 256 * wid), 4, 0, 0);
        if (wid < 4) __builtin_amdgcn_global_load_lds((const unsigned*)(bd + (size_t)u.e * D + u.pn * 256 + 64 * wid + lane), (LAS unsigned*)(lds + ROWS_OFF + (u.idx & 1) * ROWS_BUF + 2048 + 256 * wid), 4, 0, 0);
    }
    __device__ bool next(int i, Unit& u) const { return mo.unit(i, u); }
    __device__ const char* a_ptr(const Unit& u) const { return (const char*)(A + (size_t)u.pm * 256 * 1024); }
    __device__ const char* b_ptr(const Unit& u) const { return (const char*)(Bt + ((size_t)u.e * 1024 + (size_t)u.pn * 256) * 1024); }
    __device__ __forceinline__ void a_off(const Unit&, int tid, unsigned (&v)[2][2]) const {
#pragma unroll
        for (int i = 0; i < 2; ++i) { int R, C; pg8::stage_rc(tid * 16 + i * 8192, R, C); v[0][i] = (unsigned)(R * LDA + C) * 2u; v[1][i] = (unsigned)((R + 128) * LDA + C) * 2u; }
    }
    __device__ __forceinline__ bool epi(f32x4 (&acc)[2][2][4][2], const Unit& u, int wr, int wc, int fr, int fq) const {
        const LAS int* idl = (const LAS int*)(shm + ROWS_OFF + (u.idx & 1) * ROWS_BUF); const LAS float* pl = (const LAS float*)(shm + ROWS_OFF + (u.idx & 1) * ROWS_BUF + 1024);
        const int col0 = u.pn * 256 + 64 * wc + 8 * fq;
        const LAS float* b = (const LAS float*)(shm + ROWS_OFF + (u.idx & 1) * ROWS_BUF + 2048) + 64 * wc + 8 * fq;
        int idv[2][4]; float pv_[2][4];
#pragma unroll
        for (int ai = 0; ai < 2; ++ai)
#pragma unroll
            for (int m = 0; m < 4; ++m) { const int r = ai * 128 + wr * 64 + m * 16 + fr; const bool valid = (u.s0 + r < u.cnt);
                const int t_ = idl[r]; const float q_ = pl[r]; idv[ai][m] = valid ? t_ : T * 4; pv_[ai][m] = q_; }
        f32x4 bv[2][2];
#pragma unroll
        for (int bj = 0; bj < 2; ++bj)
#pragma unroll
            for (int n = 0; n < 2; ++n) bv[bj][n] = *(const LAS f32x4*)(b + 32 * bj + 4 * n);
        const bool oddq = (fq & 1) != 0;
#pragma unroll
        for (int ai = 0; ai < 2; ++ai)
#pragma unroll
            for (int mp = 0; mp < 2; ++mp) {
                const float p0 = pv_[ai][2 * mp] * 16.0f, p1 = pv_[ai][2 * mp + 1] * 16.0f;
                unsigned char* op = y + (size_t)(oddq ? idv[ai][2 * mp + 1] : idv[ai][2 * mp]) * D + (col0 - (oddq ? 8 : 0));
#pragma unroll
                for (int bj = 0; bj < 2; ++bj) {
                    const u32x2 e0 = pack8q((acc[ai][bj][2 * mp][0] * WQ_INV + bv[bj][0]) * p0, (acc[ai][bj][2 * mp][1] * WQ_INV + bv[bj][1]) * p0);
                    const u32x2 e1 = pack8q((acc[ai][bj][2 * mp + 1][0] * WQ_INV + bv[bj][0]) * p1, (acc[ai][bj][2 * mp + 1][1] * WQ_INV + bv[bj][1]) * p1);
                    const u32x2 snd = oddq ? e0 : e1;
                    u32x2 rcv; rcv.x = (unsigned)__shfl_xor((int)snd.x, 16); rcv.y = (unsigned)__shfl_xor((int)snd.y, 16);
                    const u32x4 w = oddq ? (u32x4){rcv.x, rcv.y, e1.x, e1.y} : (u32x4){e0.x, e0.y, rcv.x, rcv.y};
                    *(u32x4*)(op + 32 * bj) = w; } }
        return false;
    }
};

constexpr int CONV_GU_ITEMS = NE * 16 * 32, CONV_D_ITEMS = NE * 16 * 16, CONV_ITEMS = CONV_GU_ITEMS + CONV_D_ITEMS, CONV_PER_WAVE = CONV_ITEMS / 2048;
static_assert(CONV_PER_WAVE * 2048 == CONV_ITEMS, "items divide over 2048 waves");
struct MoeConv {
    const float* wgu; const float* wd; const float* g2; unsigned char* WGU8; unsigned char* WD8;
    struct Regs { f32x4 v0, v1, v2, v3, v4, v5, v6, v7, v8, v9, v10, v11, v12, v13, v14, v15; };
    __device__ __forceinline__ void src_of(int item, const float*& W, int& N, int& k0, int& n0) const {
        if (item < CONV_GU_ITEMS) { const int e = item >> 9, q = item & 511; W = wgu + (size_t)e * D * 2048; N = 2048; k0 = 64 * (q >> 5); n0 = 64 * (q & 31); }
        else { const int r = item - CONV_GU_ITEMS, e = r >> 8, q = r & 255; W = wd + (size_t)e * FF * D; N = D; k0 = 64 * (q >> 4); n0 = 64 * (q & 15); }
    }
    __device__ __forceinline__ void finish(Regs& R, int item, int lane) const {
        const float* W; int N, k0, n0; src_of(item, W, N, k0, n0);
        const int kc = lane >> 4, nq = lane & 15; const bool gu = item < CONV_GU_ITEMS;
        float sc[16];
        if (gu) { const f32x4* gp = (const f32x4*)(g2 + k0 + 16 * kc);
#pragma unroll
            for (int q = 0; q < 4; ++q) { const f32x4 t = gp[q]; sc[4 * q] = t[0] * 32.0f; sc[4 * q + 1] = t[1] * 32.0f; sc[4 * q + 2] = t[2] * 32.0f; sc[4 * q + 3] = t[3] * 32.0f; } }
        else {
#pragma unroll
            for (int i = 0; i < 16; ++i) sc[i] = 32.0f; }
        const int nb = n0 + 32 * (nq >> 3);
        const int e = gu ? (item >> 9) : ((item - CONV_GU_ITEMS) >> 8);
        const int up = nb >= 1024, cc = nb & 1023;
        const int pos = gu ? ((cc >> 7) * 256 + up * 128 + ((cc >> 5) & 3) * 32) : ((nb & ~255) + ((nb >> 5) & 1) * 128 + ((nb >> 6) & 3) * 32);
        unsigned char* base = (gu ? (WGU8 + ((size_t)e * 2048 + pos + ((4 * nq) & 31)) * 1024) : (WD8 + ((size_t)e * 1024 + pos + ((4 * nq) & 31)) * 1024)) + k0 + 16 * kc;
#pragma unroll
        for (int c = 0; c < 4; ++c) {
            int w0 = 0, w1 = 0, w2 = 0, w3 = 0;
            w0 = __builtin_amdgcn_cvt_pk_fp8_f32(R.v0[c] * sc[0], R.v1[c] * sc[1], w0, false); w0 = __builtin_amdgcn_cvt_pk_fp8_f32(R.v2[c] * sc[2], R.v3[c] * sc[3], w0, true);
            w1 = __builtin_amdgcn_cvt_pk_fp8_f32(R.v4[c] * sc[4], R.v5[c] * sc[5], w1, false); w1 = __builtin_amdgcn_cvt_pk_fp8_f32(R.v6[c] * sc[6], R.v7[c] * sc[7], w1, true);
            w2 = __builtin_amdgcn_cvt_pk_fp8_f32(R.v8[c] * sc[8], R.v9[c] * sc[9], w2, false); w2 = __builtin_amdgcn_cvt_pk_fp8_f32(R.v10[c] * sc[10], R.v11[c] * sc[11], w2, true);
            w3 = __builtin_amdgcn_cvt_pk_fp8_f32(R.v12[c] * sc[12], R.v13[c] * sc[13], w3, false); w3 = __builtin_amdgcn_cvt_pk_fp8_f32(R.v14[c] * sc[14], R.v15[c] * sc[15], w3, true);
            *(u32x4*)(base + (size_t)c * 1024) = (u32x4){(unsigned)w0, (unsigned)w1, (unsigned)w2, (unsigned)w3};
        }
    }
    template <int SUB> __device__ __forceinline__ void sub(Regs& R, int& st, int item0, int istride, int lane) const {
        if (SUB == 0 && (st & 1)) { finish(R, item0 + ((st >> 1) - 1) * istride, lane); st &= ~1; }
        const int it = st >> 1;
        {
            const int itc = it < CONV_PER_WAVE ? it : CONV_PER_WAVE - 1;
            const float* W; int N, k0, n0; src_of(item0 + itc * istride, W, N, k0, n0);
            const float* p = W + (size_t)(k0 + 16 * (lane >> 4) + 4 * SUB) * N + n0 + 4 * (lane & 15);
            const f32x4 t0 = *(const f32x4*)p, t1 = *(const f32x4*)(p + N), t2 = *(const f32x4*)(p + 2 * (size_t)N), t3 = *(const f32x4*)(p + 3 * (size_t)N);
            if (SUB == 0) { R.v0 = t0; R.v1 = t1; R.v2 = t2; R.v3 = t3; }
            else if (SUB == 1) { R.v4 = t0; R.v5 = t1; R.v6 = t2; R.v7 = t3; }
            else if (SUB == 2) { R.v8 = t0; R.v9 = t1; R.v10 = t2; R.v11 = t3; }
            else { R.v12 = t0; R.v13 = t1; R.v14 = t2; R.v15 = t3; if (it < CONV_PER_WAVE) st = ((it + 1) << 1) | 1; }
        }
    }
    __device__ __forceinline__ void drain(Regs& R, int& st, int item0, int istride, int lane) const {
        if (st & 1) { finish(R, item0 + ((st >> 1) - 1) * istride, lane); st &= ~1; }
        for (int it = st >> 1; it < CONV_PER_WAVE; ++it) { sub<0>(R, st, item0, istride, lane); sub<1>(R, st, item0, istride, lane); sub<2>(R, st, item0, istride, lane); sub<3>(R, st, item0, istride, lane);
            finish(R, item0 + it * istride, lane); st &= ~1; }
    }
};

namespace att {
constexpr int PITCH = 512, SLOTB = 8192;
constexpr int L_K = 0, L_V = 2 * SLOTB, L_TBL = 4 * SLOTB, L_WS = L_TBL + 4096, L_OST = L_WS + 8 * 256, L_END = L_OST + 8 * 4096;
constexpr int NTBL = 832;
__device__ __forceinline__ int crow(int r, int hi) { return (r & 3) + 8 * (r >> 2) + 4 * hi; }
__device__ __forceinline__ void glds16(const void* gsrc, unsigned lds_dst) { unsigned keep;
    asm volatile("s_mov_b32 %0, m0\n\ts_mov_b32 m0, %2\n\ts_nop 0\n\tglobal_load_lds_dwordx4 %1, off\n\ts_mov_b32 m0, %0" : "=&s"(keep) : "v"(gsrc), "s"(lds_dst) : "memory"); }
__device__ __forceinline__ unsigned cvtpk_s(float lo, float hi) { typedef __bf16 bf16x2_t __attribute__((ext_vector_type(2))); f32x2 v = {lo, hi}; bf16x2_t b = __builtin_convertvector(v, bf16x2_t); return __builtin_bit_cast(unsigned, b); }
#define ATT_SBAR() __builtin_amdgcn_sched_barrier(0)
__device__ __forceinline__ void pv(f32x16* o, int vb, bf16x8 pa0, bf16x8 pa1, bf16x8 pa2, bf16x8 pa3) {
#pragma unroll
    for (int d0 = 0; d0 < 2; ++d0) { s16x4 lo[4], hi[4];
#pragma unroll
        for (int ks = 0; ks < 4; ++ks) {
            asm volatile("ds_read_b64_tr_b16 %0,%1 offset:%c2" : "=&v"(lo[ks]) : "v"(vb), "i"(d0 * 4096 + ks * 1024) : "memory");
            asm volatile("ds_read_b64_tr_b16 %0,%1 offset:%c2" : "=&v"(hi[ks]) : "v"(vb), "i"(d0 * 4096 + ks * 1024 + 512) : "memory"); }
        asm volatile("s_waitcnt lgkmcnt(0)" ::: "memory"); ATT_SBAR();
#define ATT_PK(k) (bf16x8){lo[k][0], lo[k][1], lo[k][2], lo[k][3], hi[k][0], hi[k][1], hi[k][2], hi[k][3]}
        o[d0] = __builtin_amdgcn_mfma_f32_32x32x16_bf16(pa0, ATT_PK(0), o[d0], 0, 0, 0);
        o[d0] = __builtin_amdgcn_mfma_f32_32x32x16_bf16(pa1, ATT_PK(1), o[d0], 0, 0, 0);
        o[d0] = __builtin_amdgcn_mfma_f32_32x32x16_bf16(pa2, ATT_PK(2), o[d0], 0, 0, 0);
        o[d0] = __builtin_amdgcn_mfma_f32_32x32x16_bf16(pa3, ATT_PK(3), o[d0], 0, 0, 0);
#undef ATT_PK
    }
}
__device__ __forceinline__ void unit(int b, int h, int cg, const bf16* Q, const bf16* K, const bf16* V, const float* relb, bf16* O  , LAS unsigned char* shm,
                                     const MoeConv& cv, MoeConv::Regs& sreg, int& sctr, int item0, int istride) {
    const int tid = threadIdx.x, lane = tid & 63, r32 = lane & 31, hi = lane >> 5; const int wid = __builtin_amdgcn_readfirstlane(tid >> 6);
    const long rowbase = (long)b * SEQ; const int cq = 4 * cg + (wid >> 1), wq = wid & 1;
    const bf16* Qw = Q + (rowbase + 64 * cq + 32 * wq) * PITCH + h * HD;
    const unsigned lds0 = (unsigned)(uintptr_t)shm;
    LAS float* tbl = (LAS float*)(shm + L_TBL);
    LAS float* wsf = (LAS float*)(shm + L_WS) + wid * 64;
    for (int i = tid; i < NTBL; i += 512) tbl[i] = relb[h * NREL + (i < 512 ? i : 512)] * LOG2E;
    const int srow = tid >> 3, sc = tid & 7;
    const bf16* ksrc = K + (rowbase + srow) * PITCH + h * HD + sc * 8;
    const bf16* vsrc = V + (rowbase + srow) * PITCH + h * HD + sc * 8;
    const int kwr = L_K + sc * 1024 + ((srow ^ sc) << 4);
    const int vwr = L_V + (4 * (sc >> 2) + (srow >> 4)) * 1024 + (srow & 15) * 64 + (sc & 3) * 16;
    const int vb0 = (int)(lds0 + L_V) + ((lane >> 4) & 1) * 32 + (lane & 3) * 8 + (4 * hi + ((lane & 15) >> 2)) * 64;
    int kra[4];
#pragma unroll
    for (int d0 = 0; d0 < 4; ++d0) kra[d0] = L_K + (2 * d0 + hi) * 1024 + ((r32 ^ (2 * d0 + hi)) << 4);
    bf16x8 qr[4];
#pragma unroll
    for (int d0 = 0; d0 < 4; ++d0) qr[d0] = *reinterpret_cast<const bf16x8*>(&Qw[(long)r32 * PITCH + d0 * 16 + hi * 8]);
    f32x16 o[2]; o[0] = f32x16{}; o[1] = f32x16{}; float l_reg = 0.f;
    const int j0 = (8 - 4 * cg) > 0 ? (8 - 4 * cg) : 0;
    u32x4 kA_, vA_, kB_, vB_;
    { const long ro = (long)(4 * cg - 8 + j0) * 64 * PITCH; kA_ = *(const u32x4*)(ksrc + ro); vA_ = *(const u32x4*)(vsrc + ro); kB_ = *(const u32x4*)(ksrc + ro + 64 * PITCH); vB_ = *(const u32x4*)(vsrc + ro + 64 * PITCH); }
#define ATT_STEP(JX, SUBP, KR, VR) do { const int j = (JX); \
        const int s = (j - j0) & 1; \
        *(LAS u32x4*)(shm + kwr + s * SLOTB) = KR; *(LAS u32x4*)(shm + vwr + s * SLOTB) = VR; \
        if (j < 10) { const long ro = (long)(4 * cg - 8 + j + 2) * 64 * PITCH; KR = *(const u32x4*)(ksrc + ro); VR = *(const u32x4*)(vsrc + ro); } \
        asm volatile("s_waitcnt lgkmcnt(0)\n\ts_barrier" ::: "memory"); \
        cv.template sub<SUBP>(sreg, sctr, item0, istride, lane);     \
        const int d = (wid >> 1) + 8 - j; \
        if (d >= 0 && d <= 8) { \
            f32x16 p0 = f32x16{}, p1 = f32x16{}; \
            const LAS unsigned char* kbs = shm + s * SLOTB; \
        _Pragma("unroll") \
            for (int d0 = 0; d0 < 4; ++d0) { \
                const bf16x8 b0 = *(const LAS bf16x8*)(kbs + kra[d0]), b1 = *(const LAS bf16x8*)(kbs + kra[d0] + 512); \
                p0 = __builtin_amdgcn_mfma_f32_32x32x16_bf16(b0, qr[d0], p0, 0, 0, 0); p1 = __builtin_amdgcn_mfma_f32_32x32x16_bf16(b1, qr[d0], p1, 0, 0, 0); } \
            const LAS float* tb = tbl + (256 + 64 * d + 32 * wq + r32 - 4 * hi - 63); \
            float sacc = 0.f; \
        _Pragma("unroll") \
            for (int r = 0; r < 16; ++r) { const int c = (r & 3) + 8 * (r >> 2); \
                p0[r] = fast_exp2(p0[r] + tb[63 - c]); p1[r] = fast_exp2(p1[r] + tb[31 - c]); sacc += p0[r] + p1[r]; } \
            l_reg += sacc; \
            u32x4 pw0, pw1, pw2, pw3; \
            pw0 = (u32x4){cvtpk_s(p0[0], p0[1]), cvtpk_s(p0[2], p0[3]), cvtpk_s(p0[4], p0[5]), cvtpk_s(p0[6], p0[7])}; \
            pw1 = (u32x4){cvtpk_s(p0[8], p0[9]), cvtpk_s(p0[10], p0[11]), cvtpk_s(p0[12], p0[13]), cvtpk_s(p0[14], p0[15])}; \
            pw2 = (u32x4){cvtpk_s(p1[0], p1[1]), cvtpk_s(p1[2], p1[3]), cvtpk_s(p1[4], p1[5]), cvtpk_s(p1[6], p1[7])}; \
            pw3 = (u32x4){cvtpk_s(p1[8], p1[9]), cvtpk_s(p1[10], p1[11]), cvtpk_s(p1[12], p1[13]), cvtpk_s(p1[14], p1[15])}; \
            ATT_SBAR(); \
            pv(o, vb0 + s * SLOTB, __builtin_bit_cast(bf16x8, pw0), __builtin_bit_cast(bf16x8, pw1), __builtin_bit_cast(bf16x8, pw2), __builtin_bit_cast(bf16x8, pw3)); \
        } \
    } while (0)
    for (int jb = j0; jb < 12; jb += 4) { ATT_STEP(jb, 0, kA_, vA_); ATT_STEP(jb + 1, 1, kB_, vB_); ATT_STEP(jb + 2, 2, kA_, vA_); ATT_STEP(jb + 3, 3, kB_, vB_); }
#undef ATT_STEP
    asm volatile("s_waitcnt lgkmcnt(0)\n\ts_barrier" ::: "memory");
    { auto rr = __builtin_amdgcn_permlane32_swap(__float_as_uint(l_reg), __float_as_uint(l_reg), false, false); l_reg = __uint_as_float(rr[0]) + __uint_as_float(rr[1]); }
    if (hi == 0) wsf[32 + r32] = l_reg; asm volatile("s_waitcnt lgkmcnt(0)" ::: "memory");
    float rli[16];
#pragma unroll
    for (int r = 0; r < 16; ++r) rli[r] = fast_rcp(wsf[32 + crow(r, hi)]);
    bf16* Ow = O + (rowbase + 64 * cq + 32 * wq) * D + h * HD;
    { LAS bf16* stg = (LAS bf16*)(shm + L_OST) + wid * 2048;
#pragma unroll
        for (int r = 0; r < 16; ++r) { const int orow = crow(r, hi);
#pragma unroll
            for (int d0 = 0; d0 < 2; ++d0) stg[orow * 64 + d0 * 32 + r32] = (bf16)f2bf(o[d0][r] * rli[r]); }
        asm volatile("s_waitcnt lgkmcnt(0)" ::: "memory");
#pragma unroll
        for (int i = 0; i < 4; ++i) { const int row = i * 8 + (lane >> 3), ch = lane & 7; const u32x4 v = *(const LAS u32x4*)(stg + row * 64 + ch * 8); *(u32x4*)(Ow + (long)row * D + ch * 8) = v; } }
    asm volatile("s_waitcnt lgkmcnt(0)\n\ts_barrier" ::: "memory");
}
#undef ATT_SBAR
}

constexpr int SGU_WM_OFF = 128 * 136 * 2;
__device__ __forceinline__ void sgu_load_wm(int g, const bf16* WM, LAS unsigned char* shm) {
    const int tid = threadIdx.x, t = tid >> 2, c0 = (tid & 3) * 32;
    const bf16* src = WM + ((size_t)g * 128 + t) * 128 + c0;
#pragma unroll
    for (int q = 0; q < 4; ++q) *(LAS u32x4*)(shm + SGU_WM_OFF + (t * 136 + c0 + 8 * q) * 2) = *(const u32x4*)(src + 8 * q);
}
__device__ __forceinline__ void sgu_item(int item, const bf16* VG, const bf16* UG, const float* lng, const float* lnb, const float* sgb, bf16* YC, LAS unsigned char* shm,
                                         const MoeConv& cv, MoeConv::Regs& sreg, int& sctr, int item0, int istride) {
    const int tid = threadIdx.x, lane = tid & 63; const int wid = __builtin_amdgcn_readfirstlane(tid >> 6);
    const int g = item & 3, blk = item >> 2;
    const long t0 = (long)blk * 128;
    LAS bf16* vt = (LAS bf16*)shm;
    const LAS bf16* wmL = (const LAS bf16*)(shm + SGU_WM_OFF);
    const int ch = tid & 15, fr = lane & 15, fq = lane >> 4;
    u32x4 vraw[4];
#pragma unroll
    for (int it = 0; it < 4; ++it) vraw[it] = *(const u32x4*)(VG + (t0 + (tid >> 4) + 32 * it) * SGW + g * 128 + ch * 8);
    u32x2 uw[8]; float bs[8];
#pragma unroll
    for (int tt = 0; tt < 8; ++tt) { const int t = 16 * tt + fr; uw[tt] = *(const u32x2*)(UG + (size_t)(t0 + t) * SGW + g * 128 + 16 * wid + 4 * fq); bs[tt] = sgb[g * 128 + t]; }
    const f32x4 gA = *(const f32x4*)(lng + g * 128 + ch * 8), gB = *(const f32x4*)(lng + g * 128 + ch * 8 + 4);
    const f32x4 bA = *(const f32x4*)(lnb + g * 128 + ch * 8), bB = *(const f32x4*)(lnb + g * 128 + ch * 8 + 4);
#pragma unroll
    for (int it = 0; it < 4; ++it) {
        const int s = (tid >> 4) + 32 * it;
        const u32x4 w = vraw[it];
        f32x4 a = (f32x4){bflo(w.x), bfhi(w.x), bflo(w.y), bfhi(w.y)}, b = (f32x4){bflo(w.z), bfhi(w.z), bflo(w.w), bfhi(w.w)};
        float sum = (a[0] + a[1]) + (a[2] + a[3]) + (b[0] + b[1]) + (b[2] + b[3]);
        sum += __shfl_xor(sum, 1); sum += __shfl_xor(sum, 2); sum += __shfl_xor(sum, 4); sum += __shfl_xor(sum, 8);
        const float mean = sum * (1.0f / 128.0f);
        a = a - mean; b = b - mean;
        float q = (a[0] * a[0] + a[1] * a[1]) + (a[2] * a[2] + a[3] * a[3]) + (b[0] * b[0] + b[1] * b[1]) + (b[2] * b[2] + b[3] * b[3]);
        q += __shfl_xor(q, 1); q += __shfl_xor(q, 2); q += __shfl_xor(q, 4); q += __shfl_xor(q, 8);
        const float rstd = 1.0f / sqrtf(q * (1.0f / 128.0f) + EPS);
        a = a * rstd * gA + bA; b = b * rstd * gB + bB;
#pragma unroll
        for (int j = 0; j < 4; ++j) { vt[(j * 16 + ch) * 136 + s] = (bf16)f2bf(a[j]); vt[((4 + j) * 16 + ch) * 136 + s] = (bf16)f2bf(b[j]); }
    }
    asm volatile("s_waitcnt lgkmcnt(0)\n\ts_barrier" ::: "memory");
    f32x4 acc[8];
#pragma unroll
    for (int tt = 0; tt < 8; ++tt) acc[tt] = (f32x4){0.f, 0.f, 0.f, 0.f};
#pragma unroll
    for (int ks = 0; ks < 4; ++ks) {
        const bf16x8 a = *(const LAS bf16x8*)(vt + ((fr & 7) * 16 + 2 * wid + (fr >> 3)) * 136 + 32 * ks + 8 * fq);
#pragma unroll
        for (int tt = 0; tt < 8; ++tt) if (ks <= (tt >> 1)) {
            const bf16x8 bfrag = *(const LAS bf16x8*)(wmL + (16 * tt + fr) * 136 + 32 * ks + 8 * fq);
            acc[tt] = __builtin_amdgcn_mfma_f32_16x16x32_bf16(a, bfrag, acc[tt], 0, 0, 0); }
    }
    { const bool oddq = (fq & 1) != 0; u32x2 wp[2];
#pragma unroll
    for (int tt = 0; tt < 8; ++tt) { const int t = 16 * tt + fr; const float b_ = bs[tt];
        const u32x2 u_ = uw[tt];
        u32x2 w; w.x = cvt_pk_bf16(bflo(u_.x) * (acc[tt][0] + b_), bfhi(u_.x) * (acc[tt][1] + b_)); w.y = cvt_pk_bf16(bflo(u_.y) * (acc[tt][2] + b_), bfhi(u_.y) * (acc[tt][3] + b_));
        wp[tt & 1] = w;
        if (tt & 1) *(u32x4*)(YC + (size_t)(t0 + t - (oddq ? 0 : 16)) * D + AW + g * 128 + 16 * wid + 4 * fq - (oddq ? 4 : 0)) = pair16(wp[0], wp[1], oddq); } }
    asm volatile("s_waitcnt lgkmcnt(0)\n\ts_barrier" ::: "memory");
}

#define XB_TMO      128
#define XB_XCNT(j)  (256  + 64 * (j))
#define XB_XSUB(j)  (1280 + 64 * (j))
#define XB_XGEN(j)  (2304 + 64 * (j))
#define XB_TOP      3328
#define XB_TOPGEN   3392
#define XCD_BAR_WORDS 3456
#define XB_SPIN_CAP (1u << 18)
__device__ __forceinline__ unsigned xb_ld(unsigned* p)              { return __hip_atomic_load(p, __ATOMIC_RELAXED, __HIP_MEMORY_SCOPE_AGENT); }
__device__ __forceinline__ unsigned xb_add(unsigned* p, unsigned v) { return __hip_atomic_fetch_add(p, v, __ATOMIC_RELAXED, __HIP_MEMORY_SCOPE_AGENT); }
__device__ __forceinline__ unsigned xb_xcc_id() { return (unsigned)__builtin_amdgcn_s_getreg((3 << 11) | 20) & 0xFu; }
#define XB_SPIN(cond, bar) do { unsigned _sp = 0; while (cond) { __builtin_amdgcn_s_sleep(1); \
    if ((++_sp & 255u) == 0u) { if (xb_ld(&(bar)[XB_TMO])) break; if (_sp > XB_SPIN_CAP) { atomicAdd(&(bar)[XB_TMO], 1u); break; } } } } while (0)
struct XcdBarrier { unsigned* bar; unsigned x; volatile LAS unsigned* st; };
__device__ __forceinline__ XcdBarrier xcd_barrier_post(unsigned* bar, volatile LAS unsigned* st) {
    XcdBarrier b; b.bar = bar; b.x = xb_xcc_id(); b.st = st;
    if (threadIdx.x == 0) (void)xb_add(&bar[XB_XCNT(b.x)], 1u);
    return b;
}
__device__ __forceinline__ void xcd_barrier_complete(unsigned* bar, unsigned x, unsigned& nloc, unsigned& nx) {
    const unsigned G = gridDim.x * gridDim.y * gridDim.z;
    unsigned sum, cnt, mine, sp = 0u;
    for (;;) {
        sum = 0u; cnt = 0u; mine = 0u;
#pragma unroll
        for (unsigned j = 0; j < 16; ++j) { const unsigned c = xb_ld(&bar[XB_XCNT(j)]); sum += c; cnt += (c > 0u) ? 1u : 0u; mine = (j == x) ? c : mine; }
        if (sum == G) break;
        __builtin_amdgcn_s_sleep(1);
        if ((++sp & 255u) == 0u) { if (xb_ld(&bar[XB_TMO])) break; if (sp > XB_SPIN_CAP) { atomicAdd(&bar[XB_TMO], 1u); break; } }
    }
    nloc = mine > 0u ? mine : 1u; nx = cnt > 0u ? cnt : 1u;
}
__device__ __forceinline__ void xcd_barrier(const XcdBarrier& b) {
    asm volatile("s_waitcnt vmcnt(0)" ::: "memory");
    __syncthreads();
    if (threadIdx.x == 0) {
        unsigned* bar = b.bar;
        __builtin_amdgcn_s_waitcnt(0);
        unsigned nloc = b.st[0], nx = b.st[1];
        if (nloc == 0u) { xcd_barrier_complete(bar, b.x, nloc, nx); b.st[0] = nloc; b.st[1] = nx; }
        const unsigned old = xb_add(&bar[XB_XSUB(b.x)], 1u);
        const unsigned gen = old / nloc;
        if (old + 1u == (gen + 1u) * nloc) {
            __builtin_amdgcn_fence(__ATOMIC_RELEASE, "agent");
            asm volatile("s_waitcnt vmcnt(0)" ::: "memory");
            const unsigned og = xb_add(&bar[XB_TOP], 1u);
            const unsigned tg = og / nx;
            if (og + 1u == (tg + 1u) * nx) xb_add(&bar[XB_TOPGEN], 1u);
            else XB_SPIN(xb_ld(&bar[XB_TOPGEN]) == tg, bar);
            __builtin_amdgcn_fence(__ATOMIC_ACQUIRE, "agent");
            xb_add(&bar[XB_XGEN(b.x)], 1u);
            asm volatile("s_waitcnt vmcnt(0)" ::: "memory");
        } else {
            XB_SPIN(xb_ld(&bar[XB_XGEN(b.x)]) == gen, bar);
            __builtin_amdgcn_fence(__ATOMIC_ACQUIRE, "agent");
            asm volatile("s_waitcnt vmcnt(0)" ::: "memory");
        }
    }
    __syncthreads();
}

__device__ __forceinline__ float wave_sum(float v) {
#pragma unroll
    for (int o = 1; o < 64; o <<= 1) v += __shfl_xor(v, o);
    return v;
}
__device__ __forceinline__ int pos_gen(int n0) { return (n0 & ~255) + ((n0 >> 5) & 1) * 128 + ((n0 >> 6) & 3) * 32; }
__device__ __forceinline__ int pos_gu(int c0) { const int up = c0 >= 1024, cc = c0 & 1023; return (cc >> 7) * 256 + up * 128 + ((cc >> 5) & 3) * 32; }
__device__ __forceinline__ unsigned pack_i8(const f32x4& v) {
    const int a = (int)__builtin_rintf(v.x), b = (int)__builtin_rintf(v.y), c = (int)__builtin_rintf(v.z), d = (int)__builtin_rintf(v.w);
    return ((unsigned)a & 255u) | (((unsigned)b & 255u) << 8) | (((unsigned)c & 255u) << 16) | ((unsigned)d << 24);
}
__device__ __forceinline__ void win_absmax(const float* W, int k0, int n0, unsigned* cmax, unsigned* ccnt, int lane) {
    const int kc = lane >> 4, nq = lane & 15;
    f32x4 v[16];
#pragma unroll
    for (int i = 0; i < 16; ++i) v[i] = *(const f32x4*)(W + (size_t)(k0 + 16 * kc + i) * INW + n0 + 4 * nq);
    f32x4 mx = (f32x4){0.f, 0.f, 0.f, 0.f};
#pragma unroll
    for (int i = 0; i < 16; ++i) { mx.x = fmaxf(mx.x, fabsf(v[i].x)); mx.y = fmaxf(mx.y, fabsf(v[i].y)); mx.z = fmaxf(mx.z, fabsf(v[i].z)); mx.w = fmaxf(mx.w, fabsf(v[i].w)); }
#pragma unroll
    for (int c = 0; c < 4; ++c) { mx[c] = fmaxf(mx[c], __shfl_xor(mx[c], 16)); mx[c] = fmaxf(mx[c], __shfl_xor(mx[c], 32)); }
    if (kc == 0) {
#pragma unroll
        for (int c = 0; c < 4; ++c) (void)__hip_atomic_fetch_max(cmax + n0 + 4 * nq + c, __float_as_uint(mx[c]), RLX_AGENT);
    }
    asm volatile("s_waitcnt vmcnt(0)" ::: "memory");
    if (lane == 0) (void)__hip_atomic_fetch_add(ccnt, 1u, RLX_AGENT);
}
__device__ __forceinline__ void win_quant(const float* W, int k0, int n0, unsigned char* WT, unsigned* cmax, unsigned* ccnt, float* cs, bool write_cs, unsigned* tmo, int lane) {
    const int kc = lane >> 4, nq = lane & 15;
    f32x4 v[16];
#pragma unroll
    for (int i = 0; i < 16; ++i) v[i] = *(const f32x4*)(W + (size_t)(k0 + 16 * kc + i) * INW + n0 + 4 * nq);
    { unsigned sp = 0; while (__hip_atomic_load(ccnt, RLX_AGENT) < 16u) { __builtin_amdgcn_s_sleep(1);
        if ((++sp & 255u) == 0u) { if (__hip_atomic_load(tmo, RLX_AGENT)) break; if (sp > (1u << 18)) { atomicAdd(tmo, 1u); break; } } } }
    asm volatile("" ::: "memory");
    float sc[4];
#pragma unroll
    for (int c = 0; c < 4; ++c) { const float cm = __uint_as_float(__hip_atomic_load(cmax + n0 + 4 * nq + c, RLX_AGENT)); sc[c] = cm > 0.f ? 127.0f / cm : 0.f; if (write_cs && kc == 0) cs[n0 + 4 * nq + c] = cm * (1.0f / 127.0f); }
    const int nb = n0 + 32 * (nq >> 3);
    const int rowb = pos_gen(nb) + ((4 * nq) & 31);
#pragma unroll
    for (int c = 0; c < 4; ++c) {
        u32x4 o;
        o.x = pack_i8((f32x4){v[0][c], v[1][c], v[2][c], v[3][c]} * sc[c]); o.y = pack_i8((f32x4){v[4][c], v[5][c], v[6][c], v[7][c]} * sc[c]);
        o.z = pack_i8((f32x4){v[8][c], v[9][c], v[10][c], v[11][c]} * sc[c]); o.w = pack_i8((f32x4){v[12][c], v[13][c], v[14][c], v[15][c]} * sc[c]);
        *(u32x4*)(WT + (size_t)(rowb + c) * D + k0 + 16 * kc) = o;
    }
}
template <int MODE, int POSK>
__device__ __forceinline__ void tr_tile(const float* W, int N, int k0, int n0, unsigned char* WT, int ldt_bytes, int dk0, const float* ks, float wscale, int lane, int rowadj = 0) {
    const int kc = lane >> 4, nq = lane & 15;
    f32x4 v[16];
#pragma unroll
    for (int i = 0; i < 16; ++i) { const int kk = MODE ? (16 * kc + i) : (32 * (i >> 3) + 8 * kc + (i & 7)); v[i] = *(const f32x4*)(W + (size_t)(k0 + kk) * N + n0 + 4 * nq); }
    if (ks) {
#pragma unroll
        for (int i = 0; i < 16; ++i) { const int kk = MODE ? (16 * kc + i) : (32 * (i >> 3) + 8 * kc + (i & 7)); v[i] = v[i] * (ks[k0 + kk] * wscale); }
    } else if (MODE) {
#pragma unroll
        for (int i = 0; i < 16; ++i) v[i] = v[i] * wscale;
    }
    const int nb = n0 + 32 * (nq >> 3);
    const int rowb = (POSK ? pos_gu(nb) : pos_gen(nb)) + ((4 * nq) & 31) + rowadj;
#pragma unroll
    for (int c = 0; c < 4; ++c) {
        unsigned char* rp = WT + (size_t)(rowb + c) * ldt_bytes;
        if (MODE == 0) {
#pragma unroll
            for (int p = 0; p < 2; ++p) { u32x4 o; o.x = pk2(v[8 * p + 0][c], v[8 * p + 1][c]); o.y = pk2(v[8 * p + 2][c], v[8 * p + 3][c]); o.z = pk2(v[8 * p + 4][c], v[8 * p + 5][c]); o.w = pk2(v[8 * p + 6][c], v[8 * p + 7][c]);
                *(u32x4*)(rp + (size_t)(dk0 + 32 * p + 8 * kc) * 2) = o; }
        } else {
            int w0 = 0, w1 = 0, w2 = 0, w3 = 0;
            w0 = __builtin_amdgcn_cvt_pk_fp8_f32(v[0][c], v[1][c], w0, false); w0 = __builtin_amdgcn_cvt_pk_fp8_f32(v[2][c], v[3][c], w0, true);
            w1 = __builtin_amdgcn_cvt_pk_fp8_f32(v[4][c], v[5][c], w1, false); w1 = __builtin_amdgcn_cvt_pk_fp8_f32(v[6][c], v[7][c], w1, true);
            w2 = __builtin_amdgcn_cvt_pk_fp8_f32(v[8][c], v[9][c], w2, false); w2 = __builtin_amdgcn_cvt_pk_fp8_f32(v[10][c], v[11][c], w2, true);
            w3 = __builtin_amdgcn_cvt_pk_fp8_f32(v[12][c], v[13][c], w3, false); w3 = __builtin_amdgcn_cvt_pk_fp8_f32(v[14][c], v[15][c], w3, true);
            *(u32x4*)(rp + (size_t)(dk0 + 16 * kc)) = (u32x4){(unsigned)w0, (unsigned)w1, (unsigned)w2, (unsigned)w3};
        }
    }
}

struct Args { const float* in[20]; float* out; unsigned char* ws; int ph_lo, ph_hi, li, pad; };

__global__ void __launch_bounds__(512, 2) moe_block_fwd(Args args) {
    extern __shared__ __attribute__((aligned(16))) unsigned char lds_raw[];
    LAS unsigned char* lds = (LAS unsigned char*)lds_raw;
    volatile LAS unsigned* MISC = (volatile LAS unsigned*)(lds + MISC_OFF);
    const int tid = threadIdx.x, lane = tid & 63, wave = __builtin_amdgcn_readfirstlane(tid >> 6);
    const int G = gridDim.x, bx = blockIdx.x;
    const int vcu = (G % 8 == 0) ? (bx % 8) * (G / 8) + bx / 8 : bx;
    unsigned char* ws = args.ws;
    gu32* ctl = (gu32*)(ws + WS_CTL);
    const float* x = args.in[0]; const float* norm1_g = args.in[1]; const float* w_in = args.in[2]; const float* q_norm_g = args.in[3]; const float* k_norm_g = args.in[4];
    const float* rel_bias = args.in[5]; const float* sg_ln_g = args.in[6]; const float* sg_ln_b = args.in[7]; const float* sg_w = args.in[8]; const float* sg_b = args.in[9];
    const float* w_branch_a = args.in[10]; const float* w_branch_b = args.in[11]; const float* w_out = args.in[12]; const float* norm2_g = args.in[13];
    const float* router_w = args.in[14]; const float* router_b = args.in[15]; const float* w_gate_up = args.in[16]; const float* b_gate_up = args.in[17];
    const float* w_down = args.in[18]; const float* b_down = args.in[19];
    float* out = args.out;
    bf16* WIN = (bf16*)(ws + WS_WIN); unsigned char* WIN8 = ws + WS_WIN8; float* HS = (float*)(ws + WS_HS); float* CS = (float*)(ws + WS_CS); unsigned char* H8 = ws + WS_H8; bf16* WAB = (bf16*)(ws + WS_WAB); bf16* WO = (bf16*)(ws + WS_WO); bf16* WRH = (bf16*)(ws + WS_WR); bf16* WRL = (bf16*)(ws + WS_WR + 65536); bf16* WM = (bf16*)(ws + WS_WM);
    int* LID = (int*)(ws + WS_LID); float* LRS = (float*)(ws + WS_LRS); float* LP = (float*)(ws + WS_LP);
    unsigned char* WGU = ws + WS_WGU; unsigned char* WD = ws + WS_WD;
    bf16* HB = (bf16*)(ws + WS_H); bf16* QB = (bf16*)(ws + WS_Q); bf16* KB = (bf16*)(ws + WS_K); bf16* VB = (bf16*)(ws + WS_V);
    bf16* UG = (bf16*)(ws + WS_UG); bf16* VG = (bf16*)(ws + WS_VG); unsigned char* GA = ws + WS_GA; bf16* GB = (bf16*)(ws + WS_GB);
    bf16* YCAT = (bf16*)(ws + WS_YCAT); unsigned char* X1Q = ws + WS_X1B; bf16* X1H = (bf16*)(ws + WS_X1H); unsigned char* ACT = ws + WS_ACT; unsigned char* YB = ws + WS_Y;

    for (int u = tid; u < (LDS_BYTES - LDSCTL_OFF) / 4; u += 512) ((LAS unsigned*)(lds + LDSCTL_OFF))[u] = 0u;
    __syncthreads();
    XcdBarrier bar; bar.bar = (unsigned*)(ctl + CW_BAR); bar.x = 0; bar.st = nullptr;
    if (MK_N_LAUNCHES == 1) bar = xcd_barrier_post((unsigned*)(ctl + CW_BAR), MISC + 8);
    const int lo = args.ph_lo, hi = args.ph_hi;
#define IN(k) (lo <= (k) && (k) < hi)
#define SEAM(k) do { if (IN(k) && IN((k) + 1)) xcd_barrier(bar); } while (0)
#define REPS(k) for (int rep_ = 0; rep_ < ((REP_PHASE == (k)) ? 2 : 1); ++rep_)
#define REPSEAM(k) do { if (REP_PHASE == (k) && rep_ == 0) xcd_barrier(bar); } while (0)
    const int gw = vcu * 8 + wave, NGW = G * 8;

    if (IN(0)) REPS(0) {
        constexpr int I_IN = 16 * 72, I_A = 8 * 16, I_O = 16 * 16, I_GU = 16 * 32, I_D = 16 * 16;
        constexpr int NITEMS = I_IN + 2 * I_A + I_O;
        for (int it = gw; it < NITEMS; it += NGW) {
            int r = it;
            if (r < I_IN) { const int kb = r / 72, nb = r % 72; win_absmax(w_in, 64 * kb, 64 * nb, (unsigned*)(ctl + CW_CMAX), (unsigned*)(ctl + CW_CCNT + nb), lane); continue; } r -= I_IN;
            if (r < I_A) { const int kb = r / 16, nb = r % 16; tr_tile<0, 0>(w_branch_a, D, 64 * kb, 64 * nb, (unsigned char*)WAB, D * 2, 64 * kb, nullptr, 1.f, lane); continue; } r -= I_A;
            if (r < I_A) { const int kb = r / 16, nb = r % 16; tr_tile<0, 0>(w_branch_b, D, 64 * kb, 64 * nb, (unsigned char*)WAB, D * 2, 512 + 64 * kb, nullptr, 1.f, lane); continue; } r -= I_A;
            { const int kb = r / 16, nb = r % 16; tr_tile<0, 0>(w_out, D, 64 * kb, 64 * nb, (unsigned char*)WO, D * 2, 64 * kb, nullptr, 1.f, lane); }
        }
        for (int i = gw * 64 + lane; i < 4 * 128 * 128; i += NGW * 64) { const int s = i & 127, t = (i >> 7) & 127; WM[i] = (bf16)f2bf(s <= t ? sg_w[i] : 0.f); }
        for (int i = gw * 64 + lane; i < NE * D; i += NGW * 64) { const int k = i & 1023, e = i >> 10; const float w = router_w[k * NE + e] * norm2_g[k]; const unsigned h_ = f2bf(w); WRH[i] = (bf16)h_; WRL[i] = (bf16)f2bf(w - bf2f((unsigned short)h_)); }
        for (int m = 2 * gw; m < T; m += 2 * NGW) {
            const f32x4* xr = (const f32x4*)(x + (size_t)m * D) + lane; const f32x4* gr = (const f32x4*)norm1_g + lane;
            f32x4 v[2][4]; float s0 = 0.f, s1 = 0.f, a0 = 0.f, a1 = 0.f;
#pragma unroll
            for (int j = 0; j < 4; ++j) { v[0][j] = xr[64 * j]; v[1][j] = xr[256 + 64 * j]; }
#pragma unroll
            for (int j = 0; j < 4; ++j) { const f32x4 gq = gr[64 * j];
                s0 += (v[0][j].x * v[0][j].x + v[0][j].y * v[0][j].y) + (v[0][j].z * v[0][j].z + v[0][j].w * v[0][j].w);
                s1 += (v[1][j].x * v[1][j].x + v[1][j].y * v[1][j].y) + (v[1][j].z * v[1][j].z + v[1][j].w * v[1][j].w);
                v[0][j] = v[0][j] * gq; v[1][j] = v[1][j] * gq;
                a0 = fmaxf(a0, fmaxf(fmaxf(fabsf(v[0][j].x), fabsf(v[0][j].y)), fmaxf(fabsf(v[0][j].z), fabsf(v[0][j].w))));
                a1 = fmaxf(a1, fmaxf(fmaxf(fabsf(v[1][j].x), fabsf(v[1][j].y)), fmaxf(fabsf(v[1][j].z), fabsf(v[1][j].w)))); }
            s0 = wave_sum(s0); s1 = wave_sum(s1);
#pragma unroll
            for (int o = 1; o < 64; o <<= 1) { a0 = fmaxf(a0, __shfl_xor(a0, o)); a1 = fmaxf(a1, __shfl_xor(a1, o)); }
            const float rs0 = 1.0f / sqrtf(s0 * (1.0f / D) + EPS), rs1 = 1.0f / sqrtf(s1 * (1.0f / D) + EPS);
            const float q0 = a0 > 0.f ? 127.0f / a0 : 0.f, q1 = a1 > 0.f ? 127.0f / a1 : 0.f;
            if (lane == 0) { HS[m] = rs0 * a0 * (1.0f / 127.0f); HS[m + 1] = rs1 * a1 * (1.0f / 127.0f); }
            unsigned* q8 = (unsigned*)(H8 + (size_t)m * D) + lane;
#pragma unroll
            for (int j = 0; j < 4; ++j) { q8[64 * j] = pack_i8(v[0][j] * q0); q8[256 + 64 * j] = pack_i8(v[1][j] * q1); }
        }
        for (int it = gw; it < I_IN; it += NGW) { const int kb = it / 72, nb = it % 72;
            win_quant(w_in, 64 * kb, 64 * nb, WIN8, (unsigned*)(ctl + CW_CMAX), (unsigned*)(ctl + CW_CCNT + nb), CS, kb == 0, (unsigned*)(ctl + CW_BAR) + XB_TMO, lane); }
        REPSEAM(0);
    }
    SEAM(0);

    if (IN(1)) REPS(1) {
        { PolIn P; P.so.init(T, INW, G, bx); P.A = H8; P.Bt = WIN8; P.ws = ws; P.qg = q_norm_g; P.kg = k_norm_g; P.hs = HS; P.cs = CS; P.shm = lds;
          pg8::gemm_phase<PolIn>(lds, P); }
        REPSEAM(1);
    }
    SEAM(1);

    if (IN(2)) REPS(2) {
        const MoeConv cv{w_gate_up, w_down, norm2_g, WGU, WD}; MoeConv::Regs sreg; int sctr = 0;
        for (int u = vcu; u < NB * NHEAD * 32; u += G) {
            const int cg = u & 31, bh = u >> 5;
            att::unit(bh >> 3, bh & 7, cg, QB, KB, VB, rel_bias, YCAT, lds, cv, sreg, sctr, gw, NGW);
        }
        sgu_load_wm(vcu & 3, WM, lds);
        for (int it = vcu; it < 4 * (T / 128); it += G) sgu_item(it, VG, UG, sg_ln_g, sg_ln_b, sg_b, YCAT, lds, cv, sreg, sctr, gw, NGW);
        cv.drain(sreg, sctr, gw, NGW, lane);
        REPSEAM(2);
    }
    SEAM(2);

    if (IN(3)) REPS(3) {
        PolMerge P; P.so.init(T, D, G, bx); P.A = YCAT; P.Bt = WAB; P.ga = GA; P.gb = (const unsigned char*)GB; P.out = HB;
        pg8::gemm_phase<PolMerge>(lds, P);
        REPSEAM(3);
    }
    SEAM(3);

    if (IN(4)) REPS(4) {
        PolOut P; P.so.init(T, D, G, bx); P.A = HB; P.Bt = WO; P.x = x; P.x1 = X1H; P.x1q = X1Q;
        pg8::gemm_phase<PolOut>(lds, P);
        REPSEAM(4);
    }
    SEAM(4);

    if (IN(5)) {
        LAS int* lcnt = (LAS int*)(lds + PARK_OFF); LAS int* gbase = lcnt + 32;
        if (tid < 64) lcnt[tid] = 0;
        for (int i = tid; i < 4096; i += 512) { const int e = i & 31, gq = (i >> 5) & 3, kq = i >> 7;
            *(LAS u32x4*)(lds + (size_t)i * 16) = *(const u32x4*)(WRH + (size_t)e * D + 32 * kq + 8 * gq); *(LAS u32x4*)(lds + 65536 + (size_t)i * 16) = *(const u32x4*)(WRL + (size_t)e * D + 32 * kq + 8 * gq); }
        __syncthreads();
        const int r = lane & 15, g = lane >> 4;
        int sel_e[4], sel_rank[4]; float sel_p[4]; float rs_row = 0.f; int tok = 0;
        for (int grp = bx * 8 + wave; grp < T / 16; grp += NGW) {
            const int row0 = grp * 16; tok = row0 + r;
            const bf16* xr = X1H + (size_t)(row0 + r) * D + 8 * g;
            const LAS unsigned char* wl_ = lds + (g * 32 + r) * 16;
            f32x4 a0 = (f32x4){0.f, 0.f, 0.f, 0.f}, a1 = a0; float ssq = 0.f;
            u32x4 xq[4][4];
#define P5_LOAD(S, ss) do { _Pragma("unroll") for (int q = 0; q < 4; ++q) xq[S][q] = *(const u32x4*)(xr + 128 * (ss) + 32 * q); } while (0)
#define P5_COMP(S, ss) do { _Pragma("unroll") for (int q = 0; q < 4; ++q) { const u32x4 w_ = xq[S][q]; const int ks = 4 * (ss) + q; \
                const bf16x8 wh_0 = *(const LAS bf16x8*)(wl_ + ks * 2048), wh_1 = *(const LAS bf16x8*)(wl_ + ks * 2048 + 256), wl_0 = *(const LAS bf16x8*)(wl_ + 65536 + ks * 2048), wl_1 = *(const LAS bf16x8*)(wl_ + 65536 + ks * 2048 + 256); \
                ssq += (bflo(w_.x) * bflo(w_.x) + bfhi(w_.x) * bfhi(w_.x)) + (bflo(w_.y) * bflo(w_.y) + bfhi(w_.y) * bfhi(w_.y)) + (bflo(w_.z) * bflo(w_.z) + bfhi(w_.z) * bfhi(w_.z)) + (bflo(w_.w) * bflo(w_.w) + bfhi(w_.w) * bfhi(w_.w)); \
                const bf16x8 xh = __builtin_bit_cast(bf16x8, w_); \
                a0 = __builtin_amdgcn_mfma_f32_16x16x32_bf16(wh_0, xh, a0, 0, 0, 0); a1 = __builtin_amdgcn_mfma_f32_16x16x32_bf16(wh_1, xh, a1, 0, 0, 0); \
                a0 = __builtin_amdgcn_mfma_f32_16x16x32_bf16(wl_0, xh, a0, 0, 0, 0); a1 = __builtin_amdgcn_mfma_f32_16x16x32_bf16(wl_1, xh, a1, 0, 0, 0); } } while (0)
            P5_LOAD(0, 0); P5_LOAD(1, 1); P5_LOAD(2, 2); P5_LOAD(3, 3);
            P5_COMP(0, 0); P5_LOAD(0, 4);
            P5_COMP(1, 1); P5_LOAD(1, 5);
            P5_COMP(2, 2); P5_LOAD(2, 6);
            P5_COMP(3, 3); P5_LOAD(3, 7);
            P5_COMP(0, 4); P5_COMP(1, 5); P5_COMP(2, 6); P5_COMP(3, 7);
#undef P5_LOAD
#undef P5_COMP
            ssq += __shfl_xor(ssq, 16); ssq += __shfl_xor(ssq, 32);
            const float rs = 1.0f / sqrtf(ssq * (1.0f / D) + EPS); rs_row = rs;
            float v[8];
#pragma unroll
            for (int j = 0; j < 4; ++j) { v[j] = a0[j] * rs + router_b[4 * g + j]; v[4 + j] = a1[j] * rs + router_b[16 + 4 * g + j]; }
            unsigned taken = 0u; float sel_v[4];
#pragma unroll
            for (int k = 0; k < 4; ++k) {
                float best = -INFINITY; int bi = 1 << 20;
#pragma unroll
                for (int i = 0; i < 8; ++i) { const int ei = (i >> 2) * 16 + 4 * g + (i & 3); if (!((taken >> i) & 1u) && v[i] > best) { best = v[i]; bi = ei; } }
#pragma unroll
                for (int m = 16; m <= 32; m <<= 1) { const float ob = __shfl_xor(best, m); const int oi = __shfl_xor(bi, m); if (ob > best || (ob == best && oi < bi)) { best = ob; bi = oi; } }
                sel_e[k] = bi; sel_v[k] = best;
                if (((bi & 15) >> 2) == g) taken |= 1u << (((bi >> 4) << 2) | (bi & 3));
            }
            float den = 0.f;
#pragma unroll
            for (int k = 0; k < 4; ++k) { sel_p[k] = __expf(sel_v[k] - sel_v[0]); den += sel_p[k]; }
            const float inv = 1.0f / den;
#pragma unroll
            for (int k = 0; k < 4; ++k) sel_p[k] *= inv;
            if (g == 0) {
#pragma unroll
                for (int k = 0; k < 4; ++k) sel_rank[k] = __hip_atomic_fetch_add(lcnt + sel_e[k], 1, __ATOMIC_RELAXED, __HIP_MEMORY_SCOPE_WORKGROUP);
            }
        }
        __syncthreads();
        if (tid < NE) gbase[tid] = (int)__hip_atomic_fetch_add((unsigned*)(ctl + CW_CNT + tid), (unsigned)lcnt[tid], RLX_AGENT);
        __syncthreads();
        if (g == 0 && (bx * 8 + wave) < T / 16) {
#pragma unroll
            for (int k = 0; k < 4; ++k) { const size_t pos = (size_t)sel_e[k] * LCAP + gbase[sel_e[k]] + sel_rank[k];
                LID[pos] = tok * 4 + k; LRS[pos] = rs_row; LP[pos] = sel_p[k]; }
        }
        __syncthreads();
    }
    SEAM(5);

    if (IN(6) || IN(7)) {
        LAS int* tb = (LAS int*)(lds + MOE_OFF);
        if (tid < NE) tb[33 + tid] = (int)__hip_atomic_load(ctl + CW_CNT + tid, RLX_AGENT);
        __syncthreads();
        if (tid == 0) { int acc = 0; for (int e = 0; e < NE; ++e) { tb[e] = acc; acc += (tb[33 + e] + 255) >> 8; } tb[32] = acc; }
        __syncthreads();
    }
    if (IN(6)) REPS(6) {
        PolGU P; P.mo.init((const LAS int*)(lds + MOE_OFF), 8, G, bx); P.A = X1Q; P.Bt = WGU; P.lid = LID; P.lrs = LRS; P.bgu = b_gate_up; P.act = ACT; P.shm = lds;
        pg8::gemm_phase<PolGU>(lds, P);
        REPSEAM(6);
    }
    SEAM(6);
    if (IN(7)) REPS(7) {
        PolDown P; P.mo.init((const LAS int*)(lds + MOE_OFF), 4, G, bx); P.A = ACT; P.Bt = WD; P.lid = LID; P.lp = LP; P.bd = b_down; P.y = YB; P.shm = lds;
        pg8::gemm_phase<PolDown>(lds, P);
        REPSEAM(7);
    }
    SEAM(7);
    if (IN(8)) {
        f32x4 xa[4], xb[4]; u32x4 ya[4], yb[4];
#define P8_LOAD(X, Y, m_) do { const bf16* xr_ = X1H + (size_t)(m_) * D + 16 * lane; { f32x4 a_, b_; ld8(xr_, a_, b_); X[0] = a_; X[1] = b_; ld8(xr_ + 8, a_, b_); X[2] = a_; X[3] = b_; } \
            _Pragma("unroll") for (int k = 0; k < 4; ++k) Y[k] = *(const u32x4*)(YB + ((size_t)(m_) * 4 + k) * D + 16 * lane); } while (0)
#define P8_DONE(X, Y, m_) do { _Pragma("unroll") for (int k = 0; k < 4; ++k) { const unsigned ww[4] = {Y[k].x, Y[k].y, Y[k].z, Y[k].w}; \
            _Pragma("unroll") for (int q = 0; q < 4; ++q) { const f32x2 lo_ = __builtin_amdgcn_cvt_pk_f32_fp8((int)ww[q], false), hi_ = __builtin_amdgcn_cvt_pk_f32_fp8((int)ww[q], true); \
                X[q][0] += lo_[0] * 0.0625f; X[q][1] += lo_[1] * 0.0625f; X[q][2] += hi_[0] * 0.0625f; X[q][3] += hi_[1] * 0.0625f; } } \
            float* or_ = out + (size_t)(m_) * D + 16 * lane; _Pragma("unroll") for (int j = 0; j < 4; ++j) *(f32x4*)(or_ + 4 * j) = X[j]; } while (0)
        for (int m = gw; m < T; m += 2 * NGW) { const int m2 = m + NGW;
            P8_LOAD(xa, ya, m); P8_LOAD(xb, yb, m2);
            P8_DONE(xa, ya, m); P8_DONE(xb, yb, m2); }
#undef P8_LOAD
#undef P8_DONE
    }
#undef IN
#undef SEAM
}

extern "C" void kernel_launch(void* const* d_in, const int* in_sizes, int n_in, void* d_out, int out_size, void* d_ws, size_t ws_size, hipStream_t stream) {
    static int grid = 0;
    if (grid == 0) {
        if (n_in != 20 || in_sizes[0] != T * D || out_size != T * D || ws_size < WS_END) { fprintf(stderr, "kernel_launch: unexpected shapes (n_in %d, ws %zu)\n", n_in, ws_size); grid = -1; return; }
        int dev = 0, cus = 0;
        if (hipGetDevice(&dev) != hipSuccess || hipDeviceGetAttribute(&cus, hipDeviceAttributeMultiprocessorCount, dev) != hipSuccess) { grid = -1; return; }
        if (hipFuncSetAttribute((const void*)moe_block_fwd, hipFuncAttributeMaxDynamicSharedMemorySize, LDS_BYTES) != hipSuccess) { fprintf(stderr, "kernel_launch: hipFuncSetAttribute failed\n"); grid = -1; return; }
        (void)hipGetLastError();
        grid = cus;
        if (grid != 256) { fprintf(stderr, "kernel_launch: built for a 256-CU device, got %d\n", cus); grid = -1; return; }
    }
    if (grid < 0) return;
    if (hipMemsetAsync((char*)d_ws + WS_CTL, 0, CTL_ZERO_BYTES, stream) != hipSuccess) return;
    Args a{};
    for (int i = 0; i < 20; ++i) a.in[i] = (const float*)d_in[i];
    a.out = (float*)d_out; a.ws = (unsigned char*)d_ws;
    constexpr int NPH = 9;
    for (int li = 0; li < MK_N_LAUNCHES; ++li) {
        a.ph_lo = (MK_N_LAUNCHES == 1) ? 0 : li; a.ph_hi = (MK_N_LAUNCHES == 1) ? NPH : li + 1; a.li = li;
        hipLaunchKernelGGL(moe_block_fwd, dim3(grid), dim3(512), LDS_BYTES, stream, a);
    }
}
```

```cpp
#include <hip/hip_runtime.h>
#include <cstdio>
#include <cstdint>

#ifndef MK_N_LAUNCHES
#define MK_N_LAUNCHES 1
#endif

#ifndef REP_PHASE
#define REP_PHASE -1
#endif
#define LAS __attribute__((address_space(3)))
#define GAS __attribute__((address_space(1)))
typedef unsigned short bf16;
typedef short bf16x8 __attribute__((ext_vector_type(8)));
typedef short s16x4 __attribute__((ext_vector_type(4)));
typedef float f32x2 __attribute__((ext_vector_type(2)));
typedef float f32x4 __attribute__((ext_vector_type(4)));
typedef float f32x16 __attribute__((ext_vector_type(16)));
typedef unsigned u32x2 __attribute__((ext_vector_type(2)));
typedef unsigned u32x4 __attribute__((ext_vector_type(4)));
typedef GAS unsigned gu32;

constexpr int NB = 4, SEQ = 8192, T = NB * SEQ, D = 1024, AW = 512, SGW = 512, INW = 4608, NE = 32, FF = 1024;
constexpr int NHEAD = 8, HD = 64, CHUNK = 64, NBACK = 8, NREL = 513;
constexpr int LCAP = 32768;
constexpr float LOG2E = 1.4426950408889634f;
constexpr float EPS = 1e-6f;

constexpr size_t MiB = 1u << 20;
constexpr size_t WS_CTL = 0, CTL_ZERO_BYTES = 1 * MiB;
constexpr size_t WS_WIN = 7 * MiB;
constexpr size_t WS_WAB = 11 * MiB;
constexpr size_t WS_WO = 13 * MiB;
constexpr size_t WS_WR = 15 * MiB;
constexpr size_t WS_WM = 15 * MiB + 256 * 1024;
constexpr size_t WS_WIN8 = 2 * MiB;
constexpr size_t WS_HS = 15 * MiB + 512 * 1024;
constexpr size_t WS_CS2 = 15 * MiB + 832 * 1024;
constexpr size_t WS_MS = 15 * MiB + 896 * 1024;
constexpr size_t WS_CS = 15 * MiB + 768 * 1024;
constexpr size_t WS_H8 = 976 * MiB;
constexpr size_t WS_LID = 16 * MiB;
constexpr size_t WS_LRS = 20 * MiB;
constexpr size_t WS_LP = 24 * MiB;
constexpr size_t WS_WGU = 28 * MiB;
constexpr size_t WS_WD = 156 * MiB;
constexpr size_t WS_H = 220 * MiB;
constexpr size_t WS_Q = 284 * MiB, WS_K = 316 * MiB, WS_V = 348 * MiB;
constexpr size_t WS_UG = 380 * MiB, WS_VG = 412 * MiB;
constexpr size_t WS_GA = 444 * MiB, WS_GB = 508 * MiB;
constexpr size_t WS_YCAT = 572 * MiB;
constexpr size_t WS_X1B = 636 * MiB;
constexpr size_t WS_ACT = 700 * MiB;
constexpr size_t WS_X1H = 380 * MiB;
constexpr size_t WS_Y = 220 * MiB;
constexpr size_t WS_END = 1008 * MiB;
constexpr int CW_TMO = 0, CW_CODE = 1;
constexpr int CW_CNT = 64;
constexpr int CW_BAR = 4096;
constexpr int CW_CMAX = 8192;
constexpr int CW_CMAX2 = 13312;
constexpr int CW_CCNT2 = 16384 + 128;
constexpr int CW_RMAX = 65536;
constexpr int CW_RCNT = 98304;
constexpr int CW_CCNT = 16384;

constexpr int RING_BYTES = 131072;
constexpr int LDSCTL_OFF = RING_BYTES, MISC_OFF = LDSCTL_OFF + 320;
constexpr int MOE_OFF = MISC_OFF + 128;
constexpr int PARK_OFF = LDSCTL_OFF + 1024;
constexpr int ROWS_OFF = LDSCTL_OFF + 9216, ROWS_BUF = 3072;
constexpr int LDS_BYTES = 147456;

#define LDS_WAIT() asm volatile("s_waitcnt lgkmcnt(0)" ::: "memory")
#define VM_WAIT() asm volatile("s_waitcnt vmcnt(0)" ::: "memory")
#define RLX_AGENT __ATOMIC_RELAXED, __HIP_MEMORY_SCOPE_AGENT

__device__ __forceinline__ unsigned f2bf(float f) { unsigned u = __builtin_bit_cast(unsigned, f); return (u + 0x7fffu + ((u >> 16) & 1u)) >> 16; }
__device__ __forceinline__ unsigned pk2(float lo, float hi) { return f2bf(lo) | (f2bf(hi) << 16); }
__device__ __forceinline__ float bf2f(unsigned short b) { return __builtin_bit_cast(float, (unsigned)b << 16); }
__device__ __forceinline__ float bflo(unsigned w) { return __builtin_bit_cast(float, w << 16); }
__device__ __forceinline__ float bfhi(unsigned w) { return __builtin_bit_cast(float, w & 0xffff0000u); }
__device__ __forceinline__ unsigned cvt_pk_bf16(float lo, float hi) { unsigned r; asm volatile("v_cvt_pk_bf16_f32 %0, %1, %2" : "=v"(r) : "v"(lo), "v"(hi)); return r; }
__device__ __forceinline__ float fast_rcp(float x) { return __builtin_amdgcn_rcpf(x); }
__device__ __forceinline__ float fast_exp2(float x) { return __builtin_amdgcn_exp2f(x); }
__device__ __forceinline__ float sigmoidf_(float x) { return fast_rcp(1.0f + fast_exp2(-LOG2E * x)); }
__device__ __forceinline__ float gelu_tanh(float x) {
    const float t = x * ((-LOG2E * 1.5957691216057308f) + (-LOG2E * 1.5957691216057308f * 0.044715f) * (x * x));
    return x * fast_rcp(1.0f + fast_exp2(t));
}

namespace pg8 {
constexpr int BM = 256, BK = 64, HALF = 128, HTB = HALF * BK * 2, STAGE_BYTES = 8 * HTB, NXCD = 8, WGM = 8;
__host__ __device__ __forceinline__ int lds_byte(int r, int c) { const int st = (r >> 4) * 2 + (c >> 5), rr = r & 15, cc = c & 31, ob = rr * 64 + cc * 2; return st * 1024 + (ob ^ (((ob >> 9) & 1) << 5)); }
__host__ __device__ __forceinline__ void stage_rc(int b, int& R, int& C) { const int st = b / 1024, sb = b % 1024, swz = sb ^ (((sb >> 9) & 1) << 5); R = (st >> 1) * 16 + swz / 64; C = (st & 1) * 32 + (swz % 64) / 2; }
__host__ __device__ __forceinline__ int perm32(int rho) { const int n = rho >> 4, i = rho & 15; return 8 * (i >> 2) + 4 * n + (i & 3); }

typedef int v4i_t __attribute__((ext_vector_type(4)));
typedef int v8i_t __attribute__((ext_vector_type(8)));
__device__ __forceinline__ v8i_t cat8(bf16x8 lo, bf16x8 hi) { return __builtin_shufflevector(__builtin_bit_cast(v4i_t, lo), __builtin_bit_cast(v4i_t, hi), 0, 1, 2, 3, 4, 5, 6, 7); }
struct Unit { int pm, pn, e, s0, cnt, idx; };

struct StaticOrder {
    int nM, nN, nwg, G, c;
    __device__ void init(int M, int N, int G_, int c_) { nM = M / BM; nN = N / BM; nwg = nM * nN; G = G_; c = c_; }
    __device__ bool tile(int i, int& pm, int& pn) const {
        const long L = (long)i * G + c; if (L >= nwg) return false;
        int wgid = (int)L; { const int q = nwg / NXCD, r = nwg % NXCD, xcd = wgid % NXCD, off = wgid / NXCD; wgid = (xcd < r ? xcd * (q + 1) : r * (q + 1) + (xcd - r) * q) + off; }
        const int nig = WGM * nN, gid = wgid / nig, fm = gid * WGM, gsz = (nM - fm) < WGM ? (nM - fm) : WGM;
        pm = fm + ((wgid % nig) % gsz); pn = (wgid % nig) / gsz; return true;
    }
};

template <class P>
__device__ __forceinline__ void gemm_phase(LAS unsigned char* lds, const P& S) {
    const int tid = threadIdx.x, wid = __builtin_amdgcn_readfirstlane(tid >> 6), lane = tid & 63, wr = wid >> 2, wc = wid & 3, fr = lane & 15, fq = lane >> 4;
    constexpr int nt = P::NT;
    unsigned vA[2][2], voffB[2];
    LAS u32x4* park = (LAS u32x4*)(lds + PARK_OFF) + tid;
#pragma unroll
    for (int i = 0; i < 2; ++i) { int R, C; stage_rc(tid * 16 + i * 8192, R, C); const int Rb = (R & ~31) + perm32(R & 31);
        vA[0][i] = (unsigned)(R * P::LDA + C) * 2u; vA[1][i] = (unsigned)((R + HALF) * P::LDA + C) * 2u; voffB[i] = (unsigned)(Rb * P::LDB + C) * 2u; }
    const size_t kstep = (size_t)(BK * 2);
    const size_t hstepB = (size_t)HALF * P::LDB * 2;
    const unsigned ldsw = (unsigned)wid * 1024u;
    const int aoff = lds_byte(wr * 64 + fr, fq * 8), boff = lds_byte(wc * 32 + fr, fq * 8);
#define PG8_SA(b, h) (((b) * 2 + (h)) * HTB)
#define PG8_SB(b, h) ((4 + (b) * 2 + (h)) * HTB)
#define PG8_STAGE2(bufoff, gbase, o0, o1) do { \
        __builtin_amdgcn_global_load_lds((const unsigned*)((const char*)(gbase) + (o0)), (LAS unsigned*)(lds + (bufoff) + ldsw), 16, 0, 0); \
        __builtin_amdgcn_global_load_lds((const unsigned*)((const char*)(gbase) + (o1)), (LAS unsigned*)(lds + (bufoff) + ldsw + 8192), 16, 0, 0); } while (0)
#define PG8_STAGEB(bufoff, gbase) PG8_STAGE2(bufoff, gbase, voffB[0], voffB[1])
#define PG8_LDA(dst, b, h) do { _Pragma("unroll") for (int m = 0; m < 4; ++m) _Pragma("unroll") for (int k = 0; k < 2; ++k) dst[m][k] = *(const LAS bf16x8*)(lds + PG8_SA(b, h) + aoff + m * 2048 + k * 1024); } while (0)
#define PG8_LDB(dst, b, h) do { _Pragma("unroll") for (int n = 0; n < 2; ++n) _Pragma("unroll") for (int k = 0; k < 2; ++k) dst[n][k] = *(const LAS bf16x8*)(lds + PG8_SB(b, h) + boff + n * 2048 + k * 1024); } while (0)
#define PG8_MMA(ai, bj, At, Bt) do { __builtin_amdgcn_s_setprio(1); _Pragma("unroll") for (int m = 0; m < 4; ++m) _Pragma("unroll") for (int n = 0; n < 2; ++n) { \
        if constexpr (P::I8) { _Pragma("unroll") for (int k = 0; k < 2; ++k) acc[ai][bj][m][n] = __builtin_bit_cast(f32x4, __builtin_amdgcn_mfma_i32_16x16x64_i8(__builtin_bit_cast(v4i_t, Bt[n][k]), __builtin_bit_cast(v4i_t, At[m][k]), __builtin_bit_cast(v4i_t, acc[ai][bj][m][n]), 0, 0, 0)); }     \
        else if constexpr (P::FP8) { acc[ai][bj][m][n] = __builtin_amdgcn_mfma_scale_f32_16x16x128_f8f6f4(cat8(Bt[n][0], Bt[n][1]), cat8(At[m][0], At[m][1]), acc[ai][bj][m][n], 0, 0, 0, 0, 0, 0); }     \
        else { _Pragma("unroll") for (int k = 0; k < 2; ++k) acc[ai][bj][m][n] = __builtin_amdgcn_mfma_f32_16x16x32_bf16(Bt[n][k], At[m][k], acc[ai][bj][m][n], 0, 0, 0); } } \
        __builtin_amdgcn_s_setprio(0); } while (0)
#define PG8_WAIT_V(n) asm volatile("s_waitcnt vmcnt(" #n ")" ::: "memory")
#define PG8_WAIT_L(n) asm volatile("s_waitcnt lgkmcnt(" #n ")" ::: "memory")
#define PG8_BAR __builtin_amdgcn_s_barrier()
#define PG8_SCHED __builtin_amdgcn_sched_barrier(0)
    Unit cur, nxt; int ui = 0;
    if (!S.next(0, cur)) return;
    if constexpr (P::GATHER) S.a_off(cur, tid, vA);
    f32x4 acc[2][2][4][2];
#pragma unroll
    for (int a = 0; a < 2; ++a)
#pragma unroll
        for (int b = 0; b < 2; ++b)
#pragma unroll
            for (int m = 0; m < 4; ++m)
#pragma unroll
                for (int n = 0; n < 2; ++n) acc[a][b][m][n] = (f32x4){0.f, 0.f, 0.f, 0.f};
    bf16x8 At[4][2], B0[2][2], B1[2][2];
    const char* cA = S.a_ptr(cur); const char* cB = S.b_ptr(cur);
    PG8_STAGEB(PG8_SB(0, 0), cB); PG8_STAGEB(PG8_SB(0, 1), cB + hstepB); PG8_STAGE2(PG8_SA(0, 0), cA, vA[0][0], vA[0][1]); PG8_STAGE2(PG8_SA(0, 1), cA, vA[1][0], vA[1][1]);
    if (wr == 1) PG8_BAR;
    PG8_WAIT_V(2); PG8_BAR;
    PG8_STAGEB(PG8_SB(1, 0), cB + kstep); PG8_STAGE2(PG8_SA(1, 0), cA + kstep, vA[0][0], vA[0][1]); PG8_STAGEB(PG8_SB(1, 1), cB + hstepB + kstep);
    PG8_WAIT_V(6); PG8_BAR;
    for (;;) {
        const bool has_next = S.next(ui + 1, nxt);
        if constexpr (P::ROWDMA) S.row_dma(cur, lds, wid, lane);
        const char* nA = has_next ? S.a_ptr(nxt) : cA; const char* nB = has_next ? S.b_ptr(nxt) : cB;
        if constexpr (P::IDDMA) { if (has_next) S.ids_dma(nxt, cur, lds, wid, lane); }
        else if constexpr (P::GATHER) {
            unsigned vn[2][2];
            if (has_next) S.a_off(nxt, tid, vn);
            else { vn[0][0] = vA[0][0]; vn[0][1] = vA[0][1]; vn[1][0] = vA[1][0]; vn[1][1] = vA[1][1]; }
            *park = (u32x4){vn[0][0], vn[0][1], vn[1][0], vn[1][1]};
        }
#pragma nounroll
        for (int t = 0; t < nt; t += 2) {
            const bool last = (t == nt - 2);
            asm volatile("" : "+v"(vA[0][0]), "+v"(vA[0][1]), "+v"(vA[1][0]), "+v"(vA[1][1]), "+v"(voffB[0]), "+v"(voffB[1]));
            const char* a1 = cA + (size_t)(t + 1) * kstep;
            const char* a2 = last ? nA : cA + (size_t)(t + 2) * kstep; const char* b2 = last ? nB : cB + (size_t)(t + 2) * kstep;
            const char* a3 = a2 + kstep; const char* b3 = b2 + kstep;
            PG8_LDB(B0, 0, 0); PG8_LDB(B1, 0, 1); PG8_SCHED; PG8_LDA(At, 0, 0); PG8_STAGE2(PG8_SA(1, 1), a1, vA[1][0], vA[1][1]);
            if constexpr (P::IDDMA) { if (last && has_next) S.a_off_lds(nxt, cur, tid, lds, vA); }
            else if constexpr (P::GATHER) { if (last) { const u32x4 nv = *park; vA[0][0] = nv.x; vA[0][1] = nv.y; vA[1][0] = nv.z; vA[1][1] = nv.w; } }
            PG8_WAIT_V(8); PG8_WAIT_L(0); PG8_BAR; PG8_MMA(0, 0, At, B0); PG8_MMA(0, 1, At, B1); PG8_BAR; PG8_SCHED;
            PG8_LDA(At, 0, 1); PG8_STAGEB(PG8_SB(0, 0), b2); PG8_STAGEB(PG8_SB(0, 1), b2 + hstepB); PG8_STAGE2(PG8_SA(0, 0), a2, vA[0][0], vA[0][1]);
            PG8_WAIT_V(8); PG8_WAIT_L(0); PG8_BAR; PG8_MMA(1, 0, At, B0); PG8_MMA(1, 1, At, B1); PG8_BAR; PG8_SCHED;
            PG8_LDB(B0, 1, 0); PG8_LDB(B1, 1, 1); PG8_SCHED; PG8_LDA(At, 1, 0); PG8_STAGE2(PG8_SA(0, 1), a2, vA[1][0], vA[1][1]);
            PG8_WAIT_V(8); PG8_WAIT_L(0); PG8_BAR; PG8_MMA(0, 0, At, B0); PG8_MMA(0, 1, At, B1); PG8_BAR; PG8_SCHED;
            PG8_LDA(At, 1, 1); PG8_STAGEB(PG8_SB(1, 0), b3); PG8_STAGEB(PG8_SB(1, 1), b3 + hstepB); PG8_STAGE2(PG8_SA(1, 0), a3, vA[0][0], vA[0][1]);
            PG8_WAIT_V(8); PG8_WAIT_L(0); PG8_BAR; PG8_MMA(1, 0, At, B0); PG8_MMA(1, 1, At, B1); PG8_BAR; PG8_SCHED;
        }
        if (wr == 0) PG8_BAR;
        int fr_ = fr, fq_ = fq; asm volatile("" : "+v"(fr_), "+v"(fq_));
        const bool keep = S.epi(acc, cur, wr, wc, fr_, fq_);
        if (!has_next) break;
        if (!keep) {
#pragma unroll
            for (int a = 0; a < 2; ++a)
#pragma unroll
                for (int b = 0; b < 2; ++b)
#pragma unroll
                    for (int m = 0; m < 4; ++m)
#pragma unroll
                        for (int n = 0; n < 2; ++n) acc[a][b][m][n] = (f32x4){0.f, 0.f, 0.f, 0.f};
        }
        cur = nxt; cA = nA; cB = nB; ++ui;
        if (wr == 1) PG8_BAR;
    }
    PG8_WAIT_V(0);
    PG8_BAR;
#undef PG8_SA
#undef PG8_SB
#undef PG8_STAGE2
#undef PG8_STAGEB
#undef PG8_LDA
#undef PG8_LDB
#undef PG8_MMA
#undef PG8_WAIT_V
#undef PG8_WAIT_L
#undef PG8_BAR
#undef PG8_SCHED
}
}
using pg8::Unit;

__device__ __forceinline__ void st8(bf16* p, const f32x4& a, const f32x4& b) {
    u32x4 w; w.x = cvt_pk_bf16(a[0], a[1]); w.y = cvt_pk_bf16(a[2], a[3]); w.z = cvt_pk_bf16(b[0], b[1]); w.w = cvt_pk_bf16(b[2], b[3]);
    *(u32x4*)p = w;
}
__device__ __forceinline__ void ld8(const bf16* p, f32x4& a, f32x4& b) {
    const u32x4 w = *(const u32x4*)p;
    a = (f32x4){bflo(w.x), bfhi(w.x), bflo(w.y), bfhi(w.y)}; b = (f32x4){bflo(w.z), bfhi(w.z), bflo(w.w), bfhi(w.w)};
}

__device__ __forceinline__ void st8q(unsigned char* p, const f32x4& a, const f32x4& b) {
    int w0 = 0, w1 = 0;
    w0 = __builtin_amdgcn_cvt_pk_fp8_f32(a[0], a[1], w0, false); w0 = __builtin_amdgcn_cvt_pk_fp8_f32(a[2], a[3], w0, true);
    w1 = __builtin_amdgcn_cvt_pk_fp8_f32(b[0], b[1], w1, false); w1 = __builtin_amdgcn_cvt_pk_fp8_f32(b[2], b[3], w1, true);
    *(u32x2*)p = (u32x2){(unsigned)w0, (unsigned)w1};
}
__device__ __forceinline__ unsigned pack_i8(const f32x4& v) {
    const int a = (int)__builtin_rintf(v.x), b = (int)__builtin_rintf(v.y), c = (int)__builtin_rintf(v.z), d = (int)__builtin_rintf(v.w);
    return ((unsigned)a & 255u) | (((unsigned)b & 255u) << 8) | (((unsigned)c & 255u) << 16) | ((unsigned)d << 24);
}
__device__ __forceinline__ u32x2 pack8q(const f32x4& a, const f32x4& b) {
    int w0 = 0, w1 = 0;
    w0 = __builtin_amdgcn_cvt_pk_fp8_f32(a[0], a[1], w0, false); w0 = __builtin_amdgcn_cvt_pk_fp8_f32(a[2], a[3], w0, true);
    w1 = __builtin_amdgcn_cvt_pk_fp8_f32(b[0], b[1], w1, false); w1 = __builtin_amdgcn_cvt_pk_fp8_f32(b[2], b[3], w1, true);
    return (u32x2){(unsigned)w0, (unsigned)w1};
}
__device__ __forceinline__ u32x4 pair16(const u32x2& e0, const u32x2& e1, bool oddq) {
    const u32x2 snd = oddq ? e0 : e1;
    u32x2 rcv; rcv.x = (unsigned)__shfl_xor((int)snd.x, 16); rcv.y = (unsigned)__shfl_xor((int)snd.y, 16);
    return oddq ? (u32x4){rcv.x, rcv.y, e1.x, e1.y} : (u32x4){e0.x, e0.y, rcv.x, rcv.y};
}
constexpr float WQ_SCALE = 32.0f, WQ_INV = 1.0f / 32.0f;

struct PolIn {
    static constexpr int NT = 8, LDA = 512, LDB = 512; static constexpr bool GATHER = false, FP8 = false, I8 = true, ROWDMA = true, IDDMA = false;
    pg8::StaticOrder so; const unsigned char* A; const unsigned char* Bt; unsigned char* ws; const float* qg; const float* kg; const float* hs; const float* cs; LAS unsigned char* shm;
    __device__ bool next(int i, Unit& u) const { u.e = 0; u.s0 = 0; u.cnt = 0; u.idx = i; return so.tile(i, u.pm, u.pn); }
    __device__ __forceinline__ void row_dma(const Unit& u, LAS unsigned char* lds, int wid, int lane) const {
        const unsigned* src = (wid < 4) ? (const unsigned*)(hs + u.pm * 256 + 64 * wid + lane) : (const unsigned*)(cs + u.pn * 256 + 64 * (wid & 3) + lane);
        __builtin_amdgcn_global_load_lds(src, (LAS unsigned*)(lds + ROWS_OFF + (u.idx & 1) * ROWS_BUF + 256 * wid), 4, 0, 0);
    }
    __device__ const char* a_ptr(const Unit& u) const { return (const char*)(A + (size_t)u.pm * 256 * 1024); }
    __device__ const char* b_ptr(const Unit& u) const { return (const char*)(Bt + (size_t)u.pn * 256 * 1024); }
    __device__ void a_off(const Unit&, int, unsigned (&)[2][2]) const {}
    __device__ __forceinline__ bool epi(f32x4 (&acc)[2][2][4][2], const Unit& u, int wr, int wc, int fr, int fq) const {
        const int pn = u.pn;
        {
            const LAS float* hsr = (const LAS float*)(shm + ROWS_OFF + (u.idx & 1) * ROWS_BUF) + wr * 64 + fr;
            const LAS float* csp = (const LAS float*)(shm + ROWS_OFF + (u.idx & 1) * ROWS_BUF + 1024) + 64 * wc + 8 * fq;
            float hv[2][4]; f32x4 cv[2][2];
#pragma unroll
            for (int a = 0; a < 2; ++a)
#pragma unroll
                for (int m = 0; m < 4; ++m) hv[a][m] = hsr[a * 128 + m * 16];
#pragma unroll
            for (int b = 0; b < 2; ++b)
#pragma unroll
                for (int n = 0; n < 2; ++n) cv[b][n] = *(const LAS f32x4*)(csp + 32 * b + 4 * n);
#pragma unroll
            for (int a = 0; a < 2; ++a)
#pragma unroll
                for (int b = 0; b < 2; ++b)
#pragma unroll
                    for (int m = 0; m < 4; ++m)
#pragma unroll
                        for (int n = 0; n < 2; ++n) { const pg8::v4i_t ia = __builtin_bit_cast(pg8::v4i_t, acc[a][b][m][n]);
                            acc[a][b][m][n] = (f32x4){(float)ia.x, (float)ia.y, (float)ia.z, (float)ia.w} * hv[a][m] * cv[b][n]; }
        }
        int kind, ld, tcol; size_t off;
        if (pn < 2) { kind = 0; off = WS_Q; ld = AW; tcol = pn; }
        else if (pn < 4) { kind = 1; off = WS_K; ld = AW; tcol = pn - 2; }
        else if (pn < 6) { kind = 2; off = WS_V; ld = AW; tcol = pn - 4; }
        else if (pn < 8) { kind = 3; off = WS_UG; ld = SGW; tcol = pn - 6; }
        else if (pn < 10) { kind = 3; off = WS_VG; ld = SGW; tcol = pn - 8; }
        else if (pn < 14) { kind = 4; off = WS_GA; ld = D; tcol = pn - 10; }
        else { kind = 4; off = WS_GB; ld = D; tcol = pn - 14; }
        bf16* base = (bf16*)(ws + off) + tcol * 256 + 64 * wc + 8 * fq;
        const int row0 = u.pm * 256 + wr * 64 + fr;
        if (kind <= 1) {
            const float* g = (kind == 0 ? qg : kg) + 8 * fq;
            const float sc = (kind == 0) ? (0.125f * LOG2E) : 1.0f;
            f32x4 gv[2][2];
#pragma unroll
            for (int bj = 0; bj < 2; ++bj)
#pragma unroll
                for (int n = 0; n < 2; ++n) gv[bj][n] = *(const f32x4*)(g + 32 * bj + 4 * n) * sc;
#pragma unroll
            for (int ai = 0; ai < 2; ++ai)
#pragma unroll
                for (int m = 0; m < 4; ++m) {
                    float ss = 0.f;
#pragma unroll
                    for (int bj = 0; bj < 2; ++bj)
#pragma unroll
                        for (int n = 0; n < 2; ++n) { const f32x4 v = acc[ai][bj][m][n]; ss += (v[0] * v[0] + v[1] * v[1]) + (v[2] * v[2] + v[3] * v[3]); }
                    ss += __shfl_xor(ss, 16); ss += __shfl_xor(ss, 32);
                    const float rs = 1.0f / sqrtf(ss * (1.0f / 64.0f) + EPS);
                    bf16* rowp = base + (size_t)(row0 + ai * 128 + m * 16) * ld;
#pragma unroll
                    for (int bj = 0; bj < 2; ++bj) st8(rowp + 32 * bj, acc[ai][bj][m][0] * rs * gv[bj][0], acc[ai][bj][m][1] * rs * gv[bj][1]);
                }
        } else if (kind == 2) {
#pragma unroll
            for (int ai = 0; ai < 2; ++ai)
#pragma unroll
                for (int m = 0; m < 4; ++m) { bf16* rowp = base + (size_t)(row0 + ai * 128 + m * 16) * ld;
#pragma unroll
                    for (int bj = 0; bj < 2; ++bj) st8(rowp + 32 * bj, acc[ai][bj][m][0], acc[ai][bj][m][1]); }
        } else if (kind == 4) {
            unsigned char* b8 = ws + off + tcol * 256 + 64 * wc + 8 * fq;
#pragma unroll
            for (int ai = 0; ai < 2; ++ai)
#pragma unroll
                for (int mp = 0; mp < 2; ++mp) { const bool oddq = (fq & 1) != 0;
                    unsigned char* rowp = b8 + (size_t)(row0 + ai * 128 + (2 * mp + (oddq ? 1 : 0)) * 16) * ld - (oddq ? 8 : 0);
#pragma unroll
                    for (int bj = 0; bj < 2; ++bj) *(u32x4*)(rowp + 32 * bj) = pair16(pack8q(acc[ai][bj][2 * mp][0], acc[ai][bj][2 * mp][1]), pack8q(acc[ai][bj][2 * mp + 1][0], acc[ai][bj][2 * mp + 1][1]), oddq); }
        } else {
#pragma unroll
            for (int ai = 0; ai < 2; ++ai)
#pragma unroll
                for (int m = 0; m < 4; ++m) { bf16* rowp = base + (size_t)(row0 + ai * 128 + m * 16) * ld;
#pragma unroll
                    for (int bj = 0; bj < 2; ++bj) { f32x4 a = acc[ai][bj][m][0], b = acc[ai][bj][m][1];
#pragma unroll
                        for (int j = 0; j < 4; ++j) { a[j] = gelu_tanh(a[j]); b[j] = gelu_tanh(b[j]); }
                        st8(rowp + 32 * bj, a, b); } }
        }
        return false;
    }
};

struct PolMerge {
    static constexpr int NT = 8, LDA = D, LDB = D; static constexpr bool GATHER = false, FP8 = false, I8 = false, ROWDMA = false, IDDMA = false;
    pg8::StaticOrder so; const bf16* A; const bf16* Bt; const unsigned char* ga; const unsigned char* gb; unsigned char* out;
    unsigned* rmax; unsigned* rcnt; float* ms; unsigned* tmo; LAS unsigned char* shm;
    __device__ bool next(int i, Unit& u) const { u.e = i & 1; u.s0 = 0; u.cnt = 0; return so.tile(i >> 1, u.pm, u.pn); }
    __device__ const char* a_ptr(const Unit& u) const { return (const char*)(A + (size_t)u.pm * 256 * LDA + 512 * u.e); }
    __device__ const char* b_ptr(const Unit& u) const { return (const char*)(Bt + (size_t)u.pn * 256 * LDB + 512 * u.e); }
    __device__ void a_off(const Unit&, int, unsigned (&)[2][2]) const {}
    __device__ __forceinline__ void gates(const u32x2& w, f32x4& b0, f32x4& b1) const {
        const f32x2 p0 = __builtin_amdgcn_cvt_pk_f32_fp8((int)w.x, false), p1 = __builtin_amdgcn_cvt_pk_f32_fp8((int)w.x, true), p2 = __builtin_amdgcn_cvt_pk_f32_fp8((int)w.y, false), p3 = __builtin_amdgcn_cvt_pk_f32_fp8((int)w.y, true);
        b0 = (f32x4){p0[0], p0[1], p1[0], p1[1]}; b1 = (f32x4){p2[0], p2[1], p3[0], p3[1]};
    }
    __device__ __forceinline__ bool epi(f32x4 (&acc)[2][2][4][2], const Unit& u, int wr, int wc, int fr, int fq) const {
        const int row0 = u.pm * 256 + wr * 64 + fr, col0 = u.pn * 256 + 64 * wc + 8 * fq;
        const int tid = threadIdx.x;
        float rm[2][4];
#pragma unroll
        for (int ai = 0; ai < 2; ++ai) {
            u32x2 gbv[4][2]; u32x2 gav[4][2];
#pragma unroll
            for (int m = 0; m < 4; ++m) { const size_t o = (size_t)(row0 + ai * 128 + m * 16) * D + col0;
#pragma unroll
                for (int bj = 0; bj < 2; ++bj) { gbv[m][bj] = *(const u32x2*)(gb + o + 32 * bj); if (u.e == 0) gav[m][bj] = *(const u32x2*)(ga + o + 32 * bj); } }
#pragma unroll
            for (int m = 0; m < 4; ++m) { float mx = 0.f;
#pragma unroll
                for (int bj = 0; bj < 2; ++bj) {
                    f32x4 b0, b1; gates(gbv[m][bj], b0, b1);
                    if (u.e == 0) {
                        f32x4 a0, a1; gates(gav[m][bj], a0, a1);
#pragma unroll
                        for (int j = 0; j < 4; ++j) {
                            acc[ai][bj][m][0][j] *= (1.0f + fast_exp2(-LOG2E * b0[j])) * fast_rcp(1.0f + fast_exp2(-LOG2E * a0[j]));
                            acc[ai][bj][m][1][j] *= (1.0f + fast_exp2(-LOG2E * b1[j])) * fast_rcp(1.0f + fast_exp2(-LOG2E * a1[j])); }
                    } else {
#pragma unroll
                        for (int j = 0; j < 4; ++j) { acc[ai][bj][m][0][j] *= sigmoidf_(b0[j]); acc[ai][bj][m][1][j] *= sigmoidf_(b1[j]);
                            mx = fmaxf(mx, fmaxf(fabsf(acc[ai][bj][m][0][j]), fabsf(acc[ai][bj][m][1][j]))); }
                    }
                }
                rm[ai][m] = mx; }
        }
        if (u.e == 0) return true;
        LAS unsigned* lrm = (LAS unsigned*)(shm + ROWS_OFF);
#pragma unroll
        for (int ai = 0; ai < 2; ++ai)
#pragma unroll
            for (int m = 0; m < 4; ++m) { float mx = rm[ai][m]; mx = fmaxf(mx, __shfl_xor(mx, 16)); mx = fmaxf(mx, __shfl_xor(mx, 32));
                if (fq == 0) (void)__hip_atomic_fetch_max(lrm + (ai * 128 + wr * 64 + m * 16 + fr), __float_as_uint(mx), __ATOMIC_RELAXED, __HIP_MEMORY_SCOPE_WORKGROUP); }
        asm volatile("s_waitcnt lgkmcnt(0)\n\ts_barrier" ::: "memory");
        if (tid < 256) { const unsigned v = lrm[tid]; (void)__hip_atomic_fetch_max(rmax + u.pm * 256 + tid, v, RLX_AGENT); lrm[tid] = 0u; }
        asm volatile("s_waitcnt vmcnt(0) lgkmcnt(0)\n\ts_barrier" ::: "memory");
        if (tid == 0) { (void)__hip_atomic_fetch_add(rcnt + u.pm, 1u, RLX_AGENT);
            unsigned sp = 0; while (__hip_atomic_load(rcnt + u.pm, RLX_AGENT) < 4u) { __builtin_amdgcn_s_sleep(1);
                if ((++sp & 255u) == 0u) { if (__hip_atomic_load(tmo, RLX_AGENT)) break; if (sp > (1u << 18)) { atomicAdd(tmo, 1u); break; } } } }
        asm volatile("s_barrier" ::: "memory");
        float sc[2][4];
#pragma unroll
        for (int ai = 0; ai < 2; ++ai)
#pragma unroll
            for (int m = 0; m < 4; ++m) { const float cm = __uint_as_float(__hip_atomic_load(rmax + row0 + ai * 128 + m * 16, RLX_AGENT)); sc[ai][m] = cm > 0.f ? 127.0f / cm : 0.f; }
        if (u.pn == 0 && tid < 256) ms[u.pm * 256 + tid] = __uint_as_float(__hip_atomic_load(rmax + u.pm * 256 + tid, RLX_AGENT)) * (1.0f / 127.0f);
        const bool oddq = (fq & 1) != 0;
#pragma unroll
        for (int ai = 0; ai < 2; ++ai)
#pragma unroll
            for (int mp = 0; mp < 2; ++mp) {
                unsigned char* rowp = out + (size_t)(row0 + ai * 128 + (2 * mp + (oddq ? 1 : 0)) * 16) * D + col0 - (oddq ? 8 : 0);
#pragma unroll
                for (int bj = 0; bj < 2; ++bj) {
                    const u32x2 e0 = (u32x2){pack_i8(acc[ai][bj][2 * mp][0] * sc[ai][2 * mp]), pack_i8(acc[ai][bj][2 * mp][1] * sc[ai][2 * mp])};
                    const u32x2 e1 = (u32x2){pack_i8(acc[ai][bj][2 * mp + 1][0] * sc[ai][2 * mp + 1]), pack_i8(acc[ai][bj][2 * mp + 1][1] * sc[ai][2 * mp + 1])};
                    *(u32x4*)(rowp + 32 * bj) = pair16(e0, e1, oddq); } }
        return false;
    }
};

struct PolOut {
    static constexpr int NT = 8, LDA = 512, LDB = 512; static constexpr bool GATHER = false, FP8 = false, I8 = true, ROWDMA = true, IDDMA = false;
    pg8::StaticOrder so; const unsigned char* A; const unsigned char* Bt; const float* x; bf16* x1; unsigned char* x1q; const float* ms; const float* cs; LAS unsigned char* shm;
    __device__ bool next(int i, Unit& u) const { u.e = 0; u.s0 = 0; u.cnt = 0; u.idx = i; return so.tile(i, u.pm, u.pn); }
    __device__ const char* a_ptr(const Unit& u) const { return (const char*)(A + (size_t)u.pm * 256 * 1024); }
    __device__ const char* b_ptr(const Unit& u) const { return (const char*)(Bt + (size_t)u.pn * 256 * 1024); }
    __device__ void a_off(const Unit&, int, unsigned (&)[2][2]) const {}
    __device__ __forceinline__ void row_dma(const Unit& u, LAS unsigned char* lds, int wid, int lane) const {
        const unsigned* src = (wid < 4) ? (const unsigned*)(ms + u.pm * 256 + 64 * wid + lane) : (const unsigned*)(cs + u.pn * 256 + 64 * (wid & 3) + lane);
        __builtin_amdgcn_global_load_lds(src, (LAS unsigned*)(lds + ROWS_OFF + (u.idx & 1) * ROWS_BUF + 256 * wid), 4, 0, 0);
    }
    __device__ __forceinline__ bool epi(f32x4 (&acc)[2][2][4][2], const Unit& u, int wr, int wc, int fr, int fq) const {
        const int row0 = u.pm * 256 + wr * 64 + fr, col0 = u.pn * 256 + 64 * wc + 8 * fq;
        const LAS float* hsr = (const LAS float*)(shm + ROWS_OFF + (u.idx & 1) * ROWS_BUF) + wr * 64 + fr;
        const LAS float* csp = (const LAS float*)(shm + ROWS_OFF + (u.idx & 1) * ROWS_BUF + 1024) + 64 * wc + 8 * fq;
        f32x4 cv[2][2];
#pragma unroll
        for (int b = 0; b < 2; ++b)
#pragma unroll
            for (int n = 0; n < 2; ++n) cv[b][n] = *(const LAS f32x4*)(csp + 32 * b + 4 * n);
        const bool oddq = (fq & 1) != 0;
#pragma unroll
        for (int ai = 0; ai < 2; ++ai)
#pragma unroll
            for (int mp = 0; mp < 2; ++mp) {
                f32x4 xv[2][2][2]; u32x2 xqp[2][2];
#pragma unroll
                for (int mm = 0; mm < 2; ++mm) { const size_t o = (size_t)(row0 + ai * 128 + (2 * mp + mm) * 16) * D + col0;
#pragma unroll
                    for (int bj = 0; bj < 2; ++bj) { xv[mm][bj][0] = *(const f32x4*)(x + o + 32 * bj); xv[mm][bj][1] = *(const f32x4*)(x + o + 32 * bj + 4); } }
#pragma unroll
                for (int mm = 0; mm < 2; ++mm) { const int m = 2 * mp + mm; const size_t o = (size_t)(row0 + ai * 128 + m * 16) * D + col0; const float hv = hsr[ai * 128 + m * 16];
#pragma unroll
                    for (int bj = 0; bj < 2; ++bj) {
                        const pg8::v4i_t i0_ = __builtin_bit_cast(pg8::v4i_t, acc[ai][bj][m][0]), i1_ = __builtin_bit_cast(pg8::v4i_t, acc[ai][bj][m][1]);
                        const f32x4 r0 = xv[mm][bj][0] + (f32x4){(float)i0_.x, (float)i0_.y, (float)i0_.z, (float)i0_.w} * hv * cv[bj][0];
                        const f32x4 r1 = xv[mm][bj][1] + (f32x4){(float)i1_.x, (float)i1_.y, (float)i1_.z, (float)i1_.w} * hv * cv[bj][1];
                        st8(x1 + o + 32 * bj, r0, r1); xqp[mm][bj] = pack8q(r0, r1);
                        if (mm) *(u32x4*)(x1q + o - (oddq ? 0 : 16 * D) - (oddq ? 8 : 0) + 32 * bj) = pair16(xqp[0][bj], xqp[1][bj], oddq);
                    } } }
        return false;
    }
};

struct MoeOrder {
    const LAS int* tb;
    int NN, nwg, G, c;
    __device__ void init(const LAS int* tb_, int NN_, int G_, int c_) { tb = tb_; NN = NN_; G = G_; c = c_; nwg = tb_[32] * NN_; }
    __device__ bool unit(int i, Unit& u) const {
        const long L = (long)i * G + c; if (L >= nwg) return false;
        int wgid = (int)L; { const int q = nwg / 8, r = nwg % 8, xcd = wgid % 8, off = wgid / 8; wgid = (xcd < r ? xcd * (q + 1) : r * (q + 1) + (xcd - r) * q) + off; }
        const int Mt = wgid / NN;
        const int ln = threadIdx.x & 63;
        const unsigned long long bal = __ballot(ln < NE && tb[ln & 31] <= Mt);
        const int e = __popcll(bal) - 1;
        u.idx = i; u.pm = __builtin_amdgcn_readfirstlane(Mt); u.pn = __builtin_amdgcn_readfirstlane(wgid % NN); u.e = __builtin_amdgcn_readfirstlane(e);
        u.s0 = __builtin_amdgcn_readfirstlane((Mt - tb[e]) * 256); u.cnt = __builtin_amdgcn_readfirstlane(tb[33 + e]);
        return true;
    }
};

struct PolGU {
    static constexpr int NT = 8, LDA = 512, LDB = 512; static constexpr bool GATHER = true, FP8 = true, I8 = false, ROWDMA = true, IDDMA = true;
    MoeOrder mo; const unsigned char* A; const unsigned char* Bt; const int* lid; const float* lrs; const float* bgu; unsigned char* act; LAS unsigned char* shm;
    __device__ __forceinline__ void row_dma(const Unit& u, LAS unsigned char* lds, int wid, int lane) const {
        const unsigned* src = (wid < 4) ? (const unsigned*)(lrs + (size_t)u.e * LCAP + u.s0 + 64 * wid + lane)
                                        : (const unsigned*)(bgu + (size_t)u.e * 2048 + u.pn * 128 + 1024 * ((wid >> 1) & 1) + 64 * (wid & 1) + lane);
        __builtin_amdgcn_global_load_lds(src, (LAS unsigned*)(lds + ROWS_OFF + (u.idx & 1) * ROWS_BUF + 256 * wid), 4, 0, 0);
    }
    __device__ bool next(int i, Unit& u) const { return mo.unit(i, u); }
    __device__ __forceinline__ void ids_dma(const Unit& nx, const Unit& cu, LAS unsigned char* lds, int wid, int lane) const {
        if (wid < 4) __builtin_amdgcn_global_load_lds((const unsigned*)(lid + (size_t)nx.e * LCAP + nx.s0 + 64 * wid + lane), (LAS unsigned*)(lds + ROWS_OFF + (cu.idx & 1) * ROWS_BUF + 2048 + 256 * wid), 4, 0, 0);
    }
    __device__ __forceinline__ void a_off_lds(const Unit& nx, const Unit& cu, int tid, LAS unsigned char* lds, unsigned (&v)[2][2]) const {
        const LAS int* l = (const LAS int*)(lds + ROWS_OFF + (cu.idx & 1) * ROWS_BUF + 2048);
#pragma unroll
        for (int i = 0; i < 2; ++i) { int R, C; pg8::stage_rc(tid * 16 + i * 8192, R, C);
#pragma unroll
            for (int h = 0; h < 2; ++h) { const int s = h * 128 + R; const int id = l[s]; const int tok = (nx.s0 + s < nx.cnt) ? (id >> 2) : 0; v[h][i] = (unsigned)(tok * LDA + C) * 2u; } }
    }
    __device__ const char* a_ptr(const Unit&) const { return (const char*)A; }
    __device__ const char* b_ptr(const Unit& u) const { return (const char*)(Bt + ((size_t)u.e * 2048 + (size_t)u.pn * 256) * 1024); }
    __device__ __forceinline__ void a_off(const Unit& u, int tid, unsigned (&v)[2][2]) const {
        const int* l = lid + (size_t)u.e * LCAP;
#pragma unroll
        for (int i = 0; i < 2; ++i) { int R, C; pg8::stage_rc(tid * 16 + i * 8192, R, C);
#pragma unroll
            for (int h = 0; h < 2; ++h) { const int s = u.s0 + h * 128 + R; const int id = l[s]; const int tok = (s < u.cnt) ? (id >> 2) : 0; v[h][i] = (unsigned)(tok * LDA + C) * 2u; } }
    }
    __device__ __forceinline__ bool epi(f32x4 (&acc)[2][2][4][2], const Unit& u, int wr, int wc, int fr, int fq) const {
        const LAS float* rsl = (const LAS float*)(shm + ROWS_OFF + (u.idx & 1) * ROWS_BUF);
        const LAS float* bg = (const LAS float*)(shm + ROWS_OFF + (u.idx & 1) * ROWS_BUF + 1024) + 32 * wc + 8 * fq;
        const f32x4 bg0 = *(const LAS f32x4*)bg, bg1 = *(const LAS f32x4*)(bg + 4), bu0 = *(const LAS f32x4*)(bg + 128), bu1 = *(const LAS f32x4*)(bg + 132);
        unsigned char* ob = act + (size_t)u.pm * 256 * FF + u.pn * 128 + 32 * wc + 8 * fq;
        float rsv[2][4];
#pragma unroll
        for (int ai = 0; ai < 2; ++ai)
#pragma unroll
            for (int m = 0; m < 4; ++m) { const int r = ai * 128 + wr * 64 + m * 16 + fr; const bool valid = (u.s0 + r < u.cnt); const float t_ = rsl[r]; rsv[ai][m] = valid ? t_ * WQ_INV : 0.f; }
        const bool oddq = (fq & 1) != 0; u32x2 pkq[2];
#pragma unroll
        for (int ai = 0; ai < 2; ++ai)
#pragma unroll
            for (int m = 0; m < 4; ++m) { const int r = ai * 128 + wr * 64 + m * 16 + fr; const float rs = rsv[ai][m];
                f32x4 o[2];
#pragma unroll
                for (int n = 0; n < 2; ++n)
#pragma unroll
                    for (int h2 = 0; h2 < 2; ++h2) {
                        const f32x2 ag = {acc[ai][0][m][n][2 * h2], acc[ai][0][m][n][2 * h2 + 1]}, au = {acc[ai][1][m][n][2 * h2], acc[ai][1][m][n][2 * h2 + 1]};
                        const f32x2 bgv = n ? (f32x2){bg1[2 * h2], bg1[2 * h2 + 1]} : (f32x2){bg0[2 * h2], bg0[2 * h2 + 1]}, buv = n ? (f32x2){bu1[2 * h2], bu1[2 * h2 + 1]} : (f32x2){bu0[2 * h2], bu0[2 * h2 + 1]};
                        f32x2 g = ag * rs + bgv, up = au * rs + buv;
                        g = __builtin_elementwise_min(g, (f32x2){7.0f, 7.0f});
                        up.x = __builtin_amdgcn_fmed3f(up.x, -7.0f, 7.0f); up.y = __builtin_amdgcn_fmed3f(up.y, -7.0f, 7.0f);
                        const f32x2 t = g * (-1.702f * LOG2E);
                        f32x2 e; e.x = fast_exp2(t.x); e.y = fast_exp2(t.y);
                        const f32x2 den = e + 1.0f;
                        f32x2 rc; rc.x = fast_rcp(den.x); rc.y = fast_rcp(den.y);
                        const f32x2 res = (up + 1.0f) * (g * rc);
                        o[n][2 * h2] = res.x; o[n][2 * h2 + 1] = res.y; }
                pkq[m & 1] = pack8q(o[0], o[1]);
                if (m & 1) *(u32x4*)(ob + (size_t)(r - (oddq ? 0 : 16)) * FF - (oddq ? 8 : 0)) = pair16(pkq[0], pkq[1], oddq); }
        return false;
    }
};

struct PolDown {
    static constexpr int NT = 8, LDA = 512, LDB = 512; static constexpr bool GATHER = true, FP8 = true, I8 = false, ROWDMA = true, IDDMA = false;
    MoeOrder mo; const unsigned char* A; const unsigned char* Bt; const int* lid; const float* lp; const float* bd; unsigned char* y; LAS unsigned char* shm;
    __device__ __forceinline__ void row_dma(const Unit& u, LAS unsigned char* lds, int wid, int lane) const {
        const size_t o = (size_t)u.e * LCAP + u.s0 + 64 * (wid & 3) + lane;
        const unsigned* src = (wid < 4) ? (const unsigned*)(lid + o) : (const unsigned*)(lp + o);
        __builtin_amdgcn_global_load_lds(src, (LAS unsigned*)(lds + ROWS_OFF + (u.idx & 1) * ROWS_BUF + 256 * wid), 4, 0, 0);
        if (wid < 4) __builtin_amdgcn_global_load_lds((const unsigned*)(bd + (size_t)u.e * D + u.pn * 256 + 64 * wid + lane), (LAS unsigned*)(lds + ROWS_OFF + (u.idx & 1) * ROWS_BUF + 2048 + 256 * wid), 4, 0, 0);
    }
    __device__ bool next(int i, Unit& u) const { return mo.unit(i, u); }
    __device__ const char* a_ptr(const Unit& u) const { return (const char*)(A + (size_t)u.pm * 256 * 1024); }
    __device__ const char* b_ptr(const Unit& u) const { return (const char*)(Bt + ((size_t)u.e * 1024 + (size_t)u.pn * 256) * 1024); }
    __device__ __forceinline__ void a_off(const Unit&, int tid, unsigned (&v)[2][2]) const {
#pragma unroll
        for (int i = 0; i < 2; ++i) { int R, C; pg8::stage_rc(tid * 16 + i * 8192, R, C); v[0][i] = (unsigned)(R * LDA + C) * 2u; v[1][i] = (unsigned)((R + 128) * LDA + C) * 2u; }
    }
    __device__ __forceinline__ bool epi(f32x4 (&acc)[2][2][4][2], const Unit& u, int wr, int wc, int fr, int fq) const {
        const LAS int* idl = (const LAS int*)(shm + ROWS_OFF + (u.idx & 1) * ROWS_BUF); const LAS float* pl = (const LAS float*)(shm + ROWS_OFF + (u.idx & 1) * ROWS_BUF + 1024);
        const int col0 = u.pn * 256 + 64 * wc + 8 * fq;
        const LAS float* b = (const LAS float*)(shm + ROWS_OFF + (u.idx & 1) * ROWS_BUF + 2048) + 64 * wc + 8 * fq;
        int idv[2][4]; float pv_[2][4];
#pragma unroll
        for (int ai = 0; ai < 2; ++ai)
#pragma unroll
            for (int m = 0; m < 4; ++m) { const int r = ai * 128 + wr * 64 + m * 16 + fr; const bool valid = (u.s0 + r < u.cnt);
                const int t_ = idl[r]; const float q_ = pl[r]; idv[ai][m] = valid ? t_ : T * 4; pv_[ai][m] = q_; }
        f32x4 bv[2][2];
#pragma unroll
        for (int bj = 0; bj < 2; ++bj)
#pragma unroll
            for (int n = 0; n < 2; ++n) bv[bj][n] = *(const LAS f32x4*)(b + 32 * bj + 4 * n);
        const bool oddq = (fq & 1) != 0;
#pragma unroll
        for (int ai = 0; ai < 2; ++ai)
#pragma unroll
            for (int mp = 0; mp < 2; ++mp) {
                const float p0 = pv_[ai][2 * mp] * 16.0f, p1 = pv_[ai][2 * mp + 1] * 16.0f;
                unsigned char* op = y + (size_t)(oddq ? idv[ai][2 * mp + 1] : idv[ai][2 * mp]) * D + (col0 - (oddq ? 8 : 0));
#pragma unroll
                for (int bj = 0; bj < 2; ++bj) {
                    const u32x2 e0 = pack8q((acc[ai][bj][2 * mp][0] * WQ_INV + bv[bj][0]) * p0, (acc[ai][bj][2 * mp][1] * WQ_INV + bv[bj][1]) * p0);
                    const u32x2 e1 = pack8q((acc[ai][bj][2 * mp + 1][0] * WQ_INV + bv[bj][0]) * p1, (acc[ai][bj][2 * mp + 1][1] * WQ_INV + bv[bj][1]) * p1);
                    const u32x2 snd = oddq ? e0 : e1;
                    u32x2 rcv; rcv.x = (unsigned)__shfl_xor((int)snd.x, 16); rcv.y = (unsigned)__shfl_xor((int)snd.y, 16);
                    const u32x4 w = oddq ? (u32x4){rcv.x, rcv.y, e1.x, e1.y} : (u32x4){e0.x, e0.y, rcv.x, rcv.y};
                    *(u32x4*)(op + 32 * bj) = w; } }
        return false;
    }
};

constexpr int CONV_GU_ITEMS = NE * 16 * 32, CONV_D_ITEMS = NE * 16 * 16, CONV_ITEMS = CONV_GU_ITEMS + CONV_D_ITEMS, CONV_PER_WAVE = CONV_ITEMS / 2048;
static_assert(CONV_PER_WAVE * 2048 == CONV_ITEMS, "items divide over 2048 waves");
struct MoeConv {
    const float* wgu; const float* wd; const float* g2; unsigned char* WGU8; unsigned char* WD8;
    struct Regs { f32x4 v0, v1, v2, v3, v4, v5, v6, v7, v8, v9, v10, v11, v12, v13, v14, v15; };
    __device__ __forceinline__ void src_of(int item, const float*& W, int& N, int& k0, int& n0) const {
        if (item < CONV_GU_ITEMS) { const int e = item >> 9, q = item & 511; W = wgu + (size_t)e * D * 2048; N = 2048; k0 = 64 * (q >> 5); n0 = 64 * (q & 31); }
        else { const int r = item - CONV_GU_ITEMS, e = r >> 8, q = r & 255; W = wd + (size_t)e * FF * D; N = D; k0 = 64 * (q >> 4); n0 = 64 * (q & 15); }
    }
    __device__ __forceinline__ void finish(Regs& R, int item, int lane) const {
        const float* W; int N, k0, n0; src_of(item, W, N, k0, n0);
        const int kc = lane >> 4, nq = lane & 15; const bool gu = item < CONV_GU_ITEMS;
        float sc[16];
        if (gu) { const f32x4* gp = (const f32x4*)(g2 + k0 + 16 * kc);
#pragma unroll
            for (int q = 0; q < 4; ++q) { const f32x4 t = gp[q]; sc[4 * q] = t[0] * 32.0f; sc[4 * q + 1] = t[1] * 32.0f; sc[4 * q + 2] = t[2] * 32.0f; sc[4 * q + 3] = t[3] * 32.0f; } }
        else {
#pragma unroll
            for (int i = 0; i < 16; ++i) sc[i] = 32.0f; }
        const int nb = n0 + 32 * (nq >> 3);
        const int e = gu ? (item >> 9) : ((item - CONV_GU_ITEMS) >> 8);
        const int up = nb >= 1024, cc = nb & 1023;
        const int pos = gu ? ((cc >> 7) * 256 + up * 128 + ((cc >> 5) & 3) * 32) : ((nb & ~255) + ((nb >> 5) & 1) * 128 + ((nb >> 6) & 3) * 32);
        unsigned char* base = (gu ? (WGU8 + ((size_t)e * 2048 + pos + ((4 * nq) & 31)) * 1024) : (WD8 + ((size_t)e * 1024 + pos + ((4 * nq) & 31)) * 1024)) + k0 + 16 * kc;
#pragma unroll
        for (int c = 0; c < 4; ++c) {
            int w0 = 0, w1 = 0, w2 = 0, w3 = 0;
            w0 = __builtin_amdgcn_cvt_pk_fp8_f32(R.v0[c] * sc[0], R.v1[c] * sc[1], w0, false); w0 = __builtin_amdgcn_cvt_pk_fp8_f32(R.v2[c] * sc[2], R.v3[c] * sc[3], w0, true);
            w1 = __builtin_amdgcn_cvt_pk_fp8_f32(R.v4[c] * sc[4], R.v5[c] * sc[5], w1, false); w1 = __builtin_amdgcn_cvt_pk_fp8_f32(R.v6[c] * sc[6], R.v7[c] * sc[7], w1, true);
            w2 = __builtin_amdgcn_cvt_pk_fp8_f32(R.v8[c] * sc[8], R.v9[c] * sc[9], w2, false); w2 = __builtin_amdgcn_cvt_pk_fp8_f32(R.v10[c] * sc[10], R.v11[c] * sc[11], w2, true);
            w3 = __builtin_amdgcn_cvt_pk_fp8_f32(R.v12[c] * sc[12], R.v13[c] * sc[13], w3, false); w3 = __builtin_amdgcn_cvt_pk_fp8_f32(R.v14[c] * sc[14], R.v15[c] * sc[15], w3, true);
            *(u32x4*)(base + (size_t)c * 1024) = (u32x4){(unsigned)w0, (unsigned)w1, (unsigned)w2, (unsigned)w3};
        }
    }
    template <int SUB> __device__ __forceinline__ void sub(Regs& R, int& st, int item0, int istride, int lane) const {
        if (SUB == 0 && (st & 1)) { finish(R, item0 + ((st >> 1) - 1) * istride, lane); st &= ~1; }
        const int it = st >> 1;
        {
            const int itc = it < CONV_PER_WAVE ? it : CONV_PER_WAVE - 1;
            const float* W; int N, k0, n0; src_of(item0 + itc * istride, W, N, k0, n0);
            const float* p = W + (size_t)(k0 + 16 * (lane >> 4) + 4 * SUB) * N + n0 + 4 * (lane & 15);
            const f32x4 t0 = *(const f32x4*)p, t1 = *(const f32x4*)(p + N), t2 = *(const f32x4*)(p + 2 * (size_t)N), t3 = *(const f32x4*)(p + 3 * (size_t)N);
            if (SUB == 0) { R.v0 = t0; R.v1 = t1; R.v2 = t2; R.v3 = t3; }
            else if (SUB == 1) { R.v4 = t0; R.v5 = t1; R.v6 = t2; R.v7 = t3; }
            else if (SUB == 2) { R.v8 = t0; R.v9 = t1; R.v10 = t2; R.v11 = t3; }
            else { R.v12 = t0; R.v13 = t1; R.v14 = t2; R.v15 = t3; if (it < CONV_PER_WAVE) st = ((it + 1) << 1) | 1; }
        }
    }
    __device__ __forceinline__ void drain(Regs& R, int& st, int item0, int istride, int lane) const {
        if (st & 1) { finish(R, item0 + ((st >> 1) - 1) * istride, lane); st &= ~1; }
        for (int it = st >> 1; it < CONV_PER_WAVE; ++it) { sub<0>(R, st, item0, istride, lane); sub<1>(R, st, item0, istride, lane); sub<2>(R, st, item0, istride, lane); sub<3>(R, st, item0, istride, lane);
            finish(R, item0 + it * istride, lane); st &= ~1; }
    }
};

namespace att {
constexpr int PITCH = 512, SLOTB = 8192;
constexpr int L_K = 0, L_V = 2 * SLOTB, L_TBL = 4 * SLOTB, L_WS = L_TBL + 4096, L_OST = L_WS + 8 * 256, L_END = L_OST + 8 * 4096;
constexpr int NTBL = 832;
__device__ __forceinline__ int crow(int r, int hi) { return (r & 3) + 8 * (r >> 2) + 4 * hi; }
__device__ __forceinline__ void glds16(const void* gsrc, unsigned lds_dst) { unsigned keep;
    asm volatile("s_mov_b32 %0, m0\n\ts_mov_b32 m0, %2\n\ts_nop 0\n\tglobal_load_lds_dwordx4 %1, off\n\ts_mov_b32 m0, %0" : "=&s"(keep) : "v"(gsrc), "s"(lds_dst) : "memory"); }
__device__ __forceinline__ unsigned cvtpk_s(float lo, float hi) { typedef __bf16 bf16x2_t __attribute__((ext_vector_type(2))); f32x2 v = {lo, hi}; bf16x2_t b = __builtin_convertvector(v, bf16x2_t); return __builtin_bit_cast(unsigned, b); }
#define ATT_SBAR() __builtin_amdgcn_sched_barrier(0)
__device__ __forceinline__ void pv(f32x16* o, int vb, bf16x8 pa0, bf16x8 pa1, bf16x8 pa2, bf16x8 pa3) {
#pragma unroll
    for (int d0 = 0; d0 < 2; ++d0) { s16x4 lo[4], hi[4];
#pragma unroll
        for (int ks = 0; ks < 4; ++ks) {
            asm volatile("ds_read_b64_tr_b16 %0,%1 offset:%c2" : "=&v"(lo[ks]) : "v"(vb), "i"(d0 * 4096 + ks * 1024) : "memory");
            asm volatile("ds_read_b64_tr_b16 %0,%1 offset:%c2" : "=&v"(hi[ks]) : "v"(vb), "i"(d0 * 4096 + ks * 1024 + 512) : "memory"); }
        asm volatile("s_waitcnt lgkmcnt(0)" ::: "memory"); ATT_SBAR();
#define ATT_PK(k) (bf16x8){lo[k][0], lo[k][1], lo[k][2], lo[k][3], hi[k][0], hi[k][1], hi[k][2], hi[k][3]}
        o[d0] = __builtin_amdgcn_mfma_f32_32x32x16_bf16(pa0, ATT_PK(0), o[d0], 0, 0, 0);
        o[d0] = __builtin_amdgcn_mfma_f32_32x32x16_bf16(pa1, ATT_PK(1), o[d0], 0, 0, 0);
        o[d0] = __builtin_amdgcn_mfma_f32_32x32x16_bf16(pa2, ATT_PK(2), o[d0], 0, 0, 0);
        o[d0] = __builtin_amdgcn_mfma_f32_32x32x16_bf16(pa3, ATT_PK(3), o[d0], 0, 0, 0);
#undef ATT_PK
    }
}
__device__ __forceinline__ void unit(int b, int h, int cg, const bf16* Q, const bf16* K, const bf16* V, const float* relb, bf16* O  , LAS unsigned char* shm,
                                     const MoeConv& cv, MoeConv::Regs& sreg, int& sctr, int item0, int istride) {
    const int tid = threadIdx.x, lane = tid & 63, r32 = lane & 31, hi = lane >> 5; const int wid = __builtin_amdgcn_readfirstlane(tid >> 6);
    const long rowbase = (long)b * SEQ; const int cq = 4 * cg + (wid >> 1), wq = wid & 1;
    const bf16* Qw = Q + (rowbase + 64 * cq + 32 * wq) * PITCH + h * HD;
    const unsigned lds0 = (unsigned)(uintptr_t)shm;
    LAS float* tbl = (LAS float*)(shm + L_TBL);
    LAS float* wsf = (LAS float*)(shm + L_WS) + wid * 64;
    for (int i = tid; i < NTBL; i += 512) tbl[i] = relb[h * NREL + (i < 512 ? i : 512)] * LOG2E;
    const int srow = tid >> 3, sc = tid & 7;
    const bf16* ksrc = K + (rowbase + srow) * PITCH + h * HD + sc * 8;
    const bf16* vsrc = V + (rowbase + srow) * PITCH + h * HD + sc * 8;
    const int kwr = L_K + sc * 1024 + ((srow ^ sc) << 4);
    const int vwr = L_V + (4 * (sc >> 2) + (srow >> 4)) * 1024 + (srow & 15) * 64 + (sc & 3) * 16;
    const int vb0 = (int)(lds0 + L_V) + ((lane >> 4) & 1) * 32 + (lane & 3) * 8 + (4 * hi + ((lane & 15) >> 2)) * 64;
    int kra[4];
#pragma unroll
    for (int d0 = 0; d0 < 4; ++d0) kra[d0] = L_K + (2 * d0 + hi) * 1024 + ((r32 ^ (2 * d0 + hi)) << 4);
    bf16x8 qr[4];
#pragma unroll
    for (int d0 = 0; d0 < 4; ++d0) qr[d0] = *reinterpret_cast<const bf16x8*>(&Qw[(long)r32 * PITCH + d0 * 16 + hi * 8]);
    f32x16 o[2]; o[0] = f32x16{}; o[1] = f32x16{}; float l_reg = 0.f;
    const int j0 = (8 - 4 * cg) > 0 ? (8 - 4 * cg) : 0;
    u32x4 kA_, vA_, kB_, vB_;
    { const long ro = (long)(4 * cg - 8 + j0) * 64 * PITCH; kA_ = *(const u32x4*)(ksrc + ro); vA_ = *(const u32x4*)(vsrc + ro); kB_ = *(const u32x4*)(ksrc + ro + 64 * PITCH); vB_ = *(const u32x4*)(vsrc + ro + 64 * PITCH); }
#define ATT_STEP(JX, SUBP, KR, VR) do { const int j = (JX); \
        const int s = (j - j0) & 1; \
        *(LAS u32x4*)(shm + kwr + s * SLOTB) = KR; *(LAS u32x4*)(shm + vwr + s * SLOTB) = VR; \
        if (j < 10) { const long ro = (long)(4 * cg - 8 + j + 2) * 64 * PITCH; KR = *(const u32x4*)(ksrc + ro); VR = *(const u32x4*)(vsrc + ro); } \
        asm volatile("s_waitcnt lgkmcnt(0)\n\ts_barrier" ::: "memory"); \
        cv.template sub<SUBP>(sreg, sctr, item0, istride, lane);     \
        const int d = (wid >> 1) + 8 - j; \
        if (d >= 0 && d <= 8) { \
            f32x16 p0 = f32x16{}, p1 = f32x16{}; \
            const LAS unsigned char* kbs = shm + s * SLOTB; \
        _Pragma("unroll") \
            for (int d0 = 0; d0 < 4; ++d0) { \
                const bf16x8 b0 = *(const LAS bf16x8*)(kbs + kra[d0]), b1 = *(const LAS bf16x8*)(kbs + kra[d0] + 512); \
                p0 = __builtin_amdgcn_mfma_f32_32x32x16_bf16(b0, qr[d0], p0, 0, 0, 0); p1 = __builtin_amdgcn_mfma_f32_32x32x16_bf16(b1, qr[d0], p1, 0, 0, 0); } \
            const LAS float* tb = tbl + (256 + 64 * d + 32 * wq + r32 - 4 * hi - 63); \
            float sacc = 0.f; \
        _Pragma("unroll") \
            for (int r = 0; r < 16; ++r) { const int c = (r & 3) + 8 * (r >> 2); \
                p0[r] = fast_exp2(p0[r] + tb[63 - c]); p1[r] = fast_exp2(p1[r] + tb[31 - c]); sacc += p0[r] + p1[r]; } \
            l_reg += sacc; \
            u32x4 pw0, pw1, pw2, pw3; \
            pw0 = (u32x4){cvtpk_s(p0[0], p0[1]), cvtpk_s(p0[2], p0[3]), cvtpk_s(p0[4], p0[5]), cvtpk_s(p0[6], p0[7])}; \
            pw1 = (u32x4){cvtpk_s(p0[8], p0[9]), cvtpk_s(p0[10], p0[11]), cvtpk_s(p0[12], p0[13]), cvtpk_s(p0[14], p0[15])}; \
            pw2 = (u32x4){cvtpk_s(p1[0], p1[1]), cvtpk_s(p1[2], p1[3]), cvtpk_s(p1[4], p1[5]), cvtpk_s(p1[6], p1[7])}; \
            pw3 = (u32x4){cvtpk_s(p1[8], p1[9]), cvtpk_s(p1[10], p1[11]), cvtpk_s(p1[12], p1[13]), cvtpk_s(p1[14], p1[15])}; \
            ATT_SBAR(); \
            pv(o, vb0 + s * SLOTB, __builtin_bit_cast(bf16x8, pw0), __builtin_bit_cast(bf16x8, pw1), __builtin_bit_cast(bf16x8, pw2), __builtin_bit_cast(bf16x8, pw3)); \
        } \
    } while (0)
    for (int jb = j0; jb < 12; jb += 4) { ATT_STEP(jb, 0, kA_, vA_); ATT_STEP(jb + 1, 1, kB_, vB_); ATT_STEP(jb + 2, 2, kA_, vA_); ATT_STEP(jb + 3, 3, kB_, vB_); }
#undef ATT_STEP
    asm volatile("s_waitcnt lgkmcnt(0)\n\ts_barrier" ::: "memory");
    { auto rr = __builtin_amdgcn_permlane32_swap(__float_as_uint(l_reg), __float_as_uint(l_reg), false, false); l_reg = __uint_as_float(rr[0]) + __uint_as_float(rr[1]); }
    if (hi == 0) wsf[32 + r32] = l_reg; asm volatile("s_waitcnt lgkmcnt(0)" ::: "memory");
    float rli[16];
#pragma unroll
    for (int r = 0; r < 16; ++r) rli[r] = fast_rcp(wsf[32 + crow(r, hi)]);
    bf16* Ow = O + (rowbase + 64 * cq + 32 * wq) * D + h * HD;
    { LAS bf16* stg = (LAS bf16*)(shm + L_OST) + wid * 2048;
#pragma unroll
        for (int r = 0; r < 16; ++r) { const int orow = crow(r, hi);
#pragma unroll
            for (int d0 = 0; d0 < 2; ++d0) stg[orow * 64 + d0 * 32 + r32] = (bf16)f2bf(o[d0][r] * rli[r]); }
        asm volatile("s_waitcnt lgkmcnt(0)" ::: "memory");
#pragma unroll
        for (int i = 0; i < 4; ++i) { const int row = i * 8 + (lane >> 3), ch = lane & 7; const u32x4 v = *(const LAS u32x4*)(stg + row * 64 + ch * 8); *(u32x4*)(Ow + (long)row * D + ch * 8) = v; } }
    asm volatile("s_waitcnt lgkmcnt(0)\n\ts_barrier" ::: "memory");
}
#undef ATT_SBAR
}

constexpr int SGU_WM_OFF = 128 * 136 * 2;
__device__ __forceinline__ void sgu_load_wm(int g, const bf16* WM, LAS unsigned char* shm) {
    const int tid = threadIdx.x, t = tid >> 2, c0 = (tid & 3) * 32;
    const bf16* src = WM + ((size_t)g * 128 + t) * 128 + c0;
#pragma unroll
    for (int q = 0; q < 4; ++q) *(LAS u32x4*)(shm + SGU_WM_OFF + (t * 136 + c0 + 8 * q) * 2) = *(const u32x4*)(src + 8 * q);
}
__device__ __forceinline__ void sgu_item(int item, const bf16* VG, const bf16* UG, const float* lng, const float* lnb, const float* sgb, bf16* YC, LAS unsigned char* shm,
                                         const MoeConv& cv, MoeConv::Regs& sreg, int& sctr, int item0, int istride) {
    const int tid = threadIdx.x, lane = tid & 63; const int wid = __builtin_amdgcn_readfirstlane(tid >> 6);
    const int g = item & 3, blk = item >> 2;
    const long t0 = (long)blk * 128;
    LAS bf16* vt = (LAS bf16*)shm;
    const LAS bf16* wmL = (const LAS bf16*)(shm + SGU_WM_OFF);
    const int ch = tid & 15, fr = lane & 15, fq = lane >> 4;
    u32x4 vraw[4];
#pragma unroll
    for (int it = 0; it < 4; ++it) vraw[it] = *(const u32x4*)(VG + (t0 + (tid >> 4) + 32 * it) * SGW + g * 128 + ch * 8);
    u32x2 uw[8]; float bs[8];
#pragma unroll
    for (int tt = 0; tt < 8; ++tt) { const int t = 16 * tt + fr; uw[tt] = *(const u32x2*)(UG + (size_t)(t0 + t) * SGW + g * 128 + 16 * wid + 4 * fq); bs[tt] = sgb[g * 128 + t]; }
    const f32x4 gA = *(const f32x4*)(lng + g * 128 + ch * 8), gB = *(const f32x4*)(lng + g * 128 + ch * 8 + 4);
    const f32x4 bA = *(const f32x4*)(lnb + g * 128 + ch * 8), bB = *(const f32x4*)(lnb + g * 128 + ch * 8 + 4);
#pragma unroll
    for (int it = 0; it < 4; ++it) {
        const int s = (tid >> 4) + 32 * it;
        const u32x4 w = vraw[it];
        f32x4 a = (f32x4){bflo(w.x), bfhi(w.x), bflo(w.y), bfhi(w.y)}, b = (f32x4){bflo(w.z), bfhi(w.z), bflo(w.w), bfhi(w.w)};
        float sum = (a[0] + a[1]) + (a[2] + a[3]) + (b[0] + b[1]) + (b[2] + b[3]);
        sum += __shfl_xor(sum, 1); sum += __shfl_xor(sum, 2); sum += __shfl_xor(sum, 4); sum += __shfl_xor(sum, 8);
        const float mean = sum * (1.0f / 128.0f);
        a = a - mean; b = b - mean;
        float q = (a[0] * a[0] + a[1] * a[1]) + (a[2] * a[2] + a[3] * a[3]) + (b[0] * b[0] + b[1] * b[1]) + (b[2] * b[2] + b[3] * b[3]);
        q += __shfl_xor(q, 1); q += __shfl_xor(q, 2); q += __shfl_xor(q, 4); q += __shfl_xor(q, 8);
        const float rstd = 1.0f / sqrtf(q * (1.0f / 128.0f) + EPS);
        a = a * rstd * gA + bA; b = b * rstd * gB + bB;
#pragma unroll
        for (int j = 0; j < 4; ++j) { vt[(j * 16 + ch) * 136 + s] = (bf16)f2bf(a[j]); vt[((4 + j) * 16 + ch) * 136 + s] = (bf16)f2bf(b[j]); }
    }
    asm volatile("s_waitcnt lgkmcnt(0)\n\ts_barrier" ::: "memory");
    f32x4 acc[8];
#pragma unroll
    for (int tt = 0; tt < 8; ++tt) acc[tt] = (f32x4){0.f, 0.f, 0.f, 0.f};
#pragma unroll
    for (int ks = 0; ks < 4; ++ks) {
        const bf16x8 a = *(const LAS bf16x8*)(vt + ((fr & 7) * 16 + 2 * wid + (fr >> 3)) * 136 + 32 * ks + 8 * fq);
#pragma unroll
        for (int tt = 0; tt < 8; ++tt) if (ks <= (tt >> 1)) {
            const bf16x8 bfrag = *(const LAS bf16x8*)(wmL + (16 * tt + fr) * 136 + 32 * ks + 8 * fq);
            acc[tt] = __builtin_amdgcn_mfma_f32_16x16x32_bf16(a, bfrag, acc[tt], 0, 0, 0); }
    }
    { const bool oddq = (fq & 1) != 0; u32x2 wp[2];
#pragma unroll
    for (int tt = 0; tt < 8; ++tt) { const int t = 16 * tt + fr; const float b_ = bs[tt];
        const u32x2 u_ = uw[tt];
        u32x2 w; w.x = cvt_pk_bf16(bflo(u_.x) * (acc[tt][0] + b_), bfhi(u_.x) * (acc[tt][1] + b_)); w.y = cvt_pk_bf16(bflo(u_.y) * (acc[tt][2] + b_), bfhi(u_.y) * (acc[tt][3] + b_));
        wp[tt & 1] = w;
        if (tt & 1) *(u32x4*)(YC + (size_t)(t0 + t - (oddq ? 0 : 16)) * D + AW + g * 128 + 16 * wid + 4 * fq - (oddq ? 4 : 0)) = pair16(wp[0], wp[1], oddq); } }
    asm volatile("s_waitcnt lgkmcnt(0)\n\ts_barrier" ::: "memory");
}

#define XB_TMO      128
#define XB_XCNT(j)  (256  + 64 * (j))
#define XB_XSUB(j)  (1280 + 64 * (j))
#define XB_XGEN(j)  (2304 + 64 * (j))
#define XB_TOP      3328
#define XB_TOPGEN   3392
#define XCD_BAR_WORDS 3456
#define XB_SPIN_CAP (1u << 18)
__device__ __forceinline__ unsigned xb_ld(unsigned* p)              { return __hip_atomic_load(p, __ATOMIC_RELAXED, __HIP_MEMORY_SCOPE_AGENT); }
__device__ __forceinline__ unsigned xb_add(unsigned* p, unsigned v) { return __hip_atomic_fetch_add(p, v, __ATOMIC_RELAXED, __HIP_MEMORY_SCOPE_AGENT); }
__device__ __forceinline__ unsigned xb_xcc_id() { return (unsigned)__builtin_amdgcn_s_getreg((3 << 11) | 20) & 0xFu; }
#define XB_SPIN(cond, bar) do { unsigned _sp = 0; while (cond) { __builtin_amdgcn_s_sleep(1); \
    if ((++_sp & 255u) == 0u) { if (xb_ld(&(bar)[XB_TMO])) break; if (_sp > XB_SPIN_CAP) { atomicAdd(&(bar)[XB_TMO], 1u); break; } } } } while (0)
struct XcdBarrier { unsigned* bar; unsigned x; volatile LAS unsigned* st; };
__device__ __forceinline__ XcdBarrier xcd_barrier_post(unsigned* bar, volatile LAS unsigned* st) {
    XcdBarrier b; b.bar = bar; b.x = xb_xcc_id(); b.st = st;
    if (threadIdx.x == 0) (void)xb_add(&bar[XB_XCNT(b.x)], 1u);
    return b;
}
__device__ __forceinline__ void xcd_barrier_complete(unsigned* bar, unsigned x, unsigned& nloc, unsigned& nx) {
    const unsigned G = gridDim.x * gridDim.y * gridDim.z;
    unsigned sum, cnt, mine, sp = 0u;
    for (;;) {
        sum = 0u; cnt = 0u; mine = 0u;
#pragma unroll
        for (unsigned j = 0; j < 16; ++j) { const unsigned c = xb_ld(&bar[XB_XCNT(j)]); sum += c; cnt += (c > 0u) ? 1u : 0u; mine = (j == x) ? c : mine; }
        if (sum == G) break;
        __builtin_amdgcn_s_sleep(1);
        if ((++sp & 255u) == 0u) { if (xb_ld(&bar[XB_TMO])) break; if (sp > XB_SPIN_CAP) { atomicAdd(&bar[XB_TMO], 1u); break; } }
    }
    nloc = mine > 0u ? mine : 1u; nx = cnt > 0u ? cnt : 1u;
}
__device__ __forceinline__ void xcd_barrier(const XcdBarrier& b) {
    asm volatile("s_waitcnt vmcnt(0)" ::: "memory");
    __syncthreads();
    if (threadIdx.x == 0) {
        unsigned* bar = b.bar;
        __builtin_amdgcn_s_waitcnt(0);
        unsigned nloc = b.st[0], nx = b.st[1];
        if (nloc == 0u) { xcd_barrier_complete(bar, b.x, nloc, nx); b.st[0] = nloc; b.st[1] = nx; }
        const unsigned old = xb_add(&bar[XB_XSUB(b.x)], 1u);
        const unsigned gen = old / nloc;
        if (old + 1u == (gen + 1u) * nloc) {
            __builtin_amdgcn_fence(__ATOMIC_RELEASE, "agent");
            asm volatile("s_waitcnt vmcnt(0)" ::: "memory");
            const unsigned og = xb_add(&bar[XB_TOP], 1u);
            const unsigned tg = og / nx;
            if (og + 1u == (tg + 1u) * nx) xb_add(&bar[XB_TOPGEN], 1u);
            else XB_SPIN(xb_ld(&bar[XB_TOPGEN]) == tg, bar);
            __builtin_amdgcn_fence(__ATOMIC_ACQUIRE, "agent");
            xb_add(&bar[XB_XGEN(b.x)], 1u);
            asm volatile("s_waitcnt vmcnt(0)" ::: "memory");
        } else {
            XB_SPIN(xb_ld(&bar[XB_XGEN(b.x)]) == gen, bar);
            __builtin_amdgcn_fence(__ATOMIC_ACQUIRE, "agent");
            asm volatile("s_waitcnt vmcnt(0)" ::: "memory");
        }
    }
    __syncthreads();
}

__device__ __forceinline__ float wave_sum(float v) {
#pragma unroll
    for (int o = 1; o < 64; o <<= 1) v += __shfl_xor(v, o);
    return v;
}
__device__ __forceinline__ int pos_gen(int n0) { return (n0 & ~255) + ((n0 >> 5) & 1) * 128 + ((n0 >> 6) & 3) * 32; }
__device__ __forceinline__ int pos_gu(int c0) { const int up = c0 >= 1024, cc = c0 & 1023; return (cc >> 7) * 256 + up * 128 + ((cc >> 5) & 3) * 32; }
__device__ __forceinline__ void win_absmax(const float* W, int N, int k0, int n0, unsigned* cmax, unsigned* ccnt, int lane) {
    const int kc = lane >> 4, nq = lane & 15;
    f32x4 v[16];
#pragma unroll
    for (int i = 0; i < 16; ++i) v[i] = *(const f32x4*)(W + (size_t)(k0 + 16 * kc + i) * N + n0 + 4 * nq);
    f32x4 mx = (f32x4){0.f, 0.f, 0.f, 0.f};
#pragma unroll
    for (int i = 0; i < 16; ++i) { mx.x = fmaxf(mx.x, fabsf(v[i].x)); mx.y = fmaxf(mx.y, fabsf(v[i].y)); mx.z = fmaxf(mx.z, fabsf(v[i].z)); mx.w = fmaxf(mx.w, fabsf(v[i].w)); }
#pragma unroll
    for (int c = 0; c < 4; ++c) { mx[c] = fmaxf(mx[c], __shfl_xor(mx[c], 16)); mx[c] = fmaxf(mx[c], __shfl_xor(mx[c], 32)); }
    if (kc == 0) {
#pragma unroll
        for (int c = 0; c < 4; ++c) (void)__hip_atomic_fetch_max(cmax + n0 + 4 * nq + c, __float_as_uint(mx[c]), RLX_AGENT);
    }
    asm volatile("s_waitcnt vmcnt(0)" ::: "memory");
    if (lane == 0) (void)__hip_atomic_fetch_add(ccnt, 1u, RLX_AGENT);
}
__device__ __forceinline__ void win_quant(const float* W, int N, int k0, int n0, unsigned char* WT, unsigned* cmax, unsigned* ccnt, float* cs, bool write_cs, unsigned* tmo, int lane) {
    const int kc = lane >> 4, nq = lane & 15;
    f32x4 v[16];
#pragma unroll
    for (int i = 0; i < 16; ++i) v[i] = *(const f32x4*)(W + (size_t)(k0 + 16 * kc + i) * N + n0 + 4 * nq);
    { unsigned sp = 0; while (__hip_atomic_load(ccnt, RLX_AGENT) < 16u) { __builtin_amdgcn_s_sleep(1);
        if ((++sp & 255u) == 0u) { if (__hip_atomic_load(tmo, RLX_AGENT)) break; if (sp > (1u << 18)) { atomicAdd(tmo, 1u); break; } } } }
    asm volatile("" ::: "memory");
    float sc[4];
#pragma unroll
    for (int c = 0; c < 4; ++c) { const float cm = __uint_as_float(__hip_atomic_load(cmax + n0 + 4 * nq + c, RLX_AGENT)); sc[c] = cm > 0.f ? 127.0f / cm : 0.f; if (write_cs && kc == 0) cs[n0 + 4 * nq + c] = cm * (1.0f / 127.0f); }
    const int nb = n0 + 32 * (nq >> 3);
    const int rowb = pos_gen(nb) + ((4 * nq) & 31);
#pragma unroll
    for (int c = 0; c < 4; ++c) {
        u32x4 o;
        o.x = pack_i8((f32x4){v[0][c], v[1][c], v[2][c], v[3][c]} * sc[c]); o.y = pack_i8((f32x4){v[4][c], v[5][c], v[6][c], v[7][c]} * sc[c]);
        o.z = pack_i8((f32x4){v[8][c], v[9][c], v[10][c], v[11][c]} * sc[c]); o.w = pack_i8((f32x4){v[12][c], v[13][c], v[14][c], v[15][c]} * sc[c]);
        *(u32x4*)(WT + (size_t)(rowb + c) * D + k0 + 16 * kc) = o;
    }
}
template <int MODE, int POSK>
__device__ __forceinline__ void tr_tile(const float* W, int N, int k0, int n0, unsigned char* WT, int ldt_bytes, int dk0, const float* ks, float wscale, int lane, int rowadj = 0) {
    const int kc = lane >> 4, nq = lane & 15;
    f32x4 v[16];
#pragma unroll
    for (int i = 0; i < 16; ++i) { const int kk = MODE ? (16 * kc + i) : (32 * (i >> 3) + 8 * kc + (i & 7)); v[i] = *(const f32x4*)(W + (size_t)(k0 + kk) * N + n0 + 4 * nq); }
    if (ks) {
#pragma unroll
        for (int i = 0; i < 16; ++i) { const int kk = MODE ? (16 * kc + i) : (32 * (i >> 3) + 8 * kc + (i & 7)); v[i] = v[i] * (ks[k0 + kk] * wscale); }
    } else if (MODE) {
#pragma unroll
        for (int i = 0; i < 16; ++i) v[i] = v[i] * wscale;
    }
    const int nb = n0 + 32 * (nq >> 3);
    const int rowb = (POSK ? pos_gu(nb) : pos_gen(nb)) + ((4 * nq) & 31) + rowadj;
#pragma unroll
    for (int c = 0; c < 4; ++c) {
        unsigned char* rp = WT + (size_t)(rowb + c) * ldt_bytes;
        if (MODE == 0) {
#pragma unroll
            for (int p = 0; p < 2; ++p) { u32x4 o; o.x = pk2(v[8 * p + 0][c], v[8 * p + 1][c]); o.y = pk2(v[8 * p + 2][c], v[8 * p + 3][c]); o.z = pk2(v[8 * p + 4][c], v[8 * p + 5][c]); o.w = pk2(v[8 * p + 6][c], v[8 * p + 7][c]);
                *(u32x4*)(rp + (size_t)(dk0 + 32 * p + 8 * kc) * 2) = o; }
        } else {
            int w0 = 0, w1 = 0, w2 = 0, w3 = 0;
            w0 = __builtin_amdgcn_cvt_pk_fp8_f32(v[0][c], v[1][c], w0, false); w0 = __builtin_amdgcn_cvt_pk_fp8_f32(v[2][c], v[3][c], w0, true);
            w1 = __builtin_amdgcn_cvt_pk_fp8_f32(v[4][c], v[5][c], w1, false); w1 = __builtin_amdgcn_cvt_pk_fp8_f32(v[6][c], v[7][c], w1, true);
            w2 = __builtin_amdgcn_cvt_pk_fp8_f32(v[8][c], v[9][c], w2, false); w2 = __builtin_amdgcn_cvt_pk_fp8_f32(v[10][c], v[11][c], w2, true);
            w3 = __builtin_amdgcn_cvt_pk_fp8_f32(v[12][c], v[13][c], w3, false); w3 = __builtin_amdgcn_cvt_pk_fp8_f32(v[14][c], v[15][c], w3, true);
            *(u32x4*)(rp + (size_t)(dk0 + 16 * kc)) = (u32x4){(unsigned)w0, (unsigned)w1, (unsigned)w2, (unsigned)w3};
        }
    }
}

struct Args { const float* in[20]; float* out; unsigned char* ws; int ph_lo, ph_hi, li, pad; };

__global__ void __launch_bounds__(512, 2) moe_block_fwd(Args args) {
    extern __shared__ __attribute__((aligned(16))) unsigned char lds_raw[];
    LAS unsigned char* lds = (LAS unsigned char*)lds_raw;
    volatile LAS unsigned* MISC = (volatile LAS unsigned*)(lds + MISC_OFF);
    const int tid = threadIdx.x, lane = tid & 63, wave = __builtin_amdgcn_readfirstlane(tid >> 6);
    const int G = gridDim.x, bx = blockIdx.x;
    const int vcu = (G % 8 == 0) ? (bx % 8) * (G / 8) + bx / 8 : bx;
    unsigned char* ws = args.ws;
    gu32* ctl = (gu32*)(ws + WS_CTL);
    const float* x = args.in[0]; const float* norm1_g = args.in[1]; const float* w_in = args.in[2]; const float* q_norm_g = args.in[3]; const float* k_norm_g = args.in[4];
    const float* rel_bias = args.in[5]; const float* sg_ln_g = args.in[6]; const float* sg_ln_b = args.in[7]; const float* sg_w = args.in[8]; const float* sg_b = args.in[9];
    const float* w_branch_a = args.in[10]; const float* w_branch_b = args.in[11]; const float* w_out = args.in[12]; const float* norm2_g = args.in[13];
    const float* router_w = args.in[14]; const float* router_b = args.in[15]; const float* w_gate_up = args.in[16]; const float* b_gate_up = args.in[17];
    const float* w_down = args.in[18]; const float* b_down = args.in[19];
    float* out = args.out;
    bf16* WIN = (bf16*)(ws + WS_WIN); unsigned char* WIN8 = ws + WS_WIN8; float* HS = (float*)(ws + WS_HS); float* CS = (float*)(ws + WS_CS); float* CS2 = (float*)(ws + WS_CS2); float* MS = (float*)(ws + WS_MS); unsigned char* H8 = ws + WS_H8; bf16* WAB = (bf16*)(ws + WS_WAB); bf16* WO = (bf16*)(ws + WS_WO); bf16* WRH = (bf16*)(ws + WS_WR); bf16* WRL = (bf16*)(ws + WS_WR + 65536); bf16* WM = (bf16*)(ws + WS_WM);
    int* LID = (int*)(ws + WS_LID); float* LRS = (float*)(ws + WS_LRS); float* LP = (float*)(ws + WS_LP);
    unsigned char* WGU = ws + WS_WGU; unsigned char* WD = ws + WS_WD;
    bf16* HB = (bf16*)(ws + WS_H); bf16* QB = (bf16*)(ws + WS_Q); bf16* KB = (bf16*)(ws + WS_K); bf16* VB = (bf16*)(ws + WS_V);
    bf16* UG = (bf16*)(ws + WS_UG); bf16* VG = (bf16*)(ws + WS_VG); unsigned char* GA = ws + WS_GA; bf16* GB = (bf16*)(ws + WS_GB);
    bf16* YCAT = (bf16*)(ws + WS_YCAT); unsigned char* X1Q = ws + WS_X1B; bf16* X1H = (bf16*)(ws + WS_X1H); unsigned char* ACT = ws + WS_ACT; unsigned char* YB = ws + WS_Y;

    for (int u = tid; u < (LDS_BYTES - LDSCTL_OFF) / 4; u += 512) ((LAS unsigned*)(lds + LDSCTL_OFF))[u] = 0u;
    __syncthreads();
    XcdBarrier bar; bar.bar = (unsigned*)(ctl + CW_BAR); bar.x = 0; bar.st = nullptr;
    if (MK_N_LAUNCHES == 1) bar = xcd_barrier_post((unsigned*)(ctl + CW_BAR), MISC + 8);
    const int lo = args.ph_lo, hi = args.ph_hi;
#define IN(k) (lo <= (k) && (k) < hi)
#define SEAM(k) do { if (IN(k) && IN((k) + 1)) xcd_barrier(bar); } while (0)
#define REPS(k) for (int rep_ = 0; rep_ < ((REP_PHASE == (k)) ? 2 : 1); ++rep_)
#define REPSEAM(k) do { if (REP_PHASE == (k) && rep_ == 0) xcd_barrier(bar); } while (0)
    const int gw = vcu * 8 + wave, NGW = G * 8;

    if (IN(0)) REPS(0) {
        constexpr int I_IN = 16 * 72, I_A = 8 * 16, I_O = 16 * 16, I_GU = 16 * 32, I_D = 16 * 16;
        constexpr int NITEMS = I_IN + 2 * I_A + I_O;
        for (int it = gw; it < NITEMS; it += NGW) {
            int r = it;
            if (r < I_IN) { const int kb = r / 72, nb = r % 72; win_absmax(w_in, INW, 64 * kb, 64 * nb, (unsigned*)(ctl + CW_CMAX), (unsigned*)(ctl + CW_CCNT + nb), lane); continue; } r -= I_IN;
            if (r < I_A) { const int kb = r / 16, nb = r % 16; tr_tile<0, 0>(w_branch_a, D, 64 * kb, 64 * nb, (unsigned char*)WAB, D * 2, 64 * kb, nullptr, 1.f, lane); continue; } r -= I_A;
            if (r < I_A) { const int kb = r / 16, nb = r % 16; tr_tile<0, 0>(w_branch_b, D, 64 * kb, 64 * nb, (unsigned char*)WAB, D * 2, 512 + 64 * kb, nullptr, 1.f, lane); continue; } r -= I_A;
            { const int kb = r / 16, nb = r % 16; win_absmax(w_out, D, 64 * kb, 64 * nb, (unsigned*)(ctl + CW_CMAX2), (unsigned*)(ctl + CW_CCNT2 + nb), lane); }
        }
        for (int i = gw * 64 + lane; i < 4 * 128 * 128; i += NGW * 64) { const int s = i & 127, t = (i >> 7) & 127; WM[i] = (bf16)f2bf(s <= t ? sg_w[i] : 0.f); }
        for (int i = gw * 64 + lane; i < NE * D; i += NGW * 64) { const int k = i & 1023, e = i >> 10; const float w = router_w[k * NE + e] * norm2_g[k]; const unsigned h_ = f2bf(w); WRH[i] = (bf16)h_; WRL[i] = (bf16)f2bf(w - bf2f((unsigned short)h_)); }
        for (int m = 2 * gw; m < T; m += 2 * NGW) {
            const f32x4* xr = (const f32x4*)(x + (size_t)m * D) + lane; const f32x4* gr = (const f32x4*)norm1_g + lane;
            f32x4 v[2][4]; float s0 = 0.f, s1 = 0.f, a0 = 0.f, a1 = 0.f;
#pragma unroll
            for (int j = 0; j < 4; ++j) { v[0][j] = xr[64 * j]; v[1][j] = xr[256 + 64 * j]; }
#pragma unroll
            for (int j = 0; j < 4; ++j) { const f32x4 gq = gr[64 * j];
                s0 += (v[0][j].x * v[0][j].x + v[0][j].y * v[0][j].y) + (v[0][j].z * v[0][j].z + v[0][j].w * v[0][j].w);
                s1 += (v[1][j].x * v[1][j].x + v[1][j].y * v[1][j].y) + (v[1][j].z * v[1][j].z + v[1][j].w * v[1][j].w);
                v[0][j] = v[0][j] * gq; v[1][j] = v[1][j] * gq;
                a0 = fmaxf(a0, fmaxf(fmaxf(fabsf(v[0][j].x), fabsf(v[0][j].y)), fmaxf(fabsf(v[0][j].z), fabsf(v[0][j].w))));
                a1 = fmaxf(a1, fmaxf(fmaxf(fabsf(v[1][j].x), fabsf(v[1][j].y)), fmaxf(fabsf(v[1][j].z), fabsf(v[1][j].w)))); }
            s0 = wave_sum(s0); s1 = wave_sum(s1);
#pragma unroll
            for (int o = 1; o < 64; o <<= 1) { a0 = fmaxf(a0, __shfl_xor(a0, o)); a1 = fmaxf(a1, __shfl_xor(a1, o)); }
            const float rs0 = 1.0f / sqrtf(s0 * (1.0f / D) + EPS), rs1 = 1.0f / sqrtf(s1 * (1.0f / D) + EPS);
            const float q0 = a0 > 0.f ? 127.0f / a0 : 0.f, q1 = a1 > 0.f ? 127.0f / a1 : 0.f;
            if (lane == 0) { HS[m] = rs0 * a0 * (1.0f / 127.0f); HS[m + 1] = rs1 * a1 * (1.0f / 127.0f); }
            unsigned* q8 = (unsigned*)(H8 + (size_t)m * D) + lane;
#pragma unroll
            for (int j = 0; j < 4; ++j) { q8[64 * j] = pack_i8(v[0][j] * q0); q8[256 + 64 * j] = pack_i8(v[1][j] * q1); }
        }
        for (int it = gw; it < I_IN; it += NGW) { const int kb = it / 72, nb = it % 72;
            win_quant(w_in, INW, 64 * kb, 64 * nb, WIN8, (unsigned*)(ctl + CW_CMAX), (unsigned*)(ctl + CW_CCNT + nb), CS, kb == 0, (unsigned*)(ctl + CW_BAR) + XB_TMO, lane); }
        for (int it = gw - I_IN; it >= 0 && it < I_O; it += NGW) { const int kb = it / 16, nb = it % 16;
            win_quant(w_out, D, 64 * kb, 64 * nb, (unsigned char*)WO, (unsigned*)(ctl + CW_CMAX2), (unsigned*)(ctl + CW_CCNT2 + nb), CS2, kb == 0, (unsigned*)(ctl + CW_BAR) + XB_TMO, lane); }
        REPSEAM(0);
    }
    SEAM(0);

    if (IN(1)) REPS(1) {
        { PolIn P; P.so.init(T, INW, G, bx); P.A = H8; P.Bt = WIN8; P.ws = ws; P.qg = q_norm_g; P.kg = k_norm_g; P.hs = HS; P.cs = CS; P.shm = lds;
          pg8::gemm_phase<PolIn>(lds, P); }
        REPSEAM(1);
    }
    SEAM(1);

    if (IN(2)) REPS(2) {
        const MoeConv cv{w_gate_up, w_down, norm2_g, WGU, WD}; MoeConv::Regs sreg; int sctr = 0;
        for (int u = vcu; u < NB * NHEAD * 32; u += G) {
            const int cg = u & 31, bh = u >> 5;
            att::unit(bh >> 3, bh & 7, cg, QB, KB, VB, rel_bias, YCAT, lds, cv, sreg, sctr, gw, NGW);
        }
        sgu_load_wm(vcu & 3, WM, lds);
        for (int it = vcu; it < 4 * (T / 128); it += G) sgu_item(it, VG, UG, sg_ln_g, sg_ln_b, sg_b, YCAT, lds, cv, sreg, sctr, gw, NGW);
        cv.drain(sreg, sctr, gw, NGW, lane);
        REPSEAM(2);
    }
    SEAM(2);

    if (IN(3)) REPS(3) {
        if (tid < 256) ((LAS unsigned*)(lds + ROWS_OFF))[tid] = 0u;
        __syncthreads();
        PolMerge P; P.so.init(T, D, G, bx); P.A = YCAT; P.Bt = WAB; P.ga = GA; P.gb = (const unsigned char*)GB; P.out = (unsigned char*)HB; P.rmax = (unsigned*)(ctl + CW_RMAX); P.rcnt = (unsigned*)(ctl + CW_RCNT); P.ms = MS; P.tmo = (unsigned*)(ctl + CW_BAR) + XB_TMO; P.shm = lds;
        pg8::gemm_phase<PolMerge>(lds, P);
        REPSEAM(3);
    }
    SEAM(3);

    if (IN(4)) REPS(4) {
        PolOut P; P.so.init(T, D, G, bx); P.A = (const unsigned char*)HB; P.Bt = (const unsigned char*)WO; P.ms = MS; P.cs = CS2; P.shm = lds; P.x = x; P.x1 = X1H; P.x1q = X1Q;
        pg8::gemm_phase<PolOut>(lds, P);
        REPSEAM(4);
    }
    SEAM(4);

    if (IN(5)) {
        LAS int* lcnt = (LAS int*)(lds + PARK_OFF); LAS int* gbase = lcnt + 32;
        if (tid < 64) lcnt[tid] = 0;
        for (int i = tid; i < 4096; i += 512) { const int e = i & 31, gq = (i >> 5) & 3, kq = i >> 7;
            *(LAS u32x4*)(lds + (size_t)i * 16) = *(const u32x4*)(WRH + (size_t)e * D + 32 * kq + 8 * gq); *(LAS u32x4*)(lds + 65536 + (size_t)i * 16) = *(const u32x4*)(WRL + (size_t)e * D + 32 * kq + 8 * gq); }
        __syncthreads();
        const int r = lane & 15, g = lane >> 4;
        int sel_e[4], sel_rank[4]; float sel_p[4]; float rs_row = 0.f; int tok = 0;
        for (int grp = bx * 8 + wave; grp < T / 16; grp += NGW) {
            const int row0 = grp * 16; tok = row0 + r;
            const bf16* xr = X1H + (size_t)(row0 + r) * D + 8 * g;
            const LAS unsigned char* wl_ = lds + (g * 32 + r) * 16;
            f32x4 a0 = (f32x4){0.f, 0.f, 0.f, 0.f}, a1 = a0; float ssq = 0.f;
            u32x4 xq[4][4];
#define P5_LOAD(S, ss) do { _Pragma("unroll") for (int q = 0; q < 4; ++q) xq[S][q] = *(const u32x4*)(xr + 128 * (ss) + 32 * q); } while (0)
#define P5_COMP(S, ss) do { _Pragma("unroll") for (int q = 0; q < 4; ++q) { const u32x4 w_ = xq[S][q]; const int ks = 4 * (ss) + q; \
                const bf16x8 wh_0 = *(const LAS bf16x8*)(wl_ + ks * 2048), wh_1 = *(const LAS bf16x8*)(wl_ + ks * 2048 + 256), wl_0 = *(const LAS bf16x8*)(wl_ + 65536 + ks * 2048), wl_1 = *(const LAS bf16x8*)(wl_ + 65536 + ks * 2048 + 256); \
                ssq += (bflo(w_.x) * bflo(w_.x) + bfhi(w_.x) * bfhi(w_.x)) + (bflo(w_.y) * bflo(w_.y) + bfhi(w_.y) * bfhi(w_.y)) + (bflo(w_.z) * bflo(w_.z) + bfhi(w_.z) * bfhi(w_.z)) + (bflo(w_.w) * bflo(w_.w) + bfhi(w_.w) * bfhi(w_.w)); \
                const bf16x8 xh = __builtin_bit_cast(bf16x8, w_); \
                a0 = __builtin_amdgcn_mfma_f32_16x16x32_bf16(wh_0, xh, a0, 0, 0, 0); a1 = __builtin_amdgcn_mfma_f32_16x16x32_bf16(wh_1, xh, a1, 0, 0, 0); \
                a0 = __builtin_amdgcn_mfma_f32_16x16x32_bf16(wl_0, xh, a0, 0, 0, 0); a1 = __builtin_amdgcn_mfma_f32_16x16x32_bf16(wl_1, xh, a1, 0, 0, 0); } } while (0)
            P5_LOAD(0, 0); P5_LOAD(1, 1); P5_LOAD(2, 2); P5_LOAD(3, 3);
            P5_COMP(0, 0); P5_LOAD(0, 4);
            P5_COMP(1, 1); P5_LOAD(1, 5);
            P5_COMP(2, 2); P5_LOAD(2, 6);
            P5_COMP(3, 3); P5_LOAD(3, 7);
            P5_COMP(0, 4); P5_COMP(1, 5); P5_COMP(2, 6); P5_COMP(3, 7);
#undef P5_LOAD
#undef P5_COMP
            ssq += __shfl_xor(ssq, 16); ssq += __shfl_xor(ssq, 32);
            const float rs = 1.0f / sqrtf(ssq * (1.0f / D) + EPS); rs_row = rs;
            float v[8];
#pragma unroll
            for (int j = 0; j < 4; ++j) { v[j] = a0[j] * rs + router_b[4 * g + j]; v[4 + j] = a1[j] * rs + router_b[16 + 4 * g + j]; }
            unsigned taken = 0u; float sel_v[4];
#pragma unroll
            for (int k = 0; k < 4; ++k) {
                float best = -INFINITY; int bi = 1 << 20;
#pragma unroll
                for (int i = 0; i < 8; ++i) { const int ei = (i >> 2) * 16 + 4 * g + (i & 3); if (!((taken >> i) & 1u) && v[i] > best) { best = v[i]; bi = ei; } }
#pragma unroll
                for (int m = 16; m <= 32; m <<= 1) { const float ob = __shfl_xor(best, m); const int oi = __shfl_xor(bi, m); if (ob > best || (ob == best && oi < bi)) { best = ob; bi = oi; } }
                sel_e[k] = bi; sel_v[k] = best;
                if (((bi & 15) >> 2) == g) taken |= 1u << (((bi >> 4) << 2) | (bi & 3));
            }
            float den = 0.f;
#pragma unroll
            for (int k = 0; k < 4; ++k) { sel_p[k] = __expf(sel_v[k] - sel_v[0]); den += sel_p[k]; }
            const float inv = 1.0f / den;
#pragma unroll
            for (int k = 0; k < 4; ++k) sel_p[k] *= inv;
            if (g == 0) {
#pragma unroll
                for (int k = 0; k < 4; ++k) sel_rank[k] = __hip_atomic_fetch_add(lcnt + sel_e[k], 1, __ATOMIC_RELAXED, __HIP_MEMORY_SCOPE_WORKGROUP);
            }
        }
        __syncthreads();
        if (tid < NE) gbase[tid] = (int)__hip_atomic_fetch_add((unsigned*)(ctl + CW_CNT + tid), (unsigned)lcnt[tid], RLX_AGENT);
        __syncthreads();
        if (g == 0 && (bx * 8 + wave) < T / 16) {
#pragma unroll
            for (int k = 0; k < 4; ++k) { const size_t pos = (size_t)sel_e[k] * LCAP + gbase[sel_e[k]] + sel_rank[k];
                LID[pos] = tok * 4 + k; LRS[pos] = rs_row; LP[pos] = sel_p[k]; }
        }
        __syncthreads();
    }
    SEAM(5);

    if (IN(6) || IN(7)) {
        LAS int* tb = (LAS int*)(lds + MOE_OFF);
        if (tid < NE) tb[33 + tid] = (int)__hip_atomic_load(ctl + CW_CNT + tid, RLX_AGENT);
        __syncthreads();
        if (tid == 0) { int acc = 0; for (int e = 0; e < NE; ++e) { tb[e] = acc; acc += (tb[33 + e] + 255) >> 8; } tb[32] = acc; }
        __syncthreads();
    }
    if (IN(6)) REPS(6) {
        PolGU P; P.mo.init((const LAS int*)(lds + MOE_OFF), 8, G, bx); P.A = X1Q; P.Bt = WGU; P.lid = LID; P.lrs = LRS; P.bgu = b_gate_up; P.act = ACT; P.shm = lds;
        pg8::gemm_phase<PolGU>(lds, P);
        REPSEAM(6);
    }
    SEAM(6);
    if (IN(7)) REPS(7) {
        PolDown P; P.mo.init((const LAS int*)(lds + MOE_OFF), 4, G, bx); P.A = ACT; P.Bt = WD; P.lid = LID; P.lp = LP; P.bd = b_down; P.y = YB; P.shm = lds;
        pg8::gemm_phase<PolDown>(lds, P);
        REPSEAM(7);
    }
    SEAM(7);
    if (IN(8)) {
        f32x4 xa[4], xb[4]; u32x4 ya[4], yb[4];
#define P8_LOAD(X, Y, m_) do { const bf16* xr_ = X1H + (size_t)(m_) * D + 16 * lane; { f32x4 a_, b_; ld8(xr_, a_, b_); X[0] = a_; X[1] = b_; ld8(xr_ + 8, a_, b_); X[2] = a_; X[3] = b_; } \
            _Pragma("unroll") for (int k = 0; k < 4; ++k) Y[k] = *(const u32x4*)(YB + ((size_t)(m_) * 4 + k) * D + 16 * lane); } while (0)
#define P8_DONE(X, Y, m_) do { _Pragma("unroll") for (int k = 0; k < 4; ++k) { const unsigned ww[4] = {Y[k].x, Y[k].y, Y[k].z, Y[k].w}; \
            _Pragma("unroll") for (int q = 0; q < 4; ++q) { const f32x2 lo_ = __builtin_amdgcn_cvt_pk_f32_fp8((int)ww[q], false), hi_ = __builtin_amdgcn_cvt_pk_f32_fp8((int)ww[q], true); \
                X[q][0] += lo_[0] * 0.0625f; X[q][1] += lo_[1] * 0.0625f; X[q][2] += hi_[0] * 0.0625f; X[q][3] += hi_[1] * 0.0625f; } } \
            float* or_ = out + (size_t)(m_) * D + 16 * lane; _Pragma("unroll") for (int j = 0; j < 4; ++j) *(f32x4*)(or_ + 4 * j) = X[j]; } while (0)
        for (int m = gw; m < T; m += 2 * NGW) { const int m2 = m + NGW;
            P8_LOAD(xa, ya, m); P8_LOAD(xb, yb, m2);
            P8_DONE(xa, ya, m); P8_DONE(xb, yb, m2); }
#undef P8_LOAD
#undef P8_DONE
    }
#undef IN
#undef SEAM
}

extern "C" void kernel_launch(void* const* d_in, const int* in_sizes, int n_in, void* d_out, int out_size, void* d_ws, size_t ws_size, hipStream_t stream) {
    static int grid = 0;
    if (grid == 0) {
        if (n_in != 20 || in_sizes[0] != T * D || out_size != T * D || ws_size < WS_END) { fprintf(stderr, "kernel_launch: unexpected shapes (n_in %d, ws %zu)\n", n_in, ws_size); grid = -1; return; }
        int dev = 0, cus = 0;
        if (hipGetDevice(&dev) != hipSuccess || hipDeviceGetAttribute(&cus, hipDeviceAttributeMultiprocessorCount, dev) != hipSuccess) { grid = -1; return; }
        if (hipFuncSetAttribute((const void*)moe_block_fwd, hipFuncAttributeMaxDynamicSharedMemorySize, LDS_BYTES) != hipSuccess) { fprintf(stderr, "kernel_launch: hipFuncSetAttribute failed\n"); grid = -1; return; }
        (void)hipGetLastError();
        grid = cus;
        if (grid != 256) { fprintf(stderr, "kernel_launch: built for a 256-CU device, got %d\n", cus); grid = -1; return; }
    }
    if (grid < 0) return;
    if (hipMemsetAsync((char*)d_ws + WS_CTL, 0, CTL_ZERO_BYTES, stream) != hipSuccess) return;
    Args a{};
    for (int i = 0; i < 20; ++i) a.in[i] = (const float*)d_in[i];
    a.out = (float*)d_out; a.ws = (unsigned char*)d_ws;
    constexpr int NPH = 9;
    for (int li = 0; li < MK_N_LAUNCHES; ++li) {
        a.ph_lo = (MK_N_LAUNCHES == 1) ? 0 : li; a.ph_hi = (MK_N_LAUNCHES == 1) ? NPH : li + 1; a.li = li;
        hipLaunchKernelGGL(moe_block_fwd, dim3(grid), dim3(512), LDS_BYTES, stream, a);
    }
}
```

```cpp
#include <hip/hip_runtime.h>
#include <cstdio>
#include <cstdint>

#ifndef MK_N_LAUNCHES
#define MK_N_LAUNCHES 1
#endif

#ifndef REP_PHASE
#define REP_PHASE -1
#endif
#define LAS __attribute__((address_space(3)))
#define GAS __attribute__((address_space(1)))
typedef unsigned short bf16;
typedef short bf16x8 __attribute__((ext_vector_type(8)));
typedef short s16x4 __attribute__((ext_vector_type(4)));
typedef float f32x2 __attribute__((ext_vector_type(2)));
typedef float f32x4 __attribute__((ext_vector_type(4)));
typedef float f32x16 __attribute__((ext_vector_type(16)));
typedef unsigned u32x2 __attribute__((ext_vector_type(2)));
typedef unsigned u32x4 __attribute__((ext_vector_type(4)));
typedef GAS unsigned gu32;

constexpr int NB = 4, SEQ = 8192, T = NB * SEQ, D = 1024, AW = 512, SGW = 512, INW = 4608, NE = 32, FF = 1024;
constexpr int NHEAD = 8, HD = 64, CHUNK = 64, NBACK = 8, NREL = 513;
constexpr int LCAP = 32768;
constexpr float LOG2E = 1.4426950408889634f;
constexpr float EPS = 1e-6f;

constexpr size_t MiB = 1u << 20;
constexpr size_t WS_CTL = 0, CTL_ZERO_BYTES = 1 * MiB;
constexpr size_t WS_WIN = 7 * MiB;
constexpr size_t WS_WAB = 11 * MiB;
constexpr size_t WS_WO = 13 * MiB;
constexpr size_t WS_WR = 15 * MiB;
constexpr size_t WS_WM = 15 * MiB + 256 * 1024;
constexpr size_t WS_WIN8 = 2 * MiB;
constexpr size_t WS_HS = 15 * MiB + 512 * 1024;
constexpr size_t WS_CS2 = 15 * MiB + 832 * 1024;
constexpr size_t WS_MS = 15 * MiB + 896 * 1024;
constexpr size_t WS_CS = 15 * MiB + 768 * 1024;
constexpr size_t WS_H8 = 976 * MiB;
constexpr size_t WS_LID = 16 * MiB;
constexpr size_t WS_LRS = 20 * MiB;
constexpr size_t WS_LP = 24 * MiB;
constexpr size_t WS_WGU = 28 * MiB;
constexpr size_t WS_WD = 156 * MiB;
constexpr size_t WS_H = 220 * MiB;
constexpr size_t WS_Q = 284 * MiB, WS_K = 316 * MiB, WS_V = 348 * MiB;
constexpr size_t WS_UG = 380 * MiB, WS_VG = 412 * MiB;
constexpr size_t WS_GA = 444 * MiB, WS_GB = 508 * MiB;
constexpr size_t WS_YCAT = 572 * MiB;
constexpr size_t WS_X1B = 636 * MiB;
constexpr size_t WS_ACT = 700 * MiB;
constexpr size_t WS_X1H = 380 * MiB;
constexpr size_t WS_Y = 220 * MiB;
constexpr size_t WS_END = 1008 * MiB;
constexpr int CW_TMO = 0, CW_CODE = 1;
constexpr int CW_CNT = 64;
constexpr int CW_BAR = 4096;
constexpr int CW_CMAX = 8192;
constexpr int CW_CMAX2 = 13312;
constexpr int CW_CCNT2 = 16384 + 128;
constexpr int CW_RMAX = 65536;
constexpr int CW_RCNT = 98304;
constexpr int CW_CCNT = 16384;

constexpr int RING_BYTES = 131072;
constexpr int LDSCTL_OFF = RING_BYTES, MISC_OFF = LDSCTL_OFF + 320;
constexpr int MOE_OFF = MISC_OFF + 128;
constexpr int PARK_OFF = LDSCTL_OFF + 1024;
constexpr int ROWS_OFF = LDSCTL_OFF + 9216, ROWS_BUF = 3072;
constexpr int LDS_BYTES = 147456;

#define LDS_WAIT() asm volatile("s_waitcnt lgkmcnt(0)" ::: "memory")
#define VM_WAIT() asm volatile("s_waitcnt vmcnt(0)" ::: "memory")
#define RLX_AGENT __ATOMIC_RELAXED, __HIP_MEMORY_SCOPE_AGENT

__device__ __forceinline__ unsigned f2bf(float f) { unsigned u = __builtin_bit_cast(unsigned, f); return (u + 0x7fffu + ((u >> 16) & 1u)) >> 16; }
__device__ __forceinline__ unsigned pk2(float lo, float hi) { return f2bf(lo) | (f2bf(hi) << 16); }
__device__ __forceinline__ float bf2f(unsigned short b) { return __builtin_bit_cast(float, (unsigned)b << 16); }
__device__ __forceinline__ float bflo(unsigned w) { return __builtin_bit_cast(float, w << 16); }
__device__ __forceinline__ float bfhi(unsigned w) { return __builtin_bit_cast(float, w & 0xffff0000u); }
__device__ __forceinline__ unsigned cvt_pk_bf16(float lo, float hi) { unsigned r; asm volatile("v_cvt_pk_bf16_f32 %0, %1, %2" : "=v"(r) : "v"(lo), "v"(hi)); return r; }
__device__ __forceinline__ float fast_rcp(float x) { return __builtin_amdgcn_rcpf(x); }
__device__ __forceinline__ float fast_exp2(float x) { return __builtin_amdgcn_exp2f(x); }
__device__ __forceinline__ float sigmoidf_(float x) { return fast_rcp(1.0f + fast_exp2(-LOG2E * x)); }
__device__ __forceinline__ float gelu_tanh(float x) {
    const float t = x * ((-LOG2E * 1.5957691216057308f) + (-LOG2E * 1.5957691216057308f * 0.044715f) * (x * x));
    return x * fast_rcp(1.0f + fast_exp2(t));
}

namespace pg8 {
constexpr int BM = 256, BK = 64, HALF = 128, HTB = HALF * BK * 2, STAGE_BYTES = 8 * HTB, NXCD = 8, WGM = 8;
__host__ __device__ __forceinline__ int lds_byte(int r, int c) { const int st = (r >> 4) * 2 + (c >> 5), rr = r & 15, cc = c & 31, ob = rr * 64 + cc * 2; return st * 1024 + (ob ^ (((ob >> 9) & 1) << 5)); }
__host__ __device__ __forceinline__ void stage_rc(int b, int& R, int& C) { const int st = b / 1024, sb = b % 1024, swz = sb ^ (((sb >> 9) & 1) << 5); R = (st >> 1) * 16 + swz / 64; C = (st & 1) * 32 + (swz % 64) / 2; }
__host__ __device__ __forceinline__ int perm32(int rho) { const int n = rho >> 4, i = rho & 15; return 8 * (i >> 2) + 4 * n + (i & 3); }

typedef int v4i_t __attribute__((ext_vector_type(4)));
typedef int v8i_t __attribute__((ext_vector_type(8)));
__device__ __forceinline__ v8i_t cat8(bf16x8 lo, bf16x8 hi) { return __builtin_shufflevector(__builtin_bit_cast(v4i_t, lo), __builtin_bit_cast(v4i_t, hi), 0, 1, 2, 3, 4, 5, 6, 7); }
struct Unit { int pm, pn, e, s0, cnt, idx; };

struct StaticOrder {
    int nM, nN, nwg, G, c;
    __device__ void init(int M, int N, int G_, int c_) { nM = M / BM; nN = N / BM; nwg = nM * nN; G = G_; c = c_; }
    __device__ bool tile(int i, int& pm, int& pn) const {
        const long L = (long)i * G + c; if (L >= nwg) return false;
        int wgid = (int)L; { const int q = nwg / NXCD, r = nwg % NXCD, xcd = wgid % NXCD, off = wgid / NXCD; wgid = (xcd < r ? xcd * (q + 1) : r * (q + 1) + (xcd - r) * q) + off; }
        const int nig = WGM * nN, gid = wgid / nig, fm = gid * WGM, gsz = (nM - fm) < WGM ? (nM - fm) : WGM;
        pm = fm + ((wgid % nig) % gsz); pn = (wgid % nig) / gsz; return true;
    }
};

template <class P>
__device__ __forceinline__ void gemm_phase(LAS unsigned char* lds, const P& S) {
    const int tid = threadIdx.x, wid = __builtin_amdgcn_readfirstlane(tid >> 6), lane = tid & 63, wr = wid >> 2, wc = wid & 3, fr = lane & 15, fq = lane >> 4;
    constexpr int nt = P::NT;
    unsigned vA[2][2], voffB[2];
    LAS u32x4* park = (LAS u32x4*)(lds + PARK_OFF) + tid;
#pragma unroll
    for (int i = 0; i < 2; ++i) { int R, C; stage_rc(tid * 16 + i * 8192, R, C); const int Rb = (R & ~31) + perm32(R & 31);
        vA[0][i] = (unsigned)(R * P::LDA + C) * 2u; vA[1][i] = (unsigned)((R + HALF) * P::LDA + C) * 2u; voffB[i] = (unsigned)(Rb * P::LDB + C) * 2u; }
    const size_t kstep = (size_t)(BK * 2);
    const size_t hstepB = (size_t)HALF * P::LDB * 2;
    const unsigned ldsw = (unsigned)wid * 1024u;
    const int aoff = lds_byte(wr * 64 + fr, fq * 8), boff = lds_byte(wc * 32 + fr, fq * 8);
#define PG8_SA(b, h) (((b) * 2 + (h)) * HTB)
#define PG8_SB(b, h) ((4 + (b) * 2 + (h)) * HTB)
#define PG8_STAGE2(bufoff, gbase, o0, o1) do { \
        __builtin_amdgcn_global_load_lds((const unsigned*)((const char*)(gbase) + (o0)), (LAS unsigned*)(lds + (bufoff) + ldsw), 16, 0, 0); \
        __builtin_amdgcn_global_load_lds((const unsigned*)((const char*)(gbase) + (o1)), (LAS unsigned*)(lds + (bufoff) + ldsw + 8192), 16, 0, 0); } while (0)
#define PG8_STAGEB(bufoff, gbase) PG8_STAGE2(bufoff, gbase, voffB[0], voffB[1])
#define PG8_LDA(dst, b, h) do { _Pragma("unroll") for (int m = 0; m < 4; ++m) _Pragma("unroll") for (int k = 0; k < 2; ++k) dst[m][k] = *(const LAS bf16x8*)(lds + PG8_SA(b, h) + aoff + m * 2048 + k * 1024); } while (0)
#define PG8_LDB(dst, b, h) do { _Pragma("unroll") for (int n = 0; n < 2; ++n) _Pragma("unroll") for (int k = 0; k < 2; ++k) dst[n][k] = *(const LAS bf16x8*)(lds + PG8_SB(b, h) + boff + n * 2048 + k * 1024); } while (0)
#define PG8_MMA(ai, bj, At, Bt) do { __builtin_amdgcn_s_setprio(1); _Pragma("unroll") for (int m = 0; m < 4; ++m) _Pragma("unroll") for (int n = 0; n < 2; ++n) { \
        if constexpr (P::I8) { _Pragma("unroll") for (int k = 0; k < 2; ++k) acc[ai][bj][m][n] = __builtin_bit_cast(f32x4, __builtin_amdgcn_mfma_i32_16x16x64_i8(__builtin_bit_cast(v4i_t, Bt[n][k]), __builtin_bit_cast(v4i_t, At[m][k]), __builtin_bit_cast(v4i_t, acc[ai][bj][m][n]), 0, 0, 0)); }     \
        else if constexpr (P::FP8) { acc[ai][bj][m][n] = __builtin_amdgcn_mfma_scale_f32_16x16x128_f8f6f4(cat8(Bt[n][0], Bt[n][1]), cat8(At[m][0], At[m][1]), acc[ai][bj][m][n], 0, 0, 0, 0, 0, 0); }     \
        else { _Pragma("unroll") for (int k = 0; k < 2; ++k) acc[ai][bj][m][n] = __builtin_amdgcn_mfma_f32_16x16x32_bf16(Bt[n][k], At[m][k], acc[ai][bj][m][n], 0, 0, 0); } } \
        __builtin_amdgcn_s_setprio(0); } while (0)
#define PG8_WAIT_V(n) asm volatile("s_waitcnt vmcnt(" #n ")" ::: "memory")
#define PG8_WAIT_L(n) asm volatile("s_waitcnt lgkmcnt(" #n ")" ::: "memory")
#define PG8_BAR __builtin_amdgcn_s_barrier()
#define PG8_SCHED __builtin_amdgcn_sched_barrier(0)
    Unit cur, nxt; int ui = 0;
    if (!S.next(0, cur)) return;
    if constexpr (P::GATHER) S.a_off(cur, tid, vA);
    f32x4 acc[2][2][4][2];
#pragma unroll
    for (int a = 0; a < 2; ++a)
#pragma unroll
        for (int b = 0; b < 2; ++b)
#pragma unroll
            for (int m = 0; m < 4; ++m)
#pragma unroll
                for (int n = 0; n < 2; ++n) acc[a][b][m][n] = (f32x4){0.f, 0.f, 0.f, 0.f};
    bf16x8 At[4][2], B0[2][2], B1[2][2];
    const char* cA = S.a_ptr(cur); const char* cB = S.b_ptr(cur);
    PG8_STAGEB(PG8_SB(0, 0), cB); PG8_STAGEB(PG8_SB(0, 1), cB + hstepB); PG8_STAGE2(PG8_SA(0, 0), cA, vA[0][0], vA[0][1]); PG8_STAGE2(PG8_SA(0, 1), cA, vA[1][0], vA[1][1]);
    if (wr == 1) PG8_BAR;
    PG8_WAIT_V(2); PG8_BAR;
    PG8_STAGEB(PG8_SB(1, 0), cB + kstep); PG8_STAGE2(PG8_SA(1, 0), cA + kstep, vA[0][0], vA[0][1]); PG8_STAGEB(PG8_SB(1, 1), cB + hstepB + kstep);
    PG8_WAIT_V(6); PG8_BAR;
    for (;;) {
        const bool has_next = S.next(ui + 1, nxt);
        if constexpr (P::ROWDMA) S.row_dma(cur, lds, wid, lane);
        const char* nA = has_next ? S.a_ptr(nxt) : cA; const char* nB = has_next ? S.b_ptr(nxt) : cB;
        if constexpr (P::IDDMA) { if (has_next) S.ids_dma(nxt, cur, lds, wid, lane); }
        else if constexpr (P::GATHER) {
            unsigned vn[2][2];
            if (has_next) S.a_off(nxt, tid, vn);
            else { vn[0][0] = vA[0][0]; vn[0][1] = vA[0][1]; vn[1][0] = vA[1][0]; vn[1][1] = vA[1][1]; }
            *park = (u32x4){vn[0][0], vn[0][1], vn[1][0], vn[1][1]};
        }
#pragma nounroll
        for (int t = 0; t < nt; t += 2) {
            const bool last = (t == nt - 2);
            asm volatile("" : "+v"(vA[0][0]), "+v"(vA[0][1]), "+v"(vA[1][0]), "+v"(vA[1][1]), "+v"(voffB[0]), "+v"(voffB[1]));
            const char* a1 = cA + (size_t)(t + 1) * kstep;
            const char* a2 = last ? nA : cA + (size_t)(t + 2) * kstep; const char* b2 = last ? nB : cB + (size_t)(t + 2) * kstep;
            const char* a3 = a2 + kstep; const char* b3 = b2 + kstep;
            PG8_LDB(B0, 0, 0); PG8_LDB(B1, 0, 1); PG8_SCHED; PG8_LDA(At, 0, 0); PG8_STAGE2(PG8_SA(1, 1), a1, vA[1][0], vA[1][1]);
            if constexpr (P::IDDMA) { if (last && has_next) S.a_off_lds(nxt, cur, tid, lds, vA); }
            else if constexpr (P::GATHER) { if (last) { const u32x4 nv = *park; vA[0][0] = nv.x; vA[0][1] = nv.y; vA[1][0] = nv.z; vA[1][1] = nv.w; } }
            PG8_WAIT_V(8); PG8_WAIT_L(0); PG8_BAR; PG8_MMA(0, 0, At, B0); PG8_MMA(0, 1, At, B1); PG8_BAR; PG8_SCHED;
            PG8_LDA(At, 0, 1); PG8_STAGEB(PG8_SB(0, 0), b2); PG8_STAGEB(PG8_SB(0, 1), b2 + hstepB); PG8_STAGE2(PG8_SA(0, 0), a2, vA[0][0], vA[0][1]);
            PG8_WAIT_V(8); PG8_WAIT_L(0); PG8_BAR; PG8_MMA(1, 0, At, B0); PG8_MMA(1, 1, At, B1); PG8_BAR; PG8_SCHED;
            PG8_LDB(B0, 1, 0); PG8_LDB(B1, 1, 1); PG8_SCHED; PG8_LDA(At, 1, 0); PG8_STAGE2(PG8_SA(0, 1), a2, vA[1][0], vA[1][1]);
            PG8_WAIT_V(8); PG8_WAIT_L(0); PG8_BAR; PG8_MMA(0, 0, At, B0); PG8_MMA(0, 1, At, B1); PG8_BAR; PG8_SCHED;
            PG8_LDA(At, 1, 1); PG8_STAGEB(PG8_SB(1, 0), b3); PG8_STAGEB(PG8_SB(1, 1), b3 + hstepB); PG8_STAGE2(PG8_SA(1, 0), a3, vA[0][0], vA[0][1]);
            PG8_WAIT_V(8); PG8_WAIT_L(0); PG8_BAR; PG8_MMA(1, 0, At, B0); PG8_MMA(1, 1, At, B1); PG8_BAR; PG8_SCHED;
        }
        if (wr == 0) PG8_BAR;
        int fr_ = fr, fq_ = fq; asm volatile("" : "+v"(fr_), "+v"(fq_));
        const bool keep = S.epi(acc, cur, wr, wc, fr_, fq_);
        if (!has_next) break;
        if (!keep) {
#pragma unroll
            for (int a = 0; a < 2; ++a)
#pragma unroll
                for (int b = 0; b < 2; ++b)
#pragma unroll
                    for (int m = 0; m < 4; ++m)
#pragma unroll
                        for (int n = 0; n < 2; ++n) acc[a][b][m][n] = (f32x4){0.f, 0.f, 0.f, 0.f};
        }
        cur = nxt; cA = nA; cB = nB; ++ui;
        if (wr == 1) PG8_BAR;
    }
    PG8_WAIT_V(0);
    PG8_BAR;
#undef PG8_SA
#undef PG8_SB
#undef PG8_STAGE2
#undef PG8_STAGEB
#undef PG8_LDA
#undef PG8_LDB
#undef PG8_MMA
#undef PG8_WAIT_V
#undef PG8_WAIT_L
#undef PG8_BAR
#undef PG8_SCHED
}
}
using pg8::Unit;

__device__ __forceinline__ void st8(bf16* p, const f32x4& a, const f32x4& b) {
    u32x4 w; w.x = cvt_pk_bf16(a[0], a[1]); w.y = cvt_pk_bf16(a[2], a[3]); w.z = cvt_pk_bf16(b[0], b[1]); w.w = cvt_pk_bf16(b[2], b[3]);
    *(u32x4*)p = w;
}
__device__ __forceinline__ void ld8(const bf16* p, f32x4& a, f32x4& b) {
    const u32x4 w = *(const u32x4*)p;
    a = (f32x4){bflo(w.x), bfhi(w.x), bflo(w.y), bfhi(w.y)}; b = (f32x4){bflo(w.z), bfhi(w.z), bflo(w.w), bfhi(w.w)};
}

__device__ __forceinline__ void st8q(unsigned char* p, const f32x4& a, const f32x4& b) {
    int w0 = 0, w1 = 0;
    w0 = __builtin_amdgcn_cvt_pk_fp8_f32(a[0], a[1], w0, false); w0 = __builtin_amdgcn_cvt_pk_fp8_f32(a[2], a[3], w0, true);
    w1 = __builtin_amdgcn_cvt_pk_fp8_f32(b[0], b[1], w1, false); w1 = __builtin_amdgcn_cvt_pk_fp8_f32(b[2], b[3], w1, true);
    *(u32x2*)p = (u32x2){(unsigned)w0, (unsigned)w1};
}
__device__ __forceinline__ unsigned pack_i8(const f32x4& v) {
    const int a = (int)__builtin_rintf(v.x), b = (int)__builtin_rintf(v.y), c = (int)__builtin_rintf(v.z), d = (int)__builtin_rintf(v.w);
    return ((unsigned)a & 255u) | (((unsigned)b & 255u) << 8) | (((unsigned)c & 255u) << 16) | ((unsigned)d << 24);
}
__device__ __forceinline__ u32x2 pack8q(const f32x4& a, const f32x4& b) {
    int w0 = 0, w1 = 0;
    w0 = __builtin_amdgcn_cvt_pk_fp8_f32(a[0], a[1], w0, false); w0 = __builtin_amdgcn_cvt_pk_fp8_f32(a[2], a[3], w0, true);
    w1 = __builtin_amdgcn_cvt_pk_fp8_f32(b[0], b[1], w1, false); w1 = __builtin_amdgcn_cvt_pk_fp8_f32(b[2], b[3], w1, true);
    return (u32x2){(unsigned)w0, (unsigned)w1};
}
__device__ __forceinline__ u32x4 pair16(const u32x2& e0, const u32x2& e1, bool oddq) {
    const u32x2 snd = oddq ? e0 : e1;
    u32x2 rcv; rcv.x = (unsigned)__shfl_xor((int)snd.x, 16); rcv.y = (unsigned)__shfl_xor((int)snd.y, 16);
    return oddq ? (u32x4){rcv.x, rcv.y, e1.x, e1.y} : (u32x4){e0.x, e0.y, rcv.x, rcv.y};
}
constexpr float WQ_SCALE = 32.0f, WQ_INV = 1.0f / 32.0f;

struct PolIn {
    static constexpr int NT = 8, LDA = 512, LDB = 512; static constexpr bool GATHER = false, FP8 = false, I8 = true, ROWDMA = true, IDDMA = false;
    pg8::StaticOrder so; const unsigned char* A; const unsigned char* Bt; unsigned char* ws; const float* qg; const float* kg; const float* hs; const float* cs; LAS unsigned char* shm;
    __device__ bool next(int i, Unit& u) const { u.e = 0; u.s0 = 0; u.cnt = 0; u.idx = i; return so.tile(i, u.pm, u.pn); }
    __device__ __forceinline__ void row_dma(const Unit& u, LAS unsigned char* lds, int wid, int lane) const {
        const unsigned* src = (wid < 4) ? (const unsigned*)(hs + u.pm * 256 + 64 * wid + lane) : (const unsigned*)(cs + u.pn * 256 + 64 * (wid & 3) + lane);
        __builtin_amdgcn_global_load_lds(src, (LAS unsigned*)(lds + ROWS_OFF + (u.idx & 1) * ROWS_BUF + 256 * wid), 4, 0, 0);
    }
    __device__ const char* a_ptr(const Unit& u) const { return (const char*)(A + (size_t)u.pm * 256 * 1024); }
    __device__ const char* b_ptr(const Unit& u) const { return (const char*)(Bt + (size_t)u.pn * 256 * 1024); }
    __device__ void a_off(const Unit&, int, unsigned (&)[2][2]) const {}
    __device__ __forceinline__ bool epi(f32x4 (&acc)[2][2][4][2], const Unit& u, int wr, int wc, int fr, int fq) const {
        const int pn = u.pn;
        {
            const LAS float* hsr = (const LAS float*)(shm + ROWS_OFF + (u.idx & 1) * ROWS_BUF) + wr * 64 + fr;
            const LAS float* csp = (const LAS float*)(shm + ROWS_OFF + (u.idx & 1) * ROWS_BUF + 1024) + 64 * wc + 8 * fq;
            float hv[2][4]; f32x4 cv[2][2];
#pragma unroll
            for (int a = 0; a < 2; ++a)
#pragma unroll
                for (int m = 0; m < 4; ++m) hv[a][m] = hsr[a * 128 + m * 16];
#pragma unroll
            for (int b = 0; b < 2; ++b)
#pragma unroll
                for (int n = 0; n < 2; ++n) cv[b][n] = *(const LAS f32x4*)(csp + 32 * b + 4 * n);
#pragma unroll
            for (int a = 0; a < 2; ++a)
#pragma unroll
                for (int b = 0; b < 2; ++b)
#pragma unroll
                    for (int m = 0; m < 4; ++m)
#pragma unroll
                        for (int n = 0; n < 2; ++n) { const pg8::v4i_t ia = __builtin_bit_cast(pg8::v4i_t, acc[a][b][m][n]);
                            acc[a][b][m][n] = (f32x4){(float)ia.x, (float)ia.y, (float)ia.z, (float)ia.w} * hv[a][m] * cv[b][n]; }
        }
        int kind, ld, tcol; size_t off;
        if (pn < 2) { kind = 0; off = WS_Q; ld = AW; tcol = pn; }
        else if (pn < 4) { kind = 1; off = WS_K; ld = AW; tcol = pn - 2; }
        else if (pn < 6) { kind = 2; off = WS_V; ld = AW; tcol = pn - 4; }
        else if (pn < 8) { kind = 3; off = WS_UG; ld = SGW; tcol = pn - 6; }
        else if (pn < 10) { kind = 3; off = WS_VG; ld = SGW; tcol = pn - 8; }
        else if (pn < 14) { kind = 4; off = WS_GA; ld = D; tcol = pn - 10; }
        else { kind = 4; off = WS_GB; ld = D; tcol = pn - 14; }
        bf16* base = (bf16*)(ws + off) + tcol * 256 + 64 * wc + 8 * fq;
        const int row0 = u.pm * 256 + wr * 64 + fr;
        if (kind <= 1) {
            const float* g = (kind == 0 ? qg : kg) + 8 * fq;
            f32x4 gv[2][2];
#pragma unroll
            for (int bj = 0; bj < 2; ++bj)
#pragma unroll
                for (int n = 0; n < 2; ++n) gv[bj][n] = *(const f32x4*)(g + 32 * bj + 4 * n);
            unsigned char* b8 = ws + off + tcol * 256 + 64 * wc + 8 * fq; const bool oddq = (fq & 1) != 0;
#pragma unroll
            for (int ai = 0; ai < 2; ++ai)
#pragma unroll
                for (int mp = 0; mp < 2; ++mp) {
                    float rs[2];
#pragma unroll
                    for (int mm = 0; mm < 2; ++mm) { const int m = 2 * mp + mm; float ss = 0.f;
#pragma unroll
                        for (int bj = 0; bj < 2; ++bj)
#pragma unroll
                            for (int n = 0; n < 2; ++n) { const f32x4 v = acc[ai][bj][m][n]; ss += (v[0] * v[0] + v[1] * v[1]) + (v[2] * v[2] + v[3] * v[3]); }
                        ss += __shfl_xor(ss, 16); ss += __shfl_xor(ss, 32);
                        rs[mm] = 1.0f / sqrtf(ss * (1.0f / 64.0f) + EPS); }
                    unsigned char* rowp = b8 + (size_t)(row0 + ai * 128 + (2 * mp + (oddq ? 1 : 0)) * 16) * ld - (oddq ? 8 : 0);
#pragma unroll
                    for (int bj = 0; bj < 2; ++bj) *(u32x4*)(rowp + 32 * bj) = pair16(pack8q(acc[ai][bj][2 * mp][0] * rs[0] * gv[bj][0], acc[ai][bj][2 * mp][1] * rs[0] * gv[bj][1]),
                                                                                      pack8q(acc[ai][bj][2 * mp + 1][0] * rs[1] * gv[bj][0], acc[ai][bj][2 * mp + 1][1] * rs[1] * gv[bj][1]), oddq);
                }
        } else if (kind == 2 || kind == 4) {
            unsigned char* b8 = ws + off + tcol * 256 + 64 * wc + 8 * fq;
#pragma unroll
            for (int ai = 0; ai < 2; ++ai)
#pragma unroll
                for (int mp = 0; mp < 2; ++mp) { const bool oddq = (fq & 1) != 0;
                    unsigned char* rowp = b8 + (size_t)(row0 + ai * 128 + (2 * mp + (oddq ? 1 : 0)) * 16) * ld - (oddq ? 8 : 0);
#pragma unroll
                    for (int bj = 0; bj < 2; ++bj) *(u32x4*)(rowp + 32 * bj) = pair16(pack8q(acc[ai][bj][2 * mp][0], acc[ai][bj][2 * mp][1]), pack8q(acc[ai][bj][2 * mp + 1][0], acc[ai][bj][2 * mp + 1][1]), oddq); }
        } else {
#pragma unroll
            for (int ai = 0; ai < 2; ++ai)
#pragma unroll
                for (int m = 0; m < 4; ++m) { bf16* rowp = base + (size_t)(row0 + ai * 128 + m * 16) * ld;
#pragma unroll
                    for (int bj = 0; bj < 2; ++bj) { f32x4 a = acc[ai][bj][m][0], b = acc[ai][bj][m][1];
#pragma unroll
                        for (int j = 0; j < 4; ++j) { a[j] = gelu_tanh(a[j]); b[j] = gelu_tanh(b[j]); }
                        st8(rowp + 32 * bj, a, b); } }
        }
        return false;
    }
};

struct PolMerge {
    static constexpr int NT = 8, LDA = D, LDB = D; static constexpr bool GATHER = false, FP8 = false, I8 = false, ROWDMA = false, IDDMA = false;
    pg8::StaticOrder so; const bf16* A; const bf16* Bt; const unsigned char* ga; const unsigned char* gb; unsigned char* out;
    unsigned* rmax; unsigned* rcnt; float* ms; unsigned* tmo; LAS unsigned char* shm;
    __device__ bool next(int i, Unit& u) const { u.e = i & 1; u.s0 = 0; u.cnt = 0; return so.tile(i >> 1, u.pm, u.pn); }
    __device__ const char* a_ptr(const Unit& u) const { return (const char*)(A + (size_t)u.pm * 256 * LDA + 512 * u.e); }
    __device__ const char* b_ptr(const Unit& u) const { return (const char*)(Bt + (size_t)u.pn * 256 * LDB + 512 * u.e); }
    __device__ void a_off(const Unit&, int, unsigned (&)[2][2]) const {}
    __device__ __forceinline__ void gates(const u32x2& w, f32x4& b0, f32x4& b1) const {
        const f32x2 p0 = __builtin_amdgcn_cvt_pk_f32_fp8((int)w.x, false), p1 = __builtin_amdgcn_cvt_pk_f32_fp8((int)w.x, true), p2 = __builtin_amdgcn_cvt_pk_f32_fp8((int)w.y, false), p3 = __builtin_amdgcn_cvt_pk_f32_fp8((int)w.y, true);
        b0 = (f32x4){p0[0], p0[1], p1[0], p1[1]}; b1 = (f32x4){p2[0], p2[1], p3[0], p3[1]};
    }
    __device__ __forceinline__ bool epi(f32x4 (&acc)[2][2][4][2], const Unit& u, int wr, int wc, int fr, int fq) const {
        const int row0 = u.pm * 256 + wr * 64 + fr, col0 = u.pn * 256 + 64 * wc + 8 * fq;
        const int tid = threadIdx.x;
        float rm[2][4];
#pragma unroll
        for (int ai = 0; ai < 2; ++ai) {
            u32x2 gbv[4][2]; u32x2 gav[4][2];
#pragma unroll
            for (int m = 0; m < 4; ++m) { const size_t o = (size_t)(row0 + ai * 128 + m * 16) * D + col0;
#pragma unroll
                for (int bj = 0; bj < 2; ++bj) { gbv[m][bj] = *(const u32x2*)(gb + o + 32 * bj); if (u.e == 0) gav[m][bj] = *(const u32x2*)(ga + o + 32 * bj); } }
#pragma unroll
            for (int m = 0; m < 4; ++m) { float mx = 0.f;
#pragma unroll
                for (int bj = 0; bj < 2; ++bj) {
                    f32x4 b0, b1; gates(gbv[m][bj], b0, b1);
                    if (u.e == 0) {
                        f32x4 a0, a1; gates(gav[m][bj], a0, a1);
#pragma unroll
                        for (int j = 0; j < 4; ++j) {
                            acc[ai][bj][m][0][j] *= (1.0f + fast_exp2(-LOG2E * b0[j])) * fast_rcp(1.0f + fast_exp2(-LOG2E * a0[j]));
                            acc[ai][bj][m][1][j] *= (1.0f + fast_exp2(-LOG2E * b1[j])) * fast_rcp(1.0f + fast_exp2(-LOG2E * a1[j])); }
                    } else {
#pragma unroll
                        for (int j = 0; j < 4; ++j) { acc[ai][bj][m][0][j] *= sigmoidf_(b0[j]); acc[ai][bj][m][1][j] *= sigmoidf_(b1[j]);
                            mx = fmaxf(mx, fmaxf(fabsf(acc[ai][bj][m][0][j]), fabsf(acc[ai][bj][m][1][j]))); }
                    }
                }
                rm[ai][m] = mx; }
        }
        if (u.e == 0) return true;
        LAS unsigned* lrm = (LAS unsigned*)(shm + ROWS_OFF);
#pragma unroll
        for (int ai = 0; ai < 2; ++ai)
#pragma unroll
            for (int m = 0; m < 4; ++m) { float mx = rm[ai][m]; mx = fmaxf(mx, __shfl_xor(mx, 16)); mx = fmaxf(mx, __shfl_xor(mx, 32));
                if (fq == 0) (void)__hip_atomic_fetch_max(lrm + (ai * 128 + wr * 64 + m * 16 + fr), __float_as_uint(mx), __ATOMIC_RELAXED, __HIP_MEMORY_SCOPE_WORKGROUP); }
        asm volatile("s_waitcnt lgkmcnt(0)\n\ts_barrier" ::: "memory");
        if (tid < 256) { const unsigned v = lrm[tid]; (void)__hip_atomic_fetch_max(rmax + u.pm * 256 + tid, v, RLX_AGENT); lrm[tid] = 0u; }
        asm volatile("s_waitcnt vmcnt(0) lgkmcnt(0)\n\ts_barrier" ::: "memory");
        if (tid == 0) { (void)__hip_atomic_fetch_add(rcnt + u.pm, 1u, RLX_AGENT);
            unsigned sp = 0; while (__hip_atomic_load(rcnt + u.pm, RLX_AGENT) < 4u) { __builtin_amdgcn_s_sleep(1);
                if ((++sp & 255u) == 0u) { if (__hip_atomic_load(tmo, RLX_AGENT)) break; if (sp > (1u << 18)) { atomicAdd(tmo, 1u); break; } } } }
        asm volatile("s_barrier" ::: "memory");
        float sc[2][4];
#pragma unroll
        for (int ai = 0; ai < 2; ++ai)
#pragma unroll
            for (int m = 0; m < 4; ++m) { const float cm = __uint_as_float(__hip_atomic_load(rmax + row0 + ai * 128 + m * 16, RLX_AGENT)); sc[ai][m] = cm > 0.f ? 127.0f / cm : 0.f; }
        if (u.pn == 0 && tid < 256) ms[u.pm * 256 + tid] = __uint_as_float(__hip_atomic_load(rmax + u.pm * 256 + tid, RLX_AGENT)) * (1.0f / 127.0f);
        const bool oddq = (fq & 1) != 0;
#pragma unroll
        for (int ai = 0; ai < 2; ++ai)
#pragma unroll
            for (int mp = 0; mp < 2; ++mp) {
                unsigned char* rowp = out + (size_t)(row0 + ai * 128 + (2 * mp + (oddq ? 1 : 0)) * 16) * D + col0 - (oddq ? 8 : 0);
#pragma unroll
                for (int bj = 0; bj < 2; ++bj) {
                    const u32x2 e0 = (u32x2){pack_i8(acc[ai][bj][2 * mp][0] * sc[ai][2 * mp]), pack_i8(acc[ai][bj][2 * mp][1] * sc[ai][2 * mp])};
                    const u32x2 e1 = (u32x2){pack_i8(acc[ai][bj][2 * mp + 1][0] * sc[ai][2 * mp + 1]), pack_i8(acc[ai][bj][2 * mp + 1][1] * sc[ai][2 * mp + 1])};
                    *(u32x4*)(rowp + 32 * bj) = pair16(e0, e1, oddq); } }
        return false;
    }
};

struct PolOut {
    static constexpr int NT = 8, LDA = 512, LDB = 512; static constexpr bool GATHER = false, FP8 = false, I8 = true, ROWDMA = true, IDDMA = false;
    pg8::StaticOrder so; const unsigned char* A; const unsigned char* Bt; const float* x; bf16* x1; unsigned char* x1q; const float* ms; const float* cs; LAS unsigned char* shm;
    __device__ bool next(int i, Unit& u) const { u.e = 0; u.s0 = 0; u.cnt = 0; u.idx = i; return so.tile(i, u.pm, u.pn); }
    __device__ const char* a_ptr(const Unit& u) const { return (const char*)(A + (size_t)u.pm * 256 * 1024); }
    __device__ const char* b_ptr(const Unit& u) const { return (const char*)(Bt + (size_t)u.pn * 256 * 1024); }
    __device__ void a_off(const Unit&, int, unsigned (&)[2][2]) const {}
    __device__ __forceinline__ void row_dma(const Unit& u, LAS unsigned char* lds, int wid, int lane) const {
        const unsigned* src = (wid < 4) ? (const unsigned*)(ms + u.pm * 256 + 64 * wid + lane) : (const unsigned*)(cs + u.pn * 256 + 64 * (wid & 3) + lane);
        __builtin_amdgcn_global_load_lds(src, (LAS unsigned*)(lds + ROWS_OFF + (u.idx & 1) * ROWS_BUF + 256 * wid), 4, 0, 0);
    }
    __device__ __forceinline__ bool epi(f32x4 (&acc)[2][2][4][2], const Unit& u, int wr, int wc, int fr, int fq) const {
        const int row0 = u.pm * 256 + wr * 64 + fr, col0 = u.pn * 256 + 64 * wc + 8 * fq;
        const LAS float* hsr = (const LAS float*)(shm + ROWS_OFF + (u.idx & 1) * ROWS_BUF) + wr * 64 + fr;
        const LAS float* csp = (const LAS float*)(shm + ROWS_OFF + (u.idx & 1) * ROWS_BUF + 1024) + 64 * wc + 8 * fq;
        f32x4 cv[2][2];
#pragma unroll
        for (int b = 0; b < 2; ++b)
#pragma unroll
            for (int n = 0; n < 2; ++n) cv[b][n] = *(const LAS f32x4*)(csp + 32 * b + 4 * n);
        const bool oddq = (fq & 1) != 0;
#pragma unroll
        for (int ai = 0; ai < 2; ++ai)
#pragma unroll
            for (int mp = 0; mp < 2; ++mp) {
                f32x4 xv[2][2][2]; u32x2 xqp[2][2];
#pragma unroll
                for (int mm = 0; mm < 2; ++mm) { const size_t o = (size_t)(row0 + ai * 128 + (2 * mp + mm) * 16) * D + col0;
#pragma unroll
                    for (int bj = 0; bj < 2; ++bj) { xv[mm][bj][0] = *(const f32x4*)(x + o + 32 * bj); xv[mm][bj][1] = *(const f32x4*)(x + o + 32 * bj + 4); } }
#pragma unroll
                for (int mm = 0; mm < 2; ++mm) { const int m = 2 * mp + mm; const size_t o = (size_t)(row0 + ai * 128 + m * 16) * D + col0; const float hv = hsr[ai * 128 + m * 16];
#pragma unroll
                    for (int bj = 0; bj < 2; ++bj) {
                        const pg8::v4i_t i0_ = __builtin_bit_cast(pg8::v4i_t, acc[ai][bj][m][0]), i1_ = __builtin_bit_cast(pg8::v4i_t, acc[ai][bj][m][1]);
                        const f32x4 r0 = xv[mm][bj][0] + (f32x4){(float)i0_.x, (float)i0_.y, (float)i0_.z, (float)i0_.w} * hv * cv[bj][0];
                        const f32x4 r1 = xv[mm][bj][1] + (f32x4){(float)i1_.x, (float)i1_.y, (float)i1_.z, (float)i1_.w} * hv * cv[bj][1];
                        st8(x1 + o + 32 * bj, r0, r1); xqp[mm][bj] = pack8q(r0, r1);
                        if (mm) *(u32x4*)(x1q + o - (oddq ? 0 : 16 * D) - (oddq ? 8 : 0) + 32 * bj) = pair16(xqp[0][bj], xqp[1][bj], oddq);
                    } } }
        return false;
    }
};

struct MoeOrder {
    const LAS int* tb;
    int NN, nwg, G, c;
    __device__ void init(const LAS int* tb_, int NN_, int G_, int c_) { tb = tb_; NN = NN_; G = G_; c = c_; nwg = tb_[32] * NN_; }
    __device__ bool unit(int i, Unit& u) const {
        const long L = (long)i * G + c; if (L >= nwg) return false;
        int wgid = (int)L; { const int q = nwg / 8, r = nwg % 8, xcd = wgid % 8, off = wgid / 8; wgid = (xcd < r ? xcd * (q + 1) : r * (q + 1) + (xcd - r) * q) + off; }
        const int Mt = wgid / NN;
        const int ln = threadIdx.x & 63;
        const unsigned long long bal = __ballot(ln < NE && tb[ln & 31] <= Mt);
        const int e = __popcll(bal) - 1;
        u.idx = i; u.pm = __builtin_amdgcn_readfirstlane(Mt); u.pn = __builtin_amdgcn_readfirstlane(wgid % NN); u.e = __builtin_amdgcn_readfirstlane(e);
        u.s0 = __builtin_amdgcn_readfirstlane((Mt - tb[e]) * 256); u.cnt = __builtin_amdgcn_readfirstlane(tb[33 + e]);
        return true;
    }
};

struct PolGU {
    static constexpr int NT = 8, LDA = 512, LDB = 512; static constexpr bool GATHER = true, FP8 = true, I8 = false, ROWDMA = true, IDDMA = true;
    MoeOrder mo; const unsigned char* A; const unsigned char* Bt; const int* lid; const float* lrs; const float* bgu; unsigned char* act; LAS unsigned char* shm;
    __device__ __forceinline__ void row_dma(const Unit& u, LAS unsigned char* lds, int wid, int lane) const {
        const unsigned* src = (wid < 4) ? (const unsigned*)(lrs + (size_t)u.e * LCAP + u.s0 + 64 * wid + lane)
                                        : (const unsigned*)(bgu + (size_t)u.e * 2048 + u.pn * 128 + 1024 * ((wid >> 1) & 1) + 64 * (wid & 1) + lane);
        __builtin_amdgcn_global_load_lds(src, (LAS unsigned*)(lds + ROWS_OFF + (u.idx & 1) * ROWS_BUF + 256 * wid), 4, 0, 0);
    }
    __device__ bool next(int i, Unit& u) const { return mo.unit(i, u); }
    __device__ __forceinline__ void ids_dma(const Unit& nx, const Unit& cu, LAS unsigned char* lds, int wid, int lane) const {
        if (wid < 4) __builtin_amdgcn_global_load_lds((const unsigned*)(lid + (size_t)nx.e * LCAP + nx.s0 + 64 * wid + lane), (LAS unsigned*)(lds + ROWS_OFF + (cu.idx & 1) * ROWS_BUF + 2048 + 256 * wid), 4, 0, 0);
    }
    __device__ __forceinline__ void a_off_lds(const Unit& nx, const Unit& cu, int tid, LAS unsigned char* lds, unsigned (&v)[2][2]) const {
        const LAS int* l = (const LAS int*)(lds + ROWS_OFF + (cu.idx & 1) * ROWS_BUF + 2048);
#pragma unroll
        for (int i = 0; i < 2; ++i) { int R, C; pg8::stage_rc(tid * 16 + i * 8192, R, C);
#pragma unroll
            for (int h = 0; h < 2; ++h) { const int s = h * 128 + R; const int id = l[s]; const int tok = (nx.s0 + s < nx.cnt) ? (id >> 2) : 0; v[h][i] = (unsigned)(tok * LDA + C) * 2u; } }
    }
    __device__ const char* a_ptr(const Unit&) const { return (const char*)A; }
    __device__ const char* b_ptr(const Unit& u) const { return (const char*)(Bt + ((size_t)u.e * 2048 + (size_t)u.pn * 256) * 1024); }
    __device__ __forceinline__ void a_off(const Unit& u, int tid, unsigned (&v)[2][2]) const {
        const int* l = lid + (size_t)u.e * LCAP;
#pragma unroll
        for (int i = 0; i < 2; ++i) { int R, C; pg8::stage_rc(tid * 16 + i * 8192, R, C);
#pragma unroll
            for (int h = 0; h < 2; ++h) { const int s = u.s0 + h * 128 + R; const int id = l[s]; const int tok = (s < u.cnt) ? (id >> 2) : 0; v[h][i] = (unsigned)(tok * LDA + C) * 2u; } }
    }
    __device__ __forceinline__ bool epi(f32x4 (&acc)[2][2][4][2], const Unit& u, int wr, int wc, int fr, int fq) const {
        const LAS float* rsl = (const LAS float*)(shm + ROWS_OFF + (u.idx & 1) * ROWS_BUF);
        const LAS float* bg = (const LAS float*)(shm + ROWS_OFF + (u.idx & 1) * ROWS_BUF + 1024) + 32 * wc + 8 * fq;
        const f32x4 bg0 = *(const LAS f32x4*)bg, bg1 = *(const LAS f32x4*)(bg + 4), bu0 = *(const LAS f32x4*)(bg + 128), bu1 = *(const LAS f32x4*)(bg + 132);
        unsigned char* ob = act + (size_t)u.pm * 256 * FF + u.pn * 128 + 32 * wc + 8 * fq;
        float rsv[2][4];
#pragma unroll
        for (int ai = 0; ai < 2; ++ai)
#pragma unroll
            for (int m = 0; m < 4; ++m) { const int r = ai * 128 + wr * 64 + m * 16 + fr; const bool valid = (u.s0 + r < u.cnt); const float t_ = rsl[r]; rsv[ai][m] = valid ? t_ * WQ_INV : 0.f; }
        const bool oddq = (fq & 1) != 0; u32x2 pkq[2];
#pragma unroll
        for (int ai = 0; ai < 2; ++ai)
#pragma unroll
            for (int m = 0; m < 4; ++m) { const int r = ai * 128 + wr * 64 + m * 16 + fr; const float rs = rsv[ai][m];
                f32x4 o[2];
#pragma unroll
                for (int n = 0; n < 2; ++n)
#pragma unroll
                    for (int h2 = 0; h2 < 2; ++h2) {
                        const f32x2 ag = {acc[ai][0][m][n][2 * h2], acc[ai][0][m][n][2 * h2 + 1]}, au = {acc[ai][1][m][n][2 * h2], acc[ai][1][m][n][2 * h2 + 1]};
                        const f32x2 bgv = n ? (f32x2){bg1[2 * h2], bg1[2 * h2 + 1]} : (f32x2){bg0[2 * h2], bg0[2 * h2 + 1]}, buv = n ? (f32x2){bu1[2 * h2], bu1[2 * h2 + 1]} : (f32x2){bu0[2 * h2], bu0[2 * h2 + 1]};
                        f32x2 g = ag * rs + bgv, up = au * rs + buv;
                        g = __builtin_elementwise_min(g, (f32x2){7.0f, 7.0f});
                        up.x = __builtin_amdgcn_fmed3f(up.x, -7.0f, 7.0f); up.y = __builtin_amdgcn_fmed3f(up.y, -7.0f, 7.0f);
                        const f32x2 t = g * (-1.702f * LOG2E);
                        f32x2 e; e.x = fast_exp2(t.x); e.y = fast_exp2(t.y);
                        const f32x2 den = e + 1.0f;
                        f32x2 rc; rc.x = fast_rcp(den.x); rc.y = fast_rcp(den.y);
                        const f32x2 res = (up + 1.0f) * (g * rc);
                        o[n][2 * h2] = res.x; o[n][2 * h2 + 1] = res.y; }
                pkq[m & 1] = pack8q(o[0], o[1]);
                if (m & 1) *(u32x4*)(ob + (size_t)(r - (oddq ? 0 : 16)) * FF - (oddq ? 8 : 0)) = pair16(pkq[0], pkq[1], oddq); }
        return false;
    }
};

struct PolDown {
    static constexpr int NT = 8, LDA = 512, LDB = 512; static constexpr bool GATHER = true, FP8 = true, I8 = false, ROWDMA = true, IDDMA = false;
    MoeOrder mo; const unsigned char* A; const unsigned char* Bt; const int* lid; const float* lp; const float* bd; unsigned char* y; LAS unsigned char* shm;
    __device__ __forceinline__ void row_dma(const Unit& u, LAS unsigned char* lds, int wid, int lane) const {
        const size_t o = (size_t)u.e * LCAP + u.s0 + 64 * (wid & 3) + lane;
        const unsigned* src = (wid < 4) ? (const unsigned*)(lid + o) : (const unsigned*)(lp + o);
        __builtin_amdgcn_global_load_lds(src, (LAS unsigned*)(lds + ROWS_OFF + (u.idx & 1) * ROWS_BUF + 256 * wid), 4, 0, 0);
        if (wid < 4) __builtin_amdgcn_global_load_lds((const unsigned*)(bd + (size_t)u.e * D + u.pn * 256 + 64 * wid + lane), (LAS unsigned*)(lds + ROWS_OFF + (u.idx & 1) * ROWS_BUF + 2048 + 256 * wid), 4, 0, 0);
    }
    __device__ bool next(int i, Unit& u) const { return mo.unit(i, u); }
    __device__ const char* a_ptr(const Unit& u) const { return (const char*)(A + (size_t)u.pm * 256 * 1024); }
    __device__ const char* b_ptr(const Unit& u) const { return (const char*)(Bt + ((size_t)u.e * 1024 + (size_t)u.pn * 256) * 1024); }
    __device__ __forceinline__ void a_off(const Unit&, int tid, unsigned (&v)[2][2]) const {
#pragma unroll
        for (int i = 0; i < 2; ++i) { int R, C; pg8::stage_rc(tid * 16 + i * 8192, R, C); v[0][i] = (unsigned)(R * LDA + C) * 2u; v[1][i] = (unsigned)((R + 128) * LDA + C) * 2u; }
    }
    __device__ __forceinline__ bool epi(f32x4 (&acc)[2][2][4][2], const Unit& u, int wr, int wc, int fr, int fq) const {
        const LAS int* idl = (const LAS int*)(shm + ROWS_OFF + (u.idx & 1) * ROWS_BUF); const LAS float* pl = (const LAS float*)(shm + ROWS_OFF + (u.idx & 1) * ROWS_BUF + 1024);
        const int col0 = u.pn * 256 + 64 * wc + 8 * fq;
        const LAS float* b = (const LAS float*)(shm + ROWS_OFF + (u.idx & 1) * ROWS_BUF + 2048) + 64 * wc + 8 * fq;
        int idv[2][4]; float pv_[2][4];
#pragma unroll
        for (int ai = 0; ai < 2; ++ai)
#pragma unroll
            for (int m = 0; m < 4; ++m) { const int r = ai * 128 + wr * 64 + m * 16 + fr; const bool valid = (u.s0 + r < u.cnt);
                const int t_ = idl[r]; const float q_ = pl[r]; idv[ai][m] = valid ? t_ : T * 4; pv_[ai][m] = q_; }
        f32x4 bv[2][2];
#pragma unroll
        for (int bj = 0; bj < 2; ++bj)
#pragma unroll
            for (int n = 0; n < 2; ++n) bv[bj][n] = *(const LAS f32x4*)(b + 32 * bj + 4 * n);
        const bool oddq = (fq & 1) != 0;
#pragma unroll
        for (int ai = 0; ai < 2; ++ai)
#pragma unroll
            for (int mp = 0; mp < 2; ++mp) {
                const float p0 = pv_[ai][2 * mp] * 16.0f, p1 = pv_[ai][2 * mp + 1] * 16.0f;
                unsigned char* op = y + (size_t)(oddq ? idv[ai][2 * mp + 1] : idv[ai][2 * mp]) * D + (col0 - (oddq ? 8 : 0));
#pragma unroll
                for (int bj = 0; bj < 2; ++bj) {
                    const u32x2 e0 = pack8q((acc[ai][bj][2 * mp][0] * WQ_INV + bv[bj][0]) * p0, (acc[ai][bj][2 * mp][1] * WQ_INV + bv[bj][1]) * p0);
                    const u32x2 e1 = pack8q((acc[ai][bj][2 * mp + 1][0] * WQ_INV + bv[bj][0]) * p1, (acc[ai][bj][2 * mp + 1][1] * WQ_INV + bv[bj][1]) * p1);
                    const u32x2 snd = oddq ? e0 : e1;
                    u32x2 rcv; rcv.x = (unsigned)__shfl_xor((int)snd.x, 16); rcv.y = (unsigned)__shfl_xor((int)snd.y, 16);
                    const u32x4 w = oddq ? (u32x4){rcv.x, rcv.y, e1.x, e1.y} : (u32x4){e0.x, e0.y, rcv.x, rcv.y};
                    *(u32x4*)(op + 32 * bj) = w; } }
        return false;
    }
};

constexpr int CONV_GU_ITEMS = NE * 16 * 32, CONV_D_ITEMS = NE * 16 * 16, CONV_ITEMS = CONV_GU_ITEMS + CONV_D_ITEMS, CONV_PER_WAVE = CONV_ITEMS / 2048;
static_assert(CONV_PER_WAVE * 2048 == CONV_ITEMS, "items divide over 2048 waves");
struct MoeConv {
    const float* wgu; const float* wd; const float* g2; unsigned char* WGU8; unsigned char* WD8;
    struct Regs { f32x4 v0, v1, v2, v3, v4, v5, v6, v7, v8, v9, v10, v11, v12, v13, v14, v15; };
    __device__ __forceinline__ void src_of(int item, const float*& W, int& N, int& k0, int& n0) const {
        if (item < CONV_GU_ITEMS) { const int e = item >> 9, q = item & 511; W = wgu + (size_t)e * D * 2048; N = 2048; k0 = 64 * (q >> 5); n0 = 64 * (q & 31); }
        else { const int r = item - CONV_GU_ITEMS, e = r >> 8, q = r & 255; W = wd + (size_t)e * FF * D; N = D; k0 = 64 * (q >> 4); n0 = 64 * (q & 15); }
    }
    __device__ __forceinline__ void finish(Regs& R, int item, int lane) const {
        const float* W; int N, k0, n0; src_of(item, W, N, k0, n0);
        const int kc = lane >> 4, nq = lane & 15; const bool gu = item < CONV_GU_ITEMS;
        float sc[16];
        if (gu) { const f32x4* gp = (const f32x4*)(g2 + k0 + 16 * kc);
#pragma unroll
            for (int q = 0; q < 4; ++q) { const f32x4 t = gp[q]; sc[4 * q] = t[0] * 32.0f; sc[4 * q + 1] = t[1] * 32.0f; sc[4 * q + 2] = t[2] * 32.0f; sc[4 * q + 3] = t[3] * 32.0f; } }
        else {
#pragma unroll
            for (int i = 0; i < 16; ++i) sc[i] = 32.0f; }
        const int nb = n0 + 32 * (nq >> 3);
        const int e = gu ? (item >> 9) : ((item - CONV_GU_ITEMS) >> 8);
        const int up = nb >= 1024, cc = nb & 1023;
        const int pos = gu ? ((cc >> 7) * 256 + up * 128 + ((cc >> 5) & 3) * 32) : ((nb & ~255) + ((nb >> 5) & 1) * 128 + ((nb >> 6) & 3) * 32);
        unsigned char* base = (gu ? (WGU8 + ((size_t)e * 2048 + pos + ((4 * nq) & 31)) * 1024) : (WD8 + ((size_t)e * 1024 + pos + ((4 * nq) & 31)) * 1024)) + k0 + 16 * kc;
#pragma unroll
        for (int c = 0; c < 4; ++c) {
            int w0 = 0, w1 = 0, w2 = 0, w3 = 0;
            w0 = __builtin_amdgcn_cvt_pk_fp8_f32(R.v0[c] * sc[0], R.v1[c] * sc[1], w0, false); w0 = __builtin_amdgcn_cvt_pk_fp8_f32(R.v2[c] * sc[2], R.v3[c] * sc[3], w0, true);
            w1 = __builtin_amdgcn_cvt_pk_fp8_f32(R.v4[c] * sc[4], R.v5[c] * sc[5], w1, false); w1 = __builtin_amdgcn_cvt_pk_fp8_f32(R.v6[c] * sc[6], R.v7[c] * sc[7], w1, true);
            w2 = __builtin_amdgcn_cvt_pk_fp8_f32(R.v8[c] * sc[8], R.v9[c] * sc[9], w2, false); w2 = __builtin_amdgcn_cvt_pk_fp8_f32(R.v10[c] * sc[10], R.v11[c] * sc[11], w2, true);
            w3 = __builtin_amdgcn_cvt_pk_fp8_f32(R.v12[c] * sc[12], R.v13[c] * sc[13], w3, false); w3 = __builtin_amdgcn_cvt_pk_fp8_f32(R.v14[c] * sc[14], R.v15[c] * sc[15], w3, true);
            *(u32x4*)(base + (size_t)c * 1024) = (u32x4){(unsigned)w0, (unsigned)w1, (unsigned)w2, (unsigned)w3};
        }
    }
    template <int SUB> __device__ __forceinline__ void sub(Regs& R, int& st, int item0, int istride, int lane) const {
        if (SUB == 0 && (st & 1)) { finish(R, item0 + ((st >> 1) - 1) * istride, lane); st &= ~1; }
        const int it = st >> 1;
        {
            const int itc = it < CONV_PER_WAVE ? it : CONV_PER_WAVE - 1;
            const float* W; int N, k0, n0; src_of(item0 + itc * istride, W, N, k0, n0);
            const float* p = W + (size_t)(k0 + 16 * (lane >> 4) + 4 * SUB) * N + n0 + 4 * (lane & 15);
            const f32x4 t0 = *(const f32x4*)p, t1 = *(const f32x4*)(p + N), t2 = *(const f32x4*)(p + 2 * (size_t)N), t3 = *(const f32x4*)(p + 3 * (size_t)N);
            if (SUB == 0) { R.v0 = t0; R.v1 = t1; R.v2 = t2; R.v3 = t3; }
            else if (SUB == 1) { R.v4 = t0; R.v5 = t1; R.v6 = t2; R.v7 = t3; }
            else if (SUB == 2) { R.v8 = t0; R.v9 = t1; R.v10 = t2; R.v11 = t3; }
            else { R.v12 = t0; R.v13 = t1; R.v14 = t2; R.v15 = t3; if (it < CONV_PER_WAVE) st = ((it + 1) << 1) | 1; }
        }
    }
    __device__ __forceinline__ void drain(Regs& R, int& st, int item0, int istride, int lane) const {
        if (st & 1) { finish(R, item0 + ((st >> 1) - 1) * istride, lane); st &= ~1; }
        for (int it = st >> 1; it < CONV_PER_WAVE; ++it) { sub<0>(R, st, item0, istride, lane); sub<1>(R, st, item0, istride, lane); sub<2>(R, st, item0, istride, lane); sub<3>(R, st, item0, istride, lane);
            finish(R, item0 + it * istride, lane); st &= ~1; }
    }
};

namespace att {
constexpr int PITCH = 512, SLOTB = 8192;
__device__ __forceinline__ u32x4 f8x8_bf16(const u32x2& w, float s) {
    const f32x2 a = __builtin_amdgcn_cvt_pk_f32_fp8((int)w.x, false), b = __builtin_amdgcn_cvt_pk_f32_fp8((int)w.x, true), c = __builtin_amdgcn_cvt_pk_f32_fp8((int)w.y, false), d = __builtin_amdgcn_cvt_pk_f32_fp8((int)w.y, true);
    return (u32x4){cvt_pk_bf16(a[0] * s, a[1] * s), cvt_pk_bf16(b[0] * s, b[1] * s), cvt_pk_bf16(c[0] * s, c[1] * s), cvt_pk_bf16(d[0] * s, d[1] * s)};
}
constexpr int L_K = 0, L_V = 2 * SLOTB, L_TBL = 4 * SLOTB, L_WS = L_TBL + 4096, L_OST = L_WS + 8 * 256, L_END = L_OST + 8 * 4096;
constexpr int NTBL = 832;
__device__ __forceinline__ int crow(int r, int hi) { return (r & 3) + 8 * (r >> 2) + 4 * hi; }
__device__ __forceinline__ void glds16(const void* gsrc, unsigned lds_dst) { unsigned keep;
    asm volatile("s_mov_b32 %0, m0\n\ts_mov_b32 m0, %2\n\ts_nop 0\n\tglobal_load_lds_dwordx4 %1, off\n\ts_mov_b32 m0, %0" : "=&s"(keep) : "v"(gsrc), "s"(lds_dst) : "memory"); }
__device__ __forceinline__ unsigned cvtpk_s(float lo, float hi) { typedef __bf16 bf16x2_t __attribute__((ext_vector_type(2))); f32x2 v = {lo, hi}; bf16x2_t b = __builtin_convertvector(v, bf16x2_t); return __builtin_bit_cast(unsigned, b); }
#define ATT_SBAR() __builtin_amdgcn_sched_barrier(0)
__device__ __forceinline__ void pv(f32x16* o, int vb, bf16x8 pa0, bf16x8 pa1, bf16x8 pa2, bf16x8 pa3) {
#pragma unroll
    for (int d0 = 0; d0 < 2; ++d0) { s16x4 lo[4], hi[4];
#pragma unroll
        for (int ks = 0; ks < 4; ++ks) {
            asm volatile("ds_read_b64_tr_b16 %0,%1 offset:%c2" : "=&v"(lo[ks]) : "v"(vb), "i"(d0 * 4096 + ks * 1024) : "memory");
            asm volatile("ds_read_b64_tr_b16 %0,%1 offset:%c2" : "=&v"(hi[ks]) : "v"(vb), "i"(d0 * 4096 + ks * 1024 + 512) : "memory"); }
        asm volatile("s_waitcnt lgkmcnt(0)" ::: "memory"); ATT_SBAR();
#define ATT_PK(k) (bf16x8){lo[k][0], lo[k][1], lo[k][2], lo[k][3], hi[k][0], hi[k][1], hi[k][2], hi[k][3]}
        o[d0] = __builtin_amdgcn_mfma_f32_32x32x16_bf16(pa0, ATT_PK(0), o[d0], 0, 0, 0);
        o[d0] = __builtin_amdgcn_mfma_f32_32x32x16_bf16(pa1, ATT_PK(1), o[d0], 0, 0, 0);
        o[d0] = __builtin_amdgcn_mfma_f32_32x32x16_bf16(pa2, ATT_PK(2), o[d0], 0, 0, 0);
        o[d0] = __builtin_amdgcn_mfma_f32_32x32x16_bf16(pa3, ATT_PK(3), o[d0], 0, 0, 0);
#undef ATT_PK
    }
}
__device__ __forceinline__ void unit(int b, int h, int cg, const unsigned char* Q, const unsigned char* K, const unsigned char* V, const float* relb, bf16* O  , LAS unsigned char* shm,
                                     const MoeConv& cv, MoeConv::Regs& sreg, int& sctr, int item0, int istride) {
    const int tid = threadIdx.x, lane = tid & 63, r32 = lane & 31, hi = lane >> 5; const int wid = __builtin_amdgcn_readfirstlane(tid >> 6);
    const long rowbase = (long)b * SEQ; const int cq = 4 * cg + (wid >> 1), wq = wid & 1;
    const unsigned char* Qw = Q + (rowbase + 64 * cq + 32 * wq) * PITCH + h * HD;
    const unsigned lds0 = (unsigned)(uintptr_t)shm;
    LAS float* tbl = (LAS float*)(shm + L_TBL);
    LAS float* wsf = (LAS float*)(shm + L_WS) + wid * 64;
    for (int i = tid; i < NTBL; i += 512) tbl[i] = relb[h * NREL + (i < 512 ? i : 512)] * LOG2E;
    const int srow = tid >> 3, sc = tid & 7;
    const unsigned char* ksrc = K + (rowbase + srow) * PITCH + h * HD + sc * 8;
    const unsigned char* vsrc = V + (rowbase + srow) * PITCH + h * HD + sc * 8;
    const int kwr = L_K + sc * 1024 + ((srow ^ sc) << 4);
    const int vwr = L_V + (4 * (sc >> 2) + (srow >> 4)) * 1024 + (srow & 15) * 64 + (sc & 3) * 16;
    const int vb0 = (int)(lds0 + L_V) + ((lane >> 4) & 1) * 32 + (lane & 3) * 8 + (4 * hi + ((lane & 15) >> 2)) * 64;
    int kra[4];
#pragma unroll
    for (int d0 = 0; d0 < 4; ++d0) kra[d0] = L_K + (2 * d0 + hi) * 1024 + ((r32 ^ (2 * d0 + hi)) << 4);
    bf16x8 qr[4];
#pragma unroll
    for (int d0 = 0; d0 < 4; ++d0) qr[d0] = __builtin_bit_cast(bf16x8, f8x8_bf16(*(const u32x2*)(Qw + (long)r32 * PITCH + d0 * 16 + hi * 8), 0.125f * LOG2E));
    f32x16 o[2]; o[0] = f32x16{}; o[1] = f32x16{}; float l_reg = 0.f;
    const int j0 = (8 - 4 * cg) > 0 ? (8 - 4 * cg) : 0;
    u32x2 kA_, vA_, kB_, vB_;
    { const long ro = (long)(4 * cg - 8 + j0) * 64 * PITCH; kA_ = *(const u32x2*)(ksrc + ro); vA_ = *(const u32x2*)(vsrc + ro); kB_ = *(const u32x2*)(ksrc + ro + 64 * PITCH); vB_ = *(const u32x2*)(vsrc + ro + 64 * PITCH); }
#define ATT_STEP(JX, SUBP, KR, VR) do { const int j = (JX); \
        const int s = (j - j0) & 1; \
        *(LAS u32x4*)(shm + kwr + s * SLOTB) = f8x8_bf16(KR, 1.0f); *(LAS u32x4*)(shm + vwr + s * SLOTB) = f8x8_bf16(VR, 1.0f); \
        if (j < 10) { const long ro = (long)(4 * cg - 8 + j + 2) * 64 * PITCH; KR = *(const u32x2*)(ksrc + ro); VR = *(const u32x2*)(vsrc + ro); } \
        asm volatile("s_waitcnt lgkmcnt(0)\n\ts_barrier" ::: "memory"); \
        cv.template sub<SUBP>(sreg, sctr, item0, istride, lane);     \
        const int d = (wid >> 1) + 8 - j; \
        if (d >= 0 && d <= 8) { \
            f32x16 p0 = f32x16{}, p1 = f32x16{}; \
            const LAS unsigned char* kbs = shm + s * SLOTB; \
        _Pragma("unroll") \
            for (int d0 = 0; d0 < 4; ++d0) { \
                const bf16x8 b0 = *(const LAS bf16x8*)(kbs + kra[d0]), b1 = *(const LAS bf16x8*)(kbs + kra[d0] + 512); \
                p0 = __builtin_amdgcn_mfma_f32_32x32x16_bf16(b0, qr[d0], p0, 0, 0, 0); p1 = __builtin_amdgcn_mfma_f32_32x32x16_bf16(b1, qr[d0], p1, 0, 0, 0); } \
            const LAS float* tb = tbl + (256 + 64 * d + 32 * wq + r32 - 4 * hi - 63); \
            float sacc = 0.f; \
        _Pragma("unroll") \
            for (int r = 0; r < 16; ++r) { const int c = (r & 3) + 8 * (r >> 2); \
                p0[r] = fast_exp2(p0[r] + tb[63 - c]); p1[r] = fast_exp2(p1[r] + tb[31 - c]); sacc += p0[r] + p1[r]; } \
            l_reg += sacc; \
            u32x4 pw0, pw1, pw2, pw3; \
            pw0 = (u32x4){cvtpk_s(p0[0], p0[1]), cvtpk_s(p0[2], p0[3]), cvtpk_s(p0[4], p0[5]), cvtpk_s(p0[6], p0[7])}; \
            pw1 = (u32x4){cvtpk_s(p0[8], p0[9]), cvtpk_s(p0[10], p0[11]), cvtpk_s(p0[12], p0[13]), cvtpk_s(p0[14], p0[15])}; \
            pw2 = (u32x4){cvtpk_s(p1[0], p1[1]), cvtpk_s(p1[2], p1[3]), cvtpk_s(p1[4], p1[5]), cvtpk_s(p1[6], p1[7])}; \
            pw3 = (u32x4){cvtpk_s(p1[8], p1[9]), cvtpk_s(p1[10], p1[11]), cvtpk_s(p1[12], p1[13]), cvtpk_s(p1[14], p1[15])}; \
            ATT_SBAR(); \
            pv(o, vb0 + s * SLOTB, __builtin_bit_cast(bf16x8, pw0), __builtin_bit_cast(bf16x8, pw1), __builtin_bit_cast(bf16x8, pw2), __builtin_bit_cast(bf16x8, pw3)); \
        } \
    } while (0)
    for (int jb = j0; jb < 12; jb += 4) { ATT_STEP(jb, 0, kA_, vA_); ATT_STEP(jb + 1, 1, kB_, vB_); ATT_STEP(jb + 2, 2, kA_, vA_); ATT_STEP(jb + 3, 3, kB_, vB_); }
#undef ATT_STEP
    asm volatile("s_waitcnt lgkmcnt(0)\n\ts_barrier" ::: "memory");
    { auto rr = __builtin_amdgcn_permlane32_swap(__float_as_uint(l_reg), __float_as_uint(l_reg), false, false); l_reg = __uint_as_float(rr[0]) + __uint_as_float(rr[1]); }
    if (hi == 0) wsf[32 + r32] = l_reg; asm volatile("s_waitcnt lgkmcnt(0)" ::: "memory");
    float rli[16];
#pragma unroll
    for (int r = 0; r < 16; ++r) rli[r] = fast_rcp(wsf[32 + crow(r, hi)]);
    bf16* Ow = O + (rowbase + 64 * cq + 32 * wq) * D + h * HD;
    { LAS bf16* stg = (LAS bf16*)(shm + L_OST) + wid * 2048;
#pragma unroll
        for (int r = 0; r < 16; ++r) { const int orow = crow(r, hi);
#pragma unroll
            for (int d0 = 0; d0 < 2; ++d0) stg[orow * 64 + d0 * 32 + r32] = (bf16)f2bf(o[d0][r] * rli[r]); }
        asm volatile("s_waitcnt lgkmcnt(0)" ::: "memory");
#pragma unroll
        for (int i = 0; i < 4; ++i) { const int row = i * 8 + (lane >> 3), ch = lane & 7; const u32x4 v = *(const LAS u32x4*)(stg + row * 64 + ch * 8); *(u32x4*)(Ow + (long)row * D + ch * 8) = v; } }
    asm volatile("s_waitcnt lgkmcnt(0)\n\ts_barrier" ::: "memory");
}
#undef ATT_SBAR
}

constexpr int SGU_WM_OFF = 128 * 136 * 2;
__device__ __forceinline__ void sgu_load_wm(int g, const bf16* WM, LAS unsigned char* shm) {
    const int tid = threadIdx.x, t = tid >> 2, c0 = (tid & 3) * 32;
    const bf16* src = WM + ((size_t)g * 128 + t) * 128 + c0;
#pragma unroll
    for (int q = 0; q < 4; ++q) *(LAS u32x4*)(shm + SGU_WM_OFF + (t * 136 + c0 + 8 * q) * 2) = *(const u32x4*)(src + 8 * q);
}
__device__ __forceinline__ void sgu_item(int item, const bf16* VG, const bf16* UG, const float* lng, const float* lnb, const float* sgb, bf16* YC, LAS unsigned char* shm,
                                         const MoeConv& cv, MoeConv::Regs& sreg, int& sctr, int item0, int istride) {
    const int tid = threadIdx.x, lane = tid & 63; const int wid = __builtin_amdgcn_readfirstlane(tid >> 6);
    const int g = item & 3, blk = item >> 2;
    const long t0 = (long)blk * 128;
    LAS bf16* vt = (LAS bf16*)shm;
    const LAS bf16* wmL = (const LAS bf16*)(shm + SGU_WM_OFF);
    const int ch = tid & 15, fr = lane & 15, fq = lane >> 4;
    u32x4 vraw[4];
#pragma unroll
    for (int it = 0; it < 4; ++it) vraw[it] = *(const u32x4*)(VG + (t0 + (tid >> 4) + 32 * it) * SGW + g * 128 + ch * 8);
    u32x2 uw[8]; float bs[8];
#pragma unroll
    for (int tt = 0; tt < 8; ++tt) { const int t = 16 * tt + fr; uw[tt] = *(const u32x2*)(UG + (size_t)(t0 + t) * SGW + g * 128 + 16 * wid + 4 * fq); bs[tt] = sgb[g * 128 + t]; }
    const f32x4 gA = *(const f32x4*)(lng + g * 128 + ch * 8), gB = *(const f32x4*)(lng + g * 128 + ch * 8 + 4);
    const f32x4 bA = *(const f32x4*)(lnb + g * 128 + ch * 8), bB = *(const f32x4*)(lnb + g * 128 + ch * 8 + 4);
#pragma unroll
    for (int it = 0; it < 4; ++it) {
        const int s = (tid >> 4) + 32 * it;
        const u32x4 w = vraw[it];
        f32x4 a = (f32x4){bflo(w.x), bfhi(w.x), bflo(w.y), bfhi(w.y)}, b = (f32x4){bflo(w.z), bfhi(w.z), bflo(w.w), bfhi(w.w)};
        float sum = (a[0] + a[1]) + (a[2] + a[3]) + (b[0] + b[1]) + (b[2] + b[3]);
        sum += __shfl_xor(sum, 1); sum += __shfl_xor(sum, 2); sum += __shfl_xor(sum, 4); sum += __shfl_xor(sum, 8);
        const float mean = sum * (1.0f / 128.0f);
        a = a - mean; b = b - mean;
        float q = (a[0] * a[0] + a[1] * a[1]) + (a[2] * a[2] + a[3] * a[3]) + (b[0] * b[0] + b[1] * b[1]) + (b[2] * b[2] + b[3] * b[3]);
        q += __shfl_xor(q, 1); q += __shfl_xor(q, 2); q += __shfl_xor(q, 4); q += __shfl_xor(q, 8);
        const float rstd = 1.0f / sqrtf(q * (1.0f / 128.0f) + EPS);
        a = a * rstd * gA + bA; b = b * rstd * gB + bB;
#pragma unroll
        for (int j = 0; j < 4; ++j) { vt[(j * 16 + ch) * 136 + s] = (bf16)f2bf(a[j]); vt[((4 + j) * 16 + ch) * 136 + s] = (bf16)f2bf(b[j]); }
    }
    asm volatile("s_waitcnt lgkmcnt(0)\n\ts_barrier" ::: "memory");
    f32x4 acc[8];
#pragma unroll
    for (int tt = 0; tt < 8; ++tt) acc[tt] = (f32x4){0.f, 0.f, 0.f, 0.f};
#pragma unroll
    for (int ks = 0; ks < 4; ++ks) {
        const bf16x8 a = *(const LAS bf16x8*)(vt + ((fr & 7) * 16 + 2 * wid + (fr >> 3)) * 136 + 32 * ks + 8 * fq);
#pragma unroll
        for (int tt = 0; tt < 8; ++tt) if (ks <= (tt >> 1)) {
            const bf16x8 bfrag = *(const LAS bf16x8*)(wmL + (16 * tt + fr) * 136 + 32 * ks + 8 * fq);
            acc[tt] = __builtin_amdgcn_mfma_f32_16x16x32_bf16(a, bfrag, acc[tt], 0, 0, 0); }
    }
    { const bool oddq = (fq & 1) != 0; u32x2 wp[2];
#pragma unroll
    for (int tt = 0; tt < 8; ++tt) { const int t = 16 * tt + fr; const float b_ = bs[tt];
        const u32x2 u_ = uw[tt];
        u32x2 w; w.x = cvt_pk_bf16(bflo(u_.x) * (acc[tt][0] + b_), bfhi(u_.x) * (acc[tt][1] + b_)); w.y = cvt_pk_bf16(bflo(u_.y) * (acc[tt][2] + b_), bfhi(u_.y) * (acc[tt][3] + b_));
        wp[tt & 1] = w;
        if (tt & 1) *(u32x4*)(YC + (size_t)(t0 + t - (oddq ? 0 : 16)) * D + AW + g * 128 + 16 * wid + 4 * fq - (oddq ? 4 : 0)) = pair16(wp[0], wp[1], oddq); } }
    asm volatile("s_waitcnt lgkmcnt(0)\n\ts_barrier" ::: "memory");
}

#define XB_TMO      128
#define XB_XCNT(j)  (256  + 64 * (j))
#define XB_XSUB(j)  (1280 + 64 * (j))
#define XB_XGEN(j)  (2304 + 64 * (j))
#define XB_TOP      3328
#define XB_TOPGEN   3392
#define XCD_BAR_WORDS 3456
#define XB_SPIN_CAP (1u << 18)
__device__ __forceinline__ unsigned xb_ld(unsigned* p)              { return __hip_atomic_load(p, __ATOMIC_RELAXED, __HIP_MEMORY_SCOPE_AGENT); }
__device__ __forceinline__ unsigned xb_add(unsigned* p, unsigned v) { return __hip_atomic_fetch_add(p, v, __ATOMIC_RELAXED, __HIP_MEMORY_SCOPE_AGENT); }
__device__ __forceinline__ unsigned xb_xcc_id() { return (unsigned)__builtin_amdgcn_s_getreg((3 << 11) | 20) & 0xFu; }
#define XB_SPIN(cond, bar) do { unsigned _sp = 0; while (cond) { __builtin_amdgcn_s_sleep(1); \
    if ((++_sp & 255u) == 0u) { if (xb_ld(&(bar)[XB_TMO])) break; if (_sp > XB_SPIN_CAP) { atomicAdd(&(bar)[XB_TMO], 1u); break; } } } } while (0)
struct XcdBarrier { unsigned* bar; unsigned x; volatile LAS unsigned* st; };
__device__ __forceinline__ XcdBarrier xcd_barrier_post(unsigned* bar, volatile LAS unsigned* st) {
    XcdBarrier b; b.bar = bar; b.x = xb_xcc_id(); b.st = st;
    if (threadIdx.x == 0) (void)xb_add(&bar[XB_XCNT(b.x)], 1u);
    return b;
}
__device__ __forceinline__ void xcd_barrier_complete(unsigned* bar, unsigned x, unsigned& nloc, unsigned& nx) {
    const unsigned G = gridDim.x * gridDim.y * gridDim.z;
    unsigned sum, cnt, mine, sp = 0u;
    for (;;) {
        sum = 0u; cnt = 0u; mine = 0u;
#pragma unroll
        for (unsigned j = 0; j < 16; ++j) { const unsigned c = xb_ld(&bar[XB_XCNT(j)]); sum += c; cnt += (c > 0u) ? 1u : 0u; mine = (j == x) ? c : mine; }
        if (sum == G) break;
        __builtin_amdgcn_s_sleep(1);
        if ((++sp & 255u) == 0u) { if (xb_ld(&bar[XB_TMO])) break; if (sp > XB_SPIN_CAP) { atomicAdd(&bar[XB_TMO], 1u); break; } }
    }
    nloc = mine > 0u ? mine : 1u; nx = cnt > 0u ? cnt : 1u;
}
__device__ __forceinline__ void xcd_barrier(const XcdBarrier& b) {
    asm volatile("s_waitcnt vmcnt(0)" ::: "memory");
    __syncthreads();
    if (threadIdx.x == 0) {
        unsigned* bar = b.bar;
        __builtin_amdgcn_s_waitcnt(0);
        unsigned nloc = b.st[0], nx = b.st[1];
        if (nloc == 0u) { xcd_barrier_complete(bar, b.x, nloc, nx); b.st[0] = nloc; b.st[1] = nx; }
        const unsigned old = xb_add(&bar[XB_XSUB(b.x)], 1u);
        const unsigned gen = old / nloc;
        if (old + 1u == (gen + 1u) * nloc) {
            __builtin_amdgcn_fence(__ATOMIC_RELEASE, "agent");
            asm volatile("s_waitcnt vmcnt(0)" ::: "memory");
            const unsigned og = xb_add(&bar[XB_TOP], 1u);
            const unsigned tg = og / nx;
            if (og + 1u == (tg + 1u) * nx) xb_add(&bar[XB_TOPGEN], 1u);
            else XB_SPIN(xb_ld(&bar[XB_TOPGEN]) == tg, bar);
            __builtin_amdgcn_fence(__ATOMIC_ACQUIRE, "agent");
            xb_add(&bar[XB_XGEN(b.x)], 1u);
            asm volatile("s_waitcnt vmcnt(0)" ::: "memory");
        } else {
            XB_SPIN(xb_ld(&bar[XB_XGEN(b.x)]) == gen, bar);
            __builtin_amdgcn_fence(__ATOMIC_ACQUIRE, "agent");
            asm volatile("s_waitcnt vmcnt(0)" ::: "memory");
        }
    }
    __syncthreads();
}

__device__ __forceinline__ float wave_sum(float v) {
#pragma unroll
    for (int o = 1; o < 64; o <<= 1) v += __shfl_xor(v, o);
    return v;
}
__device__ __forceinline__ int pos_gen(int n0) { return (n0 & ~255) + ((n0 >> 5) & 1) * 128 + ((n0 >> 6) & 3) * 32; }
__device__ __forceinline__ int pos_gu(int c0) { const int up = c0 >= 1024, cc = c0 & 1023; return (cc >> 7) * 256 + up * 128 + ((cc >> 5) & 3) * 32; }
__device__ __forceinline__ void win_absmax(const float* W, int N, int k0, int n0, unsigned* cmax, unsigned* ccnt, int lane) {
    const int kc = lane >> 4, nq = lane & 15;
    f32x4 v[16];
#pragma unroll
    for (int i = 0; i < 16; ++i) v[i] = *(const f32x4*)(W + (size_t)(k0 + 16 * kc + i) * N + n0 + 4 * nq);
    f32x4 mx = (f32x4){0.f, 0.f, 0.f, 0.f};
#pragma unroll
    for (int i = 0; i < 16; ++i) { mx.x = fmaxf(mx.x, fabsf(v[i].x)); mx.y = fmaxf(mx.y, fabsf(v[i].y)); mx.z = fmaxf(mx.z, fabsf(v[i].z)); mx.w = fmaxf(mx.w, fabsf(v[i].w)); }
#pragma unroll
    for (int c = 0; c < 4; ++c) { mx[c] = fmaxf(mx[c], __shfl_xor(mx[c], 16)); mx[c] = fmaxf(mx[c], __shfl_xor(mx[c], 32)); }
    if (kc == 0) {
#pragma unroll
        for (int c = 0; c < 4; ++c) (void)__hip_atomic_fetch_max(cmax + n0 + 4 * nq + c, __float_as_uint(mx[c]), RLX_AGENT);
    }
    asm volatile("s_waitcnt vmcnt(0)" ::: "memory");
    if (lane == 0) (void)__hip_atomic_fetch_add(ccnt, 1u, RLX_AGENT);
}
__device__ __forceinline__ void win_quant(const float* W, int N, int k0, int n0, unsigned char* WT, unsigned* cmax, unsigned* ccnt, float* cs, bool write_cs, unsigned* tmo, int lane) {
    const int kc = lane >> 4, nq = lane & 15;
    f32x4 v[16];
#pragma unroll
    for (int i = 0; i < 16; ++i) v[i] = *(const f32x4*)(W + (size_t)(k0 + 16 * kc + i) * N + n0 + 4 * nq);
    { unsigned sp = 0; while (__hip_atomic_load(ccnt, RLX_AGENT) < 16u) { __builtin_amdgcn_s_sleep(1);
        if ((++sp & 255u) == 0u) { if (__hip_atomic_load(tmo, RLX_AGENT)) break; if (sp > (1u << 18)) { atomicAdd(tmo, 1u); break; } } } }
    asm volatile("" ::: "memory");
    float sc[4];
#pragma unroll
    for (int c = 0; c < 4; ++c) { const float cm = __uint_as_float(__hip_atomic_load(cmax + n0 + 4 * nq + c, RLX_AGENT)); sc[c] = cm > 0.f ? 127.0f / cm : 0.f; if (write_cs && kc == 0) cs[n0 + 4 * nq + c] = cm * (1.0f / 127.0f); }
    const int nb = n0 + 32 * (nq >> 3);
    const int rowb = pos_gen(nb) + ((4 * nq) & 31);
#pragma unroll
    for (int c = 0; c < 4; ++c) {
        u32x4 o;
        o.x = pack_i8((f32x4){v[0][c], v[1][c], v[2][c], v[3][c]} * sc[c]); o.y = pack_i8((f32x4){v[4][c], v[5][c], v[6][c], v[7][c]} * sc[c]);
        o.z = pack_i8((f32x4){v[8][c], v[9][c], v[10][c], v[11][c]} * sc[c]); o.w = pack_i8((f32x4){v[12][c], v[13][c], v[14][c], v[15][c]} * sc[c]);
        *(u32x4*)(WT + (size_t)(rowb + c) * D + k0 + 16 * kc) = o;
    }
}
template <int MODE, int POSK>
__device__ __forceinline__ void tr_tile(const float* W, int N, int k0, int n0, unsigned char* WT, int ldt_bytes, int dk0, const float* ks, float wscale, int lane, int rowadj = 0) {
    const int kc = lane >> 4, nq = lane & 15;
    f32x4 v[16];
#pragma unroll
    for (int i = 0; i < 16; ++i) { const int kk = MODE ? (16 * kc + i) : (32 * (i >> 3) + 8 * kc + (i & 7)); v[i] = *(const f32x4*)(W + (size_t)(k0 + kk) * N + n0 + 4 * nq); }
    if (ks) {
#pragma unroll
        for (int i = 0; i < 16; ++i) { const int kk = MODE ? (16 * kc + i) : (32 * (i >> 3) + 8 * kc + (i & 7)); v[i] = v[i] * (ks[k0 + kk] * wscale); }
    } else if (MODE) {
#pragma unroll
        for (int i = 0; i < 16; ++i) v[i] = v[i] * wscale;
    }
    const int nb = n0 + 32 * (nq >> 3);
    const int rowb = (POSK ? pos_gu(nb) : pos_gen(nb)) + ((4 * nq) & 31) + rowadj;
#pragma unroll
    for (int c = 0; c < 4; ++c) {
        unsigned char* rp = WT + (size_t)(rowb + c) * ldt_bytes;
        if (MODE == 0) {
#pragma unroll
            for (int p = 0; p < 2; ++p) { u32x4 o; o.x = pk2(v[8 * p + 0][c], v[8 * p + 1][c]); o.y = pk2(v[8 * p + 2][c], v[8 * p + 3][c]); o.z = pk2(v[8 * p + 4][c], v[8 * p + 5][c]); o.w = pk2(v[8 * p + 6][c], v[8 * p + 7][c]);
                *(u32x4*)(rp + (size_t)(dk0 + 32 * p + 8 * kc) * 2) = o; }
        } else {
            int w0 = 0, w1 = 0, w2 = 0, w3 = 0;
            w0 = __builtin_amdgcn_cvt_pk_fp8_f32(v[0][c], v[1][c], w0, false); w0 = __builtin_amdgcn_cvt_pk_fp8_f32(v[2][c], v[3][c], w0, true);
            w1 = __builtin_amdgcn_cvt_pk_fp8_f32(v[4][c], v[5][c], w1, false); w1 = __builtin_amdgcn_cvt_pk_fp8_f32(v[6][c], v[7][c], w1, true);
            w2 = __builtin_amdgcn_cvt_pk_fp8_f32(v[8][c], v[9][c], w2, false); w2 = __builtin_amdgcn_cvt_pk_fp8_f32(v[10][c], v[11][c], w2, true);
            w3 = __builtin_amdgcn_cvt_pk_fp8_f32(v[12][c], v[13][c], w3, false); w3 = __builtin_amdgcn_cvt_pk_fp8_f32(v[14][c], v[15][c], w3, true);
            *(u32x4*)(rp + (size_t)(dk0 + 16 * kc)) = (u32x4){(unsigned)w0, (unsigned)w1, (unsigned)w2, (unsigned)w3};
        }
    }
}

struct Args { const float* in[20]; float* out; unsigned char* ws; int ph_lo, ph_hi, li, pad; };

__global__ void __launch_bounds__(512, 2) moe_block_fwd(Args args) {
    extern __shared__ __attribute__((aligned(16))) unsigned char lds_raw[];
    LAS unsigned char* lds = (LAS unsigned char*)lds_raw;
    volatile LAS unsigned* MISC = (volatile LAS unsigned*)(lds + MISC_OFF);
    const int tid = threadIdx.x, lane = tid & 63, wave = __builtin_amdgcn_readfirstlane(tid >> 6);
    const int G = gridDim.x, bx = blockIdx.x;
    const int vcu = (G % 8 == 0) ? (bx % 8) * (G / 8) + bx / 8 : bx;
    unsigned char* ws = args.ws;
    gu32* ctl = (gu32*)(ws + WS_CTL);
    const float* x = args.in[0]; const float* norm1_g = args.in[1]; const float* w_in = args.in[2]; const float* q_norm_g = args.in[3]; const float* k_norm_g = args.in[4];
    const float* rel_bias = args.in[5]; const float* sg_ln_g = args.in[6]; const float* sg_ln_b = args.in[7]; const float* sg_w = args.in[8]; const float* sg_b = args.in[9];
    const float* w_branch_a = args.in[10]; const float* w_branch_b = args.in[11]; const float* w_out = args.in[12]; const float* norm2_g = args.in[13];
    const float* router_w = args.in[14]; const float* router_b = args.in[15]; const float* w_gate_up = args.in[16]; const float* b_gate_up = args.in[17];
    const float* w_down = args.in[18]; const float* b_down = args.in[19];
    float* out = args.out;
    bf16* WIN = (bf16*)(ws + WS_WIN); unsigned char* WIN8 = ws + WS_WIN8; float* HS = (float*)(ws + WS_HS); float* CS = (float*)(ws + WS_CS); float* CS2 = (float*)(ws + WS_CS2); float* MS = (float*)(ws + WS_MS); unsigned char* H8 = ws + WS_H8; bf16* WAB = (bf16*)(ws + WS_WAB); bf16* WO = (bf16*)(ws + WS_WO); bf16* WRH = (bf16*)(ws + WS_WR); bf16* WRL = (bf16*)(ws + WS_WR + 65536); bf16* WM = (bf16*)(ws + WS_WM);
    int* LID = (int*)(ws + WS_LID); float* LRS = (float*)(ws + WS_LRS); float* LP = (float*)(ws + WS_LP);
    unsigned char* WGU = ws + WS_WGU; unsigned char* WD = ws + WS_WD;
    bf16* HB = (bf16*)(ws + WS_H); bf16* QB = (bf16*)(ws + WS_Q); bf16* KB = (bf16*)(ws + WS_K); bf16* VB = (bf16*)(ws + WS_V);
    bf16* UG = (bf16*)(ws + WS_UG); bf16* VG = (bf16*)(ws + WS_VG); unsigned char* GA = ws + WS_GA; bf16* GB = (bf16*)(ws + WS_GB);
    bf16* YCAT = (bf16*)(ws + WS_YCAT); unsigned char* X1Q = ws + WS_X1B; bf16* X1H = (bf16*)(ws + WS_X1H); unsigned char* ACT = ws + WS_ACT; unsigned char* YB = ws + WS_Y;

    for (int u = tid; u < (LDS_BYTES - LDSCTL_OFF) / 4; u += 512) ((LAS unsigned*)(lds + LDSCTL_OFF))[u] = 0u;
    __syncthreads();
    XcdBarrier bar; bar.bar = (unsigned*)(ctl + CW_BAR); bar.x = 0; bar.st = nullptr;
    if (MK_N_LAUNCHES == 1) bar = xcd_barrier_post((unsigned*)(ctl + CW_BAR), MISC + 8);
    const int lo = args.ph_lo, hi = args.ph_hi;
#define IN(k) (lo <= (k) && (k) < hi)
#define SEAM(k) do { if (IN(k) && IN((k) + 1)) xcd_barrier(bar); } while (0)
#define REPS(k) for (int rep_ = 0; rep_ < ((REP_PHASE == (k)) ? 2 : 1); ++rep_)
#define REPSEAM(k) do { if (REP_PHASE == (k) && rep_ == 0) xcd_barrier(bar); } while (0)
    const int gw = vcu * 8 + wave, NGW = G * 8;

    if (IN(0)) REPS(0) {
        constexpr int I_IN = 16 * 72, I_A = 8 * 16, I_O = 16 * 16, I_GU = 16 * 32, I_D = 16 * 16;
        constexpr int NITEMS = I_IN + 2 * I_A + I_O;
        for (int it = gw; it < NITEMS; it += NGW) {
            int r = it;
            if (r < I_IN) { const int kb = r / 72, nb = r % 72; win_absmax(w_in, INW, 64 * kb, 64 * nb, (unsigned*)(ctl + CW_CMAX), (unsigned*)(ctl + CW_CCNT + nb), lane); continue; } r -= I_IN;
            if (r < I_A) { const int kb = r / 16, nb = r % 16; tr_tile<0, 0>(w_branch_a, D, 64 * kb, 64 * nb, (unsigned char*)WAB, D * 2, 64 * kb, nullptr, 1.f, lane); continue; } r -= I_A;
            if (r < I_A) { const int kb = r / 16, nb = r % 16; tr_tile<0, 0>(w_branch_b, D, 64 * kb, 64 * nb, (unsigned char*)WAB, D * 2, 512 + 64 * kb, nullptr, 1.f, lane); continue; } r -= I_A;
            { const int kb = r / 16, nb = r % 16; win_absmax(w_out, D, 64 * kb, 64 * nb, (unsigned*)(ctl + CW_CMAX2), (unsigned*)(ctl + CW_CCNT2 + nb), lane); }
        }
        for (int i = gw * 64 + lane; i < 4 * 128 * 128; i += NGW * 64) { const int s = i & 127, t = (i >> 7) & 127; WM[i] = (bf16)f2bf(s <= t ? sg_w[i] : 0.f); }
        for (int i = gw * 64 + lane; i < NE * D; i += NGW * 64) { const int k = i & 1023, e = i >> 10; const float w = router_w[k * NE + e] * norm2_g[k]; const unsigned h_ = f2bf(w); WRH[i] = (bf16)h_; WRL[i] = (bf16)f2bf(w - bf2f((unsigned short)h_)); }
        for (int m = 2 * gw; m < T; m += 2 * NGW) {
            const f32x4* xr = (const f32x4*)(x + (size_t)m * D) + lane; const f32x4* gr = (const f32x4*)norm1_g + lane;
            f32x4 v[2][4]; float s0 = 0.f, s1 = 0.f, a0 = 0.f, a1 = 0.f;
#pragma unroll
            for (int j = 0; j < 4; ++j) { v[0][j] = xr[64 * j]; v[1][j] = xr[256 + 64 * j]; }
#pragma unroll
            for (int j = 0; j < 4; ++j) { const f32x4 gq = gr[64 * j];
                s0 += (v[0][j].x * v[0][j].x + v[0][j].y * v[0][j].y) + (v[0][j].z * v[0][j].z + v[0][j].w * v[0][j].w);
                s1 += (v[1][j].x * v[1][j].x + v[1][j].y * v[1][j].y) + (v[1][j].z * v[1][j].z + v[1][j].w * v[1][j].w);
                v[0][j] = v[0][j] * gq; v[1][j] = v[1][j] * gq;
                a0 = fmaxf(a0, fmaxf(fmaxf(fabsf(v[0][j].x), fabsf(v[0][j].y)), fmaxf(fabsf(v[0][j].z), fabsf(v[0][j].w))));
                a1 = fmaxf(a1, fmaxf(fmaxf(fabsf(v[1][j].x), fabsf(v[1][j].y)), fmaxf(fabsf(v[1][j].z), fabsf(v[1][j].w)))); }
            s0 = wave_sum(s0); s1 = wave_sum(s1);
#pragma unroll
            for (int o = 1; o < 64; o <<= 1) { a0 = fmaxf(a0, __shfl_xor(a0, o)); a1 = fmaxf(a1, __shfl_xor(a1, o)); }
            const float rs0 = 1.0f / sqrtf(s0 * (1.0f / D) + EPS), rs1 = 1.0f / sqrtf(s1 * (1.0f / D) + EPS);
            const float q0 = a0 > 0.f ? 127.0f / a0 : 0.f, q1 = a1 > 0.f ? 127.0f / a1 : 0.f;
            if (lane == 0) { HS[m] = rs0 * a0 * (1.0f / 127.0f); HS[m + 1] = rs1 * a1 * (1.0f / 127.0f); }
            unsigned* q8 = (unsigned*)(H8 + (size_t)m * D) + lane;
#pragma unroll
            for (int j = 0; j < 4; ++j) { q8[64 * j] = pack_i8(v[0][j] * q0); q8[256 + 64 * j] = pack_i8(v[1][j] * q1); }
        }
        for (int it = gw; it < I_IN; it += NGW) { const int kb = it / 72, nb = it % 72;
            win_quant(w_in, INW, 64 * kb, 64 * nb, WIN8, (unsigned*)(ctl + CW_CMAX), (unsigned*)(ctl + CW_CCNT + nb), CS, kb == 0, (unsigned*)(ctl + CW_BAR) + XB_TMO, lane); }
        for (int it = gw - I_IN; it >= 0 && it < I_O; it += NGW) { const int kb = it / 16, nb = it % 16;
            win_quant(w_out, D, 64 * kb, 64 * nb, (unsigned char*)WO, (unsigned*)(ctl + CW_CMAX2), (unsigned*)(ctl + CW_CCNT2 + nb), CS2, kb == 0, (unsigned*)(ctl + CW_BAR) + XB_TMO, lane); }
        REPSEAM(0);
    }
    SEAM(0);

    if (IN(1)) REPS(1) {
        { PolIn P; P.so.init(T, INW, G, bx); P.A = H8; P.Bt = WIN8; P.ws = ws; P.qg = q_norm_g; P.kg = k_norm_g; P.hs = HS; P.cs = CS; P.shm = lds;
          pg8::gemm_phase<PolIn>(lds, P); }
        REPSEAM(1);
    }
    SEAM(1);

    if (IN(2)) REPS(2) {
        const MoeConv cv{w_gate_up, w_down, norm2_g, WGU, WD}; MoeConv::Regs sreg; int sctr = 0;
        for (int u = vcu; u < NB * NHEAD * 32; u += G) {
            const int cg = u & 31, bh = u >> 5;
            att::unit(bh >> 3, bh & 7, cg, (const unsigned char*)QB, (const unsigned char*)KB, (const unsigned char*)VB, rel_bias, YCAT, lds, cv, sreg, sctr, gw, NGW);
        }
        sgu_load_wm(vcu & 3, WM, lds);
        for (int it = vcu; it < 4 * (T / 128); it += G) sgu_item(it, VG, UG, sg_ln_g, sg_ln_b, sg_b, YCAT, lds, cv, sreg, sctr, gw, NGW);
        cv.drain(sreg, sctr, gw, NGW, lane);
        REPSEAM(2);
    }
    SEAM(2);

    if (IN(3)) REPS(3) {
        if (tid < 256) ((LAS unsigned*)(lds + ROWS_OFF))[tid] = 0u;
        __syncthreads();
        PolMerge P; P.so.init(T, D, G, bx); P.A = YCAT; P.Bt = WAB; P.ga = GA; P.gb = (const unsigned char*)GB; P.out = (unsigned char*)HB; P.rmax = (unsigned*)(ctl + CW_RMAX); P.rcnt = (unsigned*)(ctl + CW_RCNT); P.ms = MS; P.tmo = (unsigned*)(ctl + CW_BAR) + XB_TMO; P.shm = lds;
        pg8::gemm_phase<PolMerge>(lds, P);
        REPSEAM(3);
    }
    SEAM(3);

    if (IN(4)) REPS(4) {
        PolOut P; P.so.init(T, D, G, bx); P.A = (const unsigned char*)HB; P.Bt = (const unsigned char*)WO; P.ms = MS; P.cs = CS2; P.shm = lds; P.x = x; P.x1 = X1H; P.x1q = X1Q;
        pg8::gemm_phase<PolOut>(lds, P);
        REPSEAM(4);
    }
    SEAM(4);

    if (IN(5)) {
        LAS int* lcnt = (LAS int*)(lds + PARK_OFF); LAS int* gbase = lcnt + 32;
        if (tid < 64) lcnt[tid] = 0;
        for (int i = tid; i < 4096; i += 512) { const int e = i & 31, gq = (i >> 5) & 3, kq = i >> 7;
            *(LAS u32x4*)(lds + (size_t)i * 16) = *(const u32x4*)(WRH + (size_t)e * D + 32 * kq + 8 * gq); *(LAS u32x4*)(lds + 65536 + (size_t)i * 16) = *(const u32x4*)(WRL + (size_t)e * D + 32 * kq + 8 * gq); }
        __syncthreads();
        const int r = lane & 15, g = lane >> 4;
        int sel_e[4], sel_rank[4]; float sel_p[4]; float rs_row = 0.f; int tok = 0;
        for (int grp = bx * 8 + wave; grp < T / 16; grp += NGW) {
            const int row0 = grp * 16; tok = row0 + r;
            const bf16* xr = X1H + (size_t)(row0 + r) * D + 8 * g;
            const LAS unsigned char* wl_ = lds + (g * 32 + r) * 16;
            f32x4 a0 = (f32x4){0.f, 0.f, 0.f, 0.f}, a1 = a0; float ssq = 0.f;
            u32x4 xq[4][4];
#define P5_LOAD(S, ss) do { _Pragma("unroll") for (int q = 0; q < 4; ++q) xq[S][q] = *(const u32x4*)(xr + 128 * (ss) + 32 * q); } while (0)
#define P5_COMP(S, ss) do { _Pragma("unroll") for (int q = 0; q < 4; ++q) { const u32x4 w_ = xq[S][q]; const int ks = 4 * (ss) + q; \
                const bf16x8 wh_0 = *(const LAS bf16x8*)(wl_ + ks * 2048), wh_1 = *(const LAS bf16x8*)(wl_ + ks * 2048 + 256), wl_0 = *(const LAS bf16x8*)(wl_ + 65536 + ks * 2048), wl_1 = *(const LAS bf16x8*)(wl_ + 65536 + ks * 2048 + 256); \
                ssq += (bflo(w_.x) * bflo(w_.x) + bfhi(w_.x) * bfhi(w_.x)) + (bflo(w_.y) * bflo(w_.y) + bfhi(w_.y) * bfhi(w_.y)) + (bflo(w_.z) * bflo(w_.z) + bfhi(w_.z) * bfhi(w_.z)) + (bflo(w_.w) * bflo(w_.w) + bfhi(w_.w) * bfhi(w_.w)); \
                const bf16x8 xh = __builtin_bit_cast(bf16x8, w_); \
                a0 = __builtin_amdgcn_mfma_f32_16x16x32_bf16(wh_0, xh, a0, 0, 0, 0); a1 = __builtin_amdgcn_mfma_f32_16x16x32_bf16(wh_1, xh, a1, 0, 0, 0); \
                a0 = __builtin_amdgcn_mfma_f32_16x16x32_bf16(wl_0, xh, a0, 0, 0, 0); a1 = __builtin_amdgcn_mfma_f32_16x16x32_bf16(wl_1, xh, a1, 0, 0, 0); } } while (0)
            P5_LOAD(0, 0); P5_LOAD(1, 1); P5_LOAD(2, 2); P5_LOAD(3, 3);
            P5_COMP(0, 0); P5_LOAD(0, 4);
            P5_COMP(1, 1); P5_LOAD(1, 5);
            P5_COMP(2, 2); P5_LOAD(2, 6);
            P5_COMP(3, 3); P5_LOAD(3, 7);
            P5_COMP(0, 4); P5_COMP(1, 5); P5_COMP(2, 6); P5_COMP(3, 7);
#undef P5_LOAD
#undef P5_COMP
            ssq += __shfl_xor(ssq, 16); ssq += __shfl_xor(ssq, 32);
            const float rs = 1.0f / sqrtf(ssq * (1.0f / D) + EPS); rs_row = rs;
            float v[8];
#pragma unroll
            for (int j = 0; j < 4; ++j) { v[j] = a0[j] * rs + router_b[4 * g + j]; v[4 + j] = a1[j] * rs + router_b[16 + 4 * g + j]; }
            unsigned taken = 0u; float sel_v[4];
#pragma unroll
            for (int k = 0; k < 4; ++k) {
                float best = -INFINITY; int bi = 1 << 20;
#pragma unroll
                for (int i = 0; i < 8; ++i) { const int ei = (i >> 2) * 16 + 4 * g + (i & 3); if (!((taken >> i) & 1u) && v[i] > best) { best = v[i]; bi = ei; } }
#pragma unroll
                for (int m = 16; m <= 32; m <<= 1) { const float ob = __shfl_xor(best, m); const int oi = __shfl_xor(bi, m); if (ob > best || (ob == best && oi < bi)) { best = ob; bi = oi; } }
                sel_e[k] = bi; sel_v[k] = best;
                if (((bi & 15) >> 2) == g) taken |= 1u << (((bi >> 4) << 2) | (bi & 3));
            }
            float den = 0.f;
#pragma unroll
            for (int k = 0; k < 4; ++k) { sel_p[k] = __expf(sel_v[k] - sel_v[0]); den += sel_p[k]; }
            const float inv = 1.0f / den;
#pragma unroll
            for (int k = 0; k < 4; ++k) sel_p[k] *= inv;
            if (g == 0) {
#pragma unroll
                for (int k = 0; k < 4; ++k) sel_rank[k] = __hip_atomic_fetch_add(lcnt + sel_e[k], 1, __ATOMIC_RELAXED, __HIP_MEMORY_SCOPE_WORKGROUP);
            }
        }
        __syncthreads();
        if (tid < NE) gbase[tid] = (int)__hip_atomic_fetch_add((unsigned*)(ctl + CW_CNT + tid), (unsigned)lcnt[tid], RLX_AGENT);
        __syncthreads();
        if (g == 0 && (bx * 8 + wave) < T / 16) {
#pragma unroll
            for (int k = 0; k < 4; ++k) { const size_t pos = (size_t)sel_e[k] * LCAP + gbase[sel_e[k]] + sel_rank[k];
                LID[pos] = tok * 4 + k; LRS[pos] = rs_row; LP[pos] = sel_p[k]; }
        }
        __syncthreads();
    }
    SEAM(5);

    if (IN(6) || IN(7)) {
        LAS int* tb = (LAS int*)(lds + MOE_OFF);
        if (tid < NE) tb[33 + tid] = (int)__hip_atomic_load(ctl + CW_CNT + tid, RLX_AGENT);
        __syncthreads();
        if (tid == 0) { int acc = 0; for (int e = 0; e < NE; ++e) { tb[e] = acc; acc += (tb[33 + e] + 255) >> 8; } tb[32] = acc; }
        __syncthreads();
    }
    if (IN(6)) REPS(6) {
        PolGU P; P.mo.init((const LAS int*)(lds + MOE_OFF), 8, G, bx); P.A = X1Q; P.Bt = WGU; P.lid = LID; P.lrs = LRS; P.bgu = b_gate_up; P.act = ACT; P.shm = lds;
        pg8::gemm_phase<PolGU>(lds, P);
        REPSEAM(6);
    }
    SEAM(6);
    if (IN(7)) REPS(7) {
        PolDown P; P.mo.init((const LAS int*)(lds + MOE_OFF), 4, G, bx); P.A = ACT; P.Bt = WD; P.lid = LID; P.lp = LP; P.bd = b_down; P.y = YB; P.shm = lds;
        pg8::gemm_phase<PolDown>(lds, P);
        REPSEAM(7);
    }
    SEAM(7);
    if (IN(8)) {
        f32x4 xa[4], xb[4]; u32x4 ya[4], yb[4];
#define P8_LOAD(X, Y, m_) do { const bf16* xr_ = X1H + (size_t)(m_) * D + 16 * lane; { f32x4 a_, b_; ld8(xr_, a_, b_); X[0] = a_; X[1] = b_; ld8(xr_ + 8, a_, b_); X[2] = a_; X[3] = b_; } \
            _Pragma("unroll") for (int k = 0; k < 4; ++k) Y[k] = *(const u32x4*)(YB + ((size_t)(m_) * 4 + k) * D + 16 * lane); } while (0)
#define P8_DONE(X, Y, m_) do { _Pragma("unroll") for (int k = 0; k < 4; ++k) { const unsigned ww[4] = {Y[k].x, Y[k].y, Y[k].z, Y[k].w}; \
            _Pragma("unroll") for (int q = 0; q < 4; ++q) { const f32x2 lo_ = __builtin_amdgcn_cvt_pk_f32_fp8((int)ww[q], false), hi_ = __builtin_amdgcn_cvt_pk_f32_fp8((int)ww[q], true); \
                X[q][0] += lo_[0] * 0.0625f; X[q][1] += lo_[1] * 0.0625f; X[q][2] += hi_[0] * 0.0625f; X[q][3] += hi_[1] * 0.0625f; } } \
            float* or_ = out + (size_t)(m_) * D + 16 * lane; _Pragma("unroll") for (int j = 0; j < 4; ++j) *(f32x4*)(or_ + 4 * j) = X[j]; } while (0)
        for (int m = gw; m < T; m += 2 * NGW) { const int m2 = m + NGW;
            P8_LOAD(xa, ya, m); P8_LOAD(xb, yb, m2);
            P8_DONE(xa, ya, m); P8_DONE(xb, yb, m2); }
#undef P8_LOAD
#undef P8_DONE
    }
#undef IN
#undef SEAM
}

extern "C" void kernel_launch(void* const* d_in, const int* in_sizes, int n_in, void* d_out, int out_size, void* d_ws, size_t ws_size, hipStream_t stream) {
    static int grid = 0;
    if (grid == 0) {
        if (n_in != 20 || in_sizes[0] != T * D || out_size != T * D || ws_size < WS_END) { fprintf(stderr, "kernel_launch: unexpected shapes (n_in %d, ws %zu)\n", n_in, ws_size); grid = -1; return; }
        int dev = 0, cus = 0;
        if (hipGetDevice(&dev) != hipSuccess || hipDeviceGetAttribute(&cus, hipDeviceAttributeMultiprocessorCount, dev) != hipSuccess) { grid = -1; return; }
        if (hipFuncSetAttribute((const void*)moe_block_fwd, hipFuncAttributeMaxDynamicSharedMemorySize, LDS_BYTES) != hipSuccess) { fprintf(stderr, "kernel_launch: hipFuncSetAttribute failed\n"); grid = -1; return; }
        (void)hipGetLastError();
        grid = cus;
        if (grid != 256) { fprintf(stderr, "kernel_launch: built for a 256-CU device, got %d\n", cus); grid = -1; return; }
    }
    if (grid < 0) return;
    if (hipMemsetAsync((char*)d_ws + WS_CTL, 0, CTL_ZERO_BYTES, stream) != hipSuccess) return;
    Args a{};
    for (int i = 0; i < 20; ++i) a.in[i] = (const float*)d_in[i];
    a.out = (float*)d_out; a.ws = (unsigned char*)d_ws;
    constexpr int NPH = 9;
    for (int li = 0; li < MK_N_LAUNCHES; ++li) {
        a.ph_lo = (MK_N_LAUNCHES == 1) ? 0 : li; a.ph_hi = (MK_N_LAUNCHES == 1) ? NPH : li + 1; a.li = li;
        hipLaunchKernelGGL(moe_block_fwd, dim3(grid), dim3(512), LDS_BYTES, stream, a);
    }
}
```

```cpp
#include <hip/hip_runtime.h>
#include <cstdio>
#include <cstdint>

#ifndef MK_N_LAUNCHES
#define MK_N_LAUNCHES 1
#endif

#ifndef REP_PHASE
#define REP_PHASE -1
#endif
#define LAS __attribute__((address_space(3)))
#define GAS __attribute__((address_space(1)))
typedef unsigned short bf16;
typedef short bf16x8 __attribute__((ext_vector_type(8)));
typedef short s16x4 __attribute__((ext_vector_type(4)));
typedef float f32x2 __attribute__((ext_vector_type(2)));
typedef float f32x4 __attribute__((ext_vector_type(4)));
typedef float f32x16 __attribute__((ext_vector_type(16)));
typedef unsigned u32x2 __attribute__((ext_vector_type(2)));
typedef unsigned u32x4 __attribute__((ext_vector_type(4)));
typedef GAS unsigned gu32;

constexpr int NB = 4, SEQ = 8192, T = NB * SEQ, D = 1024, AW = 512, SGW = 512, INW = 4608, NE = 32, FF = 1024;
constexpr int NHEAD = 8, HD = 64, CHUNK = 64, NBACK = 8, NREL = 513;
constexpr int LCAP = 32768;
constexpr float LOG2E = 1.4426950408889634f;
constexpr float EPS = 1e-6f;

constexpr size_t MiB = 1u << 20;
constexpr size_t WS_CTL = 0, CTL_ZERO_BYTES = 1 * MiB;
constexpr size_t WS_WIN = 7 * MiB;
constexpr size_t WS_WAB = 11 * MiB;
constexpr size_t WS_WO = 13 * MiB;
constexpr size_t WS_WR = 15 * MiB;
constexpr size_t WS_WM = 15 * MiB + 256 * 1024;
constexpr size_t WS_WIN8 = 2 * MiB;
constexpr size_t WS_HS = 15 * MiB + 512 * 1024;
constexpr size_t WS_CS2 = 15 * MiB + 832 * 1024;
constexpr size_t WS_MS = 15 * MiB + 896 * 1024;
constexpr size_t WS_CS = 15 * MiB + 768 * 1024;
constexpr size_t WS_H8 = 976 * MiB;
constexpr size_t WS_LID = 16 * MiB;
constexpr size_t WS_LRS = 20 * MiB;
constexpr size_t WS_LP = 24 * MiB;
constexpr size_t WS_WGU = 28 * MiB;
constexpr size_t WS_WD = 156 * MiB;
constexpr size_t WS_H = 220 * MiB;
constexpr size_t WS_Q = 284 * MiB, WS_K = 316 * MiB, WS_V = 348 * MiB;
constexpr size_t WS_UG = 380 * MiB, WS_VG = 412 * MiB;
constexpr size_t WS_GA = 444 * MiB, WS_GB = 508 * MiB;
constexpr size_t WS_YCAT = 572 * MiB;
constexpr size_t WS_X1B = 636 * MiB;
constexpr size_t WS_ACT = 700 * MiB;
constexpr size_t WS_X1H = 380 * MiB;
constexpr size_t WS_Y = 220 * MiB;
constexpr size_t WS_END = 1008 * MiB;
constexpr int CW_TMO = 0, CW_CODE = 1;
constexpr int CW_CNT = 64;
constexpr int CW_BAR = 4096;
constexpr int CW_CMAX = 8192;
constexpr int CW_CMAX2 = 13312;
constexpr int CW_CCNT2 = 16384 + 128;
constexpr int CW_RMAX = 65536;
constexpr int CW_RCNT = 98304;
constexpr int CW_RSLOT = 131072;
constexpr int CW_XC1 = 35584;
constexpr int CW_TILE2 = 35328;
constexpr int CW_TILE3 = 34816, CW_TILE4 = 35072;
constexpr int CW_TILE = 32768;
constexpr int CW_CCNT = 16384;

constexpr int RING_BYTES = 131072;
constexpr int LDSCTL_OFF = RING_BYTES, MISC_OFF = LDSCTL_OFF + 320;
constexpr int MOE_OFF = MISC_OFF + 128;
constexpr int PARK_OFF = LDSCTL_OFF + 1024;
constexpr int ROWS_OFF = LDSCTL_OFF + 9216, ROWS_BUF = 3072;
constexpr int LDS_BYTES = 147456;

#define LDS_WAIT() asm volatile("s_waitcnt lgkmcnt(0)" ::: "memory")
#define VM_WAIT() asm volatile("s_waitcnt vmcnt(0)" ::: "memory")
#define RLX_AGENT __ATOMIC_RELAXED, __HIP_MEMORY_SCOPE_AGENT

__device__ __forceinline__ unsigned f2bf(float f) { unsigned u = __builtin_bit_cast(unsigned, f); return (u + 0x7fffu + ((u >> 16) & 1u)) >> 16; }
__device__ __forceinline__ unsigned pk2(float lo, float hi) { return f2bf(lo) | (f2bf(hi) << 16); }
__device__ __forceinline__ float bf2f(unsigned short b) { return __builtin_bit_cast(float, (unsigned)b << 16); }
__device__ __forceinline__ float bflo(unsigned w) { return __builtin_bit_cast(float, w << 16); }
__device__ __forceinline__ float bfhi(unsigned w) { return __builtin_bit_cast(float, w & 0xffff0000u); }
__device__ __forceinline__ unsigned cvt_pk_bf16(float lo, float hi) { unsigned r; asm volatile("v_cvt_pk_bf16_f32 %0, %1, %2" : "=v"(r) : "v"(lo), "v"(hi)); return r; }
__device__ __forceinline__ float fast_rcp(float x) { return __builtin_amdgcn_rcpf(x); }
__device__ __forceinline__ float fast_rsq(float x) { return __builtin_amdgcn_rsqf(x); }
__device__ __forceinline__ float fast_exp2(float x) { return __builtin_amdgcn_exp2f(x); }
__device__ __forceinline__ float sigmoidf_(float x) { return fast_rcp(1.0f + fast_exp2(-LOG2E * x)); }
__device__ __forceinline__ float gelu_tanh(float x) {
    const float t = x * ((-LOG2E * 1.5957691216057308f) + (-LOG2E * 1.5957691216057308f * 0.044715f) * (x * x));
    return x * fast_rcp(1.0f + fast_exp2(t));
}

namespace pg8 {
constexpr int BM = 256, BK = 64, HALF = 128, HTB = HALF * BK * 2, STAGE_BYTES = 8 * HTB, NXCD = 8, WGM = 8;
__host__ __device__ __forceinline__ int lds_byte(int r, int c) { const int st = (r >> 4) * 2 + (c >> 5), rr = r & 15, cc = c & 31, ob = rr * 64 + cc * 2; return st * 1024 + (ob ^ (((ob >> 9) & 1) << 5)); }
__host__ __device__ __forceinline__ void stage_rc(int b, int& R, int& C) { const int st = b / 1024, sb = b % 1024, swz = sb ^ (((sb >> 9) & 1) << 5); R = (st >> 1) * 16 + swz / 64; C = (st & 1) * 32 + (swz % 64) / 2; }
__host__ __device__ __forceinline__ int perm32(int rho) { const int n = rho >> 4, i = rho & 15; return 8 * (i >> 2) + 4 * n + (i & 3); }

typedef int v4i_t __attribute__((ext_vector_type(4)));
typedef int v8i_t __attribute__((ext_vector_type(8)));
__device__ __forceinline__ v8i_t cat8(bf16x8 lo, bf16x8 hi) { return __builtin_shufflevector(__builtin_bit_cast(v4i_t, lo), __builtin_bit_cast(v4i_t, hi), 0, 1, 2, 3, 4, 5, 6, 7); }
struct Unit { int pm, pn, e, s0, cnt, idx; };

struct StaticOrder {
    int nM, nN, nwg, G, c;
    __device__ void init(int M, int N, int G_, int c_) { nM = M / BM; nN = N / BM; nwg = nM * nN; G = G_; c = c_; }
    __device__ bool tile(int i, int& pm, int& pn) const {
        const long L = (long)i * G + c; if (L >= nwg) return false;
        int wgid = (int)L; { const int q = nwg / NXCD, r = nwg % NXCD, xcd = wgid % NXCD, off = wgid / NXCD; wgid = (xcd < r ? xcd * (q + 1) : r * (q + 1) + (xcd - r) * q) + off; }
        const int nig = WGM * nN, gid = wgid / nig, fm = gid * WGM, gsz = (nM - fm) < WGM ? (nM - fm) : WGM;
        pm = fm + ((wgid % nig) % gsz); pn = (wgid % nig) / gsz; return true;
    }
};

template <class P>
__device__ __forceinline__ void gemm_phase(LAS unsigned char* lds, const P& S) {
    const int tid = threadIdx.x, wid = __builtin_amdgcn_readfirstlane(tid >> 6), lane = tid & 63, wr = wid >> 2, wc = wid & 3, fr = lane & 15, fq = lane >> 4;
    constexpr int nt = P::NT;
    unsigned vA[2][2], voffB[2];
    LAS u32x4* park = (LAS u32x4*)(lds + PARK_OFF) + tid;
#pragma unroll
    for (int i = 0; i < 2; ++i) { int R, C; stage_rc(tid * 16 + i * 8192, R, C); const int Rb = (R & ~31) + perm32(R & 31);
        vA[0][i] = (unsigned)(R * P::LDA + C) * 2u; vA[1][i] = (unsigned)((R + HALF) * P::LDA + C) * 2u; voffB[i] = (unsigned)(Rb * P::LDB + C) * 2u; }
    const size_t kstep = (size_t)(BK * 2);
    const size_t hstepB = (size_t)HALF * P::LDB * 2;
    const unsigned ldsw = (unsigned)wid * 1024u;
    const int aoff = lds_byte(wr * 64 + fr, fq * 8), boff = lds_byte(wc * 32 + fr, fq * 8);
#define PG8_SA(b, h) (((b) * 2 + (h)) * HTB)
#define PG8_SB(b, h) ((4 + (b) * 2 + (h)) * HTB)
#define PG8_STAGE2(bufoff, gbase, o0, o1) do { \
        __builtin_amdgcn_global_load_lds((const unsigned*)((const char*)(gbase) + (o0)), (LAS unsigned*)(lds + (bufoff) + ldsw), 16, 0, 0); \
        __builtin_amdgcn_global_load_lds((const unsigned*)((const char*)(gbase) + (o1)), (LAS unsigned*)(lds + (bufoff) + ldsw + 8192), 16, 0, 0); } while (0)
#define PG8_STAGEB(bufoff, gbase) PG8_STAGE2(bufoff, gbase, voffB[0], voffB[1])
#define PG8_LDA(dst, b, h) do { _Pragma("unroll") for (int m = 0; m < 4; ++m) _Pragma("unroll") for (int k = 0; k < 2; ++k) dst[m][k] = *(const LAS bf16x8*)(lds + PG8_SA(b, h) + aoff + m * 2048 + k * 1024); } while (0)
#define PG8_LDB(dst, b, h) do { _Pragma("unroll") for (int n = 0; n < 2; ++n) _Pragma("unroll") for (int k = 0; k < 2; ++k) dst[n][k] = *(const LAS bf16x8*)(lds + PG8_SB(b, h) + boff + n * 2048 + k * 1024); } while (0)
#define PG8_MMA(ai, bj, At, Bt) do { __builtin_amdgcn_s_setprio(1); _Pragma("unroll") for (int m = 0; m < 4; ++m) _Pragma("unroll") for (int n = 0; n < 2; ++n) { \
        if constexpr (P::I8) { _Pragma("unroll") for (int k = 0; k < 2; ++k) acc[ai][bj][m][n] = __builtin_bit_cast(f32x4, __builtin_amdgcn_mfma_i32_16x16x64_i8(__builtin_bit_cast(v4i_t, Bt[n][k]), __builtin_bit_cast(v4i_t, At[m][k]), __builtin_bit_cast(v4i_t, acc[ai][bj][m][n]), 0, 0, 0)); }     \
        else if constexpr (P::FP8) { acc[ai][bj][m][n] = __builtin_amdgcn_mfma_scale_f32_16x16x128_f8f6f4(cat8(Bt[n][0], Bt[n][1]), cat8(At[m][0], At[m][1]), acc[ai][bj][m][n], 0, 0, 0, 0, 0, 0); }     \
        else { _Pragma("unroll") for (int k = 0; k < 2; ++k) acc[ai][bj][m][n] = __builtin_amdgcn_mfma_f32_16x16x32_bf16(Bt[n][k], At[m][k], acc[ai][bj][m][n], 0, 0, 0); } } \
        __builtin_amdgcn_s_setprio(0); } while (0)
#define PG8_WAIT_V(n) asm volatile("s_waitcnt vmcnt(" #n ")" ::: "memory")
#define PG8_WAIT_L(n) asm volatile("s_waitcnt lgkmcnt(" #n ")" ::: "memory")
#define PG8_BAR __builtin_amdgcn_s_barrier()
#define PG8_SCHED __builtin_amdgcn_sched_barrier(0)
    Unit cur, nxt; int ui = 0; int pend = 0;
    if (!S.next(0, cur)) return;
    if constexpr (P::GATHER) S.a_off(cur, tid, vA);
    f32x4 acc[2][2][4][2];
#pragma unroll
    for (int a = 0; a < 2; ++a)
#pragma unroll
        for (int b = 0; b < 2; ++b)
#pragma unroll
            for (int m = 0; m < 4; ++m)
#pragma unroll
                for (int n = 0; n < 2; ++n) acc[a][b][m][n] = (f32x4){0.f, 0.f, 0.f, 0.f};
    bf16x8 At[4][2], B0[2][2], B1[2][2];
    const char* cA = S.a_ptr(cur); const char* cB = S.b_ptr(cur);
    PG8_STAGEB(PG8_SB(0, 0), cB); PG8_STAGEB(PG8_SB(0, 1), cB + hstepB); PG8_STAGE2(PG8_SA(0, 0), cA, vA[0][0], vA[0][1]); PG8_STAGE2(PG8_SA(0, 1), cA, vA[1][0], vA[1][1]);
    if (wr == 1) PG8_BAR;
    PG8_WAIT_V(2); PG8_BAR;
    PG8_STAGEB(PG8_SB(1, 0), cB + kstep); PG8_STAGE2(PG8_SA(1, 0), cA + kstep, vA[0][0], vA[0][1]); PG8_STAGEB(PG8_SB(1, 1), cB + hstepB + kstep);
    PG8_WAIT_V(6); PG8_BAR;
    for (;;) {
        const bool has_next = S.next(ui + 1, nxt);
        if constexpr (P::ROWDMA) S.row_dma(cur, lds, wid, lane);
        const char* nA = has_next ? S.a_ptr(nxt) : cA; const char* nB = has_next ? S.b_ptr(nxt) : cB;
        if constexpr (P::IDDMA) { if (has_next) S.ids_dma(nxt, cur, lds, wid, lane); }
        else if constexpr (P::GATHER) {
            unsigned vn[2][2];
            if (has_next) S.a_off(nxt, tid, vn);
            else { vn[0][0] = vA[0][0]; vn[0][1] = vA[0][1]; vn[1][0] = vA[1][0]; vn[1][1] = vA[1][1]; }
            *park = (u32x4){vn[0][0], vn[0][1], vn[1][0], vn[1][1]};
        }
#pragma nounroll
        for (int t = 0; t < nt; t += 2) {
            const bool last = (t == nt - 2);
            asm volatile("" : "+v"(vA[0][0]), "+v"(vA[0][1]), "+v"(vA[1][0]), "+v"(vA[1][1]), "+v"(voffB[0]), "+v"(voffB[1]));
            const char* a1 = cA + (size_t)(t + 1) * kstep;
            const char* a2 = last ? nA : cA + (size_t)(t + 2) * kstep; const char* b2 = last ? nB : cB + (size_t)(t + 2) * kstep;
            const char* a3 = a2 + kstep; const char* b3 = b2 + kstep;
            PG8_LDB(B0, 0, 0); PG8_LDB(B1, 0, 1); PG8_SCHED; PG8_LDA(At, 0, 0); PG8_STAGE2(PG8_SA(1, 1), a1, vA[1][0], vA[1][1]);
            if constexpr (P::IDDMA) { if (last && has_next) S.a_off_lds(nxt, cur, tid, lds, vA); }
            else if constexpr (P::GATHER) { if (last) { const u32x4 nv = *park; vA[0][0] = nv.x; vA[0][1] = nv.y; vA[1][0] = nv.z; vA[1][1] = nv.w; } }
            PG8_WAIT_V(8); PG8_WAIT_L(0); PG8_BAR; PG8_MMA(0, 0, At, B0); PG8_MMA(0, 1, At, B1); PG8_BAR; PG8_SCHED;
            PG8_LDA(At, 0, 1); PG8_STAGEB(PG8_SB(0, 0), b2); PG8_STAGEB(PG8_SB(0, 1), b2 + hstepB); PG8_STAGE2(PG8_SA(0, 0), a2, vA[0][0], vA[0][1]);
            PG8_WAIT_V(8); PG8_WAIT_L(0); PG8_BAR; PG8_MMA(1, 0, At, B0); PG8_MMA(1, 1, At, B1); PG8_BAR; PG8_SCHED;
            PG8_LDB(B0, 1, 0); PG8_LDB(B1, 1, 1); PG8_SCHED; PG8_LDA(At, 1, 0); PG8_STAGE2(PG8_SA(0, 1), a2, vA[1][0], vA[1][1]);
            PG8_WAIT_V(8); PG8_WAIT_L(0); PG8_BAR; PG8_MMA(0, 0, At, B0); PG8_MMA(0, 1, At, B1); PG8_BAR; PG8_SCHED;
            PG8_LDA(At, 1, 1); PG8_STAGEB(PG8_SB(1, 0), b3); PG8_STAGEB(PG8_SB(1, 1), b3 + hstepB); PG8_STAGE2(PG8_SA(1, 0), a3, vA[0][0], vA[0][1]);
            PG8_WAIT_V(8); PG8_WAIT_L(0); PG8_BAR; PG8_MMA(1, 0, At, B0); PG8_MMA(1, 1, At, B1); PG8_BAR; PG8_SCHED;
        }
        if (wr == 0) PG8_BAR;
        int fr_ = fr, fq_ = fq; asm volatile("" : "+v"(fr_), "+v"(fq_));
        const bool keep = S.epi(acc, cur, wr, wc, fr_, fq_);
        if constexpr (P::SIGNAL) {
            if (++pend == 4 || !has_next) { PG8_WAIT_V(0); PG8_BAR; if (tid == 0) S.signal(cur, pend); pend = 0; }
        }
        if (!has_next) break;
        if (!keep) {
#pragma unroll
            for (int a = 0; a < 2; ++a)
#pragma unroll
                for (int b = 0; b < 2; ++b)
#pragma unroll
                    for (int m = 0; m < 4; ++m)
#pragma unroll
                        for (int n = 0; n < 2; ++n) acc[a][b][m][n] = (f32x4){0.f, 0.f, 0.f, 0.f};
        }
        cur = nxt; cA = nA; cB = nB; ++ui;
        if (wr == 1) PG8_BAR;
    }
    PG8_WAIT_V(0);
    PG8_BAR;
#undef PG8_SA
#undef PG8_SB
#undef PG8_STAGE2
#undef PG8_STAGEB
#undef PG8_LDA
#undef PG8_LDB
#undef PG8_MMA
#undef PG8_WAIT_V
#undef PG8_WAIT_L
#undef PG8_BAR
#undef PG8_SCHED
}
}
using pg8::Unit;

__device__ __forceinline__ void st16(void* p, const u32x4& w, bool wt) {
    if (wt) asm volatile("global_store_dwordx4 %0, %1, off sc0 sc1\n\ts_nop 1" :: "v"(p), "v"(w) : "memory");
    else *(u32x4*)p = w;
}
__device__ __forceinline__ void st8(bf16* p, const f32x4& a, const f32x4& b) {
    u32x4 w; w.x = cvt_pk_bf16(a[0], a[1]); w.y = cvt_pk_bf16(a[2], a[3]); w.z = cvt_pk_bf16(b[0], b[1]); w.w = cvt_pk_bf16(b[2], b[3]);
    *(u32x4*)p = w;
}
__device__ __forceinline__ void ld8(const bf16* p, f32x4& a, f32x4& b) {
    const u32x4 w = *(const u32x4*)p;
    a = (f32x4){bflo(w.x), bfhi(w.x), bflo(w.y), bfhi(w.y)}; b = (f32x4){bflo(w.z), bfhi(w.z), bflo(w.w), bfhi(w.w)};
}

__device__ __forceinline__ void st8q(unsigned char* p, const f32x4& a, const f32x4& b) {
    int w0 = 0, w1 = 0;
    w0 = __builtin_amdgcn_cvt_pk_fp8_f32(a[0], a[1], w0, false); w0 = __builtin_amdgcn_cvt_pk_fp8_f32(a[2], a[3], w0, true);
    w1 = __builtin_amdgcn_cvt_pk_fp8_f32(b[0], b[1], w1, false); w1 = __builtin_amdgcn_cvt_pk_fp8_f32(b[2], b[3], w1, true);
    *(u32x2*)p = (u32x2){(unsigned)w0, (unsigned)w1};
}
__device__ __forceinline__ unsigned pack_i8(const f32x4& v) {
    const int a = (int)__builtin_rintf(v.x), b = (int)__builtin_rintf(v.y), c = (int)__builtin_rintf(v.z), d = (int)__builtin_rintf(v.w);
    return ((unsigned)a & 255u) | (((unsigned)b & 255u) << 8) | (((unsigned)c & 255u) << 16) | ((unsigned)d << 24);
}
__device__ __forceinline__ u32x2 pack8q(const f32x4& a, const f32x4& b) {
    int w0 = 0, w1 = 0;
    w0 = __builtin_amdgcn_cvt_pk_fp8_f32(a[0], a[1], w0, false); w0 = __builtin_amdgcn_cvt_pk_fp8_f32(a[2], a[3], w0, true);
    w1 = __builtin_amdgcn_cvt_pk_fp8_f32(b[0], b[1], w1, false); w1 = __builtin_amdgcn_cvt_pk_fp8_f32(b[2], b[3], w1, true);
    return (u32x2){(unsigned)w0, (unsigned)w1};
}
template <int CTRL> __device__ __forceinline__ float dpp_get(float v) { return __uint_as_float((unsigned)__builtin_amdgcn_update_dpp(0, (int)__float_as_uint(v), CTRL, 0xF, 0xF, true)); }
__device__ __forceinline__ float row16_sum(float v) { v += dpp_get<0xB1>(v); v += dpp_get<0x4E>(v); v += dpp_get<0x141>(v); v += dpp_get<0x140>(v); return v; }
__device__ __forceinline__ float row16_max(float v) { v = fmaxf(v, dpp_get<0xB1>(v)); v = fmaxf(v, dpp_get<0x4E>(v)); v = fmaxf(v, dpp_get<0x141>(v)); v = fmaxf(v, dpp_get<0x140>(v)); return v; }
__device__ __forceinline__ float xsum_16_32(float x) {
    auto a = __builtin_amdgcn_permlane16_swap(__float_as_uint(x), __float_as_uint(x), false, false); x = __uint_as_float(a[0]) + __uint_as_float(a[1]);
    auto b = __builtin_amdgcn_permlane32_swap(__float_as_uint(x), __float_as_uint(x), false, false); return __uint_as_float(b[0]) + __uint_as_float(b[1]);
}
__device__ __forceinline__ float xmax_16_32(float x) {
    auto a = __builtin_amdgcn_permlane16_swap(__float_as_uint(x), __float_as_uint(x), false, false); x = fmaxf(__uint_as_float(a[0]), __uint_as_float(a[1]));
    auto b = __builtin_amdgcn_permlane32_swap(__float_as_uint(x), __float_as_uint(x), false, false); return fmaxf(__uint_as_float(b[0]), __uint_as_float(b[1]));
}
__device__ __forceinline__ u32x4 pair16(const u32x2& e0, const u32x2& e1, bool) {
    const auto r0 = __builtin_amdgcn_permlane16_swap(e0.x, e1.x, false, false), r1 = __builtin_amdgcn_permlane16_swap(e0.y, e1.y, false, false);
    return (u32x4){(unsigned)r0[0], (unsigned)r1[0], (unsigned)r0[1], (unsigned)r1[1]};
}
constexpr float WQ_SCALE = 32.0f, WQ_INV = 1.0f / 32.0f;

struct PolIn {
    static constexpr int NT = 8, LDA = 512, LDB = 512; static constexpr bool GATHER = false, FP8 = false, I8 = true, ROWDMA = true, IDDMA = false, SIGNAL = false;
    pg8::StaticOrder so; const unsigned char* A; const unsigned char* Bt; unsigned char* ws; const float* qg; const float* kg; const float* hs; const float* cs; LAS unsigned char* shm; bool wtx;
    __device__ bool next(int i, Unit& u) const { u.e = 0; u.s0 = 0; u.cnt = 0; u.idx = i; return so.tile(i, u.pm, u.pn); }
    __device__ __forceinline__ void row_dma(const Unit& u, LAS unsigned char* lds, int wid, int lane) const {
        const unsigned* src = (wid < 4) ? (const unsigned*)(hs + u.pm * 256 + 64 * wid + lane) : (const unsigned*)(cs + u.pn * 256 + 64 * (wid & 3) + lane);
        __builtin_amdgcn_global_load_lds(src, (LAS unsigned*)(lds + ROWS_OFF + (u.idx & 1) * ROWS_BUF + 256 * wid), 4, 0, 0);
    }
    __device__ const char* a_ptr(const Unit& u) const { return (const char*)(A + (size_t)u.pm * 256 * 1024); }
    __device__ const char* b_ptr(const Unit& u) const { return (const char*)(Bt + (size_t)u.pn * 256 * 1024); }
    __device__ void a_off(const Unit&, int, unsigned (&)[2][2]) const {}
    __device__ __forceinline__ bool epi(f32x4 (&acc)[2][2][4][2], const Unit& u, int wr, int wc, int fr, int fq) const {
        const int pn = u.pn;
        {
            const LAS float* hsr = (const LAS float*)(shm + ROWS_OFF + (u.idx & 1) * ROWS_BUF) + wr * 64 + fr;
            const LAS float* csp = (const LAS float*)(shm + ROWS_OFF + (u.idx & 1) * ROWS_BUF + 1024) + 64 * wc + 8 * fq;
            float hv[2][4]; f32x4 cv[2][2];
#pragma unroll
            for (int a = 0; a < 2; ++a)
#pragma unroll
                for (int m = 0; m < 4; ++m) hv[a][m] = hsr[a * 128 + m * 16];
#pragma unroll
            for (int b = 0; b < 2; ++b)
#pragma unroll
                for (int n = 0; n < 2; ++n) cv[b][n] = *(const LAS f32x4*)(csp + 32 * b + 4 * n) * (pn >= 10 ? -LOG2E : 1.0f);
#pragma unroll
            for (int a = 0; a < 2; ++a)
#pragma unroll
                for (int b = 0; b < 2; ++b)
#pragma unroll
                    for (int m = 0; m < 4; ++m)
#pragma unroll
                        for (int n = 0; n < 2; ++n) { const pg8::v4i_t ia = __builtin_bit_cast(pg8::v4i_t, acc[a][b][m][n]);
                            acc[a][b][m][n] = (f32x4){(float)ia.x, (float)ia.y, (float)ia.z, (float)ia.w} * hv[a][m] * cv[b][n]; }
        }
        int kind, ld, tcol; size_t off;
        if (pn < 2) { kind = 0; off = WS_Q; ld = AW; tcol = pn; }
        else if (pn < 4) { kind = 1; off = WS_K; ld = AW; tcol = pn - 2; }
        else if (pn < 6) { kind = 2; off = WS_V; ld = AW; tcol = pn - 4; }
        else if (pn < 8) { kind = 3; off = WS_UG; ld = SGW; tcol = pn - 6; }
        else if (pn < 10) { kind = 3; off = WS_VG; ld = SGW; tcol = pn - 8; }
        else if (pn < 14) { kind = 4; off = WS_GA; ld = D; tcol = pn - 10; }
        else { kind = 4; off = WS_GB; ld = D; tcol = pn - 14; }
        bf16* base = (bf16*)(ws + off) + tcol * 256 + 64 * wc + 8 * fq;
        const int row0 = u.pm * 256 + wr * 64 + fr;
        const bool wt = wtx && (kind == 1 || kind == 2) && ((u.pm & 31) == 14 || (u.pm & 31) == 15);
        if (kind <= 1) {
            const float* g = (kind == 0 ? qg : kg) + 8 * fq;
            f32x4 gv[2][2];
#pragma unroll
            for (int bj = 0; bj < 2; ++bj)
#pragma unroll
                for (int n = 0; n < 2; ++n) gv[bj][n] = *(const f32x4*)(g + 32 * bj + 4 * n);
            unsigned char* b8 = ws + off + tcol * 256 + 64 * wc + 8 * fq; const bool oddq = (fq & 1) != 0;
#pragma unroll
            for (int ai = 0; ai < 2; ++ai)
#pragma unroll
                for (int mp = 0; mp < 2; ++mp) {
                    float rs[2];
#pragma unroll
                    for (int mm = 0; mm < 2; ++mm) { const int m = 2 * mp + mm; float ss = 0.f;
#pragma unroll
                        for (int bj = 0; bj < 2; ++bj)
#pragma unroll
                            for (int n = 0; n < 2; ++n) { const f32x4 v = acc[ai][bj][m][n]; ss += (v[0] * v[0] + v[1] * v[1]) + (v[2] * v[2] + v[3] * v[3]); }
                        ss = xsum_16_32(ss);
                        rs[mm] = fast_rsq(ss * (1.0f / 64.0f) + EPS); }
                    unsigned char* rowp = b8 + (size_t)(row0 + ai * 128 + (2 * mp + (oddq ? 1 : 0)) * 16) * ld - (oddq ? 8 : 0);
#pragma unroll
                    for (int bj = 0; bj < 2; ++bj) st16(rowp + 32 * bj, pair16(pack8q(acc[ai][bj][2 * mp][0] * rs[0] * gv[bj][0], acc[ai][bj][2 * mp][1] * rs[0] * gv[bj][1]),
                                                                                pack8q(acc[ai][bj][2 * mp + 1][0] * rs[1] * gv[bj][0], acc[ai][bj][2 * mp + 1][1] * rs[1] * gv[bj][1]), oddq), wt);
                }
        } else if (kind == 4) {
            unsigned char* b8 = ws + off + tcol * 256 + 64 * wc + 16 * fq;
#pragma unroll
            for (int ai = 0; ai < 2; ++ai)
#pragma unroll
                for (int m = 0; m < 4; ++m) {
                    f32x4 t[2][2];
#pragma unroll
                    for (int bj = 0; bj < 2; ++bj)
#pragma unroll
                        for (int n = 0; n < 2; ++n)
#pragma unroll
                            for (int j = 0; j < 4; ++j) t[bj][n][j] = fminf(fast_exp2(acc[ai][bj][m][n][j]), 448.0f);
                    const u32x2 e0 = pack8q(t[0][0], t[0][1]), e1 = pack8q(t[1][0], t[1][1]);
                    st16(b8 + (size_t)(row0 + ai * 128 + m * 16) * ld, (u32x4){e0.x, e0.y, e1.x, e1.y}, wt); }
        } else if (kind == 2) {
            unsigned char* b8 = ws + off + tcol * 256 + 64 * wc + 8 * fq;
#pragma unroll
            for (int ai = 0; ai < 2; ++ai)
#pragma unroll
                for (int mp = 0; mp < 2; ++mp) { const bool oddq = (fq & 1) != 0;
                    unsigned char* rowp = b8 + (size_t)(row0 + ai * 128 + (2 * mp + (oddq ? 1 : 0)) * 16) * ld - (oddq ? 8 : 0);
#pragma unroll
                    for (int bj = 0; bj < 2; ++bj) st16(rowp + 32 * bj, pair16(pack8q(acc[ai][bj][2 * mp][0], acc[ai][bj][2 * mp][1]), pack8q(acc[ai][bj][2 * mp + 1][0], acc[ai][bj][2 * mp + 1][1]), oddq), wt); }
        } else {
#pragma unroll
            for (int ai = 0; ai < 2; ++ai)
#pragma unroll
                for (int m = 0; m < 4; ++m) { bf16* rowp = base + (size_t)(row0 + ai * 128 + m * 16) * ld;
#pragma unroll
                    for (int bj = 0; bj < 2; ++bj) { f32x4 a = acc[ai][bj][m][0], b = acc[ai][bj][m][1];
#pragma unroll
                        for (int j = 0; j < 4; ++j) { a[j] = gelu_tanh(a[j]); b[j] = gelu_tanh(b[j]); }
                        st8(rowp + 32 * bj, a, b); } }
        }
        return false;
    }
};

struct PolMerge {
    static constexpr int NT = 8, LDA = D, LDB = D; static constexpr bool GATHER = false, FP8 = false, I8 = false, ROWDMA = false, IDDMA = false, SIGNAL = false;
    pg8::StaticOrder so; const bf16* A; const bf16* Bt; const unsigned char* ga; const unsigned char* gb; unsigned char* out;
    unsigned* rslot; float* ms; unsigned* tmo; LAS unsigned char* shm;
    __device__ bool next(int i, Unit& u) const { u.e = i & 1; u.s0 = 0; u.cnt = 0; return so.tile(i >> 1, u.pm, u.pn); }
    __device__ const char* a_ptr(const Unit& u) const { return (const char*)(A + (size_t)u.pm * 256 * LDA + 512 * u.e); }
    __device__ const char* b_ptr(const Unit& u) const { return (const char*)(Bt + (size_t)u.pn * 256 * LDB + 512 * u.e); }
    __device__ void a_off(const Unit&, int, unsigned (&)[2][2]) const {}
    __device__ __forceinline__ void gates(const u32x2& w, f32x4& b0, f32x4& b1) const {
        const f32x2 p0 = __builtin_amdgcn_cvt_pk_f32_fp8((int)w.x, false), p1 = __builtin_amdgcn_cvt_pk_f32_fp8((int)w.x, true), p2 = __builtin_amdgcn_cvt_pk_f32_fp8((int)w.y, false), p3 = __builtin_amdgcn_cvt_pk_f32_fp8((int)w.y, true);
        b0 = (f32x4){p0[0], p0[1], p1[0], p1[1]}; b1 = (f32x4){p2[0], p2[1], p3[0], p3[1]};
    }
    __device__ __forceinline__ bool epi(f32x4 (&acc)[2][2][4][2], const Unit& u, int wr, int wc, int fr, int fq) const {
        const int row0 = u.pm * 256 + wr * 64 + fr, col0 = u.pn * 256 + 64 * wc + 8 * fq;
        const int tid = threadIdx.x;
        float rm[2][4];
#pragma unroll
        for (int ai = 0; ai < 2; ++ai) {
            u32x2 gbv[4][2]; u32x2 gav[4][2];
#pragma unroll
            for (int m = 0; m < 4; ++m) { const size_t o = (size_t)(row0 + ai * 128 + m * 16) * D + u.pn * 256 + 64 * wc + 16 * fq;
                const u32x4 wb = *(const u32x4*)(gb + o); gbv[m][0] = (u32x2){wb.x, wb.y}; gbv[m][1] = (u32x2){wb.z, wb.w};
                if (u.e == 0) { const u32x4 wa = *(const u32x4*)(ga + o); gav[m][0] = (u32x2){wa.x, wa.y}; gav[m][1] = (u32x2){wa.z, wa.w}; } }
#pragma unroll
            for (int m = 0; m < 4; ++m) { float mx = 0.f;
#pragma unroll
                for (int bj = 0; bj < 2; ++bj) {
                    f32x4 b0, b1; gates(gbv[m][bj], b0, b1);
                    if (u.e == 0) {
                        f32x4 a0, a1; gates(gav[m][bj], a0, a1);
#pragma unroll
                        for (int j = 0; j < 4; ++j) {
                            acc[ai][bj][m][0][j] *= (1.0f + b0[j]) * fast_rcp(1.0f + a0[j]);
                            acc[ai][bj][m][1][j] *= (1.0f + b1[j]) * fast_rcp(1.0f + a1[j]); }
                    } else {
#pragma unroll
                        for (int j = 0; j < 4; ++j) { acc[ai][bj][m][0][j] *= fast_rcp(1.0f + b0[j]); acc[ai][bj][m][1][j] *= fast_rcp(1.0f + b1[j]);
                            mx = fmaxf(mx, fmaxf(fabsf(acc[ai][bj][m][0][j]), fabsf(acc[ai][bj][m][1][j]))); }
                    }
                }
                rm[ai][m] = mx; }
        }
        if (u.e == 0) return true;
        LAS unsigned* lrm = (LAS unsigned*)(shm + ROWS_OFF);
        LAS unsigned* lmx = lrm + 256;
#pragma unroll
        for (int ai = 0; ai < 2; ++ai)
#pragma unroll
            for (int m = 0; m < 4; ++m) { float mx = rm[ai][m]; mx = xmax_16_32(mx);
                if (fq == 0) (void)__hip_atomic_fetch_max(lrm + (ai * 128 + wr * 64 + m * 16 + fr), __float_as_uint(mx), __ATOMIC_RELAXED, __HIP_MEMORY_SCOPE_WORKGROUP); }
        asm volatile("s_waitcnt lgkmcnt(0)\n\ts_barrier" ::: "memory");
        if (tid < 256) {
            unsigned own = lrm[tid]; lrm[tid] = 0u;
            unsigned* slot = rslot + u.pm * 256 + tid;
            __hip_atomic_store(slot + (size_t)u.pn * T, own + 1u, RLX_AGENT);
            unsigned mxb = own, sp = 0;
            unsigned* const p1 = slot + (size_t)((u.pn + 1) & 3) * T; unsigned* const p2 = slot + (size_t)((u.pn + 2) & 3) * T; unsigned* const p3 = slot + (size_t)((u.pn + 3) & 3) * T;
            unsigned v1, v2, v3;
            for (;;) { v1 = __hip_atomic_load(p1, RLX_AGENT); v2 = __hip_atomic_load(p2, RLX_AGENT); v3 = __hip_atomic_load(p3, RLX_AGENT);
                if (v1 != 0u && v2 != 0u && v3 != 0u) break;
                __builtin_amdgcn_s_sleep(1);
                if ((++sp & 255u) == 0u) { if (__hip_atomic_load(tmo, RLX_AGENT)) break; if (sp > (1u << 18)) { atomicAdd(tmo, 1u); break; } } }
            mxb = (v1 != 0u && v1 - 1u > mxb) ? v1 - 1u : mxb; mxb = (v2 != 0u && v2 - 1u > mxb) ? v2 - 1u : mxb; mxb = (v3 != 0u && v3 - 1u > mxb) ? v3 - 1u : mxb;
            lmx[tid] = mxb;
            if (u.pn == 0) ms[u.pm * 256 + tid] = __uint_as_float(mxb) * (1.0f / 127.0f);
        }
        asm volatile("s_waitcnt lgkmcnt(0)\n\ts_barrier" ::: "memory");
        float sc[2][4];
#pragma unroll
        for (int ai = 0; ai < 2; ++ai)
#pragma unroll
            for (int m = 0; m < 4; ++m) { const float cm = __uint_as_float(lmx[ai * 128 + wr * 64 + m * 16 + fr]); sc[ai][m] = cm > 0.f ? 127.0f * fast_rcp(cm) : 0.f; }
        const bool oddq = (fq & 1) != 0;
#pragma unroll
        for (int ai = 0; ai < 2; ++ai)
#pragma unroll
            for (int mp = 0; mp < 2; ++mp) {
                unsigned char* rowp = out + (size_t)(row0 + ai * 128 + (2 * mp + (oddq ? 1 : 0)) * 16) * D + col0 - (oddq ? 8 : 0);
#pragma unroll
                for (int bj = 0; bj < 2; ++bj) {
                    const u32x2 e0 = (u32x2){pack_i8(acc[ai][bj][2 * mp][0] * sc[ai][2 * mp]), pack_i8(acc[ai][bj][2 * mp][1] * sc[ai][2 * mp])};
                    const u32x2 e1 = (u32x2){pack_i8(acc[ai][bj][2 * mp + 1][0] * sc[ai][2 * mp + 1]), pack_i8(acc[ai][bj][2 * mp + 1][1] * sc[ai][2 * mp + 1])};
                    *(u32x4*)(rowp + 32 * bj) = pair16(e0, e1, oddq); } }
        return false;
    }
};

struct PolOut {
    static constexpr int NT = 8, LDA = 512, LDB = 512; static constexpr bool GATHER = false, FP8 = false, I8 = true, ROWDMA = true, IDDMA = false, SIGNAL = false;
    pg8::StaticOrder so; const unsigned char* A; const unsigned char* Bt; const float* x; bf16* x1; unsigned char* x1q; const float* ms; const float* cs; LAS unsigned char* shm;
    __device__ bool next(int i, Unit& u) const { u.e = 0; u.s0 = 0; u.cnt = 0; u.idx = i; return so.tile(i, u.pm, u.pn); }
    __device__ const char* a_ptr(const Unit& u) const { return (const char*)(A + (size_t)u.pm * 256 * 1024); }
    __device__ const char* b_ptr(const Unit& u) const { return (const char*)(Bt + (size_t)u.pn * 256 * 1024); }
    __device__ void a_off(const Unit&, int, unsigned (&)[2][2]) const {}
    __device__ __forceinline__ void row_dma(const Unit& u, LAS unsigned char* lds, int wid, int lane) const {
        const unsigned* src = (wid < 4) ? (const unsigned*)(ms + u.pm * 256 + 64 * wid + lane) : (const unsigned*)(cs + u.pn * 256 + 64 * (wid & 3) + lane);
        __builtin_amdgcn_global_load_lds(src, (LAS unsigned*)(lds + ROWS_OFF + (u.idx & 1) * ROWS_BUF + 256 * wid), 4, 0, 0);
    }
    __device__ __forceinline__ bool epi(f32x4 (&acc)[2][2][4][2], const Unit& u, int wr, int wc, int fr, int fq) const {
        const int row0 = u.pm * 256 + wr * 64 + fr, col0 = u.pn * 256 + 64 * wc + 8 * fq;
        const LAS float* hsr = (const LAS float*)(shm + ROWS_OFF + (u.idx & 1) * ROWS_BUF) + wr * 64 + fr;
        const LAS float* csp = (const LAS float*)(shm + ROWS_OFF + (u.idx & 1) * ROWS_BUF + 1024) + 64 * wc + 8 * fq;
        f32x4 cv[2][2];
#pragma unroll
        for (int b = 0; b < 2; ++b)
#pragma unroll
            for (int n = 0; n < 2; ++n) cv[b][n] = *(const LAS f32x4*)(csp + 32 * b + 4 * n);
        const bool oddq = (fq & 1) != 0;
        f32x4 xv[2][2][2][2];
#define PO_LOAD(B, IT) do { _Pragma("unroll") for (int mm = 0; mm < 2; ++mm) { const size_t o_ = (size_t)(row0 + ((IT) >> 1) * 128 + (2 * ((IT) & 1) + mm) * 16) * D + col0; \
            _Pragma("unroll") for (int bj = 0; bj < 2; ++bj) { xv[B][mm][bj][0] = *(const f32x4*)(x + o_ + 32 * bj); xv[B][mm][bj][1] = *(const f32x4*)(x + o_ + 32 * bj + 4); } } } while (0)
        PO_LOAD(0, 0);
#pragma unroll
        for (int it = 0; it < 4; ++it) {
                const int ai = it >> 1, mp = it & 1;
                u32x2 xqp[2][2];
                if (it < 3) PO_LOAD((it + 1) & 1, it + 1);
#pragma unroll
                for (int mm = 0; mm < 2; ++mm) { const int m = 2 * mp + mm; const size_t o = (size_t)(row0 + ai * 128 + m * 16) * D + col0; const float hv = hsr[ai * 128 + m * 16];
#pragma unroll
                    for (int bj = 0; bj < 2; ++bj) {
                        const pg8::v4i_t i0_ = __builtin_bit_cast(pg8::v4i_t, acc[ai][bj][m][0]), i1_ = __builtin_bit_cast(pg8::v4i_t, acc[ai][bj][m][1]);
                        const f32x4 r0 = xv[it & 1][mm][bj][0] + (f32x4){(float)i0_.x, (float)i0_.y, (float)i0_.z, (float)i0_.w} * hv * cv[bj][0];
                        const f32x4 r1 = xv[it & 1][mm][bj][1] + (f32x4){(float)i1_.x, (float)i1_.y, (float)i1_.z, (float)i1_.w} * hv * cv[bj][1];
                        st8(x1 + o + 32 * bj, r0, r1); xqp[mm][bj] = pack8q(r0, r1);
                        if (mm) *(u32x4*)(x1q + o - (oddq ? 0 : 16 * D) - (oddq ? 8 : 0) + 32 * bj) = pair16(xqp[0][bj], xqp[1][bj], oddq);
                    } } }
#undef PO_LOAD
        return false;
    }
};

struct MoeOrder {
    const LAS int* tb;
    int NN, nwg, G, c;
    __device__ void init(const LAS int* tb_, int NN_, int G_, int c_) { tb = tb_; NN = NN_; G = G_; c = c_; nwg = tb_[32] * NN_; }
    __device__ bool unit(int i, Unit& u) const {
        const int nt_ = nwg / NN, xcd = c % 8, t0 = (nt_ * xcd) / 8, t1 = (nt_ * (xcd + 1)) / 8;
        const int li = i * (G / 8) + c / 8; if (li >= (t1 - t0) * NN) return false;
        const int wgid = t0 * NN + li;
        const int Mt = wgid / NN;
        const int ln = threadIdx.x & 63;
        const unsigned long long bal = __ballot(ln < NE && tb[ln & 31] <= Mt);
        const int e = __popcll(bal) - 1;
        u.idx = i; u.pm = __builtin_amdgcn_readfirstlane(Mt); u.pn = __builtin_amdgcn_readfirstlane(wgid % NN); u.e = __builtin_amdgcn_readfirstlane(e);
        u.s0 = __builtin_amdgcn_readfirstlane((Mt - tb[e]) * 256); u.cnt = __builtin_amdgcn_readfirstlane(tb[33 + e]);
        return true;
    }
};

struct PolGU {
    static constexpr int NT = 8, LDA = 512, LDB = 512; static constexpr bool GATHER = true, FP8 = true, I8 = false, ROWDMA = true, IDDMA = true, SIGNAL = true;
    MoeOrder mo; const unsigned char* A; const unsigned char* Bt; const int* lid; const float* lrs; const float* bgu; unsigned char* act; LAS unsigned char* shm;
    __device__ __forceinline__ void row_dma(const Unit& u, LAS unsigned char* lds, int wid, int lane) const {
        const unsigned* src = (wid < 4) ? (const unsigned*)(lrs + (size_t)u.e * LCAP + u.s0 + 64 * wid + lane)
                                        : (const unsigned*)(bgu + (size_t)u.e * 2048 + u.pn * 128 + 1024 * ((wid >> 1) & 1) + 64 * (wid & 1) + lane);
        __builtin_amdgcn_global_load_lds(src, (LAS unsigned*)(lds + ROWS_OFF + (u.idx & 1) * ROWS_BUF + 256 * wid), 4, 0, 0);
    }
    __device__ bool next(int i, Unit& u) const { return mo.unit(i, u); }
    unsigned* tcnt;
    __device__ __forceinline__ void signal(const Unit& u, int n) const { for (int k = 0; k < n; ++k) (void)__hip_atomic_fetch_add(tcnt + u.pm - 4 * k, 1u, RLX_AGENT); }
    __device__ __forceinline__ void ids_dma(const Unit& nx, const Unit& cu, LAS unsigned char* lds, int wid, int lane) const {
        if (wid < 4) __builtin_amdgcn_global_load_lds((const unsigned*)(lid + (size_t)nx.e * LCAP + nx.s0 + 64 * wid + lane), (LAS unsigned*)(lds + ROWS_OFF + (cu.idx & 1) * ROWS_BUF + 2048 + 256 * wid), 4, 0, 0);
    }
    __device__ __forceinline__ void a_off_lds(const Unit& nx, const Unit& cu, int tid, LAS unsigned char* lds, unsigned (&v)[2][2]) const {
        const LAS int* l = (const LAS int*)(lds + ROWS_OFF + (cu.idx & 1) * ROWS_BUF + 2048);
#pragma unroll
        for (int i = 0; i < 2; ++i) { int R, C; pg8::stage_rc(tid * 16 + i * 8192, R, C);
#pragma unroll
            for (int h = 0; h < 2; ++h) { const int s = h * 128 + R; const int id = l[s]; const int tok = (nx.s0 + s < nx.cnt) ? (id >> 2) : 0; v[h][i] = (unsigned)(tok * LDA + C) * 2u; } }
    }
    __device__ const char* a_ptr(const Unit&) const { return (const char*)A; }
    __device__ const char* b_ptr(const Unit& u) const { return (const char*)(Bt + ((size_t)u.e * 2048 + (size_t)u.pn * 256) * 1024); }
    __device__ __forceinline__ void a_off(const Unit& u, int tid, unsigned (&v)[2][2]) const {
        const int* l = lid + (size_t)u.e * LCAP;
#pragma unroll
        for (int i = 0; i < 2; ++i) { int R, C; pg8::stage_rc(tid * 16 + i * 8192, R, C);
#pragma unroll
            for (int h = 0; h < 2; ++h) { const int s = u.s0 + h * 128 + R; const int id = l[s]; const int tok = (s < u.cnt) ? (id >> 2) : 0; v[h][i] = (unsigned)(tok * LDA + C) * 2u; } }
    }
    __device__ __forceinline__ bool epi(f32x4 (&acc)[2][2][4][2], const Unit& u, int wr, int wc, int fr, int fq) const {
        const LAS float* rsl = (const LAS float*)(shm + ROWS_OFF + (u.idx & 1) * ROWS_BUF);
        const LAS float* bg = (const LAS float*)(shm + ROWS_OFF + (u.idx & 1) * ROWS_BUF + 1024) + 32 * wc + 8 * fq;
        const f32x4 bg0 = *(const LAS f32x4*)bg, bg1 = *(const LAS f32x4*)(bg + 4), bu0 = *(const LAS f32x4*)(bg + 128) + 1.0f, bu1 = *(const LAS f32x4*)(bg + 132) + 1.0f;
        unsigned char* ob = act + (size_t)u.pm * 256 * FF + u.pn * 128 + 32 * wc + 8 * fq;
        float rsv[2][4];
#pragma unroll
        for (int ai = 0; ai < 2; ++ai)
#pragma unroll
            for (int m = 0; m < 4; ++m) { const int r = ai * 128 + wr * 64 + m * 16 + fr; const bool valid = (u.s0 + r < u.cnt); const float t_ = rsl[r]; rsv[ai][m] = valid ? t_ * WQ_INV : 0.f; }
        const bool oddq = (fq & 1) != 0; u32x2 pkq[2];
#pragma unroll
        for (int ai = 0; ai < 2; ++ai)
#pragma unroll
            for (int m = 0; m < 4; ++m) { const int r = ai * 128 + wr * 64 + m * 16 + fr; const float rs = rsv[ai][m];
                f32x4 o[2];
#pragma unroll
                for (int n = 0; n < 2; ++n)
#pragma unroll
                    for (int h2 = 0; h2 < 2; ++h2) {
                        const f32x2 ag = {acc[ai][0][m][n][2 * h2], acc[ai][0][m][n][2 * h2 + 1]}, au = {acc[ai][1][m][n][2 * h2], acc[ai][1][m][n][2 * h2 + 1]};
                        const f32x2 bgv = n ? (f32x2){bg1[2 * h2], bg1[2 * h2 + 1]} : (f32x2){bg0[2 * h2], bg0[2 * h2 + 1]}, buv = n ? (f32x2){bu1[2 * h2], bu1[2 * h2 + 1]} : (f32x2){bu0[2 * h2], bu0[2 * h2 + 1]};
                        f32x2 g = ag * rs + bgv, up = au * rs + buv;
                        g = __builtin_elementwise_min(g, (f32x2){7.0f, 7.0f});
                        up.x = __builtin_amdgcn_fmed3f(up.x, -6.0f, 8.0f); up.y = __builtin_amdgcn_fmed3f(up.y, -6.0f, 8.0f);
                        const f32x2 t = g * (-1.702f * LOG2E);
                        f32x2 e; e.x = fast_exp2(t.x); e.y = fast_exp2(t.y);
                        const f32x2 den = e + 1.0f;
                        f32x2 rc; rc.x = fast_rcp(den.x); rc.y = fast_rcp(den.y);
                        const f32x2 res = up * (g * rc);
                        o[n][2 * h2] = res.x; o[n][2 * h2 + 1] = res.y; }
                pkq[m & 1] = pack8q(o[0], o[1]);
                if (m & 1) *(u32x4*)(ob + (size_t)(r - (oddq ? 0 : 16)) * FF - (oddq ? 8 : 0)) = pair16(pkq[0], pkq[1], oddq); }
        return false;
    }
};

struct PolDown {
    static constexpr int NT = 8, LDA = 512, LDB = 512; static constexpr bool GATHER = true, FP8 = true, I8 = false, ROWDMA = true, IDDMA = false, SIGNAL = false;
    MoeOrder mo; const unsigned char* A; const unsigned char* Bt; const int* lid; const float* lp; const float* bd; unsigned char* y; LAS unsigned char* shm;
    __device__ __forceinline__ void row_dma(const Unit& u, LAS unsigned char* lds, int wid, int lane) const {
        const size_t o = (size_t)u.e * LCAP + u.s0 + 64 * (wid & 3) + lane;
        const unsigned* src = (wid < 4) ? (const unsigned*)(lid + o) : (const unsigned*)(lp + o);
        __builtin_amdgcn_global_load_lds(src, (LAS unsigned*)(lds + ROWS_OFF + (u.idx & 1) * ROWS_BUF + 256 * wid), 4, 0, 0);
        if (wid < 4) __builtin_amdgcn_global_load_lds((const unsigned*)(bd + (size_t)u.e * D + u.pn * 256 + 64 * wid + lane), (LAS unsigned*)(lds + ROWS_OFF + (u.idx & 1) * ROWS_BUF + 2048 + 256 * wid), 4, 0, 0);
    }
    unsigned* tcnt; unsigned* tmo;
    __device__ __forceinline__ void wait_tile(int pm) const {
        unsigned sp = 0;
        while (__hip_atomic_load(tcnt + pm, RLX_AGENT) < 8u) { __builtin_amdgcn_s_sleep(2);
            if ((++sp & 255u) == 0u) { if (__hip_atomic_load(tmo, RLX_AGENT)) break; if (sp > (1u << 18)) { atomicAdd(tmo, 1u); break; } } }
        asm volatile("" ::: "memory");
    }
    __device__ __forceinline__ bool next(int i, Unit& u) const {
        if (!mo.unit(i, u)) return false;
        if (i < 2) wait_tile(u.pm);
        return true;
    }
    __device__ const char* a_ptr(const Unit& u) const { return (const char*)(A + (size_t)u.pm * 256 * 1024); }
    __device__ const char* b_ptr(const Unit& u) const { return (const char*)(Bt + ((size_t)u.e * 1024 + (size_t)u.pn * 256) * 1024); }
    __device__ __forceinline__ void a_off(const Unit&, int tid, unsigned (&v)[2][2]) const {
#pragma unroll
        for (int i = 0; i < 2; ++i) { int R, C; pg8::stage_rc(tid * 16 + i * 8192, R, C); v[0][i] = (unsigned)(R * LDA + C) * 2u; v[1][i] = (unsigned)((R + 128) * LDA + C) * 2u; }
    }
    __device__ __forceinline__ bool epi(f32x4 (&acc)[2][2][4][2], const Unit& u, int wr, int wc, int fr, int fq) const {
        const LAS int* idl = (const LAS int*)(shm + ROWS_OFF + (u.idx & 1) * ROWS_BUF); const LAS float* pl = (const LAS float*)(shm + ROWS_OFF + (u.idx & 1) * ROWS_BUF + 1024);
        const int col0 = u.pn * 256 + 64 * wc + 8 * fq;
        Unit u2; const bool h2 = mo.unit(u.idx + 2, u2);
        unsigned fl2 = 8u; if (h2) fl2 = __hip_atomic_load(tcnt + u2.pm, RLX_AGENT);
        const LAS float* b = (const LAS float*)(shm + ROWS_OFF + (u.idx & 1) * ROWS_BUF + 2048) + 64 * wc + 8 * fq;
        int idv[2][4]; float pv_[2][4];
#pragma unroll
        for (int ai = 0; ai < 2; ++ai)
#pragma unroll
            for (int m = 0; m < 4; ++m) { const int r = ai * 128 + wr * 64 + m * 16 + fr; const bool valid = (u.s0 + r < u.cnt);
                const int t_ = idl[r]; const float q_ = pl[r]; idv[ai][m] = valid ? t_ : T * 4; pv_[ai][m] = q_; }
        f32x4 bv[2][2];
#pragma unroll
        for (int bj = 0; bj < 2; ++bj)
#pragma unroll
            for (int n = 0; n < 2; ++n) bv[bj][n] = *(const LAS f32x4*)(b + 32 * bj + 4 * n);
        const bool oddq = (fq & 1) != 0;
#pragma unroll
        for (int ai = 0; ai < 2; ++ai)
#pragma unroll
            for (int mp = 0; mp < 2; ++mp) {
                const float p0 = pv_[ai][2 * mp] * 16.0f, p1 = pv_[ai][2 * mp + 1] * 16.0f;
                unsigned char* op = y + (size_t)(oddq ? idv[ai][2 * mp + 1] : idv[ai][2 * mp]) * D + (col0 - (oddq ? 8 : 0));
#pragma unroll
                for (int bj = 0; bj < 2; ++bj) {
                    const u32x2 e0 = pack8q((acc[ai][bj][2 * mp][0] * WQ_INV + bv[bj][0]) * p0, (acc[ai][bj][2 * mp][1] * WQ_INV + bv[bj][1]) * p0);
                    const u32x2 e1 = pack8q((acc[ai][bj][2 * mp + 1][0] * WQ_INV + bv[bj][0]) * p1, (acc[ai][bj][2 * mp + 1][1] * WQ_INV + bv[bj][1]) * p1);
                    const u32x4 w = pair16(e0, e1, oddq);
                    *(u32x4*)(op + 32 * bj) = w; } }
        if (h2 && fl2 < 8u) wait_tile(u2.pm);
        return false;
    }
};

constexpr int CONV_GU_ITEMS = NE * 16 * 32, CONV_D_ITEMS = NE * 16 * 16, CONV_ITEMS = CONV_GU_ITEMS + CONV_D_ITEMS, CONV_PER_WAVE = CONV_ITEMS / 2048;
static_assert(CONV_PER_WAVE * 2048 == CONV_ITEMS, "items divide over 2048 waves");
struct MoeConv {
    const float* wgu; const float* wd; const float* g2; unsigned char* WGU8; unsigned char* WD8;
    struct Regs { f32x4 v0, v1, v2, v3, v4, v5, v6, v7, v8, v9, v10, v11, v12, v13, v14, v15; };
    __device__ __forceinline__ void src_of(int item, const float*& W, int& N, int& k0, int& n0) const {
        if (item < CONV_GU_ITEMS) { const int e = item >> 9, q = item & 511; W = wgu + (size_t)e * D * 2048; N = 2048; k0 = 128 * (q >> 6); n0 = 32 * (q & 63); }
        else { const int r = item - CONV_GU_ITEMS, e = r >> 8, q = r & 255; W = wd + (size_t)e * FF * D; N = D; k0 = 128 * (q >> 5); n0 = 32 * (q & 31); }
    }
    __device__ __forceinline__ void finish(Regs& R, int item, int lane) const {
        const float* W; int N, k0, n0; src_of(item, W, N, k0, n0);
        const int kc = lane >> 3, nq = lane & 7; const bool gu = item < CONV_GU_ITEMS;
        float sc[16];
        if (gu) { const f32x4* gp = (const f32x4*)(g2 + k0 + 16 * kc);
#pragma unroll
            for (int q = 0; q < 4; ++q) { const f32x4 t = gp[q]; sc[4 * q] = t[0] * 32.0f; sc[4 * q + 1] = t[1] * 32.0f; sc[4 * q + 2] = t[2] * 32.0f; sc[4 * q + 3] = t[3] * 32.0f; } }
        else {
#pragma unroll
            for (int i = 0; i < 16; ++i) sc[i] = 32.0f; }
        const int nb = n0;
        const int e = gu ? (item >> 9) : ((item - CONV_GU_ITEMS) >> 8);
        const int up = nb >= 1024, cc = nb & 1023;
        const int pos = gu ? ((cc >> 7) * 256 + up * 128 + ((cc >> 5) & 3) * 32) : ((nb & ~255) + ((nb >> 5) & 1) * 128 + ((nb >> 6) & 3) * 32);
        unsigned char* base = (gu ? (WGU8 + ((size_t)e * 2048 + pos + 4 * nq) * 1024) : (WD8 + ((size_t)e * 1024 + pos + 4 * nq) * 1024)) + k0 + 16 * kc;
#pragma unroll
        for (int c = 0; c < 4; ++c) {
            int w0 = 0, w1 = 0, w2 = 0, w3 = 0;
            w0 = __builtin_amdgcn_cvt_pk_fp8_f32(R.v0[c] * sc[0], R.v1[c] * sc[1], w0, false); w0 = __builtin_amdgcn_cvt_pk_fp8_f32(R.v2[c] * sc[2], R.v3[c] * sc[3], w0, true);
            w1 = __builtin_amdgcn_cvt_pk_fp8_f32(R.v4[c] * sc[4], R.v5[c] * sc[5], w1, false); w1 = __builtin_amdgcn_cvt_pk_fp8_f32(R.v6[c] * sc[6], R.v7[c] * sc[7], w1, true);
            w2 = __builtin_amdgcn_cvt_pk_fp8_f32(R.v8[c] * sc[8], R.v9[c] * sc[9], w2, false); w2 = __builtin_amdgcn_cvt_pk_fp8_f32(R.v10[c] * sc[10], R.v11[c] * sc[11], w2, true);
            w3 = __builtin_amdgcn_cvt_pk_fp8_f32(R.v12[c] * sc[12], R.v13[c] * sc[13], w3, false); w3 = __builtin_amdgcn_cvt_pk_fp8_f32(R.v14[c] * sc[14], R.v15[c] * sc[15], w3, true);
            *(u32x4*)(base + (size_t)c * 1024) = (u32x4){(unsigned)w0, (unsigned)w1, (unsigned)w2, (unsigned)w3};
        }
    }
    template <int SUB> __device__ __forceinline__ void sub(Regs& R, int& st, int item0, int istride, int lane) const {
        if (SUB == 0 && (st & 1)) { finish(R, item0 + ((st >> 1) - 1) * istride, lane); st &= ~1; }
        const int it = st >> 1;
        {
            const int itc = it < CONV_PER_WAVE ? it : CONV_PER_WAVE - 1;
            const float* W; int N, k0, n0; src_of(item0 + itc * istride, W, N, k0, n0);
            const float* p = W + (size_t)(k0 + 16 * (lane >> 3) + 4 * SUB) * N + n0 + 4 * (lane & 7);
            const f32x4 t0 = *(const f32x4*)p, t1 = *(const f32x4*)(p + N), t2 = *(const f32x4*)(p + 2 * (size_t)N), t3 = *(const f32x4*)(p + 3 * (size_t)N);
            if (SUB == 0) { R.v0 = t0; R.v1 = t1; R.v2 = t2; R.v3 = t3; }
            else if (SUB == 1) { R.v4 = t0; R.v5 = t1; R.v6 = t2; R.v7 = t3; }
            else if (SUB == 2) { R.v8 = t0; R.v9 = t1; R.v10 = t2; R.v11 = t3; }
            else { R.v12 = t0; R.v13 = t1; R.v14 = t2; R.v15 = t3; if (it < CONV_PER_WAVE) st = ((it + 1) << 1) | 1; }
        }
    }
    __device__ __forceinline__ void drain(Regs& R, int& st, int item0, int istride, int lane) const {
        if (st & 1) { finish(R, item0 + ((st >> 1) - 1) * istride, lane); st &= ~1; }
        for (int it = st >> 1; it < CONV_PER_WAVE; ++it) { sub<0>(R, st, item0, istride, lane); sub<1>(R, st, item0, istride, lane); sub<2>(R, st, item0, istride, lane); sub<3>(R, st, item0, istride, lane);
            finish(R, item0 + it * istride, lane); st &= ~1; }
    }
};

namespace att {
constexpr int PITCH = 512, SLOTB = 8192;
__device__ __forceinline__ u32x4 f8x8_bf16(const u32x2& w, float s) {
    const f32x2 a = __builtin_amdgcn_cvt_pk_f32_fp8((int)w.x, false), b = __builtin_amdgcn_cvt_pk_f32_fp8((int)w.x, true), c = __builtin_amdgcn_cvt_pk_f32_fp8((int)w.y, false), d = __builtin_amdgcn_cvt_pk_f32_fp8((int)w.y, true);
    return (u32x4){cvt_pk_bf16(a[0] * s, a[1] * s), cvt_pk_bf16(b[0] * s, b[1] * s), cvt_pk_bf16(c[0] * s, c[1] * s), cvt_pk_bf16(d[0] * s, d[1] * s)};
}
constexpr int L_K = 0, L_V = 2 * SLOTB, L_TBL = 4 * SLOTB, L_WS = L_TBL + 4096, L_OST = L_WS + 8 * 256, L_END = L_OST + 8 * 4096;
constexpr int NTBL = 832;
__device__ __forceinline__ int crow(int r, int hi) { return (r & 3) + 8 * (r >> 2) + 4 * hi; }
__device__ __forceinline__ void glds16(const void* gsrc, unsigned lds_dst) { unsigned keep;
    asm volatile("s_mov_b32 %0, m0\n\ts_mov_b32 m0, %2\n\ts_nop 0\n\tglobal_load_lds_dwordx4 %1, off\n\ts_mov_b32 m0, %0" : "=&s"(keep) : "v"(gsrc), "s"(lds_dst) : "memory"); }
__device__ __forceinline__ unsigned cvtpk_s(float lo, float hi) { typedef __bf16 bf16x2_t __attribute__((ext_vector_type(2))); f32x2 v = {lo, hi}; bf16x2_t b = __builtin_convertvector(v, bf16x2_t); return __builtin_bit_cast(unsigned, b); }
#define ATT_SBAR() __builtin_amdgcn_sched_barrier(0)
__device__ __forceinline__ void pv(f32x16* o, int vb, bf16x8 pa0, bf16x8 pa1, bf16x8 pa2, bf16x8 pa3) {
#pragma unroll
    for (int d0 = 0; d0 < 2; ++d0) { s16x4 lo[4], hi[4];
#pragma unroll
        for (int ks = 0; ks < 4; ++ks) {
            asm volatile("ds_read_b64_tr_b16 %0,%1 offset:%c2" : "=&v"(lo[ks]) : "v"(vb), "i"(d0 * 4096 + ks * 1024) : "memory");
            asm volatile("ds_read_b64_tr_b16 %0,%1 offset:%c2" : "=&v"(hi[ks]) : "v"(vb), "i"(d0 * 4096 + ks * 1024 + 512) : "memory"); }
        asm volatile("s_waitcnt lgkmcnt(0)" ::: "memory"); ATT_SBAR();
#define ATT_PK(k) (bf16x8){lo[k][0], lo[k][1], lo[k][2], lo[k][3], hi[k][0], hi[k][1], hi[k][2], hi[k][3]}
        o[d0] = __builtin_amdgcn_mfma_f32_32x32x16_bf16(pa0, ATT_PK(0), o[d0], 0, 0, 0);
        o[d0] = __builtin_amdgcn_mfma_f32_32x32x16_bf16(pa1, ATT_PK(1), o[d0], 0, 0, 0);
        o[d0] = __builtin_amdgcn_mfma_f32_32x32x16_bf16(pa2, ATT_PK(2), o[d0], 0, 0, 0);
        o[d0] = __builtin_amdgcn_mfma_f32_32x32x16_bf16(pa3, ATT_PK(3), o[d0], 0, 0, 0);
#undef ATT_PK
    }
}
struct Carry { u32x2 kA, vA, kB, vB, q[4]; };
__device__ __forceinline__ void unit(int b, int h, int cg, const unsigned char* Q, const unsigned char* K, const unsigned char* V, const float* relb, bf16* O  , LAS unsigned char* shm,
                                     const MoeConv& cv, MoeConv::Regs& sreg, int& sctr, int item0, int istride, bool first, bool fill_tbl, bool has_next, int nb, int nh, int ncg, Carry& cr) {
    const int tid = threadIdx.x, lane = tid & 63, r32 = lane & 31, hi = lane >> 5; const int wid = __builtin_amdgcn_readfirstlane(tid >> 6);
    const long rowbase = (long)b * SEQ; const int cq = 4 * cg + (wid >> 1), wq = wid & 1;
    const unsigned char* Qw = Q + (rowbase + 64 * cq + 32 * wq) * PITCH + h * HD;
    const unsigned lds0 = (unsigned)(uintptr_t)shm;
    LAS float* tbl = (LAS float*)(shm + L_TBL);
    LAS float* wsf = (LAS float*)(shm + L_WS) + wid * 64;
    if (fill_tbl) { for (int i = tid; i < NTBL; i += 512) tbl[i] = relb[h * NREL + (i < 512 ? i : 512)] * LOG2E; }
    const int srow = tid >> 3, sc = tid & 7;
    const unsigned char* ksrc = K + (rowbase + srow) * PITCH + h * HD + sc * 8;
    const unsigned char* vsrc = V + (rowbase + srow) * PITCH + h * HD + sc * 8;
    const int kwr = L_K + sc * 1024 + ((srow ^ sc) << 4);
    const int vwr = L_V + (4 * (sc >> 2) + (srow >> 4)) * 1024 + (srow & 15) * 64 + (sc & 3) * 16;
    const int vb0 = (int)(lds0 + L_V) + ((lane >> 4) & 1) * 32 + (lane & 3) * 8 + (4 * hi + ((lane & 15) >> 2)) * 64;
    int kra[4];
#pragma unroll
    for (int d0 = 0; d0 < 4; ++d0) kra[d0] = L_K + (2 * d0 + hi) * 1024 + ((r32 ^ (2 * d0 + hi)) << 4);
    bf16x8 qr[4];
#pragma unroll
    for (int d0 = 0; d0 < 4; ++d0) { if (first) cr.q[d0] = *(const u32x2*)(Qw + (long)r32 * PITCH + d0 * 16 + hi * 8); qr[d0] = __builtin_bit_cast(bf16x8, f8x8_bf16(cr.q[d0], 0.125f * LOG2E)); }
    f32x16 o[2]; o[0] = f32x16{}; o[1] = f32x16{}; float l_reg = 0.f;
    const int j0 = (8 - 4 * cg) > 0 ? (8 - 4 * cg) : 0;
    u32x2 kA_ = cr.kA, vA_ = cr.vA, kB_ = cr.kB, vB_ = cr.vB;
    if (first) { const long ro = (long)(4 * cg - 8 + j0) * 64 * PITCH; kA_ = *(const u32x2*)(ksrc + ro); vA_ = *(const u32x2*)(vsrc + ro); kB_ = *(const u32x2*)(ksrc + ro + 64 * PITCH); vB_ = *(const u32x2*)(vsrc + ro + 64 * PITCH); }
    const int nj0 = has_next ? ((8 - 4 * ncg) > 0 ? (8 - 4 * ncg) : 0) : 10;
    const long nrowbase = has_next ? (long)nb * SEQ : rowbase; const int ncg_ = has_next ? ncg : cg, nh_ = has_next ? nh : h;
    const unsigned char* nks = K + (nrowbase + srow) * PITCH + nh_ * HD + sc * 8 + (long)(4 * ncg_ - 8 + nj0 - 10) * 64 * PITCH;
    const unsigned char* nvs = V + (nrowbase + srow) * PITCH + nh_ * HD + sc * 8 + (long)(4 * ncg_ - 8 + nj0 - 10) * 64 * PITCH;
    const unsigned char* nQw = Q + (nrowbase + 64 * (4 * ncg_ + (wid >> 1)) + 32 * wq) * PITCH + nh_ * HD;
#define ATT_STEP(JX, SUBP, KR, VR) do { const int j = (JX); \
        const int s = (j - j0) & 1; \
        *(LAS u32x4*)(shm + kwr + s * SLOTB) = f8x8_bf16(KR, 1.0f); *(LAS u32x4*)(shm + vwr + s * SLOTB) = f8x8_bf16(VR, 1.0f); \
        if (j < 10) { const long ro = (long)(4 * cg - 8 + j + 2) * 64 * PITCH; KR = *(const u32x2*)(ksrc + ro); VR = *(const u32x2*)(vsrc + ro); } \
        else { KR = *(const u32x2*)(nks + (long)j * 64 * PITCH); VR = *(const u32x2*)(nvs + (long)j * 64 * PITCH); \
               if (j == 11) { _Pragma("unroll") for (int d0 = 0; d0 < 4; ++d0) cr.q[d0] = *(const u32x2*)(nQw + (long)r32 * PITCH + d0 * 16 + hi * 8); } } \
        asm volatile("s_waitcnt lgkmcnt(0)\n\ts_barrier" ::: "memory"); \
        cv.template sub<SUBP>(sreg, sctr, item0, istride, lane);     \
        const int d = (wid >> 1) + 8 - j; \
        if (d >= 0 && d <= 8) { \
            f32x16 p0 = f32x16{}, p1 = f32x16{}; \
            const LAS unsigned char* kbs = shm + s * SLOTB; \
        _Pragma("unroll") \
            for (int d0 = 0; d0 < 4; ++d0) { \
                const bf16x8 b0 = *(const LAS bf16x8*)(kbs + kra[d0]), b1 = *(const LAS bf16x8*)(kbs + kra[d0] + 512); \
                p0 = __builtin_amdgcn_mfma_f32_32x32x16_bf16(b0, qr[d0], p0, 0, 0, 0); p1 = __builtin_amdgcn_mfma_f32_32x32x16_bf16(b1, qr[d0], p1, 0, 0, 0); } \
            const LAS float* tb = tbl + (256 + 64 * d + 32 * wq + r32 - 4 * hi - 63); \
            float sacc = 0.f; \
        _Pragma("unroll") \
            for (int r = 0; r < 16; ++r) { const int c = (r & 3) + 8 * (r >> 2); \
                p0[r] = fast_exp2(p0[r] + tb[63 - c]); p1[r] = fast_exp2(p1[r] + tb[31 - c]); sacc += p0[r] + p1[r]; } \
            l_reg += sacc; \
            u32x4 pw0, pw1, pw2, pw3; \
            pw0 = (u32x4){cvtpk_s(p0[0], p0[1]), cvtpk_s(p0[2], p0[3]), cvtpk_s(p0[4], p0[5]), cvtpk_s(p0[6], p0[7])}; \
            pw1 = (u32x4){cvtpk_s(p0[8], p0[9]), cvtpk_s(p0[10], p0[11]), cvtpk_s(p0[12], p0[13]), cvtpk_s(p0[14], p0[15])}; \
            pw2 = (u32x4){cvtpk_s(p1[0], p1[1]), cvtpk_s(p1[2], p1[3]), cvtpk_s(p1[4], p1[5]), cvtpk_s(p1[6], p1[7])}; \
            pw3 = (u32x4){cvtpk_s(p1[8], p1[9]), cvtpk_s(p1[10], p1[11]), cvtpk_s(p1[12], p1[13]), cvtpk_s(p1[14], p1[15])}; \
            ATT_SBAR(); \
            pv(o, vb0 + s * SLOTB, __builtin_bit_cast(bf16x8, pw0), __builtin_bit_cast(bf16x8, pw1), __builtin_bit_cast(bf16x8, pw2), __builtin_bit_cast(bf16x8, pw3)); \
        } \
    } while (0)
    for (int jb = j0; jb < 12; jb += 4) { ATT_STEP(jb, 0, kA_, vA_); ATT_STEP(jb + 1, 1, kB_, vB_); ATT_STEP(jb + 2, 2, kA_, vA_); ATT_STEP(jb + 3, 3, kB_, vB_); }
#undef ATT_STEP
    cr.kA = kA_; cr.vA = vA_; cr.kB = kB_; cr.vB = vB_;
    asm volatile("s_waitcnt lgkmcnt(0)\n\ts_barrier" ::: "memory");
    { auto rr = __builtin_amdgcn_permlane32_swap(__float_as_uint(l_reg), __float_as_uint(l_reg), false, false); l_reg = __uint_as_float(rr[0]) + __uint_as_float(rr[1]); }
    if (hi == 0) wsf[32 + r32] = l_reg; asm volatile("s_waitcnt lgkmcnt(0)" ::: "memory");
    float rli[16];
#pragma unroll
    for (int r = 0; r < 16; ++r) rli[r] = fast_rcp(wsf[32 + crow(r, hi)]);
    bf16* Ow = O + (rowbase + 64 * cq + 32 * wq) * D + h * HD;
    { LAS bf16* stg = (LAS bf16*)(shm + L_OST) + wid * 2048;
#pragma unroll
        for (int r = 0; r < 16; ++r) { const int orow = crow(r, hi);
#pragma unroll
            for (int d0 = 0; d0 < 2; ++d0) stg[orow * 64 + d0 * 32 + r32] = (bf16)f2bf(o[d0][r] * rli[r]); }
        asm volatile("s_waitcnt lgkmcnt(0)" ::: "memory");
#pragma unroll
        for (int i = 0; i < 4; ++i) { const int row = i * 8 + (lane >> 3), ch = lane & 7; const u32x4 v = *(const LAS u32x4*)(stg + row * 64 + ch * 8); *(u32x4*)(Ow + (long)row * D + ch * 8) = v; } }
    asm volatile("s_waitcnt lgkmcnt(0)\n\ts_barrier" ::: "memory");
}
#undef ATT_SBAR
}

constexpr int SGU_WM_OFF = 128 * 136 * 2;
__device__ __forceinline__ void sgu_load_wm(int g, const bf16* WM, LAS unsigned char* shm) {
    const int tid = threadIdx.x, t = tid >> 2, c0 = (tid & 3) * 32;
    const bf16* src = WM + ((size_t)g * 128 + t) * 128 + c0;
#pragma unroll
    for (int q = 0; q < 4; ++q) *(LAS u32x4*)(shm + SGU_WM_OFF + (t * 136 + c0 + 8 * q) * 2) = *(const u32x4*)(src + 8 * q);
}
__device__ __forceinline__ void sgu_item(int item, const bf16* VG, const bf16* UG, const float* lng, const float* lnb, const float* sgb, bf16* YC, LAS unsigned char* shm,
                                         const MoeConv& cv, MoeConv::Regs& sreg, int& sctr, int item0, int istride) {
    const int tid = threadIdx.x, lane = tid & 63; const int wid = __builtin_amdgcn_readfirstlane(tid >> 6);
    const int g = item & 3, blk = item >> 2;
    const long t0 = (long)blk * 128;
    LAS bf16* vt = (LAS bf16*)shm;
    const LAS bf16* wmL = (const LAS bf16*)(shm + SGU_WM_OFF);
    const int ch = tid & 15, fr = lane & 15, fq = lane >> 4;
    u32x4 vraw[4];
#pragma unroll
    for (int it = 0; it < 4; ++it) vraw[it] = *(const u32x4*)(VG + (t0 + (tid >> 4) + 32 * it) * SGW + g * 128 + ch * 8);
    u32x2 uw[8]; float bs[8];
#pragma unroll
    for (int tt = 0; tt < 8; ++tt) { const int t = 16 * tt + fr; uw[tt] = *(const u32x2*)(UG + (size_t)(t0 + t) * SGW + g * 128 + 16 * wid + 4 * fq); bs[tt] = sgb[g * 128 + t]; }
    const f32x4 gA = *(const f32x4*)(lng + g * 128 + ch * 8), gB = *(const f32x4*)(lng + g * 128 + ch * 8 + 4);
    const f32x4 bA = *(const f32x4*)(lnb + g * 128 + ch * 8), bB = *(const f32x4*)(lnb + g * 128 + ch * 8 + 4);
#pragma unroll
    for (int it = 0; it < 4; ++it) {
        const int s = (tid >> 4) + 32 * it;
        const u32x4 w = vraw[it];
        f32x4 a = (f32x4){bflo(w.x), bfhi(w.x), bflo(w.y), bfhi(w.y)}, b = (f32x4){bflo(w.z), bfhi(w.z), bflo(w.w), bfhi(w.w)};
        float sum = (a[0] + a[1]) + (a[2] + a[3]) + (b[0] + b[1]) + (b[2] + b[3]);
        sum = row16_sum(sum);
        const float mean = sum * (1.0f / 128.0f);
        a = a - mean; b = b - mean;
        float q = (a[0] * a[0] + a[1] * a[1]) + (a[2] * a[2] + a[3] * a[3]) + (b[0] * b[0] + b[1] * b[1]) + (b[2] * b[2] + b[3] * b[3]);
        q = row16_sum(q);
        const float rstd = fast_rsq(q * (1.0f / 128.0f) + EPS);
        a = a * rstd * gA + bA; b = b * rstd * gB + bB;
#pragma unroll
        for (int j = 0; j < 4; ++j) { vt[(j * 16 + ch) * 136 + s] = (bf16)f2bf(a[j]); vt[((4 + j) * 16 + ch) * 136 + s] = (bf16)f2bf(b[j]); }
    }
    asm volatile("s_waitcnt lgkmcnt(0)\n\ts_barrier" ::: "memory");
    f32x4 acc[8];
#pragma unroll
    for (int tt = 0; tt < 8; ++tt) acc[tt] = (f32x4){0.f, 0.f, 0.f, 0.f};
#pragma unroll
    for (int ks = 0; ks < 4; ++ks) {
        const bf16x8 a = *(const LAS bf16x8*)(vt + ((fr & 7) * 16 + 2 * wid + (fr >> 3)) * 136 + 32 * ks + 8 * fq);
#pragma unroll
        for (int tt = 0; tt < 8; ++tt) if (ks <= (tt >> 1)) {
            const bf16x8 bfrag = *(const LAS bf16x8*)(wmL + (16 * tt + fr) * 136 + 32 * ks + 8 * fq);
            acc[tt] = __builtin_amdgcn_mfma_f32_16x16x32_bf16(a, bfrag, acc[tt], 0, 0, 0); }
    }
    { const bool oddq = (fq & 1) != 0; u32x2 wp[2];
#pragma unroll
    for (int tt = 0; tt < 8; ++tt) { const int t = 16 * tt + fr; const float b_ = bs[tt];
        const u32x2 u_ = uw[tt];
        u32x2 w; w.x = cvt_pk_bf16(bflo(u_.x) * (acc[tt][0] + b_), bfhi(u_.x) * (acc[tt][1] + b_)); w.y = cvt_pk_bf16(bflo(u_.y) * (acc[tt][2] + b_), bfhi(u_.y) * (acc[tt][3] + b_));
        wp[tt & 1] = w;
        if (tt & 1) *(u32x4*)(YC + (size_t)(t0 + t - (oddq ? 0 : 16)) * D + AW + g * 128 + 16 * wid + 4 * fq - (oddq ? 4 : 0)) = pair16(wp[0], wp[1], oddq); } }
    asm volatile("s_waitcnt lgkmcnt(0)\n\ts_barrier" ::: "memory");
}

#define XB_TMO      128
#define XB_XCNT(j)  (256  + 64 * (j))
#define XB_XSUB(j)  (1280 + 64 * (j))
#define XB_XGEN(j)  (2304 + 64 * (j))
#define XB_TOP      3328
#define XB_TOPGEN   3392
#define XCD_BAR_WORDS 3456
#define XB_SPIN_CAP (1u << 18)
__device__ __forceinline__ unsigned xb_ld(unsigned* p)              { return __hip_atomic_load(p, __ATOMIC_RELAXED, __HIP_MEMORY_SCOPE_AGENT); }
__device__ __forceinline__ unsigned xb_add(unsigned* p, unsigned v) { return __hip_atomic_fetch_add(p, v, __ATOMIC_RELAXED, __HIP_MEMORY_SCOPE_AGENT); }
__device__ __forceinline__ unsigned xb_xcc_id() { return (unsigned)__builtin_amdgcn_s_getreg((3 << 11) | 20) & 0xFu; }
#define XB_SPIN(cond, bar) do { unsigned _sp = 0; while (cond) { __builtin_amdgcn_s_sleep(1); \
    if ((++_sp & 255u) == 0u) { if (xb_ld(&(bar)[XB_TMO])) break; if (_sp > XB_SPIN_CAP) { atomicAdd(&(bar)[XB_TMO], 1u); break; } } } } while (0)
struct XcdBarrier { unsigned* bar; unsigned x; volatile LAS unsigned* st; };
__device__ __forceinline__ XcdBarrier xcd_barrier_post(unsigned* bar, volatile LAS unsigned* st) {
    XcdBarrier b; b.bar = bar; b.x = xb_xcc_id(); b.st = st;
    if (threadIdx.x == 0) st[2] = xb_add(&bar[XB_XCNT(b.x)], 1u);
    return b;
}
__device__ __forceinline__ void xcd_barrier_complete(unsigned* bar, unsigned x, unsigned& nloc, unsigned& nx) {
    const unsigned G = gridDim.x * gridDim.y * gridDim.z;
    unsigned sum, cnt, mine, sp = 0u;
    for (;;) {
        sum = 0u; cnt = 0u; mine = 0u;
#pragma unroll
        for (unsigned j = 0; j < 16; ++j) { const unsigned c = xb_ld(&bar[XB_XCNT(j)]); sum += c; cnt += (c > 0u) ? 1u : 0u; mine = (j == x) ? c : mine; }
        if (sum == G) break;
        __builtin_amdgcn_s_sleep(1);
        if ((++sp & 255u) == 0u) { if (xb_ld(&bar[XB_TMO])) break; if (sp > XB_SPIN_CAP) { atomicAdd(&bar[XB_TMO], 1u); break; } }
    }
    nloc = mine > 0u ? mine : 1u; nx = cnt > 0u ? cnt : 1u;
}
__device__ __forceinline__ void xcd_barrier(const XcdBarrier& b) {
    asm volatile("s_waitcnt vmcnt(0)" ::: "memory");
    __syncthreads();
    if (threadIdx.x == 0) {
        unsigned* bar = b.bar;
        __builtin_amdgcn_s_waitcnt(0);
        unsigned nloc = b.st[0], nx = b.st[1];
        if (nloc == 0u) { xcd_barrier_complete(bar, b.x, nloc, nx); b.st[0] = nloc; b.st[1] = nx; }
        const unsigned old = xb_add(&bar[XB_XSUB(b.x)], 1u);
        const unsigned gen = old / nloc;
        if (old + 1u == (gen + 1u) * nloc) {
            __builtin_amdgcn_fence(__ATOMIC_RELEASE, "agent");
            asm volatile("s_waitcnt vmcnt(0)" ::: "memory");
            const unsigned og = xb_add(&bar[XB_TOP], 1u);
            const unsigned tg = og / nx;
            if (og + 1u == (tg + 1u) * nx) xb_add(&bar[XB_TOPGEN], 1u);
            else XB_SPIN(xb_ld(&bar[XB_TOPGEN]) == tg, bar);
            __builtin_amdgcn_fence(__ATOMIC_ACQUIRE, "agent");
            xb_add(&bar[XB_XGEN(b.x)], 1u);
            asm volatile("s_waitcnt vmcnt(0)" ::: "memory");
        } else {
            XB_SPIN(xb_ld(&bar[XB_XGEN(b.x)]) == gen, bar);
            __builtin_amdgcn_fence(__ATOMIC_ACQUIRE, "agent");
            asm volatile("s_waitcnt vmcnt(0)" ::: "memory");
        }
    }
    __syncthreads();
}

__device__ __forceinline__ float wave_sum(float v) { return xsum_16_32(row16_sum(v)); }
__device__ __forceinline__ int pos_gen(int n0) { return (n0 & ~255) + ((n0 >> 5) & 1) * 128 + ((n0 >> 6) & 3) * 32; }
__device__ __forceinline__ int pos_gu(int c0) { const int up = c0 >= 1024, cc = c0 & 1023; return (cc >> 7) * 256 + up * 128 + ((cc >> 5) & 3) * 32; }
__device__ __forceinline__ void win_absmax(const float* W, int N, int k0, int n0, unsigned* cmax, unsigned* ccnt, int lane) {
    const int kc = lane >> 4, nq = lane & 15;
    f32x4 v[16];
#pragma unroll
    for (int i = 0; i < 16; ++i) v[i] = *(const f32x4*)(W + (size_t)(k0 + 16 * kc + i) * N + n0 + 4 * nq);
    f32x4 mx = (f32x4){0.f, 0.f, 0.f, 0.f};
#pragma unroll
    for (int i = 0; i < 16; ++i) { mx.x = fmaxf(mx.x, fabsf(v[i].x)); mx.y = fmaxf(mx.y, fabsf(v[i].y)); mx.z = fmaxf(mx.z, fabsf(v[i].z)); mx.w = fmaxf(mx.w, fabsf(v[i].w)); }
#pragma unroll
    for (int c = 0; c < 4; ++c) { mx[c] = xmax_16_32(mx[c]); }
    if (kc == 0) {
#pragma unroll
        for (int c = 0; c < 4; ++c) (void)__hip_atomic_fetch_max(cmax + n0 + 4 * nq + c, __float_as_uint(mx[c]), RLX_AGENT);
    }
    asm volatile("s_waitcnt vmcnt(0)" ::: "memory");
    if (lane == 0) (void)__hip_atomic_fetch_add(ccnt, 1u, RLX_AGENT);
}
__device__ __forceinline__ void win_quant(const float* W, int N, int k0, int n0, unsigned char* WT, unsigned* cmax, unsigned* ccnt, float* cs, bool write_cs, unsigned* tmo, int lane) {
    const int kc = lane >> 4, nq = lane & 15;
    f32x4 v[16];
#pragma unroll
    for (int i = 0; i < 16; ++i) v[i] = *(const f32x4*)(W + (size_t)(k0 + 16 * kc + i) * N + n0 + 4 * nq);
    { unsigned sp = 0; while (__hip_atomic_load(ccnt, RLX_AGENT) < 16u) { __builtin_amdgcn_s_sleep(1);
        if ((++sp & 255u) == 0u) { if (__hip_atomic_load(tmo, RLX_AGENT)) break; if (sp > (1u << 18)) { atomicAdd(tmo, 1u); break; } } } }
    asm volatile("" ::: "memory");
    float sc[4];
#pragma unroll
    for (int c = 0; c < 4; ++c) { const float cm = __uint_as_float(__hip_atomic_load(cmax + n0 + 4 * nq + c, RLX_AGENT)); sc[c] = cm > 0.f ? 127.0f / cm : 0.f; if (write_cs && kc == 0) cs[n0 + 4 * nq + c] = cm * (1.0f / 127.0f); }
    const int nb = n0 + 32 * (nq >> 3);
    const int rowb = pos_gen(nb) + ((4 * nq) & 31);
#pragma unroll
    for (int c = 0; c < 4; ++c) {
        u32x4 o;
        o.x = pack_i8((f32x4){v[0][c], v[1][c], v[2][c], v[3][c]} * sc[c]); o.y = pack_i8((f32x4){v[4][c], v[5][c], v[6][c], v[7][c]} * sc[c]);
        o.z = pack_i8((f32x4){v[8][c], v[9][c], v[10][c], v[11][c]} * sc[c]); o.w = pack_i8((f32x4){v[12][c], v[13][c], v[14][c], v[15][c]} * sc[c]);
        *(u32x4*)(WT + (size_t)(rowb + c) * D + k0 + 16 * kc) = o;
    }
}
template <int MODE, int POSK>
__device__ __forceinline__ void tr_tile(const float* W, int N, int k0, int n0, unsigned char* WT, int ldt_bytes, int dk0, const float* ks, float wscale, int lane, int rowadj = 0) {
    const int kc = lane >> 4, nq = lane & 15;
    f32x4 v[16];
#pragma unroll
    for (int i = 0; i < 16; ++i) { const int kk = MODE ? (16 * kc + i) : (32 * (i >> 3) + 8 * kc + (i & 7)); v[i] = *(const f32x4*)(W + (size_t)(k0 + kk) * N + n0 + 4 * nq); }
    if (ks) {
#pragma unroll
        for (int i = 0; i < 16; ++i) { const int kk = MODE ? (16 * kc + i) : (32 * (i >> 3) + 8 * kc + (i & 7)); v[i] = v[i] * (ks[k0 + kk] * wscale); }
    } else if (MODE) {
#pragma unroll
        for (int i = 0; i < 16; ++i) v[i] = v[i] * wscale;
    }
    const int nb = n0 + 32 * (nq >> 3);
    const int rowb = (POSK ? pos_gu(nb) : pos_gen(nb)) + ((4 * nq) & 31) + rowadj;
#pragma unroll
    for (int c = 0; c < 4; ++c) {
        unsigned char* rp = WT + (size_t)(rowb + c) * ldt_bytes;
        if (MODE == 0) {
#pragma unroll
            for (int p = 0; p < 2; ++p) { u32x4 o; o.x = pk2(v[8 * p + 0][c], v[8 * p + 1][c]); o.y = pk2(v[8 * p + 2][c], v[8 * p + 3][c]); o.z = pk2(v[8 * p + 4][c], v[8 * p + 5][c]); o.w = pk2(v[8 * p + 6][c], v[8 * p + 7][c]);
                *(u32x4*)(rp + (size_t)(dk0 + 32 * p + 8 * kc) * 2) = o; }
        } else {
            int w0 = 0, w1 = 0, w2 = 0, w3 = 0;
            w0 = __builtin_amdgcn_cvt_pk_fp8_f32(v[0][c], v[1][c], w0, false); w0 = __builtin_amdgcn_cvt_pk_fp8_f32(v[2][c], v[3][c], w0, true);
            w1 = __builtin_amdgcn_cvt_pk_fp8_f32(v[4][c], v[5][c], w1, false); w1 = __builtin_amdgcn_cvt_pk_fp8_f32(v[6][c], v[7][c], w1, true);
            w2 = __builtin_amdgcn_cvt_pk_fp8_f32(v[8][c], v[9][c], w2, false); w2 = __builtin_amdgcn_cvt_pk_fp8_f32(v[10][c], v[11][c], w2, true);
            w3 = __builtin_amdgcn_cvt_pk_fp8_f32(v[12][c], v[13][c], w3, false); w3 = __builtin_amdgcn_cvt_pk_fp8_f32(v[14][c], v[15][c], w3, true);
            *(u32x4*)(rp + (size_t)(dk0 + 16 * kc)) = (u32x4){(unsigned)w0, (unsigned)w1, (unsigned)w2, (unsigned)w3};
        }
    }
}

struct Args { const float* in[20]; float* out; unsigned char* ws; int ph_lo, ph_hi, li, pad; };

__global__ void __launch_bounds__(512, 2) moe_block_fwd(Args args) {
    extern __shared__ __attribute__((aligned(16))) unsigned char lds_raw[];
    LAS unsigned char* lds = (LAS unsigned char*)lds_raw;
    volatile LAS unsigned* MISC = (volatile LAS unsigned*)(lds + MISC_OFF);
    const int tid = threadIdx.x, lane = tid & 63, wave = __builtin_amdgcn_readfirstlane(tid >> 6);
    const int G = gridDim.x, bx = blockIdx.x;
    const int vcu = (G % 8 == 0) ? (bx % 8) * (G / 8) + bx / 8 : bx;
    unsigned char* ws = args.ws;
    gu32* ctl = (gu32*)(ws + WS_CTL);
    const float* x = args.in[0]; const float* norm1_g = args.in[1]; const float* w_in = args.in[2]; const float* q_norm_g = args.in[3]; const float* k_norm_g = args.in[4];
    const float* rel_bias = args.in[5]; const float* sg_ln_g = args.in[6]; const float* sg_ln_b = args.in[7]; const float* sg_w = args.in[8]; const float* sg_b = args.in[9];
    const float* w_branch_a = args.in[10]; const float* w_branch_b = args.in[11]; const float* w_out = args.in[12]; const float* norm2_g = args.in[13];
    const float* router_w = args.in[14]; const float* router_b = args.in[15]; const float* w_gate_up = args.in[16]; const float* b_gate_up = args.in[17];
    const float* w_down = args.in[18]; const float* b_down = args.in[19];
    float* out = args.out;
    bf16* WIN = (bf16*)(ws + WS_WIN); unsigned char* WIN8 = ws + WS_WIN8; float* HS = (float*)(ws + WS_HS); float* CS = (float*)(ws + WS_CS); float* CS2 = (float*)(ws + WS_CS2); float* MS = (float*)(ws + WS_MS); unsigned char* H8 = ws + WS_H8; bf16* WAB = (bf16*)(ws + WS_WAB); bf16* WO = (bf16*)(ws + WS_WO); bf16* WRH = (bf16*)(ws + WS_WR); bf16* WRL = (bf16*)(ws + WS_WR + 65536); bf16* WM = (bf16*)(ws + WS_WM);
    int* LID = (int*)(ws + WS_LID); float* LRS = (float*)(ws + WS_LRS); float* LP = (float*)(ws + WS_LP);
    unsigned char* WGU = ws + WS_WGU; unsigned char* WD = ws + WS_WD;
    bf16* HB = (bf16*)(ws + WS_H); bf16* QB = (bf16*)(ws + WS_Q); bf16* KB = (bf16*)(ws + WS_K); bf16* VB = (bf16*)(ws + WS_V);
    bf16* UG = (bf16*)(ws + WS_UG); bf16* VG = (bf16*)(ws + WS_VG); unsigned char* GA = ws + WS_GA; bf16* GB = (bf16*)(ws + WS_GB);
    bf16* YCAT = (bf16*)(ws + WS_YCAT); unsigned char* X1Q = ws + WS_X1B; bf16* X1H = (bf16*)(ws + WS_X1H); unsigned char* ACT = ws + WS_ACT; unsigned char* YB = ws + WS_Y;

    for (int u = tid; u < (LDS_BYTES - LDSCTL_OFF) / 4; u += 512) ((LAS unsigned*)(lds + LDSCTL_OFF))[u] = 0u;
    __syncthreads();
    XcdBarrier bar; bar.bar = (unsigned*)(ctl + CW_BAR); bar.x = 0; bar.st = nullptr;
    if (MK_N_LAUNCHES == 1) bar = xcd_barrier_post((unsigned*)(ctl + CW_BAR), MISC + 8);
    const int lo = args.ph_lo, hi = args.ph_hi;
#define IN(k) (lo <= (k) && (k) < hi)
#define SEAM(k) do { if (IN(k) && IN((k) + 1)) xcd_barrier(bar); } while (0)
#define REPS(k) for (int rep_ = 0; rep_ < ((REP_PHASE == (k)) ? 2 : 1); ++rep_)
#define REPSEAM(k) do { if (REP_PHASE == (k) && rep_ == 0) xcd_barrier(bar); } while (0)
    const int gw = vcu * 8 + wave, NGW = G * 8;

    if (IN(0)) REPS(0) {
        constexpr int I_IN = 16 * 72, I_A = 8 * 16, I_O = 16 * 16, I_GU = 16 * 32, I_D = 16 * 16;
        constexpr int NITEMS = I_IN + 2 * I_A + I_O;
        for (int it = gw; it < NITEMS; it += NGW) {
            int r = it;
            if (r < I_IN) { const int kb = r / 72, nb = r % 72; win_absmax(w_in, INW, 64 * kb, 64 * nb, (unsigned*)(ctl + CW_CMAX), (unsigned*)(ctl + CW_CCNT + nb), lane); continue; } r -= I_IN;
            if (r < I_A) { const int kb = r / 16, nb = r % 16; tr_tile<0, 0>(w_branch_a, D, 64 * kb, 64 * nb, (unsigned char*)WAB, D * 2, 64 * kb, nullptr, 1.f, lane); continue; } r -= I_A;
            if (r < I_A) { const int kb = r / 16, nb = r % 16; tr_tile<0, 0>(w_branch_b, D, 64 * kb, 64 * nb, (unsigned char*)WAB, D * 2, 512 + 64 * kb, nullptr, 1.f, lane); continue; } r -= I_A;
            { const int kb = r / 16, nb = r % 16; win_absmax(w_out, D, 64 * kb, 64 * nb, (unsigned*)(ctl + CW_CMAX2), (unsigned*)(ctl + CW_CCNT2 + nb), lane); }
        }
        for (int i = gw * 64 + lane; i < 4 * 128 * 128; i += NGW * 64) { const int s = i & 127, t = (i >> 7) & 127; WM[i] = (bf16)f2bf(s <= t ? sg_w[i] : 0.f); }
        for (int i = gw * 64 + lane; i < NE * D; i += NGW * 64) { const int k = i & 1023, e = i >> 10; const float w = router_w[k * NE + e] * norm2_g[k]; const unsigned h_ = f2bf(w); WRH[i] = (bf16)h_; WRL[i] = (bf16)f2bf(w - bf2f((unsigned short)h_)); }
        for (int m = 2 * gw; m < T; m += 2 * NGW) {
            const f32x4* xr = (const f32x4*)(x + (size_t)m * D) + lane; const f32x4* gr = (const f32x4*)norm1_g + lane;
            f32x4 v[2][4]; float s0 = 0.f, s1 = 0.f, a0 = 0.f, a1 = 0.f;
#pragma unroll
            for (int j = 0; j < 4; ++j) { v[0][j] = xr[64 * j]; v[1][j] = xr[256 + 64 * j]; }
#pragma unroll
            for (int j = 0; j < 4; ++j) { const f32x4 gq = gr[64 * j];
                s0 += (v[0][j].x * v[0][j].x + v[0][j].y * v[0][j].y) + (v[0][j].z * v[0][j].z + v[0][j].w * v[0][j].w);
                s1 += (v[1][j].x * v[1][j].x + v[1][j].y * v[1][j].y) + (v[1][j].z * v[1][j].z + v[1][j].w * v[1][j].w);
                v[0][j] = v[0][j] * gq; v[1][j] = v[1][j] * gq;
                a0 = fmaxf(a0, fmaxf(fmaxf(fabsf(v[0][j].x), fabsf(v[0][j].y)), fmaxf(fabsf(v[0][j].z), fabsf(v[0][j].w))));
                a1 = fmaxf(a1, fmaxf(fmaxf(fabsf(v[1][j].x), fabsf(v[1][j].y)), fmaxf(fabsf(v[1][j].z), fabsf(v[1][j].w)))); }
            s0 = wave_sum(s0); s1 = wave_sum(s1);
            a0 = xmax_16_32(row16_max(a0)); a1 = xmax_16_32(row16_max(a1));
            const float rs0 = fast_rsq(s0 * (1.0f / D) + EPS), rs1 = fast_rsq(s1 * (1.0f / D) + EPS);
            const float q0 = a0 > 0.f ? 127.0f * fast_rcp(a0) : 0.f, q1 = a1 > 0.f ? 127.0f * fast_rcp(a1) : 0.f;
            if (lane == 0) { HS[m] = rs0 * a0 * (1.0f / 127.0f); HS[m + 1] = rs1 * a1 * (1.0f / 127.0f); }
            unsigned* q8 = (unsigned*)(H8 + (size_t)m * D) + lane;
#pragma unroll
            for (int j = 0; j < 4; ++j) { q8[64 * j] = pack_i8(v[0][j] * q0); q8[256 + 64 * j] = pack_i8(v[1][j] * q1); }
        }
        for (int it = gw; it < I_IN; it += NGW) { const int kb = it / 72, nb = it % 72;
            win_quant(w_in, INW, 64 * kb, 64 * nb, WIN8, (unsigned*)(ctl + CW_CMAX), (unsigned*)(ctl + CW_CCNT + nb), CS, kb == 0, (unsigned*)(ctl + CW_BAR) + XB_TMO, lane); }
        for (int it = gw - I_IN; it >= 0 && it < I_O; it += NGW) { const int kb = it / 16, nb = it % 16;
            win_quant(w_out, D, 64 * kb, 64 * nb, (unsigned char*)WO, (unsigned*)(ctl + CW_CMAX2), (unsigned*)(ctl + CW_CCNT2 + nb), CS2, kb == 0, (unsigned*)(ctl + CW_BAR) + XB_TMO, lane); }
        REPSEAM(0);
    }
    SEAM(0);

    {
        if (tid == 0) { bool reg = (MK_N_LAUNCHES == 1) && (G == 256);
            unsigned* xb = (unsigned*)(ctl + CW_BAR);
            for (int j = 0; j < 16; ++j) { const unsigned cx = xb_ld(&xb[XB_XCNT(j)]); reg = reg && (cx == (j < 8 ? (unsigned)(G / 8) : 0u)); }
            MISC[12] = reg ? 1u : 0u; MISC[13] = reg ? (bar.x + 8u * MISC[10]) : (unsigned)bx; }
        __syncthreads();
    }
    const bool moe_reg = (MISC[12] != 0u); const int moe_c = (int)MISC[13];
    unsigned* const xc1 = (unsigned*)(ctl + CW_XC1); unsigned* const tc2 = (unsigned*)(ctl + CW_TILE2); unsigned* const tc3 = (unsigned*)(ctl + CW_TILE3); unsigned* const tc4 = (unsigned*)(ctl + CW_TILE4); unsigned* const tmo_w = (unsigned*)(ctl + CW_BAR) + XB_TMO;
#define TILE_WAIT2(cnt, pmA, pmB, need, ACQ) do { if (tid == 0) { unsigned sp_ = 0; \
        while (__hip_atomic_load((cnt) + (pmA), RLX_AGENT) < (need) || __hip_atomic_load((cnt) + (pmB), RLX_AGENT) < (need)) { __builtin_amdgcn_s_sleep(1); \
            if ((++sp_ & 255u) == 0u) { if (__hip_atomic_load(tmo_w, RLX_AGENT)) break; if (sp_ > (1u << 18)) { atomicAdd(tmo_w, 1u); break; } } } \
        if (ACQ) { __builtin_amdgcn_fence(__ATOMIC_ACQUIRE, "agent"); asm volatile("s_waitcnt vmcnt(0)" ::: "memory"); } } __syncthreads(); } while (0)

    if (IN(1)) REPS(1) {
        { PolIn P; P.so.init(T, INW, G, moe_c); P.A = H8; P.Bt = WIN8; P.ws = ws; P.qg = q_norm_g; P.kg = k_norm_g; P.hs = HS; P.cs = CS; P.shm = lds; P.wtx = moe_reg;
          pg8::gemm_phase<PolIn>(lds, P);
          if (moe_reg && tid == 0) { int n_ = 0, pm_, pn_; while (P.so.tile(n_, pm_, pn_)) ++n_; (void)__hip_atomic_fetch_add(xc1 + (moe_c % 8), (unsigned)n_, RLX_AGENT); } }
        REPSEAM(1);
    }
    if (!moe_reg) SEAM(1);

    if (IN(2)) REPS(2) {
        const MoeConv cv{w_gate_up, w_down, norm2_g, WGU, WD}; MoeConv::Regs sreg; int sctr = 0;
        const int px = moe_c % 8, prank = moe_c / 8;
        if (moe_reg) { const unsigned need1 = (unsigned)((T / 256 / 8) * (INW / 256)); const int pprev = (px & 1) ? px - 1 : px;
            if (tid == 0) { unsigned sp_ = 0;
                while (__hip_atomic_load(xc1 + px, RLX_AGENT) < need1 || __hip_atomic_load(xc1 + pprev, RLX_AGENT) < need1) { __builtin_amdgcn_s_sleep(1);
                    if ((++sp_ & 255u) == 0u) { if (__hip_atomic_load(tmo_w, RLX_AGENT)) break; if (sp_ > (1u << 18)) { atomicAdd(tmo_w, 1u); break; } } }
                __builtin_amdgcn_fence(__ATOMIC_ACQUIRE, "agent"); asm volatile("s_waitcnt vmcnt(0)" ::: "memory"); }
            __syncthreads(); }
        const int ab0 = moe_reg ? (px >> 1) : 0, adb = moe_reg ? 0 : 1, acg0 = moe_reg ? (16 * (px & 1) + (prank >> 3)) : (vcu & 31), adcg = moe_reg ? 4 : 0, ah = moe_reg ? (prank & 7) : (vcu >> 5);
        const int sit0 = moe_reg ? ((32 * px + (prank >> 2)) * 4 + (prank & 3)) : vcu, sdit = moe_reg ? 32 : G;
        constexpr int NUW = NB * NHEAD * 32 / 256, NIW = 4 * (T / 128) / 256;
        att::Carry acr;
        for (int i = 0; i < NUW; ++i)
            att::unit(ab0 + adb * i, ah, acg0 + adcg * i, (const unsigned char*)QB, (const unsigned char*)KB, (const unsigned char*)VB, rel_bias, YCAT, lds, cv, sreg, sctr, gw, NGW,
                      i == 0, i == 0, i + 1 < NUW, ab0 + adb * (i + 1), ah, acg0 + adcg * (i + 1), acr);
        sgu_load_wm(sit0 & 3, WM, lds);
        for (int i = 0; i < NIW; ++i) sgu_item(sit0 + sdit * i, VG, UG, sg_ln_g, sg_ln_b, sg_b, YCAT, lds, cv, sreg, sctr, gw, NGW);
        if (moe_reg) {
            asm volatile("s_waitcnt vmcnt(0)" ::: "memory"); __syncthreads();
            if (tid == 0) {
                for (int i = 0; i < NUW; ++i) (void)__hip_atomic_fetch_add(tc2 + (ab0 + adb * i) * 32 + acg0 + adcg * i, 1u, RLX_AGENT);
                for (int i = 0; i < NIW; ++i) (void)__hip_atomic_fetch_add(tc2 + ((sit0 + sdit * i) >> 3), 1u, RLX_AGENT); }
        }
        cv.drain(sreg, sctr, gw, NGW, lane);
        REPSEAM(2);
    }
    if (!moe_reg) SEAM(2);

    if (IN(3)) REPS(3) {
        if (tid < 512) ((LAS unsigned*)(lds + ROWS_OFF))[tid] = 0u;
        __syncthreads();
        PolMerge P; P.so.init(T, D, G, moe_c);
        if (moe_reg) { int pa_ = 0, pb_ = 0, pn_; P.so.tile(0, pa_, pn_); if (!P.so.tile(1, pb_, pn_)) pb_ = pa_; TILE_WAIT2(tc2, pa_, pb_, 16u, false); }
        P.A = YCAT; P.Bt = WAB; P.ga = GA; P.gb = (const unsigned char*)GB; P.out = (unsigned char*)HB; P.rslot = (unsigned*)(ctl + CW_RSLOT); P.ms = MS; P.tmo = (unsigned*)(ctl + CW_BAR) + XB_TMO; P.shm = lds;
        pg8::gemm_phase<PolMerge>(lds, P);
        if (moe_reg && tid == 0) { int pm_, pn_; for (int i = 0; P.so.tile(i, pm_, pn_); ++i) (void)__hip_atomic_fetch_add(tc3 + pm_, 1u, RLX_AGENT); }
        REPSEAM(3);
    }
    if (!moe_reg) SEAM(3);

    if (IN(4)) REPS(4) {
        PolOut P; P.so.init(T, D, G, moe_c); P.A = (const unsigned char*)HB; P.Bt = (const unsigned char*)WO; P.ms = MS; P.cs = CS2; P.shm = lds; P.x = x; P.x1 = X1H; P.x1q = X1Q;
        if (moe_reg) { int pa_ = 0, pb_ = 0, pn_; P.so.tile(0, pa_, pn_); if (!P.so.tile(1, pb_, pn_)) pb_ = pa_; TILE_WAIT2(tc3, pa_, pb_, 4u, false); }
        pg8::gemm_phase<PolOut>(lds, P);
        if (moe_reg && tid == 0) { int pm_, pn_; for (int i = 0; P.so.tile(i, pm_, pn_); ++i) (void)__hip_atomic_fetch_add(tc4 + pm_, 1u, RLX_AGENT); }
        REPSEAM(4);
    }
    if (!moe_reg) SEAM(4);

    if (IN(5)) {
        LAS int* lcnt = (LAS int*)(lds + PARK_OFF); LAS int* gbase = lcnt + 32;
        if (tid < 64) lcnt[tid] = 0;
        for (int i = tid; i < 4096; i += 512) { const int e = i & 31, gq = (i >> 5) & 3, kq = i >> 7;
            *(LAS u32x4*)(lds + (size_t)i * 16) = *(const u32x4*)(WRH + (size_t)e * D + 32 * kq + 8 * gq); *(LAS u32x4*)(lds + 65536 + (size_t)i * 16) = *(const u32x4*)(WRL + (size_t)e * D + 32 * kq + 8 * gq); }
        __syncthreads();
        const int r = lane & 15, g = lane >> 4;
        int sel_e[4], sel_rank[4]; float sel_p[4]; float rs_row = 0.f; int tok = 0;
        const int cu5 = moe_reg ? ((moe_c % 8) * (G / 8) + moe_c / 8) : bx;
        if (moe_reg) { const int rt_ = (cu5 * 128) / 256; TILE_WAIT2(tc4, rt_, rt_, 4u, true); }
        for (int grp = cu5 * 8 + wave; grp < T / 16; grp += NGW) {
            const int row0 = grp * 16; tok = row0 + r;
            const bf16* xr = X1H + (size_t)(row0 + r) * D + 8 * g;
            const LAS unsigned char* wl_ = lds + (g * 32 + r) * 16;
            f32x4 a0 = (f32x4){0.f, 0.f, 0.f, 0.f}, a1 = a0; float ssq = 0.f;
            u32x4 xq[4][4];
#define P5_LOAD(S, ss) do { _Pragma("unroll") for (int q = 0; q < 4; ++q) xq[S][q] = *(const u32x4*)(xr + 128 * (ss) + 32 * q); } while (0)
#define P5_COMP(S, ss) do { _Pragma("unroll") for (int q = 0; q < 4; ++q) { const u32x4 w_ = xq[S][q]; const int ks = 4 * (ss) + q; \
                const bf16x8 wh_0 = *(const LAS bf16x8*)(wl_ + ks * 2048), wh_1 = *(const LAS bf16x8*)(wl_ + ks * 2048 + 256), wl_0 = *(const LAS bf16x8*)(wl_ + 65536 + ks * 2048), wl_1 = *(const LAS bf16x8*)(wl_ + 65536 + ks * 2048 + 256); \
                ssq += (bflo(w_.x) * bflo(w_.x) + bfhi(w_.x) * bfhi(w_.x)) + (bflo(w_.y) * bflo(w_.y) + bfhi(w_.y) * bfhi(w_.y)) + (bflo(w_.z) * bflo(w_.z) + bfhi(w_.z) * bfhi(w_.z)) + (bflo(w_.w) * bflo(w_.w) + bfhi(w_.w) * bfhi(w_.w)); \
                const bf16x8 xh = __builtin_bit_cast(bf16x8, w_); \
                a0 = __builtin_amdgcn_mfma_f32_16x16x32_bf16(wh_0, xh, a0, 0, 0, 0); a1 = __builtin_amdgcn_mfma_f32_16x16x32_bf16(wh_1, xh, a1, 0, 0, 0); \
                a0 = __builtin_amdgcn_mfma_f32_16x16x32_bf16(wl_0, xh, a0, 0, 0, 0); a1 = __builtin_amdgcn_mfma_f32_16x16x32_bf16(wl_1, xh, a1, 0, 0, 0); } } while (0)
            P5_LOAD(0, 0); P5_LOAD(1, 1); P5_LOAD(2, 2); P5_LOAD(3, 3);
            P5_COMP(0, 0); P5_LOAD(0, 4);
            P5_COMP(1, 1); P5_LOAD(1, 5);
            P5_COMP(2, 2); P5_LOAD(2, 6);
            P5_COMP(3, 3); P5_LOAD(3, 7);
            P5_COMP(0, 4); P5_COMP(1, 5); P5_COMP(2, 6); P5_COMP(3, 7);
#undef P5_LOAD
#undef P5_COMP
            ssq = xsum_16_32(ssq);
            const float rs = 1.0f / sqrtf(ssq * (1.0f / D) + EPS); rs_row = rs;
            float v[8];
#pragma unroll
            for (int j = 0; j < 4; ++j) { v[j] = a0[j] * rs + router_b[4 * g + j]; v[4 + j] = a1[j] * rs + router_b[16 + 4 * g + j]; }
            unsigned taken = 0u; float sel_v[4];
#pragma unroll
            for (int k = 0; k < 4; ++k) {
                float best = -INFINITY; int bi = 1 << 20;
#pragma unroll
                for (int i = 0; i < 8; ++i) { const int ei = (i >> 2) * 16 + 4 * g + (i & 3); if (!((taken >> i) & 1u) && v[i] > best) { best = v[i]; bi = ei; } }
                {
                    auto va = __builtin_amdgcn_permlane16_swap(__float_as_uint(best), __float_as_uint(best), false, false); auto ia = __builtin_amdgcn_permlane16_swap((unsigned)bi, (unsigned)bi, false, false);
                    { const float v0 = __uint_as_float(va[0]), v1 = __uint_as_float(va[1]); const int i0 = (int)ia[0], i1 = (int)ia[1]; const bool t1 = v1 > v0 || (v1 == v0 && i1 < i0); best = t1 ? v1 : v0; bi = t1 ? i1 : i0; }
                    auto vb = __builtin_amdgcn_permlane32_swap(__float_as_uint(best), __float_as_uint(best), false, false); auto ib = __builtin_amdgcn_permlane32_swap((unsigned)bi, (unsigned)bi, false, false);
                    { const float v0 = __uint_as_float(vb[0]), v1 = __uint_as_float(vb[1]); const int i0 = (int)ib[0], i1 = (int)ib[1]; const bool t1 = v1 > v0 || (v1 == v0 && i1 < i0); best = t1 ? v1 : v0; bi = t1 ? i1 : i0; } }
                sel_e[k] = bi; sel_v[k] = best;
                if (((bi & 15) >> 2) == g) taken |= 1u << (((bi >> 4) << 2) | (bi & 3));
            }
            float den = 0.f;
#pragma unroll
            for (int k = 0; k < 4; ++k) { sel_p[k] = __expf(sel_v[k] - sel_v[0]); den += sel_p[k]; }
            const float inv = 1.0f / den;
#pragma unroll
            for (int k = 0; k < 4; ++k) sel_p[k] *= inv;
            if (g == 0) {
#pragma unroll
                for (int k = 0; k < 4; ++k) sel_rank[k] = __hip_atomic_fetch_add(lcnt + sel_e[k], 1, __ATOMIC_RELAXED, __HIP_MEMORY_SCOPE_WORKGROUP);
            }
        }
        __syncthreads();
        if (tid < NE) gbase[tid] = (int)__hip_atomic_fetch_add((unsigned*)(ctl + CW_CNT + tid), (unsigned)lcnt[tid], RLX_AGENT);
        __syncthreads();
        if (g == 0 && (cu5 * 8 + wave) < T / 16) {
#pragma unroll
            for (int k = 0; k < 4; ++k) { const size_t pos = (size_t)sel_e[k] * LCAP + gbase[sel_e[k]] + sel_rank[k];
                LID[pos] = tok * 4 + k; LRS[pos] = rs_row; LP[pos] = sel_p[k]; }
        }
        __syncthreads();
    }
    SEAM(5);

    if (IN(6) || IN(7)) {
        LAS int* tb = (LAS int*)(lds + MOE_OFF);
        if (tid < NE) tb[33 + tid] = (int)__hip_atomic_load(ctl + CW_CNT + tid, RLX_AGENT);
        __syncthreads();
        if (tid <= NE) { int acc = 0;
#pragma unroll
            for (int e = 0; e < NE; ++e) { const int n = (tb[33 + e] + 255) >> 8; acc += (e < tid) ? n : 0; }
            tb[tid] = acc; }
        __syncthreads();
    }
    if (IN(6)) REPS(6) {
        PolGU P; P.mo.init((const LAS int*)(lds + MOE_OFF), 8, G, moe_c); P.tcnt = (unsigned*)(ctl + CW_TILE); P.A = X1Q; P.Bt = WGU; P.lid = LID; P.lrs = LRS; P.bgu = b_gate_up; P.act = ACT; P.shm = lds;
        pg8::gemm_phase<PolGU>(lds, P);
        REPSEAM(6);
    }
    if (!moe_reg) SEAM(6);
    if (IN(7)) REPS(7) {
        PolDown P; P.mo.init((const LAS int*)(lds + MOE_OFF), 4, G, (G % 16 == 0) ? (moe_c + G / 2) % G : moe_c); P.tcnt = (unsigned*)(ctl + CW_TILE); P.tmo = (unsigned*)(ctl + CW_BAR) + XB_TMO; P.A = ACT; P.Bt = WD; P.lid = LID; P.lp = LP; P.bd = b_down; P.y = YB; P.shm = lds;
        pg8::gemm_phase<PolDown>(lds, P);
        REPSEAM(7);
    }
    SEAM(7);
    if (IN(8)) {
        f32x4 xa[4], xb[4]; u32x4 ya[4], yb[4];
#define P8_LOAD(X, Y, m_) do { const bf16* xr_ = X1H + (size_t)(m_) * D + 16 * lane; { f32x4 a_, b_; ld8(xr_, a_, b_); X[0] = a_; X[1] = b_; ld8(xr_ + 8, a_, b_); X[2] = a_; X[3] = b_; } \
            _Pragma("unroll") for (int k = 0; k < 4; ++k) Y[k] = *(const u32x4*)(YB + ((size_t)(m_) * 4 + k) * D + 16 * lane); } while (0)
#define P8_DONE(X, Y, m_) do { _Pragma("unroll") for (int k = 0; k < 4; ++k) { const unsigned ww[4] = {Y[k].x, Y[k].y, Y[k].z, Y[k].w}; \
            _Pragma("unroll") for (int q = 0; q < 4; ++q) { const f32x2 lo_ = __builtin_amdgcn_cvt_pk_f32_fp8((int)ww[q], false), hi_ = __builtin_amdgcn_cvt_pk_f32_fp8((int)ww[q], true); \
                X[q][0] += lo_[0] * 0.0625f; X[q][1] += lo_[1] * 0.0625f; X[q][2] += hi_[0] * 0.0625f; X[q][3] += hi_[1] * 0.0625f; } } \
            float* or_ = out + (size_t)(m_) * D + 16 * lane; _Pragma("unroll") for (int j = 0; j < 4; ++j) *(f32x4*)(or_ + 4 * j) = X[j]; } while (0)
        for (int m = gw; m < T; m += 2 * NGW) { const int m2 = m + NGW;
            P8_LOAD(xa, ya, m); P8_LOAD(xb, yb, m2);
            P8_DONE(xa, ya, m); P8_DONE(xb, yb, m2); }
#undef P8_LOAD
#undef P8_DONE
    }
#undef IN
#undef SEAM
}

extern "C" void kernel_launch(void* const* d_in, const int* in_sizes, int n_in, void* d_out, int out_size, void* d_ws, size_t ws_size, hipStream_t stream) {
    static int grid = 0;
    if (grid == 0) {
        if (n_in != 20 || in_sizes[0] != T * D || out_size != T * D || ws_size < WS_END) { fprintf(stderr, "kernel_launch: unexpected shapes (n_in %d, ws %zu)\n", n_in, ws_size); grid = -1; return; }
        int dev = 0, cus = 0;
        if (hipGetDevice(&dev) != hipSuccess || hipDeviceGetAttribute(&cus, hipDeviceAttributeMultiprocessorCount, dev) != hipSuccess) { grid = -1; return; }
        if (hipFuncSetAttribute((const void*)moe_block_fwd, hipFuncAttributeMaxDynamicSharedMemorySize, LDS_BYTES) != hipSuccess) { fprintf(stderr, "kernel_launch: hipFuncSetAttribute failed\n"); grid = -1; return; }
        (void)hipGetLastError();
        grid = cus;
        if (grid != 256) { fprintf(stderr, "kernel_launch: built for a 256-CU device, got %d\n", cus); grid = -1; return; }
    }
    if (grid < 0) return;
    if (hipMemsetAsync((char*)d_ws + WS_CTL, 0, CTL_ZERO_BYTES, stream) != hipSuccess) return;
    Args a{};
    for (int i = 0; i < 20; ++i) a.in[i] = (const float*)d_in[i];
    a.out = (float*)d_out; a.ws = (unsigned char*)d_ws;
    constexpr int NPH = 9;
    for (int li = 0; li < MK_N_LAUNCHES; ++li) {
        a.ph_lo = (MK_N_LAUNCHES == 1) ? 0 : li; a.ph_hi = (MK_N_LAUNCHES == 1) ? NPH : li + 1; a.li = li;
        hipLaunchKernelGGL(moe_block_fwd, dim3(grid), dim3(512), LDS_BYTES, stream, a);
    }
}
```
